# Optimizing an MI355X kernel written in HIP

```python
import math
import jax, jax.numpy as jnp
from jax import lax
import numpy as np

D_MODEL = 2048
BATCH = 8
SEQ = 4096
DEPTH = 4

N_MIXERS = 4
N_HEADS = 16
HEAD_DIM = 128
MIX_WIDTH = N_HEADS * HEAD_DIM
N_MEM = 256
MEM_HEADS = 4
MEM_WIDTH = MEM_HEADS * HEAD_DIM
OUT_IN = MIX_WIDTH + MEM_WIDTH
D_FF = 5632
Q_BLOCK = 128
RMS_EPS = 1e-6
REL_BUCKETS = 32
REL_MAX_DIST = 2048
T5_INIT_SCALE = 0.2
MAX_POS_OFFSET = 1024
FOX_GATE_BIAS = 4.0
FOX_COLS = 3 * MIX_WIDTH + N_HEADS
Q_LORA = 512
KV_LORA = 512
NOPE_DIM = 128
ROPE_DIM = 64
ROPE_THETA = 10000.0
MLA_COLS = Q_LORA + KV_LORA + ROPE_DIM
DIL_GROUPS = ((128, 1), (512, 4), (2048, 16))
DIL_COLS = len(DIL_GROUPS) * 3 * MIX_WIDTH
DSA_KV_HEADS = 4
IDX_HEADS = 16
IDX_DIM = 64
TOPK_MAX = 256
DSA_COLS = MIX_WIDTH + 2 * DSA_KV_HEADS * HEAD_DIM + IDX_HEADS * IDX_DIM + IDX_DIM + IDX_HEADS

kernel_name = 'hybrid_fox_mla_dilated_dsa_trunk'

F32 = jnp.float32


def rms_norm(x, g):
    xf = x.astype(F32)
    y = xf * lax.rsqrt(jnp.mean(xf * xf, axis=-1, keepdims=True) + RMS_EPS)
    return (y * g.astype(F32)).astype(x.dtype)


def swiglu(x, w_gate, w_up, w_down):
    return (jax.nn.silu(x @ w_gate) * (x @ w_up)) @ w_down


def t5_bucket(dist):
    n = jnp.maximum(dist, 0)
    exact = REL_BUCKETS // 2
    nf = jnp.maximum(n, 1).astype(F32)
    large = exact + (jnp.log(nf / exact) / math.log(REL_MAX_DIST / exact) * (REL_BUCKETS - exact)).astype(jnp.int32)
    large = jnp.minimum(large, REL_BUCKETS - 1)
    return jnp.where(n < exact, n, large)


def rope(x, cos, sin):
    half = ROPE_DIM // 2
    x1, x2 = x[..., :half].astype(F32), x[..., half:].astype(F32)
    return jnp.concatenate([x1 * cos - x2 * sin, x1 * sin + x2 * cos], axis=-1).astype(x.dtype)


def causal_block_attention(q, k, v, scale, log_decay=None):
    B, S, H, _ = q.shape
    key_pos = jnp.arange(S)
    decay_k = None if log_decay is None else jnp.moveaxis(log_decay, 2, 1)

    def block(i):
        qb = lax.dynamic_slice_in_dim(q, i * Q_BLOCK, Q_BLOCK, axis=1)
        qpos = i * Q_BLOCK + jnp.arange(Q_BLOCK)
        s = jnp.einsum('bqhd,bkhd->bhqk', qb, k, preferred_element_type=F32) * scale
        if log_decay is not None:
            db = lax.dynamic_slice_in_dim(decay_k, i * Q_BLOCK, Q_BLOCK, axis=2)
            s = s + (db[..., None] - decay_k[:, :, None, :])
        s = jnp.where(key_pos[None, :] <= qpos[:, None], s, -jnp.inf)
        pr = jax.nn.softmax(s, axis=-1).astype(v.dtype)
        return jnp.einsum('bhqk,bkhd->bqhd', pr, v)

    o = lax.map(block, jnp.arange(S // Q_BLOCK))
    return jnp.moveaxis(o, 0, 1).reshape(B, S, H * v.shape[-1])


def fox_mixer(p, b_f, qk_g):
    B, S, _ = p.shape
    q, k, v, fg = jnp.split(p, [MIX_WIDTH, 2 * MIX_WIDTH, 3 * MIX_WIDTH], axis=-1)
    shp = (B, S, N_HEADS, HEAD_DIM)
    q = rms_norm(q.reshape(shp), qk_g[0])
    k = rms_norm(k.reshape(shp), qk_g[1])
    log_f = jax.nn.log_sigmoid(fg.astype(F32) + b_f.astype(F32))
    cum = lax.cumsum(log_f, axis=1)
    return causal_block_attention(q, k, v.reshape(shp), HEAD_DIM ** -0.5, cum)


def mla_mixer(p, positions, q_norm_g, w_uq, kv_norm_g, w_ukv, nope_g, rope_g):
    B, S, _ = p.shape
    cq, ckv, kr = jnp.split(p, [Q_LORA, Q_LORA + KV_LORA], axis=-1)
    q = (rms_norm(cq, q_norm_g) @ w_uq).reshape(B, S, N_HEADS, NOPE_DIM + ROPE_DIM)
    kv = (rms_norm(ckv, kv_norm_g) @ w_ukv).reshape(B, S, N_HEADS, NOPE_DIM + HEAD_DIM)
    half = ROPE_DIM // 2
    inv = ROPE_THETA ** (-jnp.arange(half, dtype=F32) / half)
    ang = positions.astype(F32)[..., None] * inv
    cos, sin = jnp.cos(ang), jnp.sin(ang)
    q_nope = rms_norm(q[..., :NOPE_DIM], nope_g[0])
    q_rope = rope(rms_norm(q[..., NOPE_DIM:], rope_g[0]), cos[:, :, None], sin[:, :, None])
    k_nope = rms_norm(kv[..., :NOPE_DIM], nope_g[1])
    v = kv[..., NOPE_DIM:]
    k_rope = rope(rms_norm(kr, rope_g[1]), cos, sin)
    qf = jnp.concatenate([q_nope, q_rope], axis=-1)
    kf = jnp.concatenate([k_nope, jnp.broadcast_to(k_rope[:, :, None, :], (B, S, N_HEADS, ROPE_DIM))], axis=-1)
    return causal_block_attention(qf, kf, v, (NOPE_DIM + ROPE_DIM) ** -0.5)


def dilated_group(q, k, v, dil, sub_window, t5_table):
    B, S, H, D = q.shape
    Ls = S // dil
    nb = -(-Ls // Q_BLOCK)
    Lp = nb * Q_BLOCK

    def by_stride(a):
        a = a.reshape(B, Ls, dil, H, D).transpose(0, 2, 1, 3, 4).reshape(B * dil, Ls, H, D)
        return jnp.pad(a, ((0, 0), (0, Lp - Ls), (0, 0), (0, 0)))

    front = ((0, 0), (Q_BLOCK, 0), (0, 0), (0, 0))
    qs = by_stride(q)
    ks = jnp.pad(by_stride(k), front)
    vs = jnp.pad(by_stride(v), front)
    kk = jnp.arange(2 * Q_BLOCK)
    rel = jnp.arange(Q_BLOCK)[:, None] + Q_BLOCK - kk[None, :]
    band = (rel >= 0) & (rel <= sub_window)
    bias = jnp.moveaxis(t5_table[t5_bucket(rel * dil)], -1, 0).astype(F32)
    scale = D ** -0.5

    def block(i):
        qb = lax.dynamic_slice_in_dim(qs, i * Q_BLOCK, Q_BLOCK, axis=1)
        kb = lax.dynamic_slice_in_dim(ks, i * Q_BLOCK, 2 * Q_BLOCK, axis=1)
        vb = lax.dynamic_slice_in_dim(vs, i * Q_BLOCK, 2 * Q_BLOCK, axis=1)
        s = jnp.einsum('nqhd,nkhd->nhqk', qb, kb, preferred_element_type=F32) * scale + bias
        valid = band & (kk[None, :] >= Q_BLOCK - i * Q_BLOCK)
        s = jnp.where(valid, s, -jnp.inf)
        m = jnp.max(s, axis=-1, keepdims=True)
        e = jnp.exp(s - m)
        den = jnp.sum(e, axis=-1, keepdims=True)
        o = jnp.einsum('nhqk,nkhd->nqhd', (e / den).astype(vb.dtype), vb)
        lse = (m + jnp.log(den))[..., 0]
        return o, jnp.moveaxis(lse, 1, 2)

    o, lse = lax.map(block, jnp.arange(nb))

    def back(a):
        a = jnp.moveaxis(a, 0, 1)
        a = a.reshape((B * dil, Lp) + a.shape[3:])[:, :Ls]
        a = jnp.swapaxes(a.reshape((B, dil, Ls) + a.shape[2:]), 1, 2)
        return a.reshape((B, S) + a.shape[3:])

    return back(o), back(lse)


def dilated_mixer(p, qk_g, t5_table):
    B, S, _ = p.shape
    p = p.reshape(B, S, len(DIL_GROUPS), 3, N_HEADS, HEAD_DIM)
    outs, lses = [], []
    for g, (win, dil) in enumerate(DIL_GROUPS):
        q = rms_norm(p[:, :, g, 0], qk_g[g, 0])
        k = rms_norm(p[:, :, g, 1], qk_g[g, 1])
        o, lse = dilated_group(q, k, p[:, :, g, 2], dil, win // dil, t5_table)
        outs.append(o)
        lses.append(lse)
    alpha = jax.nn.softmax(jnp.stack(lses), axis=0)
    out = jnp.einsum('gbsh,gbshd->bshd', alpha, jnp.stack(outs).astype(F32))
    return out.reshape(B, S, MIX_WIDTH).astype(p.dtype)


def dsa_mixer(p, qk_g, t5_table):
    B, S, _ = p.shape
    kvw = DSA_KV_HEADS * HEAD_DIM
    offs = np.cumsum([MIX_WIDTH, kvw, kvw, IDX_HEADS * IDX_DIM, IDX_DIM]).tolist()
    q, k, v, qi, ki, wi = jnp.split(p, offs, axis=-1)
    group = N_HEADS // DSA_KV_HEADS
    q = rms_norm(q.reshape(B, S, DSA_KV_HEADS, group, HEAD_DIM), qk_g[0])
    k = rms_norm(k.reshape(B, S, DSA_KV_HEADS, HEAD_DIM), qk_g[1])
    v = v.reshape(B, S, DSA_KV_HEADS, HEAD_DIM)
    qi = qi.reshape(B, S, IDX_HEADS, IDX_DIM)
    wi = wi.astype(F32) * IDX_HEADS ** -0.5
    n_sel = min(TOPK_MAX, S // 4)
    key_pos = jnp.arange(S)
    gather = jax.vmap(lambda a, idx: a[idx])

    def block(i):
        sl = lambda a: lax.dynamic_slice_in_dim(a, i * Q_BLOCK, Q_BLOCK, axis=1)
        qb, qib, wib = sl(q), sl(qi), sl(wi)
        qpos = i * Q_BLOCK + jnp.arange(Q_BLOCK)
        dots = jnp.einsum('bqhd,bkd->bqhk', qib, ki, preferred_element_type=F32) * IDX_DIM ** -0.5
        score = jnp.einsum('bqh,bqhk->bqk', wib, jax.nn.relu(dots))
        score = jnp.where(key_pos[None, None, :] <= qpos[None, :, None], score, -jnp.inf)
        _, idx = lax.top_k(score, n_sel)
        kg, vg = gather(k, idx), gather(v, idx)
        dist = qpos[None, :, None] - idx
        bias = t5_table[t5_bucket(dist)].reshape(B, Q_BLOCK, n_sel, DSA_KV_HEADS, group)
        s = jnp.einsum('bqgrd,bqkgd->bqgrk', qb, kg, preferred_element_type=F32) * HEAD_DIM ** -0.5
        s = s + jnp.moveaxis(bias, 2, 4).astype(F32)
        s = jnp.where((dist >= 0)[:, :, None, None, :], s, -jnp.inf)
        pr = jax.nn.softmax(s, axis=-1).astype(v.dtype)
        return jnp.einsum('bqgrk,bqkgd->bqgrd', pr, vg)

    o = lax.map(block, jnp.arange(S // Q_BLOCK))
    return jnp.moveaxis(o, 0, 1).reshape(B, S, MIX_WIDTH)


def memory_attention(qm, mem_kv, qk_g):
    B, S, _ = qm.shape
    q = rms_norm(qm.reshape(B, S, MEM_HEADS, HEAD_DIM), qk_g[0])
    k, v = jnp.split(mem_kv, 2, axis=-1)
    k = rms_norm(k.reshape(B, N_MEM, MEM_HEADS, HEAD_DIM), qk_g[1])
    v = v.reshape(B, N_MEM, MEM_HEADS, HEAD_DIM)
    s = jnp.einsum('bqhd,bkhd->bhqk', q, k, preferred_element_type=F32) * HEAD_DIM ** -0.5
    pr = jax.nn.softmax(s, axis=-1).astype(v.dtype)
    return jnp.einsum('bhqk,bkhd->bqhd', pr, v).reshape(B, S, MEM_WIDTH)


def setup_inputs(seed: int = 0) -> dict:
    key = jax.random.key(seed)
    keys = iter(jax.random.split(key, 48))

    def normal(shape, scale):
        return jax.random.normal(next(keys), shape, F32) * scale

    def gain(shape):
        return 1.0 + normal(shape, 0.05)

    n_a, n_b, n_c, n_d = [len(range(m, DEPTH, N_MIXERS)) for m in range(N_MIXERS)]
    offsets = jax.random.randint(next(keys), (BATCH, 1), 0, MAX_POS_OFFSET, dtype=jnp.int32)
    positions = offsets + jnp.arange(SEQ, dtype=jnp.int32)[None, :]
    return {
        'x': normal((BATCH, SEQ, D_MODEL), 1.0),
        'mem': normal((BATCH, N_MEM, D_MODEL), 1.0),
        'positions': positions,
        't5_table': normal((REL_BUCKETS, N_HEADS), T5_INIT_SCALE),
        'ffn_norm': gain((DEPTH, 2, D_MODEL)),
        'ffn_w_gate': normal((DEPTH, 2, D_MODEL, D_FF), D_MODEL ** -0.5),
        'ffn_w_up': normal((DEPTH, 2, D_MODEL, D_FF), D_MODEL ** -0.5),
        'ffn_w_down': normal((DEPTH, 2, D_FF, D_MODEL), D_FF ** -0.5),
        'attn_norm': gain((DEPTH, D_MODEL)),
        'mem_norm': gain((DEPTH, D_MODEL)),
        'mem_w_kv': normal((DEPTH, D_MODEL, 2 * MEM_WIDTH), D_MODEL ** -0.5),
        'mem_qk_g': gain((DEPTH, 2, HEAD_DIM)),
        'w_out': normal((DEPTH, OUT_IN, D_MODEL), OUT_IN ** -0.5),
        'a_w_in': normal((n_a, D_MODEL, FOX_COLS + MEM_WIDTH), D_MODEL ** -0.5),
        'a_b_f': FOX_GATE_BIAS + normal((n_a, N_HEADS), 0.5),
        'a_qk_g': gain((n_a, 2, HEAD_DIM)),
        'b_w_in': normal((n_b, D_MODEL, MLA_COLS + MEM_WIDTH), D_MODEL ** -0.5),
        'b_q_norm': gain((n_b, Q_LORA)),
        'b_w_uq': normal((n_b, Q_LORA, N_HEADS * (NOPE_DIM + ROPE_DIM)), Q_LORA ** -0.5),
        'b_kv_norm': gain((n_b, KV_LORA)),
        'b_w_ukv': normal((n_b, KV_LORA, N_HEADS * (NOPE_DIM + HEAD_DIM)), KV_LORA ** -0.5),
        'b_nope_g': gain((n_b, 2, NOPE_DIM)),
        'b_rope_g': gain((n_b, 2, ROPE_DIM)),
        'c_w_in': normal((n_c, D_MODEL, DIL_COLS + MEM_WIDTH), D_MODEL ** -0.5),
        'c_qk_g': gain((n_c, len(DIL_GROUPS), 2, HEAD_DIM)),
        'd_w_in': normal((n_d, D_MODEL, DSA_COLS + MEM_WIDTH), D_MODEL ** -0.5),
        'd_qk_g': gain((n_d, 2, HEAD_DIM)),
    }


def reference(x, mem, positions, t5_table, ffn_norm, ffn_w_gate, ffn_w_up, ffn_w_down, attn_norm,
              mem_norm, mem_w_kv, mem_qk_g, w_out, a_w_in, a_b_f, a_qk_g, b_w_in, b_q_norm, b_w_uq,
              b_kv_norm, b_w_ukv, b_nope_g, b_rope_g, c_w_in, c_qk_g, d_w_in, d_qk_g):
    for i in range(DEPTH):
        m, j = i % N_MIXERS, i // N_MIXERS
        x = x + 0.5 * swiglu(rms_norm(x, ffn_norm[i, 0]), ffn_w_gate[i, 0], ffn_w_up[i, 0], ffn_w_down[i, 0])
        h = rms_norm(x, attn_norm[i])
        if m == 0:
            p = h @ a_w_in[j]
            mix = fox_mixer(p[..., :FOX_COLS], a_b_f[j], a_qk_g[j])
        elif m == 1:
            p = h @ b_w_in[j]
            mix = mla_mixer(p[..., :MLA_COLS], positions, b_q_norm[j], b_w_uq[j], b_kv_norm[j],
                            b_w_ukv[j], b_nope_g[j], b_rope_g[j])
        elif m == 2:
            p = h @ c_w_in[j]
            mix = dilated_mixer(p[..., :DIL_COLS], c_qk_g[j], t5_table)
        else:
            p = h @ d_w_in[j]
            mix = dsa_mixer(p[..., :DSA_COLS], d_qk_g[j], t5_table)
        mem_kv = rms_norm(mem, mem_norm[i]) @ mem_w_kv[i]
        mo = memory_attention(p[..., -MEM_WIDTH:], mem_kv, mem_qk_g[i])
        x = x + jnp.concatenate([mix.astype(x.dtype), mo.astype(x.dtype)], axis=-1) @ w_out[i]
        x = x + 0.5 * swiglu(rms_norm(x, ffn_norm[i, 1]), ffn_w_gate[i, 1], ffn_w_up[i, 1], ffn_w_down[i, 1])
    return x
```

```cpp
#define MK_ONE_LAUNCH 1
#include <hip/hip_runtime.h>
#include <cstdio>
#include <cstdint>

#define LAS __attribute__((address_space(3)))
#define GAS __attribute__((address_space(1)))
typedef unsigned short bf16_t;
typedef short bf16x8 __attribute__((ext_vector_type(8)));
typedef short s16x4 __attribute__((ext_vector_type(4)));
typedef float f32x2 __attribute__((ext_vector_type(2)));
typedef float f32x4 __attribute__((ext_vector_type(4)));
typedef float f32x16 __attribute__((ext_vector_type(16)));
typedef unsigned u32x2 __attribute__((ext_vector_type(2)));
typedef unsigned u32x4 __attribute__((ext_vector_type(4)));
typedef unsigned long long u64;

constexpr int DM = 2048, NB = 8, SEQ = 4096, MTOK = NB * SEQ, DFF = 5632, NH = 16, HD = 128, NMEM = 256, MEMW = 512, OUTIN = 2560;
constexpr float RMS_EPS = 1e-6f;
constexpr float LOG2E = 1.4426950408889634f;

__device__ __forceinline__ unsigned cvt_pk_bf16(float lo, float hi) { unsigned r; asm volatile("v_cvt_pk_bf16_f32 %0, %1, %2" : "=v"(r) : "v"(lo), "v"(hi)); return r; }
__device__ __forceinline__ float bf_lo(unsigned w) { return __uint_as_float(w << 16); }
__device__ __forceinline__ float bf_hi(unsigned w) { return __uint_as_float(w & 0xffff0000u); }

__device__ __forceinline__ int tid_opaque(int wave_id) {
    int l; asm volatile("v_mbcnt_lo_u32_b32 %0, -1, 0\n\tv_mbcnt_hi_u32_b32 %0, -1, %0" : "=v"(l)); return wave_id * 64 + l; }

namespace pg8 {
constexpr int BM = 256, BK = 64, HALF = 128, HTB = HALF * BK * 2, STAGE_BYTES = 8 * HTB, NXCD = 8, WGM = 8;
__host__ __device__ __forceinline__ int lds_byte(int r, int c) { const int st = (r >> 4) * 2 + (c >> 5), rr = r & 15, cc = c & 31, ob = rr * 64 + cc * 2; return st * 1024 + (ob ^ (((ob >> 9) & 1) << 5)); }
__host__ __device__ __forceinline__ void stage_rc(int b, int& R, int& C) { const int st = b / 1024, sb = b % 1024, swz = sb ^ (((sb >> 9) & 1) << 5); R = (st >> 1) * 16 + swz / 64; C = (st & 1) * 32 + (swz % 64) / 2; }
__host__ __device__ __forceinline__ int perm32(int rho) { const int n = rho >> 4, i = rho & 15; return 8 * (i >> 2) + 4 * n + (i & 3); }

struct Unit { int pm, pn; };
struct Gemm { const bf16_t* A; const bf16_t* Bt; int M, N, K, lda, ldb; int a_tiled; };

struct StaticOrder {
    int nM, nN, nwg, G, c;
    __host__ __device__ void init(int M, int N, int G_, int c_) { nM = M / BM; nN = N / BM; nwg = nM * nN; G = G_; c = c_; }
    __host__ __device__ bool next(int i, Unit& u) const {
        const long L = (long)i * G + c; if (L >= nwg) return false;
        int wgid = (int)L; { const int q = nwg / NXCD, r = nwg % NXCD, xcd = wgid % NXCD, off = wgid / NXCD; wgid = (xcd < r ? xcd * (q + 1) : r * (q + 1) + (xcd - r) * q) + off; }
        const int nig = WGM * nN, gid = wgid / nig, fm = gid * WGM, gsz = (nM - fm) < WGM ? (nM - fm) : WGM;
        u.pm = fm + ((wgid % nig) % gsz); u.pn = (wgid % nig) / gsz; return true;
    }
};

constexpr float SSQ_SCALE = 16777216.0f;
__device__ __forceinline__ float rs_from_ssq(const u64 v) { return __builtin_amdgcn_rsqf((float)v * (1.0f / (SSQ_SCALE * DM)) + RMS_EPS); }
__device__ __forceinline__ float rs_of(const void* rsv, int row, int mode) { return mode ? rs_from_ssq(((const u64*)rsv)[row]) : ((const float*)rsv)[row]; }

struct EpiProj {
    bf16_t* O; int ldc; const void* rsv; int rs_mode;
    float* fgout; int fg_tile;
    const float* g0; int t0a, t0b; const float* g1; int t1a, t1b; const float* g2; int t2a, t2b;
    float oscale;
    int gper, gcnt, gstride;
    __device__ __forceinline__ void operator()(f32x4 (&acc)[2][2][4][2], const Unit& u, int wr, int wc, int fr, int fq, LAS unsigned char* xlds) const {
        const int row0 = u.pm * BM + wr * 64 + fr; const int col0 = u.pn * BM + wc * 32 + 8 * fq;
        const float* gain = (u.pn >= t0a && u.pn < t0b) ? g0 : (u.pn >= t1a && u.pn < t1b) ? g1 : (u.pn >= t2a && u.pn < t2b) ? g2 : nullptr;
        if (gper) gain = (u.pn % gper < gcnt) ? g0 + (size_t)(u.pn / gper) * gstride : nullptr;
        float rsa[2][4];
#pragma unroll
        for (int ai = 0; ai < 2; ++ai)
#pragma unroll
            for (int m = 0; m < 4; ++m) rsa[ai][m] = rs_of(rsv, row0 + ai * HALF + m * 16, rs_mode) * oscale;
#pragma unroll
        for (int ai = 0; ai < 2; ++ai)
#pragma unroll
            for (int m = 0; m < 4; ++m) { const float rs = rsa[ai][m];
#pragma unroll
                for (int bj = 0; bj < 2; ++bj) { acc[ai][bj][m][0] *= rs; acc[ai][bj][m][1] *= rs; } }
        if (gain) {
            LAS float* part = (LAS float*)xlds;
#pragma unroll
            for (int ai = 0; ai < 2; ++ai)
#pragma unroll
                for (int m = 0; m < 4; ++m)
#pragma unroll
                    for (int bj = 0; bj < 2; ++bj) { const f32x4 a = acc[ai][bj][m][0], b = acc[ai][bj][m][1];
                        float ss = ((a[0] * a[0] + a[1] * a[1]) + (a[2] * a[2] + a[3] * a[3])) + ((b[0] * b[0] + b[1] * b[1]) + (b[2] * b[2] + b[3] * b[3]));
                        ss += __shfl_xor(ss, 16); ss += __shfl_xor(ss, 32);
                        if (fq == 0) part[((ai * HALF + wr * 64 + m * 16 + fr) * 2 + bj) * 4 + wc] = ss; }
            asm volatile("s_waitcnt lgkmcnt(0)" ::: "memory"); __builtin_amdgcn_s_barrier(); asm volatile("" ::: "memory");
            const f32x4 gv0 = *(const f32x4*)(gain + wc * 32 + 8 * fq), gv1 = *(const f32x4*)(gain + wc * 32 + 8 * fq + 4);
#pragma unroll
            for (int ai = 0; ai < 2; ++ai)
#pragma unroll
                for (int m = 0; m < 4; ++m)
#pragma unroll
                    for (int bj = 0; bj < 2; ++bj) { const f32x4 p4 = *(const LAS f32x4*)(part + ((ai * HALF + wr * 64 + m * 16 + fr) * 2 + bj) * 4);
                        const float r2 = __builtin_amdgcn_rsqf(((p4[0] + p4[1]) + (p4[2] + p4[3])) * (1.0f / 128.0f) + RMS_EPS);
                        acc[ai][bj][m][0] *= gv0 * r2; acc[ai][bj][m][1] *= gv1 * r2; }
        }
#pragma unroll
        for (int ai = 0; ai < 2; ++ai)
#pragma unroll
            for (int m = 0; m < 4; ++m) { const int row = row0 + ai * HALF + m * 16;
                bf16_t* rowp = O + (size_t)row * ldc + col0;
#pragma unroll
                for (int bj = 0; bj < 2; ++bj) { const f32x4 v0 = acc[ai][bj][m][0], v1 = acc[ai][bj][m][1];
                    u32x4 w; w.x = cvt_pk_bf16(v0[0], v0[1]); w.y = cvt_pk_bf16(v0[2], v0[3]); w.z = cvt_pk_bf16(v1[0], v1[1]); w.w = cvt_pk_bf16(v1[2], v1[3]);
                    *(u32x4*)(rowp + bj * HALF) = w;
                    if (fgout && bj == 0 && u.pn == fg_tile && wc == 0 && fq < 2) { float* fp = fgout + (size_t)row * 16 + 8 * fq; *(f32x4*)fp = v0; *(f32x4*)(fp + 4) = v1; } } }
    }
};
struct EpiSwiGLU {
    bf16_t* O; int ldc; const u64* ssq;
    __device__ __forceinline__ void operator()(f32x4 (&acc)[2][2][4][2], const Unit& u, int wr, int wc, int fr, int fq, LAS unsigned char*) const {
        const int row0 = u.pm * BM + wr * 64 + fr; const int col0 = u.pn * HALF + wc * 32 + 8 * fq;
        float rsv[2][4];
#pragma unroll
        for (int ai = 0; ai < 2; ++ai)
#pragma unroll
            for (int m = 0; m < 4; ++m) rsv[ai][m] = rs_from_ssq(ssq[row0 + ai * HALF + m * 16]);
#pragma unroll
        for (int ai = 0; ai < 2; ++ai)
#pragma unroll
            for (int m = 0; m < 4; ++m) { const int row = row0 + ai * HALF + m * 16; const float rs = rsv[ai][m];
                float h[8];
#pragma unroll
                for (int n = 0; n < 2; ++n)
#pragma unroll
                    for (int j = 0; j < 4; ++j) { const float g = acc[ai][0][m][n][j] * rs, uu = acc[ai][1][m][n][j] * rs;
                        const float e = __builtin_amdgcn_exp2f(-g * LOG2E); h[n * 4 + j] = g * __builtin_amdgcn_rcpf(1.0f + e) * uu; }
                u32x4 w; w.x = cvt_pk_bf16(h[0], h[1]); w.y = cvt_pk_bf16(h[2], h[3]); w.z = cvt_pk_bf16(h[4], h[5]); w.w = cvt_pk_bf16(h[6], h[7]);
                const int kt = col0 >> 6, hh = (row >> 7) & 1;
                __builtin_nontemporal_store(w, (u32x4*)(O + ((size_t)((size_t)u.pm * (ldc >> 6) + kt) * 2 + hh) * (HALF * BK) + (size_t)(row & 127) * BK + (col0 & 63))); }
    }
};
struct EpiResid {
    const float* xin; float* xout; bf16_t* xb; u64* ssq_out; unsigned char* xb8; float alpha;
    __device__ __forceinline__ void operator()(f32x4 (&acc)[2][2][4][2], const Unit& u, int wr, int wc, int fr, int fq, LAS unsigned char*) const {
        const int row0 = u.pm * BM + wr * 64 + fr; const int col0 = u.pn * BM + wc * 32 + 8 * fq;
#pragma unroll
        for (int ai = 0; ai < 2; ++ai) {
            f32x4 xi[4][2][2];
#pragma unroll
            for (int m = 0; m < 4; ++m) { const size_t off = (size_t)(row0 + ai * HALF + m * 16) * DM + col0;
#pragma unroll
                for (int bj = 0; bj < 2; ++bj) { xi[m][bj][0] = *(const f32x4*)(xin + off + bj * HALF); xi[m][bj][1] = *(const f32x4*)(xin + off + bj * HALF + 4); } }
            asm volatile("" ::: "memory");
#pragma unroll
            for (int m = 0; m < 4; ++m) { const int row = row0 + ai * HALF + m * 16; const size_t off = (size_t)row * DM + col0; float ss = 0.f;
#pragma unroll
                for (int bj = 0; bj < 2; ++bj) {
                    const f32x4 v0 = xi[m][bj][0] + acc[ai][bj][m][0] * alpha, v1 = xi[m][bj][1] + acc[ai][bj][m][1] * alpha;
                    *(f32x4*)(xout + off + bj * HALF) = v0; *(f32x4*)(xout + off + bj * HALF + 4) = v1;
                    u32x4 w; w.x = cvt_pk_bf16(v0[0], v0[1]); w.y = cvt_pk_bf16(v0[2], v0[3]); w.z = cvt_pk_bf16(v1[0], v1[1]); w.w = cvt_pk_bf16(v1[2], v1[3]);
                    *(u32x4*)(xb + off + bj * HALF) = w;
                    if (xb8) { int q0 = __builtin_amdgcn_cvt_pk_fp8_f32(v0[0], v0[1], 0, false); q0 = __builtin_amdgcn_cvt_pk_fp8_f32(v0[2], v0[3], q0, true);
                               int q1 = __builtin_amdgcn_cvt_pk_fp8_f32(v1[0], v1[1], 0, false); q1 = __builtin_amdgcn_cvt_pk_fp8_f32(v1[2], v1[3], q1, true);
                               *(u32x2*)(xb8 + off + bj * HALF) = (u32x2){(unsigned)q0, (unsigned)q1}; }
                    ss += (v0[0] * v0[0] + v0[1] * v0[1]) + (v0[2] * v0[2] + v0[3] * v0[3]) + (v1[0] * v1[0] + v1[1] * v1[1]) + (v1[2] * v1[2] + v1[3] * v1[3]); }
                if (ssq_out) { ss += __shfl_xor(ss, 16); ss += __shfl_xor(ss, 32); if (fq == 0) atomicAdd(ssq_out + row, (u64)(ss * SSQ_SCALE)); } }
            asm volatile("" ::: "memory");
        }
    }
};

template <bool FP8 = false, class Epi, class Sched>
__device__ __forceinline__ void gemm_phase(LAS unsigned char* lds, const Gemm g, const Sched& S, const Epi& E, const int tid) {
    const int wid = __builtin_amdgcn_readfirstlane(tid >> 6), lane = tid & 63, wr = wid >> 2, wc = wid & 3, fr = lane & 15, fq = lane >> 4;
    const int K = g.K, nt = K / BK;
    unsigned voffA[2], voffB[2];
#pragma unroll
    for (int i = 0; i < 2; ++i) { int R, C; stage_rc(tid * 16 + i * 8192, R, C); const int Rb = (R & ~31) + perm32(R & 31);
        voffA[i] = (unsigned)(R * (g.a_tiled ? BK : g.lda) + C) * 2u; voffB[i] = (unsigned)(Rb * g.ldb + C) * 2u; }
    const size_t kstep = (size_t)(BK * 2), kstepA = g.a_tiled ? (size_t)(2 * HTB) : kstep;
    const size_t hstepA = g.a_tiled ? (size_t)HTB : (size_t)HALF * g.lda * 2, hstepB = (size_t)HALF * g.ldb * 2;
    const size_t tstepA = g.a_tiled ? (size_t)nt * 2 * HTB : 2 * hstepA, tstepB = 2 * hstepB;
    const unsigned ldsw = (unsigned)wid * 1024u;
    const int aoff = lds_byte(wr * 64 + fr, fq * 8), boff = lds_byte(wc * 32 + fr, fq * 8);
#define PG8_SA(b, h) (((b) * 2 + (h)) * HTB)
#define PG8_SB(b, h) ((4 + (b) * 2 + (h)) * HTB)
#define PG8_STAGE(bufoff, gbase, voff) do { _Pragma("unroll") for (int _i = 0; _i < 2; ++_i) \
        __builtin_amdgcn_global_load_lds((const unsigned*)((const char*)(gbase) + (voff)[_i]), (LAS unsigned*)(lds + (bufoff) + ldsw + _i * 8192), 16, 0, 0); } while (0)
#define PG8_LDA(dst, b, h) do { _Pragma("unroll") for (int m = 0; m < 4; ++m) _Pragma("unroll") for (int k = 0; k < 2; ++k) dst[m][k] = *(const LAS bf16x8*)(lds + PG8_SA(b, h) + aoff + m * 2048 + k * 1024); } while (0)
#define PG8_LDB(dst, b, h) do { _Pragma("unroll") for (int n = 0; n < 2; ++n) _Pragma("unroll") for (int k = 0; k < 2; ++k) dst[n][k] = *(const LAS bf16x8*)(lds + PG8_SB(b, h) + boff + n * 2048 + k * 1024); } while (0)
typedef long i64x2_t __attribute__((ext_vector_type(2)));
#define PG8_MMA(ai, bj, At, Bt) do { __builtin_amdgcn_s_setprio(1); \
        if constexpr (FP8) { _Pragma("unroll") for (int m = 0; m < 4; ++m) _Pragma("unroll") for (int n = 0; n < 2; ++n) _Pragma("unroll") for (int k = 0; k < 2; ++k) { \
            const i64x2_t b_ = __builtin_bit_cast(i64x2_t, Bt[n][k]), a_ = __builtin_bit_cast(i64x2_t, At[m][k]); \
            acc[ai][bj][m][n] = __builtin_amdgcn_mfma_f32_16x16x32_fp8_fp8(b_[0], a_[0], acc[ai][bj][m][n], 0, 0, 0); \
            acc[ai][bj][m][n] = __builtin_amdgcn_mfma_f32_16x16x32_fp8_fp8(b_[1], a_[1], acc[ai][bj][m][n], 0, 0, 0); } } \
        else { _Pragma("unroll") for (int m = 0; m < 4; ++m) _Pragma("unroll") for (int n = 0; n < 2; ++n) _Pragma("unroll") for (int k = 0; k < 2; ++k) \
            acc[ai][bj][m][n] = __builtin_amdgcn_mfma_f32_16x16x32_bf16(Bt[n][k], At[m][k], acc[ai][bj][m][n], 0, 0, 0); } \
        __builtin_amdgcn_s_setprio(0); } while (0)
#define PG8_WAIT_V(n) asm volatile("s_waitcnt vmcnt(" #n ")" ::: "memory")
#define PG8_WAIT_L(n) asm volatile("s_waitcnt lgkmcnt(" #n ")" ::: "memory")
#define PG8_BAR __builtin_amdgcn_s_barrier()
#define PG8_SCHED __builtin_amdgcn_sched_barrier(0)
    Unit cur, nxt; int ui = 0;
    if (!S.next(0, cur)) return;
    f32x4 acc[2][2][4][2];
#pragma unroll
    for (int a = 0; a < 2; ++a)
#pragma unroll
        for (int b = 0; b < 2; ++b)
#pragma unroll
            for (int m = 0; m < 4; ++m)
#pragma unroll
                for (int n = 0; n < 2; ++n) acc[a][b][m][n] = (f32x4){0.f, 0.f, 0.f, 0.f};
    bf16x8 At[4][2], B0[2][2], B1[2][2];
    const char* cA = (const char*)g.A + (size_t)cur.pm * tstepA; const char* cB = (const char*)g.Bt + (size_t)cur.pn * tstepB;
    PG8_STAGE(PG8_SB(0, 0), cB, voffB); PG8_STAGE(PG8_SB(0, 1), cB + hstepB, voffB); PG8_STAGE(PG8_SA(0, 0), cA, voffA); PG8_STAGE(PG8_SA(0, 1), cA + hstepA, voffA);
    if (wr == 1) PG8_BAR;
    PG8_WAIT_V(2); PG8_BAR;
    PG8_STAGE(PG8_SB(1, 0), cB + kstep, voffB); PG8_STAGE(PG8_SA(1, 0), cA + kstepA, voffA); PG8_STAGE(PG8_SB(1, 1), cB + hstepB + kstep, voffB);
    PG8_WAIT_V(6); PG8_BAR;
    for (;;) {
        const bool has_next = S.next(ui + 1, nxt);
        const char* nA = has_next ? (const char*)g.A + (size_t)nxt.pm * tstepA : cA; const char* nB = has_next ? (const char*)g.Bt + (size_t)nxt.pn * tstepB : cB;
        for (int t = 0; t < nt; t += 2) {
            const bool last = (t == nt - 2);
            const char* a1 = cA + (size_t)(t + 1) * kstepA;
            const char* a2 = last ? nA : cA + (size_t)(t + 2) * kstepA; const char* b2 = last ? nB : cB + (size_t)(t + 2) * kstep;
            const char* a3 = a2 + kstepA; const char* b3 = b2 + kstep;
            PG8_LDB(B0, 0, 0); PG8_LDB(B1, 0, 1); PG8_SCHED; PG8_LDA(At, 0, 0); PG8_STAGE(PG8_SA(1, 1), a1 + hstepA, voffA);
            PG8_WAIT_V(8); PG8_WAIT_L(0); PG8_BAR; PG8_MMA(0, 0, At, B0); PG8_MMA(0, 1, At, B1); PG8_BAR; PG8_SCHED;
            PG8_LDA(At, 0, 1); PG8_STAGE(PG8_SB(0, 0), b2, voffB); PG8_STAGE(PG8_SB(0, 1), b2 + hstepB, voffB); PG8_STAGE(PG8_SA(0, 0), a2, voffA);
            PG8_WAIT_V(8); PG8_WAIT_L(0); PG8_BAR; PG8_MMA(1, 0, At, B0); PG8_MMA(1, 1, At, B1); PG8_BAR; PG8_SCHED;
            PG8_LDB(B0, 1, 0); PG8_LDB(B1, 1, 1); PG8_SCHED; PG8_LDA(At, 1, 0); PG8_STAGE(PG8_SA(0, 1), a2 + hstepA, voffA);
            PG8_WAIT_V(8); PG8_WAIT_L(0); PG8_BAR; PG8_MMA(0, 0, At, B0); PG8_MMA(0, 1, At, B1); PG8_BAR; PG8_SCHED;
            PG8_LDA(At, 1, 1); PG8_STAGE(PG8_SB(1, 0), b3, voffB); PG8_STAGE(PG8_SB(1, 1), b3 + hstepB, voffB); PG8_STAGE(PG8_SA(1, 0), a3, voffA);
            PG8_WAIT_V(8); PG8_WAIT_L(0); PG8_BAR; PG8_MMA(1, 0, At, B0); PG8_MMA(1, 1, At, B1); PG8_BAR; PG8_SCHED;
        }
        if (wr == 0) PG8_BAR;
        E(acc, cur, wr, wc, fr, fq, lds + STAGE_BYTES);
        if (!has_next) break;
#pragma unroll
        for (int a = 0; a < 2; ++a)
#pragma unroll
            for (int b = 0; b < 2; ++b)
#pragma unroll
                for (int m = 0; m < 4; ++m)
#pragma unroll
                    for (int n = 0; n < 2; ++n) acc[a][b][m][n] = (f32x4){0.f, 0.f, 0.f, 0.f};
        cur = nxt; cA = nA; cB = nB; ++ui;
        if (wr == 1) PG8_BAR;
    }
    PG8_WAIT_V(0);
    PG8_BAR;
#undef PG8_SA
#undef PG8_SB
#undef PG8_STAGE
#undef PG8_LDA
#undef PG8_LDB
#undef PG8_MMA
#undef PG8_WAIT_V
#undef PG8_WAIT_L
#undef PG8_BAR
#undef PG8_SCHED
}
}

#define XB_TMO      128
#define XB_XCNT(j)  (256  + 64 * (j))
#define XB_XSUB(j)  (1280 + 64 * (j))
#define XB_XGEN(j)  (2304 + 64 * (j))
#define XB_TOP      3328
#define XB_TOPGEN   3392
#define XCD_BAR_WORDS 3456
#define XB_SPIN_CAP (1u << 22)

__device__ __forceinline__ unsigned xb_ld(unsigned* p)              { return __hip_atomic_load(p, __ATOMIC_RELAXED, __HIP_MEMORY_SCOPE_AGENT); }
__device__ __forceinline__ unsigned xb_add(unsigned* p, unsigned v) { return __hip_atomic_fetch_add(p, v, __ATOMIC_RELAXED, __HIP_MEMORY_SCOPE_AGENT); }
__device__ __forceinline__ unsigned xb_xcc_id() { return (unsigned)__builtin_amdgcn_s_getreg((3 << 11) | 20) & 0xFu; }
#define XB_SPIN(cond, bar) do { unsigned _sp = 0; while (cond) { __builtin_amdgcn_s_sleep(1); \
    if ((++_sp & 255u) == 0u) { if (xb_ld(&(bar)[XB_TMO])) break; if (_sp > XB_SPIN_CAP) { atomicAdd(&(bar)[XB_TMO], 1u); break; } } } } while (0)

struct XcdBarrier { unsigned* bar; unsigned x; volatile LAS unsigned* st; };

__device__ __forceinline__ XcdBarrier xcd_barrier_post(unsigned* bar, volatile LAS unsigned* st) {
    XcdBarrier b; b.bar = bar; b.x = xb_xcc_id(); b.st = st;
    if (threadIdx.x == 0) (void)xb_add(&bar[XB_XCNT(b.x)], 1u);
    return b;
}
__device__ __forceinline__ void xcd_barrier_complete(unsigned* bar, unsigned x, unsigned& nloc, unsigned& nx) {
    const unsigned G = gridDim.x * gridDim.y * gridDim.z;
    unsigned sum, cnt, mine, sp = 0u;
    for (;;) {
        sum = 0u; cnt = 0u; mine = 0u;
#pragma unroll
        for (unsigned j = 0; j < 16; ++j) { const unsigned c = xb_ld(&bar[XB_XCNT(j)]); sum += c; cnt += (c > 0u) ? 1u : 0u; mine = (j == x) ? c : mine; }
        if (sum == G) break;
        __builtin_amdgcn_s_sleep(1);
        if ((++sp & 255u) == 0u) { if (xb_ld(&bar[XB_TMO])) break; if (sp > XB_SPIN_CAP) { atomicAdd(&bar[XB_TMO], 1u); break; } }
    }
    nloc = mine > 0u ? mine : 1u; nx = cnt > 0u ? cnt : 1u;
}
__device__ __forceinline__ void xcd_barrier(const XcdBarrier& b) {
    asm volatile("s_waitcnt vmcnt(0)" ::: "memory");
    __syncthreads();
    if (threadIdx.x == 0) {
        unsigned* bar = b.bar; unsigned bx_ = b.x; asm volatile("" : "+s"(bar), "+s"(bx_));
        __builtin_amdgcn_s_waitcnt(0);
        unsigned nloc = b.st[0], nx = b.st[1];
        if (nloc == 0u) { xcd_barrier_complete(bar, bx_, nloc, nx); b.st[0] = nloc; b.st[1] = nx; }
        const unsigned old = xb_add(&bar[XB_XSUB(bx_)], 1u);
        const unsigned gen = old / nloc;
        if (old + 1u == (gen + 1u) * nloc) {
            __builtin_amdgcn_fence(__ATOMIC_RELEASE, "agent");
            asm volatile("s_waitcnt vmcnt(0)" ::: "memory");
            const unsigned og = xb_add(&bar[XB_TOP], 1u);
            const unsigned tg = og / nx;
            if (og + 1u == (tg + 1u) * nx) xb_add(&bar[XB_TOPGEN], 1u);
            else XB_SPIN(xb_ld(&bar[XB_TOPGEN]) == tg, bar);
            __builtin_amdgcn_fence(__ATOMIC_ACQUIRE, "agent");
            xb_add(&bar[XB_XGEN(bx_)], 1u);
            asm volatile("s_waitcnt vmcnt(0)" ::: "memory");
        } else {
            XB_SPIN(xb_ld(&bar[XB_XGEN(bx_)]) == gen, bar);
            __builtin_amdgcn_fence(__ATOMIC_ACQUIRE, "agent");
            asm volatile("s_waitcnt vmcnt(0)" ::: "memory");
        }
    }
    __syncthreads();
}

namespace att {
constexpr int NW = 8, QBLK = 32, KVBLK = 64;
constexpr float THR2 = 8.f * LOG2E;
enum { K_MEM = 0, K_FOX = 1, K_MLA = 2, K_DIL = 3, K_DSA = 4 };
constexpr int L_V = 0, L_K = 49152, L_XB = 100352, L_TBL = 106496, L_END = 141312, VB = 16384;

struct AP {
    const bf16_t* Q; const bf16_t* K; const bf16_t* V; bf16_t* O;
    long qs, ks, vs, os;
    int kt0, nt;
    int q0;
    float C;
    const float* cum; long cums;
    const u64* msk;
    float* ost; long osts;
    float* mst; long msts;
    int carry_in, carry_out;
    const float* t5; int head, dil;
};

#define ATT_SBAR() __builtin_amdgcn_sched_barrier(0)
__device__ __forceinline__ int crow(int r, int hi) { return (r & 3) + 8 * (r >> 2) + 4 * hi; }
__device__ __forceinline__ int t5_bucket(int dist) {
    const int n = dist < 0 ? 0 : dist; if (n < 16) return n;
    const float v = __log2f((float)n * 0.0625f) * (16.0f / 7.0f); int b = 16 + (int)v; return b > 31 ? 31 : b;
}
__device__ __forceinline__ void rowmax_decide(const f32x16& p0, const f32x16& p1, float& m_reg, float& alpha) {
    float pmax = p0[0];
#pragma unroll
    for (int r = 1; r < 16; ++r) pmax = fmaxf(pmax, p0[r]);
#pragma unroll
    for (int r = 0; r < 16; ++r) pmax = fmaxf(pmax, p1[r]);
    { auto rr = __builtin_amdgcn_permlane32_swap(__float_as_uint(pmax), __float_as_uint(pmax), false, false); pmax = fmaxf(__uint_as_float(rr[0]), __uint_as_float(rr[1])); }
    if (__builtin_expect(__all(pmax - m_reg <= THR2), 1)) { alpha = 1.f; }
    else { const float mn = fmaxf(m_reg, pmax); alpha = __builtin_amdgcn_exp2f(m_reg - mn); m_reg = mn; }
}
__device__ __forceinline__ float half_sum(float ps) {
    auto rr = __builtin_amdgcn_permlane32_swap(__float_as_uint(ps), __float_as_uint(ps), false, false); return __uint_as_float(rr[0]) + __uint_as_float(rr[1]);
}
__device__ __forceinline__ void pack_p(const f32x16& p0, const f32x16& p1, bf16x8& pa0, bf16x8& pa1, bf16x8& pa2, bf16x8& pa3) {
#define ATT_PK4(P, BASE, OUT) do { unsigned a0 = cvt_pk_bf16(P[BASE + 0], P[BASE + 1]), a1 = cvt_pk_bf16(P[BASE + 2], P[BASE + 3]);   \
    unsigned b0 = cvt_pk_bf16(P[BASE + 4], P[BASE + 5]), b1 = cvt_pk_bf16(P[BASE + 6], P[BASE + 7]);                              \
    auto r0 = __builtin_amdgcn_permlane32_swap(a0, b0, false, false); auto r1 = __builtin_amdgcn_permlane32_swap(a1, b1, false, false); \
    u32x4 w = {r0[0], r1[0], r0[1], r1[1]}; OUT = __builtin_bit_cast(bf16x8, w); } while (0)
    ATT_PK4(p0, 0, pa0); ATT_PK4(p0, 8, pa1); ATT_PK4(p1, 0, pa2); ATT_PK4(p1, 8, pa3);
#undef ATT_PK4
}
template <int DK, int NQL>
__device__ __forceinline__ void qkt(f32x16& p0, f32x16& p1, const LAS unsigned char* Ks, const int (&kad)[4], const bf16x8* qr, const LAS unsigned char* qsp) {
    p0 = f32x16{}; p1 = f32x16{};
    constexpr int ND = DK / 16, NQR = ND - NQL;
#define ATT_LDK(d, hf) (*(const LAS bf16x8*)(Ks + ((DK == 128) ? (kad[(d) & 3] ^ (((d) >> 2) ? 128 : 0)) : (kad[(d) & 3] + 128 * ((d) >> 2))) + (hf) * 32 * DK * 2))
#define ATT_LDQ(d) (((d) < NQR) ? qr[(d) < NQR ? (d) : 0] : *(const LAS bf16x8*)(qsp + ((d) - NQR) * 1024))
    bf16x8 b0 = ATT_LDK(0, 0), b1 = ATT_LDK(0, 1), qf = ATT_LDQ(0);
#pragma unroll
    for (int d0 = 0; d0 < ND; ++d0) {
        bf16x8 c0 = b0, c1 = b1, qn = qf;
        if (d0 + 1 < ND) { c0 = ATT_LDK(d0 + 1, 0); c1 = ATT_LDK(d0 + 1, 1); qn = ATT_LDQ(d0 + 1); }
        ATT_SBAR();
        p0 = __builtin_amdgcn_mfma_f32_32x32x16_bf16(b0, qf, p0, 0, 0, 0);
        p1 = __builtin_amdgcn_mfma_f32_32x32x16_bf16(b1, qf, p1, 0, 0, 0);
        ATT_SBAR();
        b0 = c0; b1 = c1; qf = qn; }
#undef ATT_LDK
#undef ATT_LDQ
}
__device__ __forceinline__ int v_st(int k, int c) { const int kk = (k & ~0xC) | ((k & 4) << 1) | ((k & 8) >> 1); return ((kk >> 3) * 4 + (c >> 5)) * 512 + ((kk & 7) * 32 + (c & 31)) * 2; }
__device__ __forceinline__ int v_rd_base(int lane) { return ((lane & 3) << 3) | (((lane >> 2) & 3) << 6) | (((lane >> 4) & 1) << 5) | (((lane >> 5) & 1) << 8); }
constexpr int v_rd_off(int d0, int ks, int half) { return d0 * 512 + ks * 4096 + half * 2048; }
template <int OFF> __device__ __forceinline__ s16x4 tr_read(int vb) { s16x4 r; asm volatile("ds_read_b64_tr_b16 %0, %1 offset:%2" : "=&v"(r) : "v"(vb), "i"(OFF) : "memory"); return r; }
struct VF { s16x4 l0, h0, l1, h1, l2, h2, l3, h3; };
template <int D0> __device__ __forceinline__ void pv_read(VF& f, int vb) {
    f.l0 = tr_read<v_rd_off(D0, 0, 0)>(vb); f.h0 = tr_read<v_rd_off(D0, 0, 1)>(vb); f.l1 = tr_read<v_rd_off(D0, 1, 0)>(vb); f.h1 = tr_read<v_rd_off(D0, 1, 1)>(vb);
    f.l2 = tr_read<v_rd_off(D0, 2, 0)>(vb); f.h2 = tr_read<v_rd_off(D0, 2, 1)>(vb); f.l3 = tr_read<v_rd_off(D0, 3, 0)>(vb); f.h3 = tr_read<v_rd_off(D0, 3, 1)>(vb);
}
#define ATT_VWAIT(n, f) asm volatile("s_waitcnt lgkmcnt(" #n ")" : "+v"(f.l0), "+v"(f.h0), "+v"(f.l1), "+v"(f.h1), "+v"(f.l2), "+v"(f.h2), "+v"(f.l3), "+v"(f.h3) :: "memory")
#define ATT_PK(L, H) (bf16x8){L[0], L[1], L[2], L[3], H[0], H[1], H[2], H[3]}
__device__ __forceinline__ void pv_only(f32x16* o, int vb, bf16x8 pa0, bf16x8 pa1, bf16x8 pa2, bf16x8 pa3) {
    VF fa, fb;
#define ATT_MMA4(od, f) do { od = __builtin_amdgcn_mfma_f32_32x32x16_bf16(pa0, ATT_PK(f.l0, f.h0), od, 0, 0, 0); od = __builtin_amdgcn_mfma_f32_32x32x16_bf16(pa1, ATT_PK(f.l1, f.h1), od, 0, 0, 0); \
        od = __builtin_amdgcn_mfma_f32_32x32x16_bf16(pa2, ATT_PK(f.l2, f.h2), od, 0, 0, 0); od = __builtin_amdgcn_mfma_f32_32x32x16_bf16(pa3, ATT_PK(f.l3, f.h3), od, 0, 0, 0); } while (0)
    pv_read<0>(fa, vb); pv_read<1>(fb, vb);
    ATT_VWAIT(8, fa); ATT_SBAR(); ATT_MMA4(o[0], fa); ATT_SBAR(); pv_read<2>(fa, vb);
    ATT_VWAIT(8, fb); ATT_SBAR(); ATT_MMA4(o[1], fb); ATT_SBAR(); pv_read<3>(fb, vb);
    ATT_VWAIT(8, fa); ATT_SBAR(); ATT_MMA4(o[2], fa); ATT_SBAR();
    ATT_VWAIT(0, fb); ATT_SBAR(); ATT_MMA4(o[3], fb);
#undef ATT_MMA4
}
__device__ __forceinline__ float sm_only(f32x16& p0, f32x16& p1, float m) {
    float s = 0.f;
#pragma unroll
    for (int r = 0; r < 16; ++r) { p0[r] = __builtin_amdgcn_exp2f(p0[r] - m); s += p0[r]; }
#pragma unroll
    for (int r = 0; r < 16; ++r) { p1[r] = __builtin_amdgcn_exp2f(p1[r] - m); s += p1[r]; }
    return s;
}
__device__ __forceinline__ float pv_sm(f32x16* o, int vb, bf16x8 pa0, bf16x8 pa1, bf16x8 pa2, bf16x8 pa3, f32x16& p0, f32x16& p1, float m) {
    VF fa, fb; float s = 0.f;
#define ATT_GAP(od, pa, L, H, X, B) do { od = __builtin_amdgcn_mfma_f32_32x32x16_bf16(pa, ATT_PK(L, H), od, 0, 0, 0); \
        { float t0_ = X[B] - m, t1_ = X[B + 1] - m, e0_, e1_; asm volatile("v_exp_f32 %0, %1" : "=v"(e0_) : "v"(t0_)); asm volatile("v_exp_f32 %0, %1" : "=v"(e1_) : "v"(t1_));     \
          X[B] = e0_; X[B + 1] = e1_; s += e0_; s += e1_; } ATT_SBAR(); } while (0)
    pv_read<0>(fa, vb); pv_read<1>(fb, vb);
    ATT_VWAIT(8, fa); ATT_SBAR();
    ATT_GAP(o[0], pa0, fa.l0, fa.h0, p0, 0); ATT_GAP(o[0], pa1, fa.l1, fa.h1, p0, 2); ATT_GAP(o[0], pa2, fa.l2, fa.h2, p0, 4); ATT_GAP(o[0], pa3, fa.l3, fa.h3, p0, 6);
    pv_read<2>(fa, vb); ATT_VWAIT(8, fb); ATT_SBAR();
    ATT_GAP(o[1], pa0, fb.l0, fb.h0, p0, 8); ATT_GAP(o[1], pa1, fb.l1, fb.h1, p0, 10); ATT_GAP(o[1], pa2, fb.l2, fb.h2, p0, 12); ATT_GAP(o[1], pa3, fb.l3, fb.h3, p0, 14);
    pv_read<3>(fb, vb); ATT_VWAIT(8, fa); ATT_SBAR();
    ATT_GAP(o[2], pa0, fa.l0, fa.h0, p1, 0); ATT_GAP(o[2], pa1, fa.l1, fa.h1, p1, 2); ATT_GAP(o[2], pa2, fa.l2, fa.h2, p1, 4); ATT_GAP(o[2], pa3, fa.l3, fa.h3, p1, 6);
    ATT_VWAIT(0, fb); ATT_SBAR();
    ATT_GAP(o[3], pa0, fb.l0, fb.h0, p1, 8); ATT_GAP(o[3], pa1, fb.l1, fb.h1, p1, 10); ATT_GAP(o[3], pa2, fb.l2, fb.h2, p1, 12); ATT_GAP(o[3], pa3, fb.l3, fb.h3, p1, 14);
#undef ATT_GAP
    return s;
}

template <int KIND>
__device__ __forceinline__ void score(f32x16& p0, f32x16& p1, const AP& a, int t, int buf, LAS unsigned char* lds, int wid, int r32, int hi, float cq) {
    const float C = a.C; const int k0 = t * 64; const int q = a.q0 + wid * 32 + r32; const float NEG = -INFINITY;
    if constexpr (KIND == K_FOX) {
        const LAS f32x4* cb = (const LAS f32x4*)(lds + L_XB + buf * 2048) + hi;
#pragma unroll
        for (int g = 0; g < 4; ++g) { const f32x4 c4 = cb[2 * g], c4b = cb[2 * g + 8];
#pragma unroll
            for (int j = 0; j < 4; ++j) { p0[4 * g + j] = fmaf(p0[4 * g + j], C, cq - c4[j]); p1[4 * g + j] = fmaf(p1[4 * g + j], C, cq - c4b[j]); } }
    } else if constexpr (KIND == K_DSA || KIND == K_DIL) {
        const LAS float* tb = (const LAS float*)(lds + L_TBL) + (q - k0 - 4 * hi + 256 - 59);
#pragma unroll
        for (int r = 0; r < 16; ++r) { const int cc = (r & 3) + 8 * (r >> 2); p0[r] = fmaf(p0[r], C, tb[59 - cc]); p1[r] = fmaf(p1[r], C, tb[59 - cc - 32]); }
        if constexpr (KIND == K_DSA) {
            const LAS unsigned* mb = (const LAS unsigned*)(lds + L_XB + buf * 2048) + wid * 64;
            const unsigned wl = mb[r32] >> (4 * hi), wh = mb[32 + r32] >> (4 * hi);
#pragma unroll
            for (int r = 0; r < 16; ++r) { const int cc = (r & 3) + 8 * (r >> 2); p0[r] = ((wl >> cc) & 1u) ? p0[r] : NEG; p1[r] = ((wh >> cc) & 1u) ? p1[r] : NEG; }
        }
    } else {
#pragma unroll
        for (int r = 0; r < 16; ++r) { p0[r] *= C; p1[r] *= C; }
    }
    if constexpr (KIND == K_FOX || KIND == K_MLA) {
        if (k0 + 63 > a.q0) {
            const int kb = k0 + 4 * hi;
#pragma unroll
            for (int r = 0; r < 16; ++r) { const int kv = kb + (r & 3) + 8 * (r >> 2); if (kv > q) p0[r] = NEG; if (kv + 32 > q) p1[r] = NEG; }
        }
    }
}

template <int KIND, int DK>
__device__ __forceinline__ void attn_unit(LAS unsigned char* lds, const AP& a, const int wave_id) {
    const int tid = tid_opaque(wave_id);
    const int lane = tid & 63, r32 = lane & 31, hi = lane >> 5; const int wid = __builtin_amdgcn_readfirstlane(tid >> 6);
    constexpr bool HAS_TBL = (KIND == K_DSA || KIND == K_DIL), HAS_X = (KIND == K_FOX || KIND == K_DSA);
    constexpr int KB = KVBLK * DK * 2, NKC = DK / 8, NKL = (64 * NKC) / 512, ND0 = DK / 16;
    constexpr int NQL = (DK == 192) ? 2 : (HAS_TBL ? 2 : 4), NQR = ND0 - NQL, NLD = NKL + 2 + (HAS_X ? 1 : 0);
    constexpr int LWS = (DK == 192) ? 122880 : 98304, LQSP = (DK == 192) ? 124928 : (HAS_TBL ? 123904 : 106496);
    LAS unsigned char* V_lds = lds + L_V; LAS unsigned char* K_lds = lds + L_K;
    LAS float* wsf = (LAS float*)(lds + LWS) + wid * 64; LAS float* li_l = wsf; LAS float* al_l = wsf + 32;
    LAS unsigned char* qsp = lds + LQSP + wid * (NQL * 1024) + lane * 16;
    float m_reg = -1e30f, l_reg = 0.f; f32x16 o[4] = {}; bf16x8 qr[NQR];
    const int qi = wid * 32 + r32;
    const bf16_t* Qw = a.Q + (long)qi * a.qs + hi * 8;
#pragma unroll
    for (int d0 = 0; d0 < ND0; ++d0) { const bf16x8 qv = *(const bf16x8*)(Qw + d0 * 16); if (d0 < NQR) qr[d0 < NQR ? d0 : 0] = qv; else *(LAS bf16x8*)(qsp + (d0 - NQR) * 1024) = qv; }
    float cq = 0.f;
    if constexpr (KIND == K_FOX) cq = a.cum[(long)(a.q0 + qi) * a.cums];
    if constexpr (KIND == K_DIL) {
        if (a.carry_in) {
            m_reg = a.mst[(long)qi * a.msts]; l_reg = a.mst[(long)qi * a.msts + 1];
#pragma unroll
            for (int r = 0; r < 16; ++r) { const float* orow = a.ost + (long)(wid * 32 + crow(r, hi)) * a.osts + r32;
#pragma unroll
                for (int d0 = 0; d0 < 4; ++d0) o[d0][r] = orow[d0 * 32]; }
        }
    }
    if constexpr (KIND == K_DSA) {
        LAS float* tbl = (LAS float*)(lds + L_TBL);
        for (int i = tid; i < 4352; i += 512) { const int dist = i - 256; tbl[i] = dist < 0 ? -INFINITY : a.t5[t5_bucket(dist) * 16 + a.head] * LOG2E; }
    }
    if constexpr (KIND == K_DIL) {
        LAS float* tbl = (LAS float*)(lds + L_TBL);
        for (int i = tid; i < 640; i += 512) { const int rel = i - 256; tbl[i] = (rel < 0 || rel > 128) ? -INFINITY : a.t5[t5_bucket(rel * a.dil) * 16 + a.head] * LOG2E; }
    }
    int ksrc[NKL], vsrc[2];
#pragma unroll
    for (int c = 0; c < NKL; ++c) { const int Lb = (wid * NKL + c) * 1024 + lane * 16, row = Lb / (DK * 2), chp = (Lb % (DK * 2)) / 16; ksrc[c] = row * (int)a.ks + ((DK == 128) ? (chp ^ (row & 15)) : ((chp & ~7) | ((chp & 7) ^ (row & 7)))) * 8; }
#pragma unroll
    for (int c = 0; c < 2; ++c) { const int sl = (2 * wid + c) * 64 + lane, st = sl >> 5, wi = sl & 31, kk = ((st >> 2) << 3) | (wi >> 2), k = (kk & ~0xC) | ((kk & 4) << 1) | ((kk & 8) >> 1); vsrc[c] = k * (int)a.vs + (st & 3) * 32 + (wi & 3) * 8; }
    const int vb0 = (int)(unsigned)(uintptr_t)V_lds + v_rd_base(lane);
    int kad[4];
#pragma unroll
    for (int j = 0; j < 4; ++j) kad[j] = r32 * (DK * 2) + (((hi | (j << 1)) ^ (r32 & 7)) << 4) + ((DK == 128) ? 128 * ((r32 >> 3) & 1) : 0);
#define ATT_DMA(t, sl) do { const long kb_ = (long)(t) * 64; \
        _Pragma("unroll") for (int c_ = 0; c_ < NKL; ++c_) __builtin_amdgcn_global_load_lds((const unsigned*)(a.K + kb_ * a.ks + ksrc[c_]), (LAS unsigned*)(K_lds + (sl) * KB + (wid * NKL + c_) * 1024), 16, 0, 0); \
        _Pragma("unroll") for (int c_ = 0; c_ < 2; ++c_) __builtin_amdgcn_global_load_lds((const unsigned*)(a.V + kb_ * a.vs + vsrc[c_]), (LAS unsigned*)(V_lds + (sl) * VB + (2 * wid + c_) * 1024), 16, 0, 0); \
        if constexpr (KIND == K_FOX) __builtin_amdgcn_global_load_lds((const unsigned*)(a.cum + (kb_ + lane) * a.cums), (LAS unsigned*)(lds + L_XB + (sl) * 2048), 4, 0, 0);     \
        if constexpr (KIND == K_DSA) __builtin_amdgcn_global_load_lds((const unsigned*)(a.msk + (long)(wid * 32 + r32) * 64 + (t)) + hi, (LAS unsigned*)(lds + L_XB + (sl) * 2048 + wid * 256), 4, 0, 0); } while (0)
#define ATT_RESC(al) do { if (__any((al) < 1.f)) { if (hi == 0) al_l[r32] = (al); asm volatile("s_waitcnt lgkmcnt(0)" ::: "memory"); \
        _Pragma("unroll") for (int d = 0; d < 4; ++d) _Pragma("unroll") for (int r = 0; r < 16; ++r) o[d][r] *= al_l[crow(r, hi)]; } } while (0)
#define ATT_BAR() do { asm volatile("s_waitcnt lgkmcnt(0)" ::: "memory"); __builtin_amdgcn_s_barrier(); asm volatile("" ::: "memory"); } while (0)
    f32x16 p0, p1; float al = 1.f; bf16x8 pa0, pa1, pa2, pa3; const int NT = a.nt, T0 = a.kt0;
    asm volatile("s_waitcnt vmcnt(0) lgkmcnt(0)" ::: "memory");
    ATT_DMA(T0, 0);
    if (NT > 1) { ATT_DMA(T0 + 1, 1); asm volatile("s_waitcnt vmcnt(%0)" :: "n"(NLD) : "memory"); } else { asm volatile("s_waitcnt vmcnt(0)" ::: "memory"); }
    ATT_BAR();
    int sl = 0, sl2 = 2;
    for (int jj = 0; jj < NT; ++jj) {
        const int t = T0 + jj;
        if (jj + 2 < NT) ATT_DMA(t + 2, sl2);
        bool lv = true; { const int k0_ = t * 64, qw_ = a.q0 + wid * 32;
            if constexpr (KIND == K_FOX || KIND == K_MLA || KIND == K_DSA) lv = k0_ <= qw_ + 31;
            if constexpr (KIND == K_DIL) lv = (k0_ <= qw_ + 31) && (k0_ + 63 >= qw_ - 128); }
        if (lv) {
            ATT_SBAR(); qkt<DK, NQL>(p0, p1, K_lds + sl * KB, kad, qr, qsp);
            score<KIND>(p0, p1, a, t, sl, lds, wid, r32, hi, cq);
            rowmax_decide(p0, p1, m_reg, al);
            const float ps = sm_only(p0, p1, m_reg);
            l_reg = l_reg * al + half_sum(ps);
            ATT_RESC(al);
            pack_p(p0, p1, pa0, pa1, pa2, pa3); ATT_SBAR();
            pv_only(o, vb0 + sl * VB, pa0, pa1, pa2, pa3);
        }
        if (jj + 2 < NT) asm volatile("s_waitcnt vmcnt(%0)" :: "n"(NLD) : "memory"); else asm volatile("s_waitcnt vmcnt(0)" ::: "memory");
        ATT_BAR();
        sl = (sl == 2) ? 0 : sl + 1; sl2 = (sl2 == 2) ? 0 : sl2 + 1;
    }
    bool stateout = false;
    if constexpr (KIND == K_DIL) stateout = a.carry_out != 0;
    if (stateout) {
        int qi2 = qi; asm volatile("" : "+v"(qi2));
        if (hi == 0) { a.mst[(long)qi2 * a.msts] = m_reg; a.mst[(long)qi2 * a.msts + 1] = l_reg; }
#pragma unroll
        for (int r = 0; r < 16; ++r) { float* orow = a.ost + (long)(wid * 32 + crow(r, hi)) * a.osts + r32;
#pragma unroll
            for (int d0 = 0; d0 < 4; ++d0) orow[d0 * 32] = o[d0][r]; }
        __syncthreads();
    } else {
        if (hi == 0) li_l[r32] = l_reg;
        asm volatile("s_waitcnt lgkmcnt(0)" ::: "memory");
        float rli[16];
#pragma unroll
        for (int r = 0; r < 16; ++r) rli[r] = __builtin_amdgcn_rcpf(li_l[crow(r, hi)]);
        __syncthreads();
        LAS unsigned short* ost = (LAS unsigned short*)(lds + wid * 8192);
#pragma unroll
        for (int r = 0; r < 16; ++r) { const int orow = crow(r, hi);
#pragma unroll
            for (int d0 = 0; d0 < 4; ++d0) { const unsigned w = cvt_pk_bf16(o[d0][r] * rli[r], 0.f); ost[orow * 128 + d0 * 32 + r32] = (unsigned short)w; } }
        asm volatile("s_waitcnt lgkmcnt(0)" ::: "memory");
#pragma unroll
        for (int i = 0; i < 8; ++i) { const int ch = lane + 64 * i, row = ch >> 4, c16 = ch & 15;
            const u32x4 v = *(const LAS u32x4*)(lds + wid * 8192 + row * 256 + c16 * 16);
            *(u32x4*)(a.O + (long)(wid * 32 + row) * a.os + c16 * 8) = v; }
        __syncthreads();
    }
#undef ATT_DMA
#undef ATT_RESC
#undef ATT_BAR
}
#undef ATT_VWAIT
#undef ATT_PK
}

struct Fr { LAS unsigned char* lds; int tid, lane, wave, vcu, G, gw, ngw; };

__device__ __forceinline__ float wave_sum(float v) {
#pragma unroll
    for (int o = 1; o < 64; o <<= 1) v += __shfl_xor(v, o);
    return v;
}
__device__ __forceinline__ void unpack8(const u32x4 w, float (&v)[8]) {
    v[0] = bf_lo(w.x); v[1] = bf_hi(w.x); v[2] = bf_lo(w.y); v[3] = bf_hi(w.y); v[4] = bf_lo(w.z); v[5] = bf_hi(w.z); v[6] = bf_lo(w.w); v[7] = bf_hi(w.w);
}
__device__ __forceinline__ u32x4 pack8(const float (&v)[8]) {
    u32x4 w; w.x = cvt_pk_bf16(v[0], v[1]); w.y = cvt_pk_bf16(v[2], v[3]); w.z = cvt_pk_bf16(v[4], v[5]); w.w = cvt_pk_bf16(v[6], v[7]); return w;
}
__device__ __forceinline__ float sumsq8(const float (&v)[8]) { return ((v[0] * v[0] + v[1] * v[1]) + (v[2] * v[2] + v[3] * v[3])) + ((v[4] * v[4] + v[5] * v[5]) + (v[6] * v[6] + v[7] * v[7])); }

__device__ __forceinline__ int map_col(int kind, int n) {
    switch (kind) {
        case 1: return 256 * (n >> 7) + (n & 127);
        case 2: return 256 * (n >> 7) + 128 + (n & 127);
        case 3: return n < 6144 ? n : (n < 6160 ? 6656 + (n - 6144) : 6144 + (n - 6160));
        case 4: return n < 1088 ? n : 1280 + (n - 1088);
        case 5: return n < 6144 ? n : (n < 18432 ? n + 512 : 6144 + (n - 18432));
        case 6: return n < 4176 ? n : 4352 + (n - 4176);
        default: return n;
    }
}
struct TrDesc { const float* W; const float* gain; bf16_t* WT; int K, N, ldt, kind, r, f8; };
__device__ __forceinline__ void tr_load(const TrDesc& d, int lane, f32x4 (&v)[16]) {
    const int nblk = (d.N + 63) / 64, kb = d.r / nblk, nb = d.r % nblk, k0 = 64 * kb, n = 64 * nb + 4 * (lane & 15); const bool ok = n < d.N;
    const float* src = d.W + (size_t)(k0 + (lane >> 4)) * d.N + (ok ? n : 0); const size_t rs = (size_t)4 * d.N;
#pragma unroll
    for (int j = 0; j < 16; ++j) v[j] = __builtin_nontemporal_load((const f32x4*)(src + (size_t)j * rs));
}
__device__ __forceinline__ void tr_store(const TrDesc& d, int lane, const f32x4 (&v)[16], LAS float* scr) {
    const int nblk = (d.N + 63) / 64, kb = d.r / nblk, nb = d.r % nblk, k0 = 64 * kb, n0 = 64 * nb;
    { LAS float* w = scr + (lane >> 4) * 65 + 4 * (lane & 15);
#pragma unroll
      for (int j = 0; j < 16; ++j) { w[j * 260 + 0] = v[j][0]; w[j * 260 + 1] = v[j][1]; w[j * 260 + 2] = v[j][2]; w[j * 260 + 3] = v[j][3]; } }
    const int c = lane >> 3, nn = lane & 7; float g[8];
#pragma unroll
    for (int jj = 0; jj < 8; ++jj) g[jj] = d.gain ? d.gain[k0 + 8 * c + jj] : 1.f;
    asm volatile("s_waitcnt lgkmcnt(0)" ::: "memory");
#pragma unroll
    for (int it = 0; it < 8; ++it) { const int nl = nn + 8 * it; const LAS float* rp = scr + (8 * c) * 65 + nl;
        u32x4 o; o.x = cvt_pk_bf16(rp[0 * 65] * g[0], rp[1 * 65] * g[1]); o.y = cvt_pk_bf16(rp[2 * 65] * g[2], rp[3 * 65] * g[3]); o.z = cvt_pk_bf16(rp[4 * 65] * g[4], rp[5 * 65] * g[5]); o.w = cvt_pk_bf16(rp[6 * 65] * g[6], rp[7 * 65] * g[7]);
        if (n0 + nl < d.N) {
            if (d.f8) { int q0 = __builtin_amdgcn_cvt_pk_fp8_f32(rp[0 * 65] * g[0] * 64.f, rp[1 * 65] * g[1] * 64.f, 0, false); q0 = __builtin_amdgcn_cvt_pk_fp8_f32(rp[2 * 65] * g[2] * 64.f, rp[3 * 65] * g[3] * 64.f, q0, true);
                        int q1 = __builtin_amdgcn_cvt_pk_fp8_f32(rp[4 * 65] * g[4] * 64.f, rp[5 * 65] * g[5] * 64.f, 0, false); q1 = __builtin_amdgcn_cvt_pk_fp8_f32(rp[6 * 65] * g[6] * 64.f, rp[7 * 65] * g[7] * 64.f, q1, true);
                        *(u32x2*)((unsigned char*)d.WT + (size_t)map_col(d.kind, n0 + nl) * d.ldt + k0 + 8 * c) = (u32x2){(unsigned)q0, (unsigned)q1}; }
            else *(u32x4*)(d.WT + (size_t)map_col(d.kind, n0 + nl) * d.ldt + k0 + 8 * c) = o; } }
    asm volatile("s_waitcnt lgkmcnt(0)" ::: "memory");
}

__device__ __forceinline__ void rows2048(const Fr& F, const float* x, int nrows, bf16_t* xb, void* out, int mode) {
    for (int m = F.gw; m < nrows; m += F.ngw) {
        const f32x4* xr = (const f32x4*)(x + (size_t)m * DM) + F.lane; f32x4 v[8]; float s = 0.f;
#pragma unroll
        for (int j = 0; j < 8; ++j) { v[j] = xr[64 * j]; s += (v[j].x * v[j].x + v[j].y * v[j].y) + (v[j].z * v[j].z + v[j].w * v[j].w); }
        s = wave_sum(s);
        if (F.lane == 0) { if (mode) ((float*)out)[m] = __builtin_amdgcn_rsqf(s * (1.0f / DM) + RMS_EPS); else ((u64*)out)[m] = (u64)(s * pg8::SSQ_SCALE); }
        if (xb) { u32x2* o8 = (u32x2*)(xb + (size_t)m * DM) + F.lane;
#pragma unroll
            for (int j = 0; j < 8; ++j) { u32x2 w; w.x = cvt_pk_bf16(v[j].x, v[j].y); w.y = cvt_pk_bf16(v[j].z, v[j].w); o8[64 * j] = w; } }
    }
}

__device__ __forceinline__ void hn_step(bf16_t* p, const float (&g)[8]) {
    float v[8]; unpack8(*(const u32x4*)p, v); float ss = sumsq8(v);
    ss += __shfl_xor(ss, 1); ss += __shfl_xor(ss, 2); ss += __shfl_xor(ss, 4); ss += __shfl_xor(ss, 8);
    const float rs = __builtin_amdgcn_rsqf(ss * (1.0f / 128.0f) + RMS_EPS);
#pragma unroll
    for (int j = 0; j < 8; ++j) v[j] = v[j] * rs * g[j];
    *(u32x4*)p = pack8(v);
}
__device__ __forceinline__ void load_gain8(const float* g, int lane, float (&o)[8]) {
#pragma unroll
    for (int j = 0; j < 8; ++j) o[j] = g ? g[(lane & 15) * 8 + j] : 1.f;
}
__device__ __forceinline__ void prep_rows(const Fr& F, bf16_t* P, long ld, int nrows, int c0, int n0, const float* g0, int c1, int n1, const float* g1, int c2, int n2, const float* g2) {
    float ga[8], gb[8], gc[8]; load_gain8(g0, F.lane, ga); load_gain8(g1, F.lane, gb); load_gain8(g2, F.lane, gc);
    for (int m = F.gw; m < nrows; m += F.ngw) {
        bf16_t* row = P + (size_t)m * ld + F.lane * 8;
        for (int s = 0; s < n0; ++s) hn_step(row + c0 + s * 512, ga);
        for (int s = 0; s < n1; ++s) hn_step(row + c1 + s * 512, gb);
        for (int s = 0; s < n2; ++s) hn_step(row + c2 + s * 512, gc);
    }
}

__device__ __forceinline__ void fox_cumsum(const Fr& F, const float* FG, const float* b_f, float* CUM) {
    for (int task = F.gw; task < NB * NH; task += F.ngw) {
        const int b = task >> 4, h = task & 15; const float bias = b_f[h];
        const float* src = FG + ((size_t)b * SEQ + (size_t)F.lane * 64) * 16 + h; float v[64]; float run = 0.f;
#pragma unroll
        for (int i = 0; i < 64; ++i) { const float xg = src[(size_t)i * 16] + bias;
            const float e = __expf(-fabsf(xg)); const float ls = fminf(xg, 0.f) - __logf(1.0f + e);
            run += ls; v[i] = run; }
        float incl = run;
#pragma unroll
        for (int o = 1; o < 64; o <<= 1) { const float t = __shfl_up(incl, o); if (F.lane >= o) incl += t; }
        const float excl = incl - run;
        float* dst = CUM + ((size_t)b * SEQ + (size_t)F.lane * 64) * 16 + h;
#pragma unroll
        for (int i = 0; i < 64; ++i) dst[(size_t)i * 16] = (v[i] + excl) * LOG2E;
    }
}

__device__ const double ROPE_INV[32] = {
    1.0, 0.7498942093324559, 0.5623413251903491, 0.4216965034285822, 0.31622776601683794, 0.23713737056616552, 0.1778279410038923, 0.1333521432163324,
    0.1, 0.07498942093324558, 0.05623413251903491, 0.04216965034285822, 0.03162277660168379, 0.023713737056616554, 0.01778279410038923, 0.01333521432163324,
    0.01, 0.007498942093324558, 0.005623413251903491, 0.004216965034285823, 0.0031622776601683794, 0.0023713737056616554, 0.001778279410038923, 0.001333521432163324,
    0.001, 0.0007498942093324559, 0.0005623413251903491, 0.0004216965034285823, 0.00031622776601683794, 0.00023713737056616554, 0.0001778279410038923, 0.0001333521432163324};
__device__ __forceinline__ void rope_table(const Fr& F, const int* pos, float* COS, float* SIN) {
    const int gt = F.vcu * 512 + F.tid, ngt = F.G * 512;
    for (int i = gt; i < MTOK * 32; i += ngt) { const int m = i >> 5, f = i & 31;
        const double a = (double)pos[m] * (double)(float)ROPE_INV[f]; const double rev = a * 0.15915494309189535; const float fr = (float)(rev - floor(rev));
        COS[i] = __builtin_amdgcn_cosf(fr); SIN[i] = __builtin_amdgcn_sinf(fr); }
}

__device__ __forceinline__ void mla_prep_a(const Fr& F, bf16_t* P, float* RSQ, float* RSKV, bf16_t* KR, const float* rope_g1, const float* gmem, const float* COS, const float* SIN) {
    const int lane = F.lane; float gr[8];
#pragma unroll
    for (int j = 0; j < 8; ++j) gr[j] = rope_g1[(lane & 7) * 8 + j];
    for (int m = F.gw; m < MTOK; m += F.ngw) {
        bf16_t* pr = P + (size_t)m * 1792; float v[8];
        const u32x4 wq = *(const u32x4*)(pr + lane * 8), wk = *(const u32x4*)(pr + 512 + lane * 8);
        u32x4 w = (u32x4){0u, 0u, 0u, 0u}; if (lane < 8) w = *(const u32x4*)(pr + 1024 + lane * 8);
        const float* cp = COS + (size_t)m * 32 + (lane & 3) * 8; const float* sp = SIN + (size_t)m * 32 + (lane & 3) * 8; float cs[8], sn[8];
#pragma unroll
        for (int j = 0; j < 8; ++j) { cs[j] = cp[j]; sn[j] = sp[j]; }
        asm volatile("" ::: "memory");
        unpack8(wq, v); float ss = wave_sum(sumsq8(v)); if (lane == 0) RSQ[m] = __builtin_amdgcn_rsqf(ss * (1.0f / 512.0f) + RMS_EPS);
        unpack8(wk, v); ss = wave_sum(sumsq8(v)); if (lane == 0) RSKV[m] = __builtin_amdgcn_rsqf(ss * (1.0f / 512.0f) + RMS_EPS);
        unpack8(w, v); ss = sumsq8(v); ss += __shfl_xor(ss, 1); ss += __shfl_xor(ss, 2); ss += __shfl_xor(ss, 4);
        const float rs = __builtin_amdgcn_rsqf(ss * (1.0f / 64.0f) + RMS_EPS); float o[8];
#pragma unroll
        for (int j = 0; j < 8; ++j) { const float x = v[j] * rs * gr[j]; const float y = __shfl_xor(x, 4); o[j] = (lane & 4) ? (y * sn[j] + x * cs[j]) : (x * cs[j] - y * sn[j]); }
        if (lane < 8) *(u32x4*)(KR + (size_t)m * 64 + lane * 8) = pack8(o);
    }
}
__device__ __forceinline__ void mla_prep_b(const Fr& F, bf16_t* Q, const bf16_t* KV, bf16_t* KF, const bf16_t* KR, const float* nope_g, const float* rope_g, const float* COS, const float* SIN) {
    const int lane = F.lane, half = lane >> 5, l5 = lane & 31; float gqn[8], gqr[8], gkn[8];
#pragma unroll
    for (int j = 0; j < 8; ++j) { gqn[j] = nope_g[(l5 & 15) * 8 + j]; gkn[j] = nope_g[128 + (l5 & 15) * 8 + j]; gqr[j] = rope_g[(l5 & 7) * 8 + j]; }
    for (int m = F.gw; m < MTOK; m += F.ngw) {
        const float* cp = COS + (size_t)m * 32 + (l5 & 3) * 8; const float* sp = SIN + (size_t)m * 32 + (l5 & 3) * 8; float cs[8], sn[8];
#pragma unroll
        for (int j = 0; j < 8; ++j) { cs[j] = cp[j]; sn[j] = sp[j]; }
        u32x4 krw = (u32x4){0u, 0u, 0u, 0u}; if (l5 >= 16 && l5 < 24) krw = *(const u32x4*)(KR + (size_t)m * 64 + (l5 - 16) * 8);
        u32x4 qw[8], kw[8];
#pragma unroll
        for (int it = 0; it < 8; ++it) { const int h = 2 * it + half;
            qw[it] = (u32x4){0u, 0u, 0u, 0u}; if (l5 < 24) qw[it] = *(const u32x4*)(Q + (size_t)m * 3072 + h * 192 + l5 * 8);
            kw[it] = (u32x4){0u, 0u, 0u, 0u}; if (l5 < 16) kw[it] = *(const u32x4*)(KV + (size_t)m * 4096 + h * 256 + l5 * 8); }
        asm volatile("" ::: "memory");
#pragma unroll
        for (int it = 0; it < 8; ++it) { const int h = 2 * it + half;
            bf16_t* qrow = Q + (size_t)m * 3072 + h * 192 + l5 * 8; float v[8];
            unpack8(qw[it], v); float s8 = sumsq8(v); s8 += __shfl_xor(s8, 1); s8 += __shfl_xor(s8, 2); s8 += __shfl_xor(s8, 4); const float s16 = s8 + __shfl_xor(s8, 8);
            const float rs = (l5 < 16) ? __builtin_amdgcn_rsqf(s16 * (1.0f / 128.0f) + RMS_EPS) : __builtin_amdgcn_rsqf(s8 * (1.0f / 64.0f) + RMS_EPS);
            float o[8];
#pragma unroll
            for (int j = 0; j < 8; ++j) { const float x = v[j] * rs * ((l5 < 16) ? gqn[j] : gqr[j]); const float y = __shfl_xor(x, 4);
                const float rot = (l5 & 4) ? (y * sn[j] + x * cs[j]) : (x * cs[j] - y * sn[j]); o[j] = (l5 < 16) ? x : rot; }
            if (l5 < 24) *(u32x4*)qrow = pack8(o);
            bf16_t* kfrow = KF + (size_t)m * 3072 + h * 192;
            unpack8(kw[it], v); float k16 = sumsq8(v); k16 += __shfl_xor(k16, 1); k16 += __shfl_xor(k16, 2); k16 += __shfl_xor(k16, 4); k16 += __shfl_xor(k16, 8);
            const float krs = __builtin_amdgcn_rsqf(k16 * (1.0f / 128.0f) + RMS_EPS);
#pragma unroll
            for (int j = 0; j < 8; ++j) o[j] = v[j] * krs * gkn[j];
            if (l5 < 16) *(u32x4*)(kfrow + l5 * 8) = pack8(o);
            else if (l5 < 24) *(u32x4*)(kfrow + 128 + (l5 - 16) * 8) = krw;
        }
    }
}

__device__ __forceinline__ void dsa_indexer(const Fr& F, const bf16_t* P, float* SC) {
    constexpr int LDP = 4864, CQI = 3072, CKI = 4096, CWI = 4160;
    const int lane = F.lane, r32 = lane & 31, hg = lane >> 5;
    for (int ui = blockIdx.x; ui < 512; ui += F.G) {
        const int c = ui & 255, second = ui >> 8, b = c >> 5, qb0 = c & 31, qb = second ? 63 - qb0 : qb0;
        const size_t tok0 = (size_t)b * SEQ + qb * 64 + F.wave * 8;
        bf16x8 aq[4][4]; float wv[4][16];
#pragma unroll
        for (int g = 0; g < 4; ++g) { const size_t tok = tok0 + 2 * g + (r32 >> 4); const bf16_t* qp = P + tok * LDP + CQI + (r32 & 15) * 64 + 8 * hg;
#pragma unroll
            for (int ks = 0; ks < 4; ++ks) aq[g][ks] = *(const bf16x8*)(qp + 16 * ks);
#pragma unroll
            for (int r = 0; r < 16; ++r) { const int head = (r & 3) + 8 * ((r >> 2) & 1) + 4 * hg; const size_t tq = tok0 + 2 * g + (r >> 3);
                wv[g][r] = bf_lo((unsigned)P[tq * LDP + CWI + head]) * (0.25f * 0.125f); } }
        const int ntile = 2 * (qb + 1);
        const bf16_t* kp = P + ((size_t)b * SEQ + r32) * LDP + CKI + 8 * hg;
        bf16x8 bk[4], bn[4];
#pragma unroll
        for (int ks = 0; ks < 4; ++ks) bk[ks] = *(const bf16x8*)(kp + 16 * ks);
        for (int t = 0; t < ntile; ++t) {
            if (t + 1 < ntile) {
#pragma unroll
                for (int ks = 0; ks < 4; ++ks) bn[ks] = *(const bf16x8*)(kp + (size_t)(t + 1) * 32 * LDP + 16 * ks);
            }
#pragma unroll
            for (int g = 0; g < 4; ++g) {
                f32x16 d = f32x16{};
#pragma unroll
                for (int ks = 0; ks < 4; ++ks) d = __builtin_amdgcn_mfma_f32_32x32x16_bf16(aq[g][ks], bk[ks], d, 0, 0, 0);
                float s0 = 0.f, s1 = 0.f;
#pragma unroll
                for (int r = 0; r < 8; ++r) { s0 = fmaf(wv[g][r], fmaxf(d[r], 0.f), s0); s1 = fmaf(wv[g][r + 8], fmaxf(d[r + 8], 0.f), s1); }
                auto rr = __builtin_amdgcn_permlane32_swap(__float_as_uint(s0), __float_as_uint(s1), false, false);
                const float tot = __uint_as_float(rr[0]) + __uint_as_float(rr[1]);
                SC[(tok0 + 2 * g + hg) * (size_t)SEQ + t * 32 + r32] = tot;
            }
#pragma unroll
            for (int ks = 0; ks < 4; ++ks) bk[ks] = bn[ks];
        }
    }
}

__device__ __forceinline__ void dsa_select(const Fr& F, const float* SC, u64* MSK) {
    const int lane = F.lane;
    for (int qidx = F.gw; qidx < MTOK; qidx += F.ngw) {
        const int s = qidx & (SEQ - 1); const float* row = SC + (size_t)qidx * SEQ; u64* mrow = MSK + (size_t)qidx * 64;
        if (s < 256) { const int lo = 64 * lane; u64 w = 0ull; if (s >= lo + 63) w = ~0ull; else if (s >= lo) w = (2ull << (s - lo)) - 1ull; mrow[lane] = w; continue; }
        unsigned u[64];
#pragma unroll
        for (int i = 0; i < 64; ++i) { unsigned ov = 0u;
            if (64 * i <= s) { const int key = 64 * i + lane; const unsigned bits = __float_as_uint(row[key]); const unsigned ord = (bits & 0x80000000u) ? ~bits : (bits | 0x80000000u); ov = (key <= s) ? ord : 0u; }
            u[i] = ov; }
        unsigned T = 0u;
        for (int bit = 31; bit >= 0; --bit) { const unsigned cand = T | (1u << bit); int cl = 0;
#pragma unroll
            for (int i0 = 0; i0 < 64; i0 += 8) {
#pragma unroll
                for (int i = i0; i < i0 + 8; ++i) cl += __popcll(__ballot(u[i] >= cand));
                __builtin_amdgcn_sched_barrier(0); }
            if (cl >= 256) T = cand; }
        int cgt = 0;
#pragma unroll
        for (int i0 = 0; i0 < 64; i0 += 8) {
#pragma unroll
            for (int i = i0; i < i0 + 8; ++i) cgt += __popcll(__ballot(u[i] > T));
            __builtin_amdgcn_sched_barrier(0); }
        int need = 256 - cgt; unsigned mlo = 0u, mhi = 0u;
#pragma unroll
        for (int i = 0; i < 64; ++i) { const u64 gt = __ballot(u[i] > T), eq = __ballot(u[i] == T); u64 take = 0ull;
            if (need > 0 && eq != 0ull) { const int c = __popcll(eq);
                if (c <= need) { take = eq; need -= c; }
                else { u64 e = eq; for (int n = 0; n < need; ++n) { const u64 low = e & (0ull - e); take |= low; e ^= low; } need = 0; } }
            const u64 w = gt | take; { const unsigned wl = __builtin_amdgcn_readfirstlane((unsigned)w), wh = __builtin_amdgcn_readfirstlane((unsigned)(w >> 32));
                asm volatile("s_nop 4\n\tv_writelane_b32 %0, %1, %2\n\ts_nop 1" : "+v"(mlo) : "s"(wl), "n"(i)); asm volatile("s_nop 4\n\tv_writelane_b32 %0, %1, %2\n\ts_nop 1" : "+v"(mhi) : "s"(wh), "n"(i)); } }
        mrow[lane] = ((u64)mhi << 32) | (u64)mlo;
    }
}

constexpr size_t MiB = 1u << 20;
constexpr size_t WS_CTL = 0, CTL_ZERO_BYTES = 8 * MiB;
constexpr int CW_BAR = 4096;
constexpr size_t WS_SSQ = 1 * MiB;
constexpr size_t WS_WB = 8 * MiB;
constexpr size_t WS_XB = 236 * MiB;
constexpr size_t WS_MEMB = 364 * MiB;
constexpr size_t WS_MEMKV = 372 * MiB;
constexpr size_t WS_COS = 388 * MiB, WS_SIN = 392 * MiB, WS_RSMEM = 396 * MiB, WS_RSQ = 397 * MiB, WS_RSKV = 398 * MiB;
constexpr size_t WS_XB8 = 560 * MiB;
constexpr size_t WS_MIX = 400 * MiB;
constexpr size_t WS_SCR = 624 * MiB;
constexpr size_t WS_END = (624 + 832) * MiB;
constexpr size_t WB_GU0 = 0, WB_GU1 = 23068672, WB_D0 = 46137344, WB_D1 = 57671680, WB_IN = 69206016, WB_OUT = 108003328, WB_MKV = 113246208, WB_UQ = 115343360, WB_UKV = 116916224;
constexpr int RING_BYTES = 146944, MISC_OFF = RING_BYTES + 64, LDS_BYTES = 147456;
static_assert(att::L_END <= RING_BYTES && pg8::STAGE_BYTES <= RING_BYTES, "LDS map");
constexpr int NPHASES = 44;
#ifndef F8MASK
#define F8MASK 4
#endif
#define F8LAYER(L) (((F8MASK) >> (L)) & 1)
#ifndef RG
#define RG 1
#endif
#ifndef RD
#define RD 1
#endif
#ifndef RI
#define RI 1
#endif
#ifndef RA
#define RA 1
#endif
#ifndef RC
#define RC 1
#endif
#define REP(n) for (int rep_ = 0; rep_ < (n); ++rep_)

struct Args { const void* in[27]; float* out; unsigned char* ws; int ph_lo, ph_hi; };

typedef const __attribute__((address_space(4))) struct Args* ArgsPc;
__device__ __forceinline__ TrDesc tr_desc(ArgsPc A, int L, bf16_t* WB, int it) {
    const float* w_gate = (const float*)A->in[5]; const float* w_up = (const float*)A->in[6]; const float* w_down = (const float*)A->in[7];
    const float* ffn_norm = (const float*)A->in[4]; const float* attn_norm = (const float*)A->in[8];
    const float* w_out = (const float*)A->in[12];
    const float* w_in = (const float*)(L == 0 ? A->in[13] : L == 1 ? A->in[16] : L == 2 ? A->in[23] : A->in[25]);
    const int nin = (L == 0 ? 6672 : L == 1 ? 1600 : L == 2 ? 18944 : 4688);
    const int I_GU = 32 * 88, I_D = 88 * 32, I_IN = 32 * ((nin + 63) / 64), I_OUT = 40 * 32, I_UQ = (L == 1) ? 8 * 48 : 0;
    TrDesc d; d.f8 = 0; int r = it;
    if (r < 4 * I_GU) { const int s = r / I_GU; r -= s * I_GU; const int f = s >> 1, up = s & 1;
        d.W = (up ? w_up : w_gate) + (size_t)(L * 2 + f) * DM * DFF; d.K = DM; d.N = DFF; d.gain = ffn_norm + (size_t)(L * 2 + f) * DM; d.WT = WB + (f ? WB_GU1 : WB_GU0); d.ldt = DM; d.kind = up ? 2 : 1; }
    else { r -= 4 * I_GU;
        if (r < 2 * I_D) { const int f = r / I_D; r -= f * I_D; d.W = w_down + (size_t)(L * 2 + f) * DFF * DM; d.K = DFF; d.N = DM; d.gain = nullptr; d.WT = WB + (f ? WB_D1 : WB_D0); d.ldt = DFF; d.kind = 0; }
        else { r -= 2 * I_D;
            if (r < I_IN) { d.W = w_in; d.K = DM; d.N = nin; d.gain = attn_norm + (size_t)L * DM; d.WT = WB + WB_IN; d.ldt = DM; d.kind = 3 + L; d.f8 = F8LAYER(L) ? 1 : 0; }
            else { r -= I_IN;
                if (r < I_OUT) { d.W = w_out + (size_t)L * OUTIN * DM; d.K = OUTIN; d.N = DM; d.gain = nullptr; d.WT = WB + WB_OUT; d.ldt = OUTIN; d.kind = 0; }
                else { r -= I_OUT;
                    if (r < I_UQ) { d.W = (const float*)A->in[18]; d.K = 512; d.N = 3072; d.gain = (const float*)A->in[17]; d.WT = WB + WB_UQ; d.ldt = 512; d.kind = 0; }
                    else { r -= I_UQ; d.W = (const float*)A->in[20]; d.K = 512; d.N = 4096; d.gain = (const float*)A->in[19]; d.WT = WB + WB_UKV; d.ldt = 512; d.kind = 0; } } } } }
    d.r = r; return d;
}
__device__ __forceinline__ void convert_layer(const Fr& F, ArgsPc A, int L, bf16_t* WB) {
    const int nin = (L == 0 ? 6672 : L == 1 ? 1600 : L == 2 ? 18944 : 4688);
    const int total = 4 * 32 * 88 + 2 * 88 * 32 + 32 * ((nin + 63) / 64) + 40 * 32 + ((L == 1) ? 8 * 48 + 8 * 64 : 0);
    LAS float* scr = (LAS float*)(F.lds + F.wave * 16640);
    f32x4 va[16], vb[16]; int it = F.gw;
    if (it >= total) return;
    TrDesc da = tr_desc(A, L, WB, it), db = da; tr_load(da, F.lane, va);
    for (;;) {
        const bool nb_ = it + F.ngw < total; if (nb_) { db = tr_desc(A, L, WB, it + F.ngw); tr_load(db, F.lane, vb); }
        tr_store(da, F.lane, va, scr); it += F.ngw; if (!nb_) break;
        const bool na_ = it + F.ngw < total; if (na_) { da = tr_desc(A, L, WB, it + F.ngw); tr_load(da, F.lane, va); }
        tr_store(db, F.lane, vb, scr); it += F.ngw; if (!na_) break;
    }
}

__device__ __forceinline__ void mem_attn_units(const Fr& F, const bf16_t* P, long ldp, int memq_col, const bf16_t* MEMKV, bf16_t* MIX) {
    for (int i = blockIdx.x; i < 512; i += F.G) {
        const int b = i >> 6, mh = (i >> 4) & 3, qb = i & 15; const size_t tok = (size_t)b * SEQ + qb * 256;
        att::AP a{}; a.Q = P + tok * ldp + memq_col + mh * 128; a.qs = ldp; a.K = MEMKV + (size_t)b * NMEM * 4096 + mh * 128; a.ks = 4096; a.V = a.K + 512; a.vs = 4096;
        a.O = MIX + tok * OUTIN + 2048 + mh * 128; a.os = OUTIN; a.kt0 = 0; a.nt = 4; a.q0 = 0; a.C = 0.08838834764831845f * LOG2E;
        att::attn_unit<att::K_MEM, 128>(F.lds, a, F.wave);
    }
}
__device__ __forceinline__ void causal_unit_ids(int i, int& b, int& h, int& qb) {
    const int slot = i >> 8, c = i & 255, bh = (c >> 4) * 8 + (c & 7), half = (c >> 3) & 1;
    qb = half ? ((slot & 1) ? slot : 14 - slot) : ((slot & 1) ? slot - 1 : 15 - slot); b = bh >> 4; h = bh & 15;
}

__device__ __forceinline__ Fr mk_frame(unsigned char* lds_raw, int wave_id) {
    Fr F; F.lds = (LAS unsigned char*)lds_raw; F.tid = tid_opaque(wave_id); F.lane = F.tid & 63; F.wave = __builtin_amdgcn_readfirstlane(F.tid >> 6);
    F.G = gridDim.x; { const int bx = blockIdx.x; F.vcu = (F.G % 8 == 0) ? (bx % 8) * (F.G / 8) + bx / 8 : bx; }
    F.gw = F.vcu * 8 + F.wave; F.ngw = F.G * 8; return F;
}
typedef const __attribute__((address_space(4))) Args* ArgsP;
__device__ __forceinline__ ArgsP args_ptr() { auto p = __builtin_amdgcn_kernarg_segment_ptr(); asm volatile("" : "+s"(p)); return (ArgsP)p; }
#define WSP(T, off) ((T*)(AP_->ws + (off)))
#define SCRP(T, mib) ((T*)(AP_->ws + WS_SCR + (size_t)(mib) * MiB))

__global__ void __launch_bounds__(512, 2) fwd(Args A) {
    extern __shared__ __attribute__((aligned(16))) unsigned char lds_raw[];
    { LAS unsigned* z = (LAS unsigned*)((LAS unsigned char*)lds_raw + RING_BYTES); for (int u = threadIdx.x; u < (LDS_BYTES - RING_BYTES) / 4; u += 512) z[u] = 0u; }
    __syncthreads();
    const int lo = A.ph_lo, hi = A.ph_hi; const int wave_id = __builtin_amdgcn_readfirstlane((int)threadIdx.x >> 6);
    XcdBarrier bar; bar.bar = (unsigned*)(A.ws + WS_CTL) + CW_BAR; bar.x = 0; bar.st = nullptr;
    if (hi - lo > 1) bar = xcd_barrier_post((unsigned*)(A.ws + WS_CTL) + CW_BAR, (volatile LAS unsigned*)((LAS unsigned char*)lds_raw + MISC_OFF) + 8);
    int ph = 0;
#define PH_BEGIN if (ph >= lo && ph < hi) { const Fr F = mk_frame(lds_raw, wave_id); const ArgsP AP_ = args_ptr();
#define PH_END   if (ph + 1 < hi) xcd_barrier(bar); } ++ph;
    const float SC128 = 0.08838834764831845f * LOG2E, SC192 = 0.07216878364870323f * LOG2E;

    PH_BEGIN
        rows2048(F, (const float*)AP_->in[1], NB * NMEM, WSP(bf16_t, WS_MEMB), WSP(float, WS_RSMEM), 1);
        rope_table(F, (const int*)AP_->in[2], WSP(float, WS_COS), WSP(float, WS_SIN));
        rows2048(F, (const float*)AP_->in[0], MTOK, WSP(bf16_t, WS_XB), WSP(u64, WS_SSQ), 0);
#ifdef RZ
        { u32x4* z = WSP(u32x4, WS_END); for (size_t i = (size_t)F.vcu * 512 + F.tid; i < (size_t)2 * DFF * DM * 2 / 16; i += (size_t)F.G * 512) z[i] = (u32x4){0u, 0u, 0u, 0u}; }
#endif
        { LAS float* scr = (LAS float*)(F.lds + F.wave * 16640);
          for (int it = F.gw; it < 4 * 512; it += F.ngw) { const int Lm = it >> 9; TrDesc d; d.W = (const float*)AP_->in[10] + (size_t)Lm * DM * 1024; d.K = DM; d.N = 1024; d.gain = (const float*)AP_->in[9] + (size_t)Lm * DM;
              d.WT = SCRP(bf16_t, 0) + (size_t)Lm * 1024 * DM; d.ldt = DM; d.kind = 0; d.f8 = 0; d.r = it & 511; f32x4 v[16]; tr_load(d, F.lane, v); tr_store(d, F.lane, v, scr); } }
    PH_END
    PH_BEGIN { pg8::Gemm g{WSP(bf16_t, WS_MEMB), SCRP(bf16_t, 0), NB * NMEM, 4096, DM, DM, DM, 0}; pg8::StaticOrder S; S.init(g.M, g.N, F.G, (int)blockIdx.x);
        pg8::EpiProj E{WSP(bf16_t, WS_MEMKV), 4096, WSP(float, WS_RSMEM), 0, nullptr, -1, (const float*)AP_->in[11] + 128, 0, 0, nullptr, 0, 0, nullptr, 0, 0, 1.0f, 4, 2, 256}; pg8::gemm_phase(F.lds, g, S, E, F.tid); } PH_END

    int ver = 0;
#pragma clang loop unroll(full)
    for (int hl = 0; hl < 8; ++hl) {
        const int L = hl >> 1, f = hl & 1;
        if (f == 0) {
            PH_BEGIN REP(RC) convert_layer(F, AP_, L, WSP(bf16_t, WS_WB)); PH_END

        }
        PH_BEGIN
#ifdef RZ
            { pg8::Gemm g{WSP(bf16_t, WS_XB), WSP(bf16_t, WS_END), MTOK, 2 * DFF, DM, DM, DM, 0}; pg8::StaticOrder S; S.init(g.M, g.N, F.G, (int)blockIdx.x);
              pg8::EpiSwiGLU E{SCRP(bf16_t, 0), DFF, WSP(u64, WS_SSQ) + (size_t)ver * MTOK}; pg8::gemm_phase(F.lds, g, S, E, F.tid); }
#endif
            REP(RG) { pg8::Gemm g{WSP(bf16_t, WS_XB), WSP(bf16_t, WS_WB) + (f ? WB_GU1 : WB_GU0), MTOK, 2 * DFF, DM, DM, DM, 0}; pg8::StaticOrder S; S.init(g.M, g.N, F.G, (int)blockIdx.x);
            pg8::EpiSwiGLU E{SCRP(bf16_t, 0), DFF, WSP(u64, WS_SSQ) + (size_t)ver * MTOK}; pg8::gemm_phase(F.lds, g, S, E, F.tid); } PH_END
        PH_BEGIN { pg8::Gemm g{SCRP(bf16_t, 0), WSP(bf16_t, WS_WB) + (f ? WB_D1 : WB_D0), MTOK, DM, DFF, DFF, DFF, 1}; pg8::StaticOrder S; S.init(g.M, g.N, F.G, (int)blockIdx.x);
            if (RD > 1) { pg8::EpiResid E0{ver == 0 ? (const float*)AP_->in[0] : AP_->out, SCRP(float, 400), SCRP(bf16_t, 660), nullptr, nullptr, 0.5f}; pg8::gemm_phase(F.lds, g, S, E0, F.tid); }
            pg8::EpiResid E{ver == 0 ? (const float*)AP_->in[0] : AP_->out, AP_->out, WSP(bf16_t, WS_XB), WSP(u64, WS_SSQ) + (size_t)(ver + 1) * MTOK, (f == 0 && F8LAYER(L)) ? WSP(unsigned char, WS_XB8) : nullptr, 0.5f}; pg8::gemm_phase(F.lds, g, S, E, F.tid); } PH_END
        ++ver;
        if (f != 0) continue;
        const int ngrp = (L == 2) ? 3 : 1;
#pragma clang loop unroll(full)
        for (int g = 0; g < ngrp; ++g) {
            PH_BEGIN REP(RI) { const int ldp = (L == 0) ? 6912 : (L == 1) ? 1792 : (L == 2) ? 6656 : 4864;
                const int nproj = (L == 2) ? (g == 0 ? 6656 : 6144) : ldp; const size_t roff = (L == 2) ? (g == 0 ? 0 : (g == 1 ? 6656 : 12800)) : 0;
                pg8::Gemm gm = F8LAYER(L) ? pg8::Gemm{WSP(bf16_t, WS_XB8), (const bf16_t*)((const unsigned char*)(WSP(bf16_t, WS_WB) + WB_IN) + roff * DM), MTOK, nproj, DM / 2, DM / 2, DM / 2, 0}
                                       : pg8::Gemm{WSP(bf16_t, WS_XB), WSP(bf16_t, WS_WB) + WB_IN + roff * DM, MTOK, nproj, DM, DM, DM, 0};
                pg8::StaticOrder S; S.init(gm.M, gm.N, F.G, (int)blockIdx.x);
                const float* gmq = (const float*)AP_->in[11] + (size_t)L * 256;
                const float* qg = (L == 0) ? (const float*)AP_->in[15] : (L == 2) ? (const float*)AP_->in[24] + (size_t)g * 256 : (L == 3) ? (const float*)AP_->in[26] : nullptr;
                const int kt_hi = (L == 3) ? 10 : 16, mq_lo = (L == 0 || L == 2) ? 24 : (L == 1) ? 5 : 17, mq_hi = (L == 2 && g > 0) ? mq_lo : mq_lo + 2;
                pg8::EpiProj E{SCRP(bf16_t, 0), ldp, WSP(u64, WS_SSQ) + (size_t)ver * MTOK, 1, (L == 0) ? SCRP(float, 432) : nullptr, 26,
                               qg, 0, (L == 1) ? 0 : 8, qg ? qg + 128 : nullptr, 8, (L == 1) ? 8 : kt_hi, gmq, mq_lo, mq_hi, F8LAYER(L) ? (1.0f / 64.0f) : 1.0f, 0, 0, 0}; if (F8LAYER(L)) pg8::gemm_phase<true>(F.lds, gm, S, E, F.tid); else pg8::gemm_phase<false>(F.lds, gm, S, E, F.tid); } PH_END
            if (L == 0) { PH_BEGIN fox_cumsum(F, SCRP(const float, 432), (const float*)AP_->in[14], SCRP(float, 434)); PH_END }
            if (L == 1) { PH_BEGIN mla_prep_a(F, SCRP(bf16_t, 0), WSP(float, WS_RSQ), WSP(float, WS_RSKV), SCRP(bf16_t, 752), (const float*)AP_->in[22] + 64, nullptr, WSP(float, WS_COS), WSP(float, WS_SIN)); PH_END }
            if (L == 1) {
                PH_BEGIN
                    REP(RI) for (int i = 0; i < 2; ++i) { pg8::Gemm gm{SCRP(bf16_t, 0) + (i ? 512 : 0), WSP(bf16_t, WS_WB) + (i ? WB_UKV : WB_UQ), MTOK, i ? 4096 : 3072, 512, 1792, 512, 0}; pg8::StaticOrder S; S.init(gm.M, gm.N, F.G, (int)blockIdx.x);
                        pg8::EpiProj E{i ? SCRP(bf16_t, 304) : SCRP(bf16_t, 112), i ? 4096 : 3072, i ? WSP(float, WS_RSKV) : WSP(float, WS_RSQ), 0, nullptr, -1, nullptr, 0, 0, nullptr, 0, 0, nullptr, 0, 0, 1.0f, 0, 0, 0}; pg8::gemm_phase(F.lds, gm, S, E, F.tid); }
                PH_END
                PH_BEGIN mla_prep_b(F, SCRP(bf16_t, 112), SCRP(const bf16_t, 304), SCRP(bf16_t, 560), SCRP(const bf16_t, 752), (const float*)AP_->in[21], (const float*)AP_->in[22], WSP(float, WS_COS), WSP(float, WS_SIN)); PH_END
            }
            if (L == 3) {
                PH_BEGIN REP(RC) dsa_indexer(F, SCRP(const bf16_t, 0), SCRP(float, 304)); PH_END
                PH_BEGIN REP(RC) dsa_select(F, SCRP(const float, 304), SCRP(u64, 816)); PH_END
            }
            PH_BEGIN
                bf16_t* P = SCRP(bf16_t, 0); bf16_t* MIX = WSP(bf16_t, WS_MIX);
                const long ldp = (L == 0) ? 6912 : (L == 1) ? 1792 : (L == 2) ? 6656 : 4864;
                REP(L == 2 ? 1 : RA) {
                if (L == 0) {
                    const float* CUM = SCRP(const float, 434);
                    for (int i = blockIdx.x; i < 2048; i += F.G) { int b, h, qb; causal_unit_ids(i, b, h, qb); const size_t t0 = (size_t)b * SEQ;
                        att::AP a{}; a.Q = P + (t0 + qb * 256) * ldp + h * 128; a.qs = ldp; a.K = P + t0 * ldp + 2048 + h * 128; a.ks = ldp; a.V = a.K + 2048; a.vs = ldp;
                        a.O = MIX + (t0 + qb * 256) * OUTIN + h * 128; a.os = OUTIN; a.kt0 = 0; a.nt = 4 * (qb + 1); a.q0 = qb * 256; a.C = SC128; a.cum = CUM + t0 * 16 + h; a.cums = 16;
                        att::attn_unit<att::K_FOX, 128>(F.lds, a, F.wave); }
                }
                if (L == 1) {
                    const bf16_t* Qb = SCRP(const bf16_t, 112); const bf16_t* KVb = SCRP(const bf16_t, 304); const bf16_t* KF = SCRP(const bf16_t, 560);
                    for (int i = blockIdx.x; i < 2048; i += F.G) { int b, h, qb; causal_unit_ids(i, b, h, qb); const size_t t0 = (size_t)b * SEQ;
                        att::AP a{}; a.Q = Qb + (t0 + qb * 256) * 3072 + h * 192; a.qs = 3072; a.K = KF + t0 * 3072 + h * 192; a.ks = 3072; a.V = KVb + t0 * 4096 + h * 256 + 128; a.vs = 4096;
                        a.O = MIX + (t0 + qb * 256) * OUTIN + h * 128; a.os = OUTIN; a.kt0 = 0; a.nt = 4 * (qb + 1); a.q0 = qb * 256; a.C = SC192;
                        att::attn_unit<att::K_MLA, 192>(F.lds, a, F.wave); }
                }
                if (L == 2) {
                    const int dil = (g == 0) ? 1 : (g == 1 ? 4 : 16), nblk = 16 / dil; float* OST = SCRP(float, 416); float* ML = SCRP(float, 672);
                    for (int i = blockIdx.x; i < 2048; i += F.G) { const int h = i & 15, rest = i >> 4, b = rest >> 4, rj = rest & 15, r = rj / nblk, jb = rj % nblk;
                        const size_t tokz = (size_t)b * SEQ + r, tokq = tokz + (size_t)jb * 256 * dil;
                        att::AP a{}; a.Q = P + tokq * ldp + h * 128; a.qs = (long)dil * ldp; a.K = P + tokz * ldp + 2048 + h * 128; a.ks = (long)dil * ldp; a.V = a.K + 2048; a.vs = a.ks;
                        a.O = MIX + tokq * OUTIN + h * 128; a.os = (long)dil * OUTIN; a.q0 = jb * 256; a.kt0 = jb == 0 ? 0 : 4 * jb - 2; a.nt = jb == 0 ? 4 : 6; a.C = SC128;
                        a.ost = OST + tokq * 2048 + h * 128; a.osts = (long)dil * 2048; a.mst = ML + (tokq * 16 + h) * 2; a.msts = (long)dil * 32; a.carry_in = g > 0; a.carry_out = g < 2;
                        a.t5 = (const float*)AP_->in[3]; a.head = h; a.dil = dil;
                        att::attn_unit<att::K_DIL, 128>(F.lds, a, F.wave); }
                }
                if (L == 3) {
                    const u64* MSK = SCRP(const u64, 816);
                    for (int i = blockIdx.x; i < 2048; i += F.G) { int b, h, qb; causal_unit_ids(i, b, h, qb); const size_t t0 = (size_t)b * SEQ;
                        att::AP a{}; a.Q = P + (t0 + qb * 256) * ldp + h * 128; a.qs = ldp; a.K = P + t0 * ldp + 2048 + (h >> 2) * 128; a.ks = ldp; a.V = a.K + 512; a.vs = ldp;
                        a.O = MIX + (t0 + qb * 256) * OUTIN + h * 128; a.os = OUTIN; a.kt0 = 0; a.nt = 4 * (qb + 1); a.q0 = qb * 256; a.C = SC128; a.msk = MSK + (t0 + qb * 256) * 64; a.t5 = (const float*)AP_->in[3]; a.head = h;
                        att::attn_unit<att::K_DSA, 128>(F.lds, a, F.wave); }
                }
                if (g == 0) { const int memq_col = (L == 0) ? 6144 : (L == 1) ? 1280 : (L == 2) ? 6144 : 4352; mem_attn_units(F, P, ldp, memq_col, WSP(const bf16_t, WS_MEMKV) + L * 1024, MIX); }
                }
            PH_END
        }
        PH_BEGIN { pg8::Gemm gm{WSP(bf16_t, WS_MIX), WSP(bf16_t, WS_WB) + WB_OUT, MTOK, DM, OUTIN, OUTIN, OUTIN, 0}; pg8::StaticOrder S; S.init(gm.M, gm.N, F.G, (int)blockIdx.x);
            if (RD > 1) { pg8::EpiResid E0{AP_->out, SCRP(float, 400), SCRP(bf16_t, 660), nullptr, nullptr, 1.0f}; pg8::gemm_phase(F.lds, gm, S, E0, F.tid); }
            pg8::EpiResid E{AP_->out, AP_->out, WSP(bf16_t, WS_XB), WSP(u64, WS_SSQ) + (size_t)(ver + 1) * MTOK, nullptr, 1.0f}; pg8::gemm_phase(F.lds, gm, S, E, F.tid); } PH_END
        ++ver;
    }
#undef PH_BEGIN
#undef PH_END
}

#ifndef MK_ONE_LAUNCH
#define MK_ONE_LAUNCH 0
#endif
extern "C" void kernel_launch(void* const* d_in, const int* in_sizes, int n_in, void* d_out, int out_size, void* d_ws, size_t ws_size, hipStream_t stream) {
    static int grid = 0;
    if (grid == 0) {
        if (n_in != 27 || in_sizes[0] != MTOK * DM || out_size != MTOK * DM || ws_size < WS_END) {
            fprintf(stderr, "kernel_launch: unexpected shapes: n_in %d in0 %d out %d ws %zu (need >= %zu); nothing launched\n", n_in, n_in > 0 ? in_sizes[0] : -1, out_size, ws_size, (size_t)WS_END); grid = -1; return; }
        int dev = 0, cus = 0, per_cu = 0;
        if (hipGetDevice(&dev) != hipSuccess || hipDeviceGetAttribute(&cus, hipDeviceAttributeMultiprocessorCount, dev) != hipSuccess) { fprintf(stderr, "kernel_launch: device query failed\n"); grid = -1; return; }
        if (hipFuncSetAttribute((const void*)fwd, hipFuncAttributeMaxDynamicSharedMemorySize, LDS_BYTES) != hipSuccess) { fprintf(stderr, "kernel_launch: hipFuncSetAttribute failed\n"); grid = -1; return; }
        if (hipOccupancyMaxActiveBlocksPerMultiprocessor(&per_cu, (const void*)fwd, 512, LDS_BYTES) != hipSuccess || per_cu < 1)
            fprintf(stderr, "kernel_launch: note: occupancy query reports %d workgroups per CU\n", per_cu);
        (void)hipGetLastError();
        grid = cus;
    }
    if (grid < 0) return;
    if (hipMemsetAsync((char*)d_ws + WS_CTL, 0, CTL_ZERO_BYTES, stream) != hipSuccess) { fprintf(stderr, "kernel_launch: memset failed\n"); return; }
    Args a{};
    for (int i = 0; i < 27; ++i) a.in[i] = d_in[i];
    a.out = (float*)d_out; a.ws = (unsigned char*)d_ws;
#if MK_ONE_LAUNCH
    a.ph_lo = 0; a.ph_hi = NPHASES;
    hipLaunchKernelGGL(fwd, dim3(grid), dim3(512), LDS_BYTES, stream, a);
#else
#ifndef NPH_LIMIT
#define NPH_LIMIT NPHASES
#endif
    for (int p = 0; p < NPH_LIMIT; ++p) { a.ph_lo = p; a.ph_hi = p + 1; hipLaunchKernelGGL(fwd, dim3(grid), dim3(512), LDS_BYTES, stream, a); }
#endif
    const hipError_t le = hipPeekAtLastError();
    if (le != hipSuccess) fprintf(stderr, "kernel_launch: launch failed: %s\n", hipGetErrorName(le));
}
```

```cpp
#define MK_ONE_LAUNCH 1
#include <hip/hip_runtime.h>
#include <cstdio>
#include <cstdint>

#define LAS __attribute__((address_space(3)))
#define GAS __attribute__((address_space(1)))
typedef unsigned short bf16_t;
typedef short bf16x8 __attribute__((ext_vector_type(8)));
typedef short s16x4 __attribute__((ext_vector_type(4)));
typedef float f32x2 __attribute__((ext_vector_type(2)));
typedef float f32x4 __attribute__((ext_vector_type(4)));
typedef float f32x16 __attribute__((ext_vector_type(16)));
typedef unsigned u32x2 __attribute__((ext_vector_type(2)));
typedef unsigned u32x4 __attribute__((ext_vector_type(4)));
typedef unsigned long long u64;

constexpr int DM = 2048, NB = 8, SEQ = 4096, MTOK = NB * SEQ, DFF = 5632, NH = 16, HD = 128, NMEM = 256, MEMW = 512, OUTIN = 2560;
constexpr float RMS_EPS = 1e-6f;
constexpr float LOG2E = 1.4426950408889634f;

__device__ __forceinline__ unsigned cvt_pk_bf16(float lo, float hi) { unsigned r; asm volatile("v_cvt_pk_bf16_f32 %0, %1, %2" : "=v"(r) : "v"(lo), "v"(hi)); return r; }
__device__ __forceinline__ float bf_lo(unsigned w) { return __uint_as_float(w << 16); }
__device__ __forceinline__ float bf_hi(unsigned w) { return __uint_as_float(w & 0xffff0000u); }

__device__ __forceinline__ int tid_opaque(int wave_id) {
    int l; asm volatile("v_mbcnt_lo_u32_b32 %0, -1, 0\n\tv_mbcnt_hi_u32_b32 %0, -1, %0" : "=v"(l)); return wave_id * 64 + l; }

namespace pg8 {
constexpr int BM = 256, BK = 64, HALF = 128, HTB = HALF * BK * 2, STAGE_BYTES = 8 * HTB, NXCD = 8, WGM = 8;
__host__ __device__ __forceinline__ int lds_byte(int r, int c) { const int st = (r >> 4) * 2 + (c >> 5), rr = r & 15, cc = c & 31, ob = rr * 64 + cc * 2; return st * 1024 + (ob ^ (((ob >> 9) & 1) << 5)); }
__host__ __device__ __forceinline__ void stage_rc(int b, int& R, int& C) { const int st = b / 1024, sb = b % 1024, swz = sb ^ (((sb >> 9) & 1) << 5); R = (st >> 1) * 16 + swz / 64; C = (st & 1) * 32 + (swz % 64) / 2; }
__host__ __device__ __forceinline__ int perm32(int rho) { const int n = rho >> 4, i = rho & 15; return 8 * (i >> 2) + 4 * n + (i & 3); }

struct Unit { int pm, pn; };
struct Gemm { const bf16_t* A; const bf16_t* Bt; int M, N, K, lda, ldb; int a_tiled; };

struct StaticOrder {
    int nM, nN, nwg, G, c;
    __host__ __device__ void init(int M, int N, int G_, int c_) { nM = M / BM; nN = N / BM; nwg = nM * nN; G = G_; c = c_; }
    __host__ __device__ bool next(int i, Unit& u) const {
        const long L = (long)i * G + c; if (L >= nwg) return false;
        int wgid = (int)L; { const int q = nwg / NXCD, r = nwg % NXCD, xcd = wgid % NXCD, off = wgid / NXCD; wgid = (xcd < r ? xcd * (q + 1) : r * (q + 1) + (xcd - r) * q) + off; }
        const int nig = WGM * nN, gid = wgid / nig, fm = gid * WGM, gsz = (nM - fm) < WGM ? (nM - fm) : WGM;
        u.pm = fm + ((wgid % nig) % gsz); u.pn = (wgid % nig) / gsz; return true;
    }
};

constexpr float SSQ_SCALE = 16777216.0f;
__device__ __forceinline__ float rs_from_ssq(const u64 v) { return __builtin_amdgcn_rsqf((float)v * (1.0f / (SSQ_SCALE * DM)) + RMS_EPS); }
__device__ __forceinline__ float rs_of(const void* rsv, int row, int mode) { return mode ? rs_from_ssq(((const u64*)rsv)[row]) : ((const float*)rsv)[row]; }

struct EpiProj {
    bf16_t* O; int ldc; const void* rsv; int rs_mode;
    float* fgout; int fg_tile;
    const float* g0; int t0a, t0b; const float* g1; int t1a, t1b; const float* g2; int t2a, t2b;
    float oscale;
    int gper, gcnt, gstride;
    __device__ __forceinline__ void operator()(f32x4 (&acc)[2][2][4][2], const Unit& u, int wr, int wc, int fr, int fq, LAS unsigned char* xlds) const {
        const int row0 = u.pm * BM + wr * 64 + fr; const int col0 = u.pn * BM + wc * 32 + 8 * fq;
        const float* gain = (u.pn >= t0a && u.pn < t0b) ? g0 : (u.pn >= t1a && u.pn < t1b) ? g1 : (u.pn >= t2a && u.pn < t2b) ? g2 : nullptr;
        if (gper) gain = (u.pn % gper < gcnt) ? g0 + (size_t)(u.pn / gper) * gstride : nullptr;
        float rsa[2][4];
#pragma unroll
        for (int ai = 0; ai < 2; ++ai)
#pragma unroll
            for (int m = 0; m < 4; ++m) rsa[ai][m] = rs_of(rsv, row0 + ai * HALF + m * 16, rs_mode) * oscale;
#pragma unroll
        for (int ai = 0; ai < 2; ++ai)
#pragma unroll
            for (int m = 0; m < 4; ++m) { const float rs = rsa[ai][m];
#pragma unroll
                for (int bj = 0; bj < 2; ++bj) { acc[ai][bj][m][0] *= rs; acc[ai][bj][m][1] *= rs; } }
        if (gain) {
            LAS float* part = (LAS float*)xlds;
#pragma unroll
            for (int ai = 0; ai < 2; ++ai)
#pragma unroll
                for (int m = 0; m < 4; ++m)
#pragma unroll
                    for (int bj = 0; bj < 2; ++bj) { const f32x4 a = acc[ai][bj][m][0], b = acc[ai][bj][m][1];
                        float ss = ((a[0] * a[0] + a[1] * a[1]) + (a[2] * a[2] + a[3] * a[3])) + ((b[0] * b[0] + b[1] * b[1]) + (b[2] * b[2] + b[3] * b[3]));
                        ss += __shfl_xor(ss, 16); ss += __shfl_xor(ss, 32);
                        if (fq == 0) part[((ai * HALF + wr * 64 + m * 16 + fr) * 2 + bj) * 4 + wc] = ss; }
            asm volatile("s_waitcnt lgkmcnt(0)" ::: "memory"); __builtin_amdgcn_s_barrier(); asm volatile("" ::: "memory");
            const f32x4 gv0 = *(const f32x4*)(gain + wc * 32 + 8 * fq), gv1 = *(const f32x4*)(gain + wc * 32 + 8 * fq + 4);
#pragma unroll
            for (int ai = 0; ai < 2; ++ai)
#pragma unroll
                for (int m = 0; m < 4; ++m)
#pragma unroll
                    for (int bj = 0; bj < 2; ++bj) { const f32x4 p4 = *(const LAS f32x4*)(part + ((ai * HALF + wr * 64 + m * 16 + fr) * 2 + bj) * 4);
                        const float r2 = __builtin_amdgcn_rsqf(((p4[0] + p4[1]) + (p4[2] + p4[3])) * (1.0f / 128.0f) + RMS_EPS);
                        acc[ai][bj][m][0] *= gv0 * r2; acc[ai][bj][m][1] *= gv1 * r2; }
        }
#pragma unroll
        for (int ai = 0; ai < 2; ++ai)
#pragma unroll
            for (int m = 0; m < 4; ++m) { const int row = row0 + ai * HALF + m * 16;
                bf16_t* rowp = O + (size_t)row * ldc + col0;
#pragma unroll
                for (int bj = 0; bj < 2; ++bj) { const f32x4 v0 = acc[ai][bj][m][0], v1 = acc[ai][bj][m][1];
                    u32x4 w; w.x = cvt_pk_bf16(v0[0], v0[1]); w.y = cvt_pk_bf16(v0[2], v0[3]); w.z = cvt_pk_bf16(v1[0], v1[1]); w.w = cvt_pk_bf16(v1[2], v1[3]);
                    *(u32x4*)(rowp + bj * HALF) = w;
                    if (fgout && bj == 0 && u.pn == fg_tile && wc == 0 && fq < 2) { float* fp = fgout + (size_t)row * 16 + 8 * fq; *(f32x4*)fp = v0; *(f32x4*)(fp + 4) = v1; } } }
    }
};
struct EpiSwiGLU {
    bf16_t* O; int ldc; const u64* ssq;
    __device__ __forceinline__ void operator()(f32x4 (&acc)[2][2][4][2], const Unit& u, int wr, int wc, int fr, int fq, LAS unsigned char*) const {
        const int row0 = u.pm * BM + wr * 64 + fr; const int col0 = u.pn * HALF + wc * 32 + 8 * fq;
        float rsv[2][4];
#pragma unroll
        for (int ai = 0; ai < 2; ++ai)
#pragma unroll
            for (int m = 0; m < 4; ++m) rsv[ai][m] = rs_from_ssq(ssq[row0 + ai * HALF + m * 16]);
#pragma unroll
        for (int ai = 0; ai < 2; ++ai)
#pragma unroll
            for (int m = 0; m < 4; ++m) { const int row = row0 + ai * HALF + m * 16; const float rs = rsv[ai][m];
                float h[8];
#pragma unroll
                for (int n = 0; n < 2; ++n)
#pragma unroll
                    for (int j = 0; j < 4; ++j) { const float g = acc[ai][0][m][n][j] * rs, uu = acc[ai][1][m][n][j] * rs;
                        const float e = __builtin_amdgcn_exp2f(-g * LOG2E); h[n * 4 + j] = g * __builtin_amdgcn_rcpf(1.0f + e) * uu; }
                u32x4 w; w.x = cvt_pk_bf16(h[0], h[1]); w.y = cvt_pk_bf16(h[2], h[3]); w.z = cvt_pk_bf16(h[4], h[5]); w.w = cvt_pk_bf16(h[6], h[7]);
                const int kt = col0 >> 6, hh = (row >> 7) & 1;
                __builtin_nontemporal_store(w, (u32x4*)(O + ((size_t)((size_t)u.pm * (ldc >> 6) + kt) * 2 + hh) * (HALF * BK) + (size_t)(row & 127) * BK + (col0 & 63))); }
    }
};
struct EpiResid {
    const float* xin; float* xout; bf16_t* xb; u64* ssq_out; unsigned char* xb8; float alpha;
    __device__ __forceinline__ void operator()(f32x4 (&acc)[2][2][4][2], const Unit& u, int wr, int wc, int fr, int fq, LAS unsigned char*) const {
        const int row0 = u.pm * BM + wr * 64 + fr; const int col0 = u.pn * BM + wc * 32 + 8 * fq;
#pragma unroll
        for (int ai = 0; ai < 2; ++ai) {
            f32x4 xi[4][2][2];
#pragma unroll
            for (int m = 0; m < 4; ++m) { const size_t off = (size_t)(row0 + ai * HALF + m * 16) * DM + col0;
#pragma unroll
                for (int bj = 0; bj < 2; ++bj) { xi[m][bj][0] = __builtin_nontemporal_load((const f32x4*)(xin + off + bj * HALF)); xi[m][bj][1] = __builtin_nontemporal_load((const f32x4*)(xin + off + bj * HALF + 4)); } }
            asm volatile("" ::: "memory");
#pragma unroll
            for (int m = 0; m < 4; ++m) { const int row = row0 + ai * HALF + m * 16; const size_t off = (size_t)row * DM + col0; float ss = 0.f;
#pragma unroll
                for (int bj = 0; bj < 2; ++bj) {
                    const f32x4 v0 = xi[m][bj][0] + acc[ai][bj][m][0] * alpha, v1 = xi[m][bj][1] + acc[ai][bj][m][1] * alpha;
                    __builtin_nontemporal_store(v0, (f32x4*)(xout + off + bj * HALF)); __builtin_nontemporal_store(v1, (f32x4*)(xout + off + bj * HALF + 4));
                    u32x4 w; w.x = cvt_pk_bf16(v0[0], v0[1]); w.y = cvt_pk_bf16(v0[2], v0[3]); w.z = cvt_pk_bf16(v1[0], v1[1]); w.w = cvt_pk_bf16(v1[2], v1[3]);
                    *(u32x4*)(xb + off + bj * HALF) = w;
                    if (xb8) { int q0 = __builtin_amdgcn_cvt_pk_fp8_f32(v0[0], v0[1], 0, false); q0 = __builtin_amdgcn_cvt_pk_fp8_f32(v0[2], v0[3], q0, true);
                               int q1 = __builtin_amdgcn_cvt_pk_fp8_f32(v1[0], v1[1], 0, false); q1 = __builtin_amdgcn_cvt_pk_fp8_f32(v1[2], v1[3], q1, true);
                               *(u32x2*)(xb8 + off + bj * HALF) = (u32x2){(unsigned)q0, (unsigned)q1}; }
                    ss += (v0[0] * v0[0] + v0[1] * v0[1]) + (v0[2] * v0[2] + v0[3] * v0[3]) + (v1[0] * v1[0] + v1[1] * v1[1]) + (v1[2] * v1[2] + v1[3] * v1[3]); }
                if (ssq_out) { ss += __shfl_xor(ss, 16); ss += __shfl_xor(ss, 32); if (fq == 0) atomicAdd(ssq_out + row, (u64)(ss * SSQ_SCALE)); } }
            asm volatile("" ::: "memory");
        }
    }
};

template <bool FP8 = false, class Epi, class Sched>
__device__ __forceinline__ void gemm_phase(LAS unsigned char* lds, const Gemm g, const Sched& S, const Epi& E, const int tid) {
    const int wid = __builtin_amdgcn_readfirstlane(tid >> 6), lane = tid & 63, wr = wid >> 2, wc = wid & 3, fr = lane & 15, fq = lane >> 4;
    const int K = g.K, nt = K / BK;
    unsigned voffA[2], voffB[2];
#pragma unroll
    for (int i = 0; i < 2; ++i) { int R, C; stage_rc(tid * 16 + i * 8192, R, C); const int Rb = (R & ~31) + perm32(R & 31);
        voffA[i] = (unsigned)(R * (g.a_tiled ? BK : g.lda) + C) * 2u; voffB[i] = (unsigned)(Rb * g.ldb + C) * 2u; }
    const size_t kstep = (size_t)(BK * 2), kstepA = g.a_tiled ? (size_t)(2 * HTB) : kstep;
    const size_t hstepA = g.a_tiled ? (size_t)HTB : (size_t)HALF * g.lda * 2, hstepB = (size_t)HALF * g.ldb * 2;
    const size_t tstepA = g.a_tiled ? (size_t)nt * 2 * HTB : 2 * hstepA, tstepB = 2 * hstepB;
    const unsigned ldsw = (unsigned)wid * 1024u;
    const int aoff = lds_byte(wr * 64 + fr, fq * 8), boff = lds_byte(wc * 32 + fr, fq * 8);
#define PG8_SA(b, h) (((b) * 2 + (h)) * HTB)
#define PG8_SB(b, h) ((4 + (b) * 2 + (h)) * HTB)
#define PG8_STAGE(bufoff, gbase, voff) do { _Pragma("unroll") for (int _i = 0; _i < 2; ++_i) \
        __builtin_amdgcn_global_load_lds((const unsigned*)((const char*)(gbase) + (voff)[_i]), (LAS unsigned*)(lds + (bufoff) + ldsw + _i * 8192), 16, 0, 0); } while (0)
#define PG8_LDA(dst, b, h) do { _Pragma("unroll") for (int m = 0; m < 4; ++m) _Pragma("unroll") for (int k = 0; k < 2; ++k) dst[m][k] = *(const LAS bf16x8*)(lds + PG8_SA(b, h) + aoff + m * 2048 + k * 1024); } while (0)
#define PG8_LDB(dst, b, h) do { _Pragma("unroll") for (int n = 0; n < 2; ++n) _Pragma("unroll") for (int k = 0; k < 2; ++k) dst[n][k] = *(const LAS bf16x8*)(lds + PG8_SB(b, h) + boff + n * 2048 + k * 1024); } while (0)
typedef long i64x2_t __attribute__((ext_vector_type(2)));
#define PG8_MMA(ai, bj, At, Bt) do { __builtin_amdgcn_s_setprio(1); \
        if constexpr (FP8) { _Pragma("unroll") for (int m = 0; m < 4; ++m) _Pragma("unroll") for (int n = 0; n < 2; ++n) _Pragma("unroll") for (int k = 0; k < 2; ++k) { \
            const i64x2_t b_ = __builtin_bit_cast(i64x2_t, Bt[n][k]), a_ = __builtin_bit_cast(i64x2_t, At[m][k]); \
            acc[ai][bj][m][n] = __builtin_amdgcn_mfma_f32_16x16x32_fp8_fp8(b_[0], a_[0], acc[ai][bj][m][n], 0, 0, 0); \
            acc[ai][bj][m][n] = __builtin_amdgcn_mfma_f32_16x16x32_fp8_fp8(b_[1], a_[1], acc[ai][bj][m][n], 0, 0, 0); } } \
        else { _Pragma("unroll") for (int m = 0; m < 4; ++m) _Pragma("unroll") for (int n = 0; n < 2; ++n) _Pragma("unroll") for (int k = 0; k < 2; ++k) \
            acc[ai][bj][m][n] = __builtin_amdgcn_mfma_f32_16x16x32_bf16(Bt[n][k], At[m][k], acc[ai][bj][m][n], 0, 0, 0); } \
        __builtin_amdgcn_s_setprio(0); } while (0)
#define PG8_WAIT_V(n) asm volatile("s_waitcnt vmcnt(" #n ")" ::: "memory")
#define PG8_WAIT_L(n) asm volatile("s_waitcnt lgkmcnt(" #n ")" ::: "memory")
#define PG8_BAR __builtin_amdgcn_s_barrier()
#define PG8_SCHED __builtin_amdgcn_sched_barrier(0)
    Unit cur, nxt; int ui = 0;
    if (!S.next(0, cur)) return;
    f32x4 acc[2][2][4][2];
#pragma unroll
    for (int a = 0; a < 2; ++a)
#pragma unroll
        for (int b = 0; b < 2; ++b)
#pragma unroll
            for (int m = 0; m < 4; ++m)
#pragma unroll
                for (int n = 0; n < 2; ++n) acc[a][b][m][n] = (f32x4){0.f, 0.f, 0.f, 0.f};
    bf16x8 At[4][2], B0[2][2], B1[2][2];
    const char* cA = (const char*)g.A + (size_t)cur.pm * tstepA; const char* cB = (const char*)g.Bt + (size_t)cur.pn * tstepB;
    PG8_STAGE(PG8_SB(0, 0), cB, voffB); PG8_STAGE(PG8_SB(0, 1), cB + hstepB, voffB); PG8_STAGE(PG8_SA(0, 0), cA, voffA); PG8_STAGE(PG8_SA(0, 1), cA + hstepA, voffA);
    if (wr == 1) PG8_BAR;
    PG8_WAIT_V(2); PG8_BAR;
    PG8_STAGE(PG8_SB(1, 0), cB + kstep, voffB); PG8_STAGE(PG8_SA(1, 0), cA + kstepA, voffA); PG8_STAGE(PG8_SB(1, 1), cB + hstepB + kstep, voffB);
    PG8_WAIT_V(6); PG8_BAR;
    for (;;) {
        const bool has_next = S.next(ui + 1, nxt);
        const char* nA = has_next ? (const char*)g.A + (size_t)nxt.pm * tstepA : cA; const char* nB = has_next ? (const char*)g.Bt + (size_t)nxt.pn * tstepB : cB;
        for (int t = 0; t < nt; t += 2) {
            const bool last = (t == nt - 2);
            const char* a1 = cA + (size_t)(t + 1) * kstepA;
            const char* a2 = last ? nA : cA + (size_t)(t + 2) * kstepA; const char* b2 = last ? nB : cB + (size_t)(t + 2) * kstep;
            const char* a3 = a2 + kstepA; const char* b3 = b2 + kstep;
            PG8_LDB(B0, 0, 0); PG8_LDB(B1, 0, 1); PG8_SCHED; PG8_LDA(At, 0, 0); PG8_STAGE(PG8_SA(1, 1), a1 + hstepA, voffA);
            PG8_WAIT_V(8); PG8_WAIT_L(0); PG8_BAR; PG8_MMA(0, 0, At, B0); PG8_MMA(0, 1, At, B1); PG8_BAR; PG8_SCHED;
            PG8_LDA(At, 0, 1); PG8_STAGE(PG8_SB(0, 0), b2, voffB); PG8_STAGE(PG8_SB(0, 1), b2 + hstepB, voffB); PG8_STAGE(PG8_SA(0, 0), a2, voffA);
            PG8_WAIT_V(8); PG8_WAIT_L(0); PG8_BAR; PG8_MMA(1, 0, At, B0); PG8_MMA(1, 1, At, B1); PG8_BAR; PG8_SCHED;
            PG8_LDB(B0, 1, 0); PG8_LDB(B1, 1, 1); PG8_SCHED; PG8_LDA(At, 1, 0); PG8_STAGE(PG8_SA(0, 1), a2 + hstepA, voffA);
            PG8_WAIT_V(8); PG8_WAIT_L(0); PG8_BAR; PG8_MMA(0, 0, At, B0); PG8_MMA(0, 1, At, B1); PG8_BAR; PG8_SCHED;
            PG8_LDA(At, 1, 1); PG8_STAGE(PG8_SB(1, 0), b3, voffB); PG8_STAGE(PG8_SB(1, 1), b3 + hstepB, voffB); PG8_STAGE(PG8_SA(1, 0), a3, voffA);
            PG8_WAIT_V(8); PG8_WAIT_L(0); PG8_BAR; PG8_MMA(1, 0, At, B0); PG8_MMA(1, 1, At, B1); PG8_BAR; PG8_SCHED;
        }
        if (wr == 0) PG8_BAR;
        E(acc, cur, wr, wc, fr, fq, lds + STAGE_BYTES);
        if (!has_next) break;
#pragma unroll
        for (int a = 0; a < 2; ++a)
#pragma unroll
            for (int b = 0; b < 2; ++b)
#pragma unroll
                for (int m = 0; m < 4; ++m)
#pragma unroll
                    for (int n = 0; n < 2; ++n) acc[a][b][m][n] = (f32x4){0.f, 0.f, 0.f, 0.f};
        cur = nxt; cA = nA; cB = nB; ++ui;
        if (wr == 1) PG8_BAR;
    }
    PG8_WAIT_V(0);
    PG8_BAR;
#undef PG8_SA
#undef PG8_SB
#undef PG8_STAGE
#undef PG8_LDA
#undef PG8_LDB
#undef PG8_MMA
#undef PG8_WAIT_V
#undef PG8_WAIT_L
#undef PG8_BAR
#undef PG8_SCHED
}
}

#define XB_TMO      128
#define XB_XCNT(j)  (256  + 64 * (j))
#define XB_XSUB(j)  (1280 + 64 * (j))
#define XB_XGEN(j)  (2304 + 64 * (j))
#define XB_TOP      3328
#define XB_TOPGEN   3392
#define XCD_BAR_WORDS 3456
#define XB_SPIN_CAP (1u << 22)

__device__ __forceinline__ unsigned xb_ld(unsigned* p)              { return __hip_atomic_load(p, __ATOMIC_RELAXED, __HIP_MEMORY_SCOPE_AGENT); }
__device__ __forceinline__ unsigned xb_add(unsigned* p, unsigned v) { return __hip_atomic_fetch_add(p, v, __ATOMIC_RELAXED, __HIP_MEMORY_SCOPE_AGENT); }
__device__ __forceinline__ unsigned xb_xcc_id() { return (unsigned)__builtin_amdgcn_s_getreg((3 << 11) | 20) & 0xFu; }
#define XB_SPIN(cond, bar) do { unsigned _sp = 0; while (cond) { __builtin_amdgcn_s_sleep(1); \
    if ((++_sp & 255u) == 0u) { if (xb_ld(&(bar)[XB_TMO])) break; if (_sp > XB_SPIN_CAP) { atomicAdd(&(bar)[XB_TMO], 1u); break; } } } } while (0)

struct XcdBarrier { unsigned* bar; unsigned x; volatile LAS unsigned* st; };

__device__ __forceinline__ XcdBarrier xcd_barrier_post(unsigned* bar, volatile LAS unsigned* st) {
    XcdBarrier b; b.bar = bar; b.x = xb_xcc_id(); b.st = st;
    if (threadIdx.x == 0) (void)xb_add(&bar[XB_XCNT(b.x)], 1u);
    return b;
}
__device__ __forceinline__ void xcd_barrier_complete(unsigned* bar, unsigned x, unsigned& nloc, unsigned& nx) {
    const unsigned G = gridDim.x * gridDim.y * gridDim.z;
    unsigned sum, cnt, mine, sp = 0u;
    for (;;) {
        sum = 0u; cnt = 0u; mine = 0u;
#pragma unroll
        for (unsigned j = 0; j < 16; ++j) { const unsigned c = xb_ld(&bar[XB_XCNT(j)]); sum += c; cnt += (c > 0u) ? 1u : 0u; mine = (j == x) ? c : mine; }
        if (sum == G) break;
        __builtin_amdgcn_s_sleep(1);
        if ((++sp & 255u) == 0u) { if (xb_ld(&bar[XB_TMO])) break; if (sp > XB_SPIN_CAP) { atomicAdd(&bar[XB_TMO], 1u); break; } }
    }
    nloc = mine > 0u ? mine : 1u; nx = cnt > 0u ? cnt : 1u;
}
__device__ __forceinline__ void xcd_barrier(const XcdBarrier& b) {
    asm volatile("s_waitcnt vmcnt(0)" ::: "memory");
    __syncthreads();
    if (threadIdx.x == 0) {
        unsigned* bar = b.bar; unsigned bx_ = b.x; asm volatile("" : "+s"(bar), "+s"(bx_));
        __builtin_amdgcn_s_waitcnt(0);
        unsigned nloc = b.st[0], nx = b.st[1];
        if (nloc == 0u) { xcd_barrier_complete(bar, bx_, nloc, nx); b.st[0] = nloc; b.st[1] = nx; }
        const unsigned old = xb_add(&bar[XB_XSUB(bx_)], 1u);
        const unsigned gen = old / nloc;
        if (old + 1u == (gen + 1u) * nloc) {
            __builtin_amdgcn_fence(__ATOMIC_RELEASE, "agent");
            asm volatile("s_waitcnt vmcnt(0)" ::: "memory");
            const unsigned og = xb_add(&bar[XB_TOP], 1u);
            const unsigned tg = og / nx;
            if (og + 1u == (tg + 1u) * nx) xb_add(&bar[XB_TOPGEN], 1u);
            else XB_SPIN(xb_ld(&bar[XB_TOPGEN]) == tg, bar);
            __builtin_amdgcn_fence(__ATOMIC_ACQUIRE, "agent");
            xb_add(&bar[XB_XGEN(bx_)], 1u);
            asm volatile("s_waitcnt vmcnt(0)" ::: "memory");
        } else {
            XB_SPIN(xb_ld(&bar[XB_XGEN(bx_)]) == gen, bar);
            __builtin_amdgcn_fence(__ATOMIC_ACQUIRE, "agent");
            asm volatile("s_waitcnt vmcnt(0)" ::: "memory");
        }
    }
    __syncthreads();
}

namespace att {
constexpr int NW = 8, QBLK = 32, KVBLK = 64;
constexpr float THR2 = 8.f * LOG2E;
enum { K_MEM = 0, K_FOX = 1, K_MLA = 2, K_DIL = 3, K_DSA = 4 };
constexpr int L_V = 0, L_K = 49152, L_XB = 100352, L_TBL = 106496, L_END = 141312, VB = 16384;

struct AP {
    const bf16_t* Q; const bf16_t* K; const bf16_t* V; bf16_t* O;
    long qs, ks, vs, os;
    int kt0, nt;
    int q0;
    float C;
    const float* cum; long cums;
    const u64* msk;
    float* ost; long osts;
    float* mst; long msts;
    int carry_in, carry_out;
    const float* t5; int head, dil;
};

#define ATT_SBAR() __builtin_amdgcn_sched_barrier(0)
__device__ __forceinline__ int crow(int r, int hi) { return (r & 3) + 8 * (r >> 2) + 4 * hi; }
__device__ __forceinline__ int t5_bucket(int dist) {
    const int n = dist < 0 ? 0 : dist; if (n < 16) return n;
    const float v = __log2f((float)n * 0.0625f) * (16.0f / 7.0f); int b = 16 + (int)v; return b > 31 ? 31 : b;
}
__device__ __forceinline__ void rowmax_decide(const f32x16& p0, const f32x16& p1, float& m_reg, float& alpha) {
    float pmax = p0[0];
#pragma unroll
    for (int r = 1; r < 16; ++r) pmax = fmaxf(pmax, p0[r]);
#pragma unroll
    for (int r = 0; r < 16; ++r) pmax = fmaxf(pmax, p1[r]);
    { auto rr = __builtin_amdgcn_permlane32_swap(__float_as_uint(pmax), __float_as_uint(pmax), false, false); pmax = fmaxf(__uint_as_float(rr[0]), __uint_as_float(rr[1])); }
    if (__builtin_expect(__all(pmax - m_reg <= THR2), 1)) { alpha = 1.f; }
    else { const float mn = fmaxf(m_reg, pmax); alpha = __builtin_amdgcn_exp2f(m_reg - mn); m_reg = mn; }
}
__device__ __forceinline__ float half_sum(float ps) {
    auto rr = __builtin_amdgcn_permlane32_swap(__float_as_uint(ps), __float_as_uint(ps), false, false); return __uint_as_float(rr[0]) + __uint_as_float(rr[1]);
}
__device__ __forceinline__ void pack_p(const f32x16& p0, const f32x16& p1, bf16x8& pa0, bf16x8& pa1, bf16x8& pa2, bf16x8& pa3) {
#define ATT_PK4(P, BASE, OUT) do { unsigned a0 = cvt_pk_bf16(P[BASE + 0], P[BASE + 1]), a1 = cvt_pk_bf16(P[BASE + 2], P[BASE + 3]);   \
    unsigned b0 = cvt_pk_bf16(P[BASE + 4], P[BASE + 5]), b1 = cvt_pk_bf16(P[BASE + 6], P[BASE + 7]);                              \
    auto r0 = __builtin_amdgcn_permlane32_swap(a0, b0, false, false); auto r1 = __builtin_amdgcn_permlane32_swap(a1, b1, false, false); \
    u32x4 w = {r0[0], r1[0], r0[1], r1[1]}; OUT = __builtin_bit_cast(bf16x8, w); } while (0)
    ATT_PK4(p0, 0, pa0); ATT_PK4(p0, 8, pa1); ATT_PK4(p1, 0, pa2); ATT_PK4(p1, 8, pa3);
#undef ATT_PK4
}
template <int DK, int NQL>
__device__ __forceinline__ void qkt(f32x16& p0, f32x16& p1, const LAS unsigned char* Ks, const int (&kad)[4], const bf16x8* qr, const LAS unsigned char* qsp) {
    p0 = f32x16{}; p1 = f32x16{};
    constexpr int ND = DK / 16, NQR = ND - NQL;
#define ATT_LDK(d, hf) (*(const LAS bf16x8*)(Ks + ((DK == 128) ? (kad[(d) & 3] ^ (((d) >> 2) ? 128 : 0)) : (kad[(d) & 3] + 128 * ((d) >> 2))) + (hf) * 32 * DK * 2))
#define ATT_LDQ(d) (((d) < NQR) ? qr[(d) < NQR ? (d) : 0] : *(const LAS bf16x8*)(qsp + ((d) - NQR) * 1024))
    bf16x8 b0 = ATT_LDK(0, 0), b1 = ATT_LDK(0, 1), qf = ATT_LDQ(0);
#pragma unroll
    for (int d0 = 0; d0 < ND; ++d0) {
        bf16x8 c0 = b0, c1 = b1, qn = qf;
        if (d0 + 1 < ND) { c0 = ATT_LDK(d0 + 1, 0); c1 = ATT_LDK(d0 + 1, 1); qn = ATT_LDQ(d0 + 1); }
        ATT_SBAR();
        p0 = __builtin_amdgcn_mfma_f32_32x32x16_bf16(b0, qf, p0, 0, 0, 0);
        p1 = __builtin_amdgcn_mfma_f32_32x32x16_bf16(b1, qf, p1, 0, 0, 0);
        ATT_SBAR();
        b0 = c0; b1 = c1; qf = qn; }
#undef ATT_LDK
#undef ATT_LDQ
}
__device__ __forceinline__ int v_st(int k, int c) { const int kk = (k & ~0xC) | ((k & 4) << 1) | ((k & 8) >> 1); return ((kk >> 3) * 4 + (c >> 5)) * 512 + ((kk & 7) * 32 + (c & 31)) * 2; }
__device__ __forceinline__ int v_rd_base(int lane) { return ((lane & 3) << 3) | (((lane >> 2) & 3) << 6) | (((lane >> 4) & 1) << 5) | (((lane >> 5) & 1) << 8); }
constexpr int v_rd_off(int d0, int ks, int half) { return d0 * 512 + ks * 4096 + half * 2048; }
template <int OFF> __device__ __forceinline__ s16x4 tr_read(int vb) { s16x4 r; asm volatile("ds_read_b64_tr_b16 %0, %1 offset:%2" : "=&v"(r) : "v"(vb), "i"(OFF) : "memory"); return r; }
struct VF { s16x4 l0, h0, l1, h1, l2, h2, l3, h3; };
template <int D0> __device__ __forceinline__ void pv_read(VF& f, int vb) {
    f.l0 = tr_read<v_rd_off(D0, 0, 0)>(vb); f.h0 = tr_read<v_rd_off(D0, 0, 1)>(vb); f.l1 = tr_read<v_rd_off(D0, 1, 0)>(vb); f.h1 = tr_read<v_rd_off(D0, 1, 1)>(vb);
    f.l2 = tr_read<v_rd_off(D0, 2, 0)>(vb); f.h2 = tr_read<v_rd_off(D0, 2, 1)>(vb); f.l3 = tr_read<v_rd_off(D0, 3, 0)>(vb); f.h3 = tr_read<v_rd_off(D0, 3, 1)>(vb);
}
#define ATT_VWAIT(n, f) asm volatile("s_waitcnt lgkmcnt(" #n ")" : "+v"(f.l0), "+v"(f.h0), "+v"(f.l1), "+v"(f.h1), "+v"(f.l2), "+v"(f.h2), "+v"(f.l3), "+v"(f.h3) :: "memory")
#define ATT_PK(L, H) (bf16x8){L[0], L[1], L[2], L[3], H[0], H[1], H[2], H[3]}
__device__ __forceinline__ void pv_only(f32x16* o, int vb, bf16x8 pa0, bf16x8 pa1, bf16x8 pa2, bf16x8 pa3) {
    VF fa, fb;
#define ATT_MMA4(od, f) do { od = __builtin_amdgcn_mfma_f32_32x32x16_bf16(pa0, ATT_PK(f.l0, f.h0), od, 0, 0, 0); od = __builtin_amdgcn_mfma_f32_32x32x16_bf16(pa1, ATT_PK(f.l1, f.h1), od, 0, 0, 0); \
        od = __builtin_amdgcn_mfma_f32_32x32x16_bf16(pa2, ATT_PK(f.l2, f.h2), od, 0, 0, 0); od = __builtin_amdgcn_mfma_f32_32x32x16_bf16(pa3, ATT_PK(f.l3, f.h3), od, 0, 0, 0); } while (0)
    pv_read<0>(fa, vb); pv_read<1>(fb, vb);
    ATT_VWAIT(8, fa); ATT_SBAR(); ATT_MMA4(o[0], fa); ATT_SBAR(); pv_read<2>(fa, vb);
    ATT_VWAIT(8, fb); ATT_SBAR(); ATT_MMA4(o[1], fb); ATT_SBAR(); pv_read<3>(fb, vb);
    ATT_VWAIT(8, fa); ATT_SBAR(); ATT_MMA4(o[2], fa); ATT_SBAR();
    ATT_VWAIT(0, fb); ATT_SBAR(); ATT_MMA4(o[3], fb);
#undef ATT_MMA4
}
__device__ __forceinline__ float sm_only(f32x16& p0, f32x16& p1, float m) {
    float s = 0.f;
#pragma unroll
    for (int r = 0; r < 16; ++r) { p0[r] = __builtin_amdgcn_exp2f(p0[r] - m); s += p0[r]; }
#pragma unroll
    for (int r = 0; r < 16; ++r) { p1[r] = __builtin_amdgcn_exp2f(p1[r] - m); s += p1[r]; }
    return s;
}
__device__ __forceinline__ float pv_sm(f32x16* o, int vb, bf16x8 pa0, bf16x8 pa1, bf16x8 pa2, bf16x8 pa3, f32x16& p0, f32x16& p1, float m) {
    VF fa, fb; float s = 0.f;
#define ATT_GAP(od, pa, L, H, X, B) do { od = __builtin_amdgcn_mfma_f32_32x32x16_bf16(pa, ATT_PK(L, H), od, 0, 0, 0); \
        { float t0_ = X[B] - m, t1_ = X[B + 1] - m, e0_, e1_; asm volatile("v_exp_f32 %0, %1" : "=v"(e0_) : "v"(t0_)); asm volatile("v_exp_f32 %0, %1" : "=v"(e1_) : "v"(t1_));     \
          X[B] = e0_; X[B + 1] = e1_; s += e0_; s += e1_; } ATT_SBAR(); } while (0)
    pv_read<0>(fa, vb); pv_read<1>(fb, vb);
    ATT_VWAIT(8, fa); ATT_SBAR();
    ATT_GAP(o[0], pa0, fa.l0, fa.h0, p0, 0); ATT_GAP(o[0], pa1, fa.l1, fa.h1, p0, 2); ATT_GAP(o[0], pa2, fa.l2, fa.h2, p0, 4); ATT_GAP(o[0], pa3, fa.l3, fa.h3, p0, 6);
    pv_read<2>(fa, vb); ATT_VWAIT(8, fb); ATT_SBAR();
    ATT_GAP(o[1], pa0, fb.l0, fb.h0, p0, 8); ATT_GAP(o[1], pa1, fb.l1, fb.h1, p0, 10); ATT_GAP(o[1], pa2, fb.l2, fb.h2, p0, 12); ATT_GAP(o[1], pa3, fb.l3, fb.h3, p0, 14);
    pv_read<3>(fb, vb); ATT_VWAIT(8, fa); ATT_SBAR();
    ATT_GAP(o[2], pa0, fa.l0, fa.h0, p1, 0); ATT_GAP(o[2], pa1, fa.l1, fa.h1, p1, 2); ATT_GAP(o[2], pa2, fa.l2, fa.h2, p1, 4); ATT_GAP(o[2], pa3, fa.l3, fa.h3, p1, 6);
    ATT_VWAIT(0, fb); ATT_SBAR();
    ATT_GAP(o[3], pa0, fb.l0, fb.h0, p1, 8); ATT_GAP(o[3], pa1, fb.l1, fb.h1, p1, 10); ATT_GAP(o[3], pa2, fb.l2, fb.h2, p1, 12); ATT_GAP(o[3], pa3, fb.l3, fb.h3, p1, 14);
#undef ATT_GAP
    return s;
}

template <int KIND>
__device__ __forceinline__ void score(f32x16& p0, f32x16& p1, const AP& a, int t, int buf, LAS unsigned char* lds, int wid, int r32, int hi, float cq) {
    const float C = a.C; const int k0 = t * 64; const int q = a.q0 + wid * 32 + r32; const float NEG = -INFINITY;
    if constexpr (KIND == K_FOX) {
        const LAS f32x4* cb = (const LAS f32x4*)(lds + L_XB + buf * 2048) + hi;
#pragma unroll
        for (int g = 0; g < 4; ++g) { const f32x4 c4 = cb[2 * g], c4b = cb[2 * g + 8];
#pragma unroll
            for (int j = 0; j < 4; ++j) { p0[4 * g + j] = fmaf(p0[4 * g + j], C, cq - c4[j]); p1[4 * g + j] = fmaf(p1[4 * g + j], C, cq - c4b[j]); } }
    } else if constexpr (KIND == K_DSA || KIND == K_DIL) {
        const LAS float* tb = (const LAS float*)(lds + L_TBL) + (q - k0 - 4 * hi + 256 - 59);
#pragma unroll
        for (int r = 0; r < 16; ++r) { const int cc = (r & 3) + 8 * (r >> 2); p0[r] = fmaf(p0[r], C, tb[59 - cc]); p1[r] = fmaf(p1[r], C, tb[59 - cc - 32]); }
        if constexpr (KIND == K_DSA) {
            const LAS unsigned* mb = (const LAS unsigned*)(lds + L_XB + buf * 2048) + wid * 64;
            const unsigned wl = mb[r32] >> (4 * hi), wh = mb[32 + r32] >> (4 * hi);
#pragma unroll
            for (int r = 0; r < 16; ++r) { const int cc = (r & 3) + 8 * (r >> 2); p0[r] = ((wl >> cc) & 1u) ? p0[r] : NEG; p1[r] = ((wh >> cc) & 1u) ? p1[r] : NEG; }
        }
    } else {
#pragma unroll
        for (int r = 0; r < 16; ++r) { p0[r] *= C; p1[r] *= C; }
    }
    if constexpr (KIND == K_FOX || KIND == K_MLA) {
        if (k0 + 63 > a.q0) {
            const int kb = k0 + 4 * hi;
#pragma unroll
            for (int r = 0; r < 16; ++r) { const int kv = kb + (r & 3) + 8 * (r >> 2); if (kv > q) p0[r] = NEG; if (kv + 32 > q) p1[r] = NEG; }
        }
    }
}

template <int KIND, int DK>
__device__ __forceinline__ void attn_unit(LAS unsigned char* lds, const AP& a, const int wave_id) {
    const int tid = tid_opaque(wave_id);
    const int lane = tid & 63, r32 = lane & 31, hi = lane >> 5; const int wid = __builtin_amdgcn_readfirstlane(tid >> 6);
    constexpr bool HAS_TBL = (KIND == K_DSA || KIND == K_DIL), HAS_X = (KIND == K_FOX || KIND == K_DSA);
    constexpr int KB = KVBLK * DK * 2, NKC = DK / 8, NKL = (64 * NKC) / 512, ND0 = DK / 16;
    constexpr int NQL = (DK == 192) ? 2 : (HAS_TBL ? 2 : 4), NQR = ND0 - NQL, NLD = NKL + 2 + (HAS_X ? 1 : 0);
    constexpr int LWS = (DK == 192) ? 122880 : 98304, LQSP = (DK == 192) ? 124928 : (HAS_TBL ? 123904 : 106496);
    LAS unsigned char* V_lds = lds + L_V; LAS unsigned char* K_lds = lds + L_K;
    LAS float* wsf = (LAS float*)(lds + LWS) + wid * 64; LAS float* li_l = wsf; LAS float* al_l = wsf + 32;
    LAS unsigned char* qsp = lds + LQSP + wid * (NQL * 1024) + lane * 16;
    float m_reg = -1e30f, l_reg = 0.f; f32x16 o[4] = {}; bf16x8 qr[NQR];
    const int qi = wid * 32 + r32;
    const bf16_t* Qw = a.Q + (long)qi * a.qs + hi * 8;
#pragma unroll
    for (int d0 = 0; d0 < ND0; ++d0) { const bf16x8 qv = *(const bf16x8*)(Qw + d0 * 16); if (d0 < NQR) qr[d0 < NQR ? d0 : 0] = qv; else *(LAS bf16x8*)(qsp + (d0 - NQR) * 1024) = qv; }
    float cq = 0.f;
    if constexpr (KIND == K_FOX) cq = a.cum[(long)(a.q0 + qi) * a.cums];
    if constexpr (KIND == K_DIL) {
        if (a.carry_in) {
            m_reg = a.mst[(long)qi * a.msts]; l_reg = a.mst[(long)qi * a.msts + 1];
#pragma unroll
            for (int r = 0; r < 16; ++r) { const float* orow = a.ost + (long)(wid * 32 + crow(r, hi)) * a.osts + r32;
#pragma unroll
                for (int d0 = 0; d0 < 4; ++d0) o[d0][r] = orow[d0 * 32]; }
        }
    }
    if constexpr (KIND == K_DSA) {
        LAS float* tbl = (LAS float*)(lds + L_TBL);
        for (int i = tid; i < 4352; i += 512) { const int dist = i - 256; tbl[i] = dist < 0 ? -INFINITY : a.t5[t5_bucket(dist) * 16 + a.head] * LOG2E; }
    }
    if constexpr (KIND == K_DIL) {
        LAS float* tbl = (LAS float*)(lds + L_TBL);
        for (int i = tid; i < 640; i += 512) { const int rel = i - 256; tbl[i] = (rel < 0 || rel > 128) ? -INFINITY : a.t5[t5_bucket(rel * a.dil) * 16 + a.head] * LOG2E; }
    }
    int ksrc[NKL], vsrc[2];
#pragma unroll
    for (int c = 0; c < NKL; ++c) { const int Lb = (wid * NKL + c) * 1024 + lane * 16, row = Lb / (DK * 2), chp = (Lb % (DK * 2)) / 16; ksrc[c] = row * (int)a.ks + ((DK == 128) ? (chp ^ (row & 15)) : ((chp & ~7) | ((chp & 7) ^ (row & 7)))) * 8; }
#pragma unroll
    for (int c = 0; c < 2; ++c) { const int sl = (2 * wid + c) * 64 + lane, st = sl >> 5, wi = sl & 31, kk = ((st >> 2) << 3) | (wi >> 2), k = (kk & ~0xC) | ((kk & 4) << 1) | ((kk & 8) >> 1); vsrc[c] = k * (int)a.vs + (st & 3) * 32 + (wi & 3) * 8; }
    const int vb0 = (int)(unsigned)(uintptr_t)V_lds + v_rd_base(lane);
    int kad[4];
#pragma unroll
    for (int j = 0; j < 4; ++j) kad[j] = r32 * (DK * 2) + (((hi | (j << 1)) ^ (r32 & 7)) << 4) + ((DK == 128) ? 128 * ((r32 >> 3) & 1) : 0);
#define ATT_DMA(t, sl) do { const long kb_ = (long)(t) * 64; \
        _Pragma("unroll") for (int c_ = 0; c_ < NKL; ++c_) __builtin_amdgcn_global_load_lds((const unsigned*)(a.K + kb_ * a.ks + ksrc[c_]), (LAS unsigned*)(K_lds + (sl) * KB + (wid * NKL + c_) * 1024), 16, 0, 0); \
        _Pragma("unroll") for (int c_ = 0; c_ < 2; ++c_) __builtin_amdgcn_global_load_lds((const unsigned*)(a.V + kb_ * a.vs + vsrc[c_]), (LAS unsigned*)(V_lds + (sl) * VB + (2 * wid + c_) * 1024), 16, 0, 0); \
        if constexpr (KIND == K_FOX) __builtin_amdgcn_global_load_lds((const unsigned*)(a.cum + (kb_ + lane) * a.cums), (LAS unsigned*)(lds + L_XB + (sl) * 2048), 4, 0, 0);     \
        if constexpr (KIND == K_DSA) __builtin_amdgcn_global_load_lds((const unsigned*)(a.msk + (long)(wid * 32 + r32) * 64 + (t)) + hi, (LAS unsigned*)(lds + L_XB + (sl) * 2048 + wid * 256), 4, 0, 0); } while (0)
#define ATT_RESC(al) do { if (__any((al) < 1.f)) { if (hi == 0) al_l[r32] = (al); asm volatile("s_waitcnt lgkmcnt(0)" ::: "memory"); \
        _Pragma("unroll") for (int d = 0; d < 4; ++d) _Pragma("unroll") for (int r = 0; r < 16; ++r) o[d][r] *= al_l[crow(r, hi)]; } } while (0)
#define ATT_BAR() do { asm volatile("s_waitcnt lgkmcnt(0)" ::: "memory"); __builtin_amdgcn_s_barrier(); asm volatile("" ::: "memory"); } while (0)
    f32x16 p0, p1; float al = 1.f; bf16x8 pa0, pa1, pa2, pa3; const int NT = a.nt, T0 = a.kt0;
    asm volatile("s_waitcnt vmcnt(0) lgkmcnt(0)" ::: "memory");
    ATT_DMA(T0, 0);
    if (NT > 1) { ATT_DMA(T0 + 1, 1); asm volatile("s_waitcnt vmcnt(%0)" :: "n"(NLD) : "memory"); } else { asm volatile("s_waitcnt vmcnt(0)" ::: "memory"); }
    ATT_BAR();
    int sl = 0, sl2 = 2;
    for (int jj = 0; jj < NT; ++jj) {
        const int t = T0 + jj;
        if (jj + 2 < NT) ATT_DMA(t + 2, sl2);
        bool lv = true; { const int k0_ = t * 64, qw_ = a.q0 + wid * 32;
            if constexpr (KIND == K_FOX || KIND == K_MLA || KIND == K_DSA) lv = k0_ <= qw_ + 31;
            if constexpr (KIND == K_DIL) lv = (k0_ <= qw_ + 31) && (k0_ + 63 >= qw_ - 128); }
        if (lv) {
            ATT_SBAR(); qkt<DK, NQL>(p0, p1, K_lds + sl * KB, kad, qr, qsp);
            score<KIND>(p0, p1, a, t, sl, lds, wid, r32, hi, cq);
            rowmax_decide(p0, p1, m_reg, al);
            const float ps = sm_only(p0, p1, m_reg);
            l_reg = l_reg * al + half_sum(ps);
            ATT_RESC(al);
            pack_p(p0, p1, pa0, pa1, pa2, pa3); ATT_SBAR();
            pv_only(o, vb0 + sl * VB, pa0, pa1, pa2, pa3);
        }
        if (jj + 2 < NT) asm volatile("s_waitcnt vmcnt(%0)" :: "n"(NLD) : "memory"); else asm volatile("s_waitcnt vmcnt(0)" ::: "memory");
        ATT_BAR();
        sl = (sl == 2) ? 0 : sl + 1; sl2 = (sl2 == 2) ? 0 : sl2 + 1;
    }
    bool stateout = false;
    if constexpr (KIND == K_DIL) stateout = a.carry_out != 0;
    if (stateout) {
        int qi2 = qi; asm volatile("" : "+v"(qi2));
        if (hi == 0) { a.mst[(long)qi2 * a.msts] = m_reg; a.mst[(long)qi2 * a.msts + 1] = l_reg; }
#pragma unroll
        for (int r = 0; r < 16; ++r) { float* orow = a.ost + (long)(wid * 32 + crow(r, hi)) * a.osts + r32;
#pragma unroll
            for (int d0 = 0; d0 < 4; ++d0) orow[d0 * 32] = o[d0][r]; }
        __syncthreads();
    } else {
        if (hi == 0) li_l[r32] = l_reg;
        asm volatile("s_waitcnt lgkmcnt(0)" ::: "memory");
        float rli[16];
#pragma unroll
        for (int r = 0; r < 16; ++r) rli[r] = __builtin_amdgcn_rcpf(li_l[crow(r, hi)]);
        __syncthreads();
        LAS unsigned short* ost = (LAS unsigned short*)(lds + wid * 8192);
#pragma unroll
        for (int r = 0; r < 16; ++r) { const int orow = crow(r, hi);
#pragma unroll
            for (int d0 = 0; d0 < 4; ++d0) { const unsigned w = cvt_pk_bf16(o[d0][r] * rli[r], 0.f); ost[orow * 128 + d0 * 32 + r32] = (unsigned short)w; } }
        asm volatile("s_waitcnt lgkmcnt(0)" ::: "memory");
#pragma unroll
        for (int i = 0; i < 8; ++i) { const int ch = lane + 64 * i, row = ch >> 4, c16 = ch & 15;
            const u32x4 v = *(const LAS u32x4*)(lds + wid * 8192 + row * 256 + c16 * 16);
            *(u32x4*)(a.O + (long)(wid * 32 + row) * a.os + c16 * 8) = v; }
        __syncthreads();
    }
#undef ATT_DMA
#undef ATT_RESC
#undef ATT_BAR
}
#undef ATT_VWAIT
#undef ATT_PK
}

struct Fr { LAS unsigned char* lds; int tid, lane, wave, vcu, G, gw, ngw; };

__device__ __forceinline__ float wave_sum(float v) {
#pragma unroll
    for (int o = 1; o < 64; o <<= 1) v += __shfl_xor(v, o);
    return v;
}
__device__ __forceinline__ void unpack8(const u32x4 w, float (&v)[8]) {
    v[0] = bf_lo(w.x); v[1] = bf_hi(w.x); v[2] = bf_lo(w.y); v[3] = bf_hi(w.y); v[4] = bf_lo(w.z); v[5] = bf_hi(w.z); v[6] = bf_lo(w.w); v[7] = bf_hi(w.w);
}
__device__ __forceinline__ u32x4 pack8(const float (&v)[8]) {
    u32x4 w; w.x = cvt_pk_bf16(v[0], v[1]); w.y = cvt_pk_bf16(v[2], v[3]); w.z = cvt_pk_bf16(v[4], v[5]); w.w = cvt_pk_bf16(v[6], v[7]); return w;
}
__device__ __forceinline__ float sumsq8(const float (&v)[8]) { return ((v[0] * v[0] + v[1] * v[1]) + (v[2] * v[2] + v[3] * v[3])) + ((v[4] * v[4] + v[5] * v[5]) + (v[6] * v[6] + v[7] * v[7])); }

__device__ __forceinline__ int map_col(int kind, int n) {
    switch (kind) {
        case 1: return 256 * (n >> 7) + (n & 127);
        case 2: return 256 * (n >> 7) + 128 + (n & 127);
        case 3: return n < 6144 ? n : (n < 6160 ? 6656 + (n - 6144) : 6144 + (n - 6160));
        case 4: return n < 1088 ? n : 1280 + (n - 1088);
        case 5: return n < 6144 ? n : (n < 18432 ? n + 512 : 6144 + (n - 18432));
        case 6: return n < 4176 ? n : 4352 + (n - 4176);
        default: return n;
    }
}
struct TrDesc { const float* W; const float* gain; bf16_t* WT; int K, N, ldt, kind, r, f8; };
__device__ __forceinline__ void tr_load(const TrDesc& d, int lane, f32x4 (&v)[16]) {
    const int nblk = (d.N + 63) / 64, kb = d.r / nblk, nb = d.r % nblk, k0 = 64 * kb, n = 64 * nb + 4 * (lane & 15); const bool ok = n < d.N;
    const float* src = d.W + (size_t)(k0 + (lane >> 4)) * d.N + (ok ? n : 0); const size_t rs = (size_t)4 * d.N;
#pragma unroll
    for (int j = 0; j < 16; ++j) v[j] = __builtin_nontemporal_load((const f32x4*)(src + (size_t)j * rs));
}
__device__ __forceinline__ void tr_store(const TrDesc& d, int lane, const f32x4 (&v)[16], LAS float* scr) {
    const int nblk = (d.N + 63) / 64, kb = d.r / nblk, nb = d.r % nblk, k0 = 64 * kb, n0 = 64 * nb;
    { LAS float* w = scr + (lane >> 4) * 65 + 4 * (lane & 15);
#pragma unroll
      for (int j = 0; j < 16; ++j) { w[j * 260 + 0] = v[j][0]; w[j * 260 + 1] = v[j][1]; w[j * 260 + 2] = v[j][2]; w[j * 260 + 3] = v[j][3]; } }
    const int c = lane >> 3, nn = lane & 7; float g[8];
#pragma unroll
    for (int jj = 0; jj < 8; ++jj) g[jj] = d.gain ? d.gain[k0 + 8 * c + jj] : 1.f;
    asm volatile("s_waitcnt lgkmcnt(0)" ::: "memory");
#pragma unroll
    for (int it = 0; it < 8; ++it) { const int nl = nn + 8 * it; const LAS float* rp = scr + (8 * c) * 65 + nl;
        u32x4 o; o.x = cvt_pk_bf16(rp[0 * 65] * g[0], rp[1 * 65] * g[1]); o.y = cvt_pk_bf16(rp[2 * 65] * g[2], rp[3 * 65] * g[3]); o.z = cvt_pk_bf16(rp[4 * 65] * g[4], rp[5 * 65] * g[5]); o.w = cvt_pk_bf16(rp[6 * 65] * g[6], rp[7 * 65] * g[7]);
        if (n0 + nl < d.N) {
            if (d.f8) { int q0 = __builtin_amdgcn_cvt_pk_fp8_f32(rp[0 * 65] * g[0] * 64.f, rp[1 * 65] * g[1] * 64.f, 0, false); q0 = __builtin_amdgcn_cvt_pk_fp8_f32(rp[2 * 65] * g[2] * 64.f, rp[3 * 65] * g[3] * 64.f, q0, true);
                        int q1 = __builtin_amdgcn_cvt_pk_fp8_f32(rp[4 * 65] * g[4] * 64.f, rp[5 * 65] * g[5] * 64.f, 0, false); q1 = __builtin_amdgcn_cvt_pk_fp8_f32(rp[6 * 65] * g[6] * 64.f, rp[7 * 65] * g[7] * 64.f, q1, true);
                        *(u32x2*)((unsigned char*)d.WT + (size_t)map_col(d.kind, n0 + nl) * d.ldt + k0 + 8 * c) = (u32x2){(unsigned)q0, (unsigned)q1}; }
            else *(u32x4*)(d.WT + (size_t)map_col(d.kind, n0 + nl) * d.ldt + k0 + 8 * c) = o; } }
    asm volatile("s_waitcnt lgkmcnt(0)" ::: "memory");
}

__device__ __forceinline__ void rows2048(const Fr& F, const float* x, int nrows, bf16_t* xb, void* out, int mode) {
    for (int m = F.gw; m < nrows; m += F.ngw) {
        const f32x4* xr = (const f32x4*)(x + (size_t)m * DM) + F.lane; f32x4 v[8]; float s = 0.f;
#pragma unroll
        for (int j = 0; j < 8; ++j) { v[j] = xr[64 * j]; s += (v[j].x * v[j].x + v[j].y * v[j].y) + (v[j].z * v[j].z + v[j].w * v[j].w); }
        s = wave_sum(s);
        if (F.lane == 0) { if (mode) ((float*)out)[m] = __builtin_amdgcn_rsqf(s * (1.0f / DM) + RMS_EPS); else ((u64*)out)[m] = (u64)(s * pg8::SSQ_SCALE); }
        if (xb) { u32x2* o8 = (u32x2*)(xb + (size_t)m * DM) + F.lane;
#pragma unroll
            for (int j = 0; j < 8; ++j) { u32x2 w; w.x = cvt_pk_bf16(v[j].x, v[j].y); w.y = cvt_pk_bf16(v[j].z, v[j].w); o8[64 * j] = w; } }
    }
}

__device__ __forceinline__ void hn_step(bf16_t* p, const float (&g)[8]) {
    float v[8]; unpack8(*(const u32x4*)p, v); float ss = sumsq8(v);
    ss += __shfl_xor(ss, 1); ss += __shfl_xor(ss, 2); ss += __shfl_xor(ss, 4); ss += __shfl_xor(ss, 8);
    const float rs = __builtin_amdgcn_rsqf(ss * (1.0f / 128.0f) + RMS_EPS);
#pragma unroll
    for (int j = 0; j < 8; ++j) v[j] = v[j] * rs * g[j];
    *(u32x4*)p = pack8(v);
}
__device__ __forceinline__ void load_gain8(const float* g, int lane, float (&o)[8]) {
#pragma unroll
    for (int j = 0; j < 8; ++j) o[j] = g ? g[(lane & 15) * 8 + j] : 1.f;
}
__device__ __forceinline__ void prep_rows(const Fr& F, bf16_t* P, long ld, int nrows, int c0, int n0, const float* g0, int c1, int n1, const float* g1, int c2, int n2, const float* g2) {
    float ga[8], gb[8], gc[8]; load_gain8(g0, F.lane, ga); load_gain8(g1, F.lane, gb); load_gain8(g2, F.lane, gc);
    for (int m = F.gw; m < nrows; m += F.ngw) {
        bf16_t* row = P + (size_t)m * ld + F.lane * 8;
        for (int s = 0; s < n0; ++s) hn_step(row + c0 + s * 512, ga);
        for (int s = 0; s < n1; ++s) hn_step(row + c1 + s * 512, gb);
        for (int s = 0; s < n2; ++s) hn_step(row + c2 + s * 512, gc);
    }
}

__device__ __forceinline__ void fox_cumsum(const Fr& F, const float* FG, const float* b_f, float* CUM) {
    for (int task = F.gw; task < NB * NH; task += F.ngw) {
        const int b = task >> 4, h = task & 15; const float bias = b_f[h];
        const float* src = FG + ((size_t)b * SEQ + (size_t)F.lane * 64) * 16 + h; float v[64]; float run = 0.f;
#pragma unroll
        for (int i = 0; i < 64; ++i) { const float xg = src[(size_t)i * 16] + bias;
            const float e = __expf(-fabsf(xg)); const float ls = fminf(xg, 0.f) - __logf(1.0f + e);
            run += ls; v[i] = run; }
        float incl = run;
#pragma unroll
        for (int o = 1; o < 64; o <<= 1) { const float t = __shfl_up(incl, o); if (F.lane >= o) incl += t; }
        const float excl = incl - run;
        float* dst = CUM + ((size_t)b * SEQ + (size_t)F.lane * 64) * 16 + h;
#pragma unroll
        for (int i = 0; i < 64; ++i) dst[(size_t)i * 16] = (v[i] + excl) * LOG2E;
    }
}

__device__ const double ROPE_INV[32] = {
    1.0, 0.7498942093324559, 0.5623413251903491, 0.4216965034285822, 0.31622776601683794, 0.23713737056616552, 0.1778279410038923, 0.1333521432163324,
    0.1, 0.07498942093324558, 0.05623413251903491, 0.04216965034285822, 0.03162277660168379, 0.023713737056616554, 0.01778279410038923, 0.01333521432163324,
    0.01, 0.007498942093324558, 0.005623413251903491, 0.004216965034285823, 0.0031622776601683794, 0.0023713737056616554, 0.001778279410038923, 0.001333521432163324,
    0.001, 0.0007498942093324559, 0.0005623413251903491, 0.0004216965034285823, 0.00031622776601683794, 0.00023713737056616554, 0.0001778279410038923, 0.0001333521432163324};
__device__ __forceinline__ void rope_table(const Fr& F, const int* pos, float* COS, float* SIN) {
    const int gt = F.vcu * 512 + F.tid, ngt = F.G * 512;
    for (int i = gt; i < MTOK * 32; i += ngt) { const int m = i >> 5, f = i & 31;
        const double a = (double)pos[m] * (double)(float)ROPE_INV[f]; const double rev = a * 0.15915494309189535; const float fr = (float)(rev - floor(rev));
        COS[i] = __builtin_amdgcn_cosf(fr); SIN[i] = __builtin_amdgcn_sinf(fr); }
}

__device__ __forceinline__ void mla_prep_a(const Fr& F, bf16_t* P, float* RSQ, float* RSKV, bf16_t* KR, const float* rope_g1, const float* gmem, const float* COS, const float* SIN) {
    const int lane = F.lane; float gr[8];
#pragma unroll
    for (int j = 0; j < 8; ++j) gr[j] = rope_g1[(lane & 7) * 8 + j];
    for (int m = F.gw; m < MTOK; m += F.ngw) {
        bf16_t* pr = P + (size_t)m * 1792; float v[8];
        const u32x4 wq = *(const u32x4*)(pr + lane * 8), wk = *(const u32x4*)(pr + 512 + lane * 8);
        u32x4 w = (u32x4){0u, 0u, 0u, 0u}; if (lane < 8) w = *(const u32x4*)(pr + 1024 + lane * 8);
        const float* cp = COS + (size_t)m * 32 + (lane & 3) * 8; const float* sp = SIN + (size_t)m * 32 + (lane & 3) * 8; float cs[8], sn[8];
#pragma unroll
        for (int j = 0; j < 8; ++j) { cs[j] = cp[j]; sn[j] = sp[j]; }
        asm volatile("" ::: "memory");
        unpack8(wq, v); float ss = wave_sum(sumsq8(v)); if (lane == 0) RSQ[m] = __builtin_amdgcn_rsqf(ss * (1.0f / 512.0f) + RMS_EPS);
        unpack8(wk, v); ss = wave_sum(sumsq8(v)); if (lane == 0) RSKV[m] = __builtin_amdgcn_rsqf(ss * (1.0f / 512.0f) + RMS_EPS);
        unpack8(w, v); ss = sumsq8(v); ss += __shfl_xor(ss, 1); ss += __shfl_xor(ss, 2); ss += __shfl_xor(ss, 4);
        const float rs = __builtin_amdgcn_rsqf(ss * (1.0f / 64.0f) + RMS_EPS); float o[8];
#pragma unroll
        for (int j = 0; j < 8; ++j) { const float x = v[j] * rs * gr[j]; const float y = __shfl_xor(x, 4); o[j] = (lane & 4) ? (y * sn[j] + x * cs[j]) : (x * cs[j] - y * sn[j]); }
        if (lane < 8) *(u32x4*)(KR + (size_t)m * 64 + lane * 8) = pack8(o);
    }
}
__device__ __forceinline__ void mla_prep_b(const Fr& F, bf16_t* Q, const bf16_t* KV, bf16_t* KF, const bf16_t* KR, const float* nope_g, const float* rope_g, const float* COS, const float* SIN) {
    const int lane = F.lane, half = lane >> 5, l5 = lane & 31; float gqn[8], gqr[8], gkn[8];
#pragma unroll
    for (int j = 0; j < 8; ++j) { gqn[j] = nope_g[(l5 & 15) * 8 + j]; gkn[j] = nope_g[128 + (l5 & 15) * 8 + j]; gqr[j] = rope_g[(l5 & 7) * 8 + j]; }
    for (int m = F.gw; m < MTOK; m += F.ngw) {
        const float* cp = COS + (size_t)m * 32 + (l5 & 3) * 8; const float* sp = SIN + (size_t)m * 32 + (l5 & 3) * 8; float cs[8], sn[8];
#pragma unroll
        for (int j = 0; j < 8; ++j) { cs[j] = cp[j]; sn[j] = sp[j]; }
        u32x4 krw = (u32x4){0u, 0u, 0u, 0u}; if (l5 >= 16 && l5 < 24) krw = *(const u32x4*)(KR + (size_t)m * 64 + (l5 - 16) * 8);
        u32x4 qw[8], kw[8];
#pragma unroll
        for (int it = 0; it < 8; ++it) { const int h = 2 * it + half;
            qw[it] = (u32x4){0u, 0u, 0u, 0u}; if (l5 < 24) qw[it] = *(const u32x4*)(Q + (size_t)m * 3072 + h * 192 + l5 * 8);
            kw[it] = (u32x4){0u, 0u, 0u, 0u}; if (l5 < 16) kw[it] = *(const u32x4*)(KV + (size_t)m * 4096 + h * 256 + l5 * 8); }
        asm volatile("" ::: "memory");
#pragma unroll
        for (int it = 0; it < 8; ++it) { const int h = 2 * it + half;
            bf16_t* qrow = Q + (size_t)m * 3072 + h * 192 + l5 * 8; float v[8];
            unpack8(qw[it], v); float s8 = sumsq8(v); s8 += __shfl_xor(s8, 1); s8 += __shfl_xor(s8, 2); s8 += __shfl_xor(s8, 4); const float s16 = s8 + __shfl_xor(s8, 8);
            const float rs = (l5 < 16) ? __builtin_amdgcn_rsqf(s16 * (1.0f / 128.0f) + RMS_EPS) : __builtin_amdgcn_rsqf(s8 * (1.0f / 64.0f) + RMS_EPS);
            float o[8];
#pragma unroll
            for (int j = 0; j < 8; ++j) { const float x = v[j] * rs * ((l5 < 16) ? gqn[j] : gqr[j]); const float y = __shfl_xor(x, 4);
                const float rot = (l5 & 4) ? (y * sn[j] + x * cs[j]) : (x * cs[j] - y * sn[j]); o[j] = (l5 < 16) ? x : rot; }
            if (l5 < 24) *(u32x4*)qrow = pack8(o);
            bf16_t* kfrow = KF + (size_t)m * 3072 + h * 192;
            unpack8(kw[it], v); float k16 = sumsq8(v); k16 += __shfl_xor(k16, 1); k16 += __shfl_xor(k16, 2); k16 += __shfl_xor(k16, 4); k16 += __shfl_xor(k16, 8);
            const float krs = __builtin_amdgcn_rsqf(k16 * (1.0f / 128.0f) + RMS_EPS);
#pragma unroll
            for (int j = 0; j < 8; ++j) o[j] = v[j] * krs * gkn[j];
            if (l5 < 16) *(u32x4*)(kfrow + l5 * 8) = pack8(o);
            else if (l5 < 24) *(u32x4*)(kfrow + 128 + (l5 - 16) * 8) = krw;
        }
    }
}

__device__ __forceinline__ void dsa_indexer(const Fr& F, const bf16_t* P, float* SC) {
    constexpr int LDP = 4864, CQI = 3072, CKI = 4096, CWI = 4160;
    const int lane = F.lane, r32 = lane & 31, hg = lane >> 5;
    for (int ui = blockIdx.x; ui < 512; ui += F.G) {
        const int c = ui & 255, second = ui >> 8, b = c >> 5, qb0 = c & 31, qb = second ? 63 - qb0 : qb0;
        const size_t tok0 = (size_t)b * SEQ + qb * 64 + F.wave * 8;
        bf16x8 aq[4][4]; float wv[4][16];
#pragma unroll
        for (int g = 0; g < 4; ++g) { const size_t tok = tok0 + 2 * g + (r32 >> 4); const bf16_t* qp = P + tok * LDP + CQI + (r32 & 15) * 64 + 8 * hg;
#pragma unroll
            for (int ks = 0; ks < 4; ++ks) aq[g][ks] = *(const bf16x8*)(qp + 16 * ks);
#pragma unroll
            for (int r = 0; r < 16; ++r) { const int head = (r & 3) + 8 * ((r >> 2) & 1) + 4 * hg; const size_t tq = tok0 + 2 * g + (r >> 3);
                wv[g][r] = bf_lo((unsigned)P[tq * LDP + CWI + head]) * (0.25f * 0.125f); } }
        const int ntile = 2 * (qb + 1);
        const bf16_t* kp = P + ((size_t)b * SEQ + r32) * LDP + CKI + 8 * hg;
        bf16x8 bk[4], bn[4];
#pragma unroll
        for (int ks = 0; ks < 4; ++ks) bk[ks] = *(const bf16x8*)(kp + 16 * ks);
        for (int t = 0; t < ntile; ++t) {
            if (t + 1 < ntile) {
#pragma unroll
                for (int ks = 0; ks < 4; ++ks) bn[ks] = *(const bf16x8*)(kp + (size_t)(t + 1) * 32 * LDP + 16 * ks);
            }
#pragma unroll
            for (int g = 0; g < 4; ++g) {
                f32x16 d = f32x16{};
#pragma unroll
                for (int ks = 0; ks < 4; ++ks) d = __builtin_amdgcn_mfma_f32_32x32x16_bf16(aq[g][ks], bk[ks], d, 0, 0, 0);
                float s0 = 0.f, s1 = 0.f;
#pragma unroll
                for (int r = 0; r < 8; ++r) { s0 = fmaf(wv[g][r], fmaxf(d[r], 0.f), s0); s1 = fmaf(wv[g][r + 8], fmaxf(d[r + 8], 0.f), s1); }
                auto rr = __builtin_amdgcn_permlane32_swap(__float_as_uint(s0), __float_as_uint(s1), false, false);
                const float tot = __uint_as_float(rr[0]) + __uint_as_float(rr[1]);
                SC[(tok0 + 2 * g + hg) * (size_t)SEQ + t * 32 + r32] = tot;
            }
#pragma unroll
            for (int ks = 0; ks < 4; ++ks) bk[ks] = bn[ks];
        }
    }
}

__device__ __forceinline__ void dsa_select(const Fr& F, const float* SC, u64* MSK) {
    const int lane = F.lane;
    for (int qidx = F.gw; qidx < MTOK; qidx += F.ngw) {
        const int s = qidx & (SEQ - 1); const float* row = SC + (size_t)qidx * SEQ; u64* mrow = MSK + (size_t)qidx * 64;
        if (s < 256) { const int lo = 64 * lane; u64 w = 0ull; if (s >= lo + 63) w = ~0ull; else if (s >= lo) w = (2ull << (s - lo)) - 1ull; mrow[lane] = w; continue; }
        unsigned u[64];
#pragma unroll
        for (int i = 0; i < 64; ++i) { unsigned ov = 0u;
            if (64 * i <= s) { const int key = 64 * i + lane; const unsigned bits = __float_as_uint(row[key]); const unsigned ord = (bits & 0x80000000u) ? ~bits : (bits | 0x80000000u); ov = (key <= s) ? ord : 0u; }
            u[i] = ov; }
        unsigned T = 0u;
        for (int bit = 31; bit >= 0; --bit) { const unsigned cand = T | (1u << bit); int cl = 0;
#pragma unroll
            for (int i0 = 0; i0 < 64; i0 += 8) {
#pragma unroll
                for (int i = i0; i < i0 + 8; ++i) cl += __popcll(__ballot(u[i] >= cand));
                __builtin_amdgcn_sched_barrier(0); }
            if (cl >= 256) T = cand; }
        int cgt = 0;
#pragma unroll
        for (int i0 = 0; i0 < 64; i0 += 8) {
#pragma unroll
            for (int i = i0; i < i0 + 8; ++i) cgt += __popcll(__ballot(u[i] > T));
            __builtin_amdgcn_sched_barrier(0); }
        int need = 256 - cgt; unsigned mlo = 0u, mhi = 0u;
#pragma unroll
        for (int i = 0; i < 64; ++i) { const u64 gt = __ballot(u[i] > T), eq = __ballot(u[i] == T); u64 take = 0ull;
            if (need > 0 && eq != 0ull) { const int c = __popcll(eq);
                if (c <= need) { take = eq; need -= c; }
                else { u64 e = eq; for (int n = 0; n < need; ++n) { const u64 low = e & (0ull - e); take |= low; e ^= low; } need = 0; } }
            const u64 w = gt | take; { const unsigned wl = __builtin_amdgcn_readfirstlane((unsigned)w), wh = __builtin_amdgcn_readfirstlane((unsigned)(w >> 32));
                asm volatile("s_nop 4\n\tv_writelane_b32 %0, %1, %2\n\ts_nop 1" : "+v"(mlo) : "s"(wl), "n"(i)); asm volatile("s_nop 4\n\tv_writelane_b32 %0, %1, %2\n\ts_nop 1" : "+v"(mhi) : "s"(wh), "n"(i)); } }
        mrow[lane] = ((u64)mhi << 32) | (u64)mlo;
    }
}

constexpr size_t MiB = 1u << 20;
constexpr size_t WS_CTL = 0, CTL_ZERO_BYTES = 8 * MiB;
constexpr int CW_BAR = 4096;
constexpr size_t WS_SSQ = 1 * MiB;
constexpr size_t WS_WB = 8 * MiB;
constexpr size_t WS_XB = 236 * MiB;
constexpr size_t WS_MEMB = 364 * MiB;
constexpr size_t WS_MEMKV = 372 * MiB;
constexpr size_t WS_COS = 388 * MiB, WS_SIN = 392 * MiB, WS_RSMEM = 396 * MiB, WS_RSQ = 397 * MiB, WS_RSKV = 398 * MiB;
constexpr size_t WS_XB8 = 560 * MiB;
constexpr size_t WS_MIX = 400 * MiB;
constexpr size_t WS_SCR = 624 * MiB;
constexpr size_t WS_END = (624 + 832) * MiB;
constexpr size_t WB_GU0 = 0, WB_GU1 = 23068672, WB_D0 = 46137344, WB_D1 = 57671680, WB_IN = 69206016, WB_OUT = 108003328, WB_MKV = 113246208, WB_UQ = 115343360, WB_UKV = 116916224;
constexpr int RING_BYTES = 146944, MISC_OFF = RING_BYTES + 64, LDS_BYTES = 147456;
static_assert(att::L_END <= RING_BYTES && pg8::STAGE_BYTES <= RING_BYTES, "LDS map");
constexpr int NPHASES = 44;
#ifndef F8MASK
#define F8MASK 4
#endif
#define F8LAYER(L) (((F8MASK) >> (L)) & 1)
#ifndef RG
#define RG 1
#endif
#ifndef RD
#define RD 1
#endif
#ifndef RI
#define RI 1
#endif
#ifndef RA
#define RA 1
#endif
#ifndef RC
#define RC 1
#endif
#define REP(n) for (int rep_ = 0; rep_ < (n); ++rep_)

struct Args { const void* in[27]; float* out; unsigned char* ws; int ph_lo, ph_hi; };

typedef const __attribute__((address_space(4))) struct Args* ArgsPc;
__device__ __forceinline__ TrDesc tr_desc(ArgsPc A, int L, bf16_t* WB, int it) {
    const float* w_gate = (const float*)A->in[5]; const float* w_up = (const float*)A->in[6]; const float* w_down = (const float*)A->in[7];
    const float* ffn_norm = (const float*)A->in[4]; const float* attn_norm = (const float*)A->in[8];
    const float* w_out = (const float*)A->in[12];
    const float* w_in = (const float*)(L == 0 ? A->in[13] : L == 1 ? A->in[16] : L == 2 ? A->in[23] : A->in[25]);
    const int nin = (L == 0 ? 6672 : L == 1 ? 1600 : L == 2 ? 18944 : 4688);
    const int I_GU = 32 * 88, I_D = 88 * 32, I_IN = 32 * ((nin + 63) / 64), I_OUT = 40 * 32, I_UQ = (L == 1) ? 8 * 48 : 0;
    TrDesc d; d.f8 = 0; int r = it;
    if (r < 4 * I_GU) { const int s = r / I_GU; r -= s * I_GU; const int f = s >> 1, up = s & 1;
        d.W = (up ? w_up : w_gate) + (size_t)(L * 2 + f) * DM * DFF; d.K = DM; d.N = DFF; d.gain = ffn_norm + (size_t)(L * 2 + f) * DM; d.WT = WB + (f ? WB_GU1 : WB_GU0); d.ldt = DM; d.kind = up ? 2 : 1; }
    else { r -= 4 * I_GU;
        if (r < 2 * I_D) { const int f = r / I_D; r -= f * I_D; d.W = w_down + (size_t)(L * 2 + f) * DFF * DM; d.K = DFF; d.N = DM; d.gain = nullptr; d.WT = WB + (f ? WB_D1 : WB_D0); d.ldt = DFF; d.kind = 0; }
        else { r -= 2 * I_D;
            if (r < I_IN) { d.W = w_in; d.K = DM; d.N = nin; d.gain = attn_norm + (size_t)L * DM; d.WT = WB + WB_IN; d.ldt = DM; d.kind = 3 + L; d.f8 = F8LAYER(L) ? 1 : 0; }
            else { r -= I_IN;
                if (r < I_OUT) { d.W = w_out + (size_t)L * OUTIN * DM; d.K = OUTIN; d.N = DM; d.gain = nullptr; d.WT = WB + WB_OUT; d.ldt = OUTIN; d.kind = 0; }
                else { r -= I_OUT;
                    if (r < I_UQ) { d.W = (const float*)A->in[18]; d.K = 512; d.N = 3072; d.gain = (const float*)A->in[17]; d.WT = WB + WB_UQ; d.ldt = 512; d.kind = 0; }
                    else { r -= I_UQ; d.W = (const float*)A->in[20]; d.K = 512; d.N = 4096; d.gain = (const float*)A->in[19]; d.WT = WB + WB_UKV; d.ldt = 512; d.kind = 0; } } } } }
    d.r = r; return d;
}
__device__ __forceinline__ void convert_layer(const Fr& F, ArgsPc A, int L, bf16_t* WB) {
    const int nin = (L == 0 ? 6672 : L == 1 ? 1600 : L == 2 ? 18944 : 4688);
    const int total = 4 * 32 * 88 + 2 * 88 * 32 + 32 * ((nin + 63) / 64) + 40 * 32 + ((L == 1) ? 8 * 48 + 8 * 64 : 0);
    LAS float* scr = (LAS float*)(F.lds + F.wave * 16640);
    f32x4 va[16], vb[16]; int it = F.gw;
    if (it >= total) return;
    TrDesc da = tr_desc(A, L, WB, it), db = da; tr_load(da, F.lane, va);
    for (;;) {
        const bool nb_ = it + F.ngw < total; if (nb_) { db = tr_desc(A, L, WB, it + F.ngw); tr_load(db, F.lane, vb); }
        tr_store(da, F.lane, va, scr); it += F.ngw; if (!nb_) break;
        const bool na_ = it + F.ngw < total; if (na_) { da = tr_desc(A, L, WB, it + F.ngw); tr_load(da, F.lane, va); }
        tr_store(db, F.lane, vb, scr); it += F.ngw; if (!na_) break;
    }
}

__device__ __forceinline__ void mem_attn_units(const Fr& F, const bf16_t* P, long ldp, int memq_col, const bf16_t* MEMKV, bf16_t* MIX) {
    for (int i = blockIdx.x; i < 512; i += F.G) {
        const int b = i >> 6, mh = (i >> 4) & 3, qb = i & 15; const size_t tok = (size_t)b * SEQ + qb * 256;
        att::AP a{}; a.Q = P + tok * ldp + memq_col + mh * 128; a.qs = ldp; a.K = MEMKV + (size_t)b * NMEM * 4096 + mh * 128; a.ks = 4096; a.V = a.K + 512; a.vs = 4096;
        a.O = MIX + tok * OUTIN + 2048 + mh * 128; a.os = OUTIN; a.kt0 = 0; a.nt = 4; a.q0 = 0; a.C = 0.08838834764831845f * LOG2E;
        att::attn_unit<att::K_MEM, 128>(F.lds, a, F.wave);
    }
}
__device__ __forceinline__ void causal_unit_ids(int i, int& b, int& h, int& qb) {
    const int slot = i >> 8, c = i & 255, bh = (c >> 4) * 8 + (c & 7), half = (c >> 3) & 1;
    qb = half ? ((slot & 1) ? slot : 14 - slot) : ((slot & 1) ? slot - 1 : 15 - slot); b = bh >> 4; h = bh & 15;
}

__device__ __forceinline__ Fr mk_frame(unsigned char* lds_raw, int wave_id) {
    Fr F; F.lds = (LAS unsigned char*)lds_raw; F.tid = tid_opaque(wave_id); F.lane = F.tid & 63; F.wave = __builtin_amdgcn_readfirstlane(F.tid >> 6);
    F.G = gridDim.x; { const int bx = blockIdx.x; F.vcu = (F.G % 8 == 0) ? (bx % 8) * (F.G / 8) + bx / 8 : bx; }
    F.gw = F.vcu * 8 + F.wave; F.ngw = F.G * 8; return F;
}
typedef const __attribute__((address_space(4))) Args* ArgsP;
__device__ __forceinline__ ArgsP args_ptr() { auto p = __builtin_amdgcn_kernarg_segment_ptr(); asm volatile("" : "+s"(p)); return (ArgsP)p; }
#define WSP(T, off) ((T*)(AP_->ws + (off)))
#define SCRP(T, mib) ((T*)(AP_->ws + WS_SCR + (size_t)(mib) * MiB))

__global__ void __launch_bounds__(512, 2) fwd(Args A) {
    extern __shared__ __attribute__((aligned(16))) unsigned char lds_raw[];
    { LAS unsigned* z = (LAS unsigned*)((LAS unsigned char*)lds_raw + RING_BYTES); for (int u = threadIdx.x; u < (LDS_BYTES - RING_BYTES) / 4; u += 512) z[u] = 0u; }
    __syncthreads();
    const int lo = A.ph_lo, hi = A.ph_hi; const int wave_id = __builtin_amdgcn_readfirstlane((int)threadIdx.x >> 6);
    XcdBarrier bar; bar.bar = (unsigned*)(A.ws + WS_CTL) + CW_BAR; bar.x = 0; bar.st = nullptr;
    if (hi - lo > 1) bar = xcd_barrier_post((unsigned*)(A.ws + WS_CTL) + CW_BAR, (volatile LAS unsigned*)((LAS unsigned char*)lds_raw + MISC_OFF) + 8);
    int ph = 0;
#define PH_BEGIN if (ph >= lo && ph < hi) { const Fr F = mk_frame(lds_raw, wave_id); const ArgsP AP_ = args_ptr();
#define PH_END   if (ph + 1 < hi) xcd_barrier(bar); } ++ph;
    const float SC128 = 0.08838834764831845f * LOG2E, SC192 = 0.07216878364870323f * LOG2E;

    PH_BEGIN
        rows2048(F, (const float*)AP_->in[1], NB * NMEM, WSP(bf16_t, WS_MEMB), WSP(float, WS_RSMEM), 1);
        rope_table(F, (const int*)AP_->in[2], WSP(float, WS_COS), WSP(float, WS_SIN));
        rows2048(F, (const float*)AP_->in[0], MTOK, WSP(bf16_t, WS_XB), WSP(u64, WS_SSQ), 0);
#ifdef RZ
        { u32x4* z = WSP(u32x4, WS_END); for (size_t i = (size_t)F.vcu * 512 + F.tid; i < (size_t)2 * DFF * DM * 2 / 16; i += (size_t)F.G * 512) z[i] = (u32x4){0u, 0u, 0u, 0u}; }
#endif
        { LAS float* scr = (LAS float*)(F.lds + F.wave * 16640);
          for (int it = F.gw; it < 4 * 512; it += F.ngw) { const int Lm = it >> 9; TrDesc d; d.W = (const float*)AP_->in[10] + (size_t)Lm * DM * 1024; d.K = DM; d.N = 1024; d.gain = (const float*)AP_->in[9] + (size_t)Lm * DM;
              d.WT = SCRP(bf16_t, 0) + (size_t)Lm * 1024 * DM; d.ldt = DM; d.kind = 0; d.f8 = 0; d.r = it & 511; f32x4 v[16]; tr_load(d, F.lane, v); tr_store(d, F.lane, v, scr); } }
    PH_END
    PH_BEGIN { pg8::Gemm g{WSP(bf16_t, WS_MEMB), SCRP(bf16_t, 0), NB * NMEM, 4096, DM, DM, DM, 0}; pg8::StaticOrder S; S.init(g.M, g.N, F.G, (int)blockIdx.x);
        pg8::EpiProj E{WSP(bf16_t, WS_MEMKV), 4096, WSP(float, WS_RSMEM), 0, nullptr, -1, (const float*)AP_->in[11] + 128, 0, 0, nullptr, 0, 0, nullptr, 0, 0, 1.0f, 4, 2, 256}; pg8::gemm_phase(F.lds, g, S, E, F.tid); } PH_END

    int ver = 0;
#pragma clang loop unroll(full)
    for (int hl = 0; hl < 8; ++hl) {
        const int L = hl >> 1, f = hl & 1;
        if (f == 0) {
            PH_BEGIN REP(RC) convert_layer(F, AP_, L, WSP(bf16_t, WS_WB)); PH_END

        }
        PH_BEGIN
#ifdef RZ
            { pg8::Gemm g{WSP(bf16_t, WS_XB), WSP(bf16_t, WS_END), MTOK, 2 * DFF, DM, DM, DM, 0}; pg8::StaticOrder S; S.init(g.M, g.N, F.G, (int)blockIdx.x);
              pg8::EpiSwiGLU E{SCRP(bf16_t, 0), DFF, WSP(u64, WS_SSQ) + (size_t)ver * MTOK}; pg8::gemm_phase(F.lds, g, S, E, F.tid); }
#endif
            REP(RG) { pg8::Gemm g{WSP(bf16_t, WS_XB), WSP(bf16_t, WS_WB) + (f ? WB_GU1 : WB_GU0), MTOK, 2 * DFF, DM, DM, DM, 0}; pg8::StaticOrder S; S.init(g.M, g.N, F.G, (int)blockIdx.x);
            pg8::EpiSwiGLU E{SCRP(bf16_t, 0), DFF, WSP(u64, WS_SSQ) + (size_t)ver * MTOK}; pg8::gemm_phase(F.lds, g, S, E, F.tid); } PH_END
        PH_BEGIN { pg8::Gemm g{SCRP(bf16_t, 0), WSP(bf16_t, WS_WB) + (f ? WB_D1 : WB_D0), MTOK, DM, DFF, DFF, DFF, 1}; pg8::StaticOrder S; S.init(g.M, g.N, F.G, (int)blockIdx.x);
            if (RD > 1) { pg8::EpiResid E0{ver == 0 ? (const float*)AP_->in[0] : AP_->out, SCRP(float, 400), SCRP(bf16_t, 660), nullptr, nullptr, 0.5f}; pg8::gemm_phase(F.lds, g, S, E0, F.tid); }
            pg8::EpiResid E{ver == 0 ? (const float*)AP_->in[0] : AP_->out, AP_->out, WSP(bf16_t, WS_XB), WSP(u64, WS_SSQ) + (size_t)(ver + 1) * MTOK, (f == 0 && F8LAYER(L)) ? WSP(unsigned char, WS_XB8) : nullptr, 0.5f}; pg8::gemm_phase(F.lds, g, S, E, F.tid); } PH_END
        ++ver;
        if (f != 0) continue;
        const int ngrp = (L == 2) ? 3 : 1;
#pragma clang loop unroll(full)
        for (int g = 0; g < ngrp; ++g) {
            PH_BEGIN REP(RI) { const int ldp = (L == 0) ? 6912 : (L == 1) ? 1792 : (L == 2) ? 6656 : 4864;
                const int nproj = (L == 2) ? (g == 0 ? 6656 : 6144) : ldp; const size_t roff = (L == 2) ? (g == 0 ? 0 : (g == 1 ? 6656 : 12800)) : 0;
                pg8::Gemm gm = F8LAYER(L) ? pg8::Gemm{WSP(bf16_t, WS_XB8), (const bf16_t*)((const unsigned char*)(WSP(bf16_t, WS_WB) + WB_IN) + roff * DM), MTOK, nproj, DM / 2, DM / 2, DM / 2, 0}
                                       : pg8::Gemm{WSP(bf16_t, WS_XB), WSP(bf16_t, WS_WB) + WB_IN + roff * DM, MTOK, nproj, DM, DM, DM, 0};
                pg8::StaticOrder S; S.init(gm.M, gm.N, F.G, (int)blockIdx.x);
                const float* gmq = (const float*)AP_->in[11] + (size_t)L * 256;
                const float* qg = (L == 0) ? (const float*)AP_->in[15] : (L == 2) ? (const float*)AP_->in[24] + (size_t)g * 256 : (L == 3) ? (const float*)AP_->in[26] : nullptr;
                const int kt_hi = (L == 3) ? 10 : 16, mq_lo = (L == 0 || L == 2) ? 24 : (L == 1) ? 5 : 17, mq_hi = (L == 2 && g > 0) ? mq_lo : mq_lo + 2;
                pg8::EpiProj E{SCRP(bf16_t, 0), ldp, WSP(u64, WS_SSQ) + (size_t)ver * MTOK, 1, (L == 0) ? SCRP(float, 432) : nullptr, 26,
                               qg, 0, (L == 1) ? 0 : 8, qg ? qg + 128 : nullptr, 8, (L == 1) ? 8 : kt_hi, gmq, mq_lo, mq_hi, F8LAYER(L) ? (1.0f / 64.0f) : 1.0f, 0, 0, 0}; if (F8LAYER(L)) pg8::gemm_phase<true>(F.lds, gm, S, E, F.tid); else pg8::gemm_phase<false>(F.lds, gm, S, E, F.tid); } PH_END
            if (L == 0) { PH_BEGIN fox_cumsum(F, SCRP(const float, 432), (const float*)AP_->in[14], SCRP(float, 434)); PH_END }
            if (L == 1) { PH_BEGIN mla_prep_a(F, SCRP(bf16_t, 0), WSP(float, WS_RSQ), WSP(float, WS_RSKV), SCRP(bf16_t, 752), (const float*)AP_->in[22] + 64, nullptr, WSP(float, WS_COS), WSP(float, WS_SIN)); PH_END }
            if (L == 1) {
                PH_BEGIN
                    REP(RI) for (int i = 0; i < 2; ++i) { pg8::Gemm gm{SCRP(bf16_t, 0) + (i ? 512 : 0), WSP(bf16_t, WS_WB) + (i ? WB_UKV : WB_UQ), MTOK, i ? 4096 : 3072, 512, 1792, 512, 0}; pg8::StaticOrder S; S.init(gm.M, gm.N, F.G, (int)blockIdx.x);
                        pg8::EpiProj E{i ? SCRP(bf16_t, 304) : SCRP(bf16_t, 112), i ? 4096 : 3072, i ? WSP(float, WS_RSKV) : WSP(float, WS_RSQ), 0, nullptr, -1, nullptr, 0, 0, nullptr, 0, 0, nullptr, 0, 0, 1.0f, 0, 0, 0}; pg8::gemm_phase(F.lds, gm, S, E, F.tid); }
                PH_END
                PH_BEGIN mla_prep_b(F, SCRP(bf16_t, 112), SCRP(const bf16_t, 304), SCRP(bf16_t, 560), SCRP(const bf16_t, 752), (const float*)AP_->in[21], (const float*)AP_->in[22], WSP(float, WS_COS), WSP(float, WS_SIN)); PH_END
            }
            if (L == 3) {
                PH_BEGIN REP(RC) dsa_indexer(F, SCRP(const bf16_t, 0), SCRP(float, 304)); PH_END
                PH_BEGIN REP(RC) dsa_select(F, SCRP(const float, 304), SCRP(u64, 816)); PH_END
            }
            PH_BEGIN
                bf16_t* P = SCRP(bf16_t, 0); bf16_t* MIX = WSP(bf16_t, WS_MIX);
                const long ldp = (L == 0) ? 6912 : (L == 1) ? 1792 : (L == 2) ? 6656 : 4864;
                REP(L == 2 ? 1 : RA) {
                if (L == 0) {
                    const float* CUM = SCRP(const float, 434);
                    for (int i = blockIdx.x; i < 2048; i += F.G) { int b, h, qb; causal_unit_ids(i, b, h, qb); const size_t t0 = (size_t)b * SEQ;
                        att::AP a{}; a.Q = P + (t0 + qb * 256) * ldp + h * 128; a.qs = ldp; a.K = P + t0 * ldp + 2048 + h * 128; a.ks = ldp; a.V = a.K + 2048; a.vs = ldp;
                        a.O = MIX + (t0 + qb * 256) * OUTIN + h * 128; a.os = OUTIN; a.kt0 = 0; a.nt = 4 * (qb + 1); a.q0 = qb * 256; a.C = SC128; a.cum = CUM + t0 * 16 + h; a.cums = 16;
                        att::attn_unit<att::K_FOX, 128>(F.lds, a, F.wave); }
                }
                if (L == 1) {
                    const bf16_t* Qb = SCRP(const bf16_t, 112); const bf16_t* KVb = SCRP(const bf16_t, 304); const bf16_t* KF = SCRP(const bf16_t, 560);
                    for (int i = blockIdx.x; i < 2048; i += F.G) { int b, h, qb; causal_unit_ids(i, b, h, qb); const size_t t0 = (size_t)b * SEQ;
                        att::AP a{}; a.Q = Qb + (t0 + qb * 256) * 3072 + h * 192; a.qs = 3072; a.K = KF + t0 * 3072 + h * 192; a.ks = 3072; a.V = KVb + t0 * 4096 + h * 256 + 128; a.vs = 4096;
                        a.O = MIX + (t0 + qb * 256) * OUTIN + h * 128; a.os = OUTIN; a.kt0 = 0; a.nt = 4 * (qb + 1); a.q0 = qb * 256; a.C = SC192;
                        att::attn_unit<att::K_MLA, 192>(F.lds, a, F.wave); }
                }
                if (L == 2) {
                    const int dil = (g == 0) ? 1 : (g == 1 ? 4 : 16), nblk = 16 / dil; float* OST = SCRP(float, 416); float* ML = SCRP(float, 672);
                    for (int i = blockIdx.x; i < 2048; i += F.G) { const int h = i & 15, rest = i >> 4, b = rest >> 4, rj = rest & 15, r = rj / nblk, jb = rj % nblk;
                        const size_t tokz = (size_t)b * SEQ + r, tokq = tokz + (size_t)jb * 256 * dil;
                        att::AP a{}; a.Q = P + tokq * ldp + h * 128; a.qs = (long)dil * ldp; a.K = P + tokz * ldp + 2048 + h * 128; a.ks = (long)dil * ldp; a.V = a.K + 2048; a.vs = a.ks;
                        a.O = MIX + tokq * OUTIN + h * 128; a.os = (long)dil * OUTIN; a.q0 = jb * 256; a.kt0 = jb == 0 ? 0 : 4 * jb - 2; a.nt = jb == 0 ? 4 : 6; a.C = SC128;
                        a.ost = OST + tokq * 2048 + h * 128; a.osts = (long)dil * 2048; a.mst = ML + (tokq * 16 + h) * 2; a.msts = (long)dil * 32; a.carry_in = g > 0; a.carry_out = g < 2;
                        a.t5 = (const float*)AP_->in[3]; a.head = h; a.dil = dil;
                        att::attn_unit<att::K_DIL, 128>(F.lds, a, F.wave); }
                }
                if (L == 3) {
                    const u64* MSK = SCRP(const u64, 816);
                    for (int i = blockIdx.x; i < 2048; i += F.G) { int b, h, qb; causal_unit_ids(i, b, h, qb); const size_t t0 = (size_t)b * SEQ;
                        att::AP a{}; a.Q = P + (t0 + qb * 256) * ldp + h * 128; a.qs = ldp; a.K = P + t0 * ldp + 2048 + (h >> 2) * 128; a.ks = ldp; a.V = a.K + 512; a.vs = ldp;
                        a.O = MIX + (t0 + qb * 256) * OUTIN + h * 128; a.os = OUTIN; a.kt0 = 0; a.nt = 4 * (qb + 1); a.q0 = qb * 256; a.C = SC128; a.msk = MSK + (t0 + qb * 256) * 64; a.t5 = (const float*)AP_->in[3]; a.head = h;
                        att::attn_unit<att::K_DSA, 128>(F.lds, a, F.wave); }
                }
                if (g == 0) { const int memq_col = (L == 0) ? 6144 : (L == 1) ? 1280 : (L == 2) ? 6144 : 4352; mem_attn_units(F, P, ldp, memq_col, WSP(const bf16_t, WS_MEMKV) + L * 1024, MIX); }
                }
            PH_END
        }
        PH_BEGIN { pg8::Gemm gm{WSP(bf16_t, WS_MIX), WSP(bf16_t, WS_WB) + WB_OUT, MTOK, DM, OUTIN, OUTIN, OUTIN, 0}; pg8::StaticOrder S; S.init(gm.M, gm.N, F.G, (int)blockIdx.x);
            if (RD > 1) { pg8::EpiResid E0{AP_->out, SCRP(float, 400), SCRP(bf16_t, 660), nullptr, nullptr, 1.0f}; pg8::gemm_phase(F.lds, gm, S, E0, F.tid); }
            pg8::EpiResid E{AP_->out, AP_->out, WSP(bf16_t, WS_XB), WSP(u64, WS_SSQ) + (size_t)(ver + 1) * MTOK, nullptr, 1.0f}; pg8::gemm_phase(F.lds, gm, S, E, F.tid); } PH_END
        ++ver;
    }
#undef PH_BEGIN
#undef PH_END
}

#ifndef MK_ONE_LAUNCH
#define MK_ONE_LAUNCH 0
#endif
extern "C" void kernel_launch(void* const* d_in, const int* in_sizes, int n_in, void* d_out, int out_size, void* d_ws, size_t ws_size, hipStream_t stream) {
    static int grid = 0;
    if (grid == 0) {
        if (n_in != 27 || in_sizes[0] != MTOK * DM || out_size != MTOK * DM || ws_size < WS_END) {
            fprintf(stderr, "kernel_launch: unexpected shapes: n_in %d in0 %d out %d ws %zu (need >= %zu); nothing launched\n", n_in, n_in > 0 ? in_sizes[0] : -1, out_size, ws_size, (size_t)WS_END); grid = -1; return; }
        int dev = 0, cus = 0, per_cu = 0;
        if (hipGetDevice(&dev) != hipSuccess || hipDeviceGetAttribute(&cus, hipDeviceAttributeMultiprocessorCount, dev) != hipSuccess) { fprintf(stderr, "kernel_launch: device query failed\n"); grid = -1; return; }
        if (hipFuncSetAttribute((const void*)fwd, hipFuncAttributeMaxDynamicSharedMemorySize, LDS_BYTES) != hipSuccess) { fprintf(stderr, "kernel_launch: hipFuncSetAttribute failed\n"); grid = -1; return; }
        if (hipOccupancyMaxActiveBlocksPerMultiprocessor(&per_cu, (const void*)fwd, 512, LDS_BYTES) != hipSuccess || per_cu < 1)
            fprintf(stderr, "kernel_launch: note: occupancy query reports %d workgroups per CU\n", per_cu);
        (void)hipGetLastError();
        grid = cus;
    }
    if (grid < 0) return;
    if (hipMemsetAsync((char*)d_ws + WS_CTL, 0, CTL_ZERO_BYTES, stream) != hipSuccess) { fprintf(stderr, "kernel_launch: memset failed\n"); return; }
    Args a{};
    for (int i = 0; i < 27; ++i) a.in[i] = d_in[i];
    a.out = (float*)d_out; a.ws = (unsigned char*)d_ws;
#if MK_ONE_LAUNCH
    a.ph_lo = 0; a.ph_hi = NPHASES;
    hipLaunchKernelGGL(fwd, dim3(grid), dim3(512), LDS_BYTES, stream, a);
#else
#ifndef NPH_LIMIT
#define NPH_LIMIT NPHASES
#endif
    for (int p = 0; p < NPH_LIMIT; ++p) { a.ph_lo = p; a.ph_hi = p + 1; hipLaunchKernelGGL(fwd, dim3(grid), dim3(512), LDS_BYTES, stream, a); }
#endif
    const hipError_t le = hipPeekAtLastError();
    if (le != hipSuccess) fprintf(stderr, "kernel_launch: launch failed: %s\n", hipGetErrorName(le));
}
```

```cpp
#define MK_ONE_LAUNCH 1
#include <hip/hip_runtime.h>
#include <cstdio>
#include <cstdint>

#define LAS __attribute__((address_space(3)))
#define GAS __attribute__((address_space(1)))
typedef unsigned short bf16_t;
typedef short bf16x8 __attribute__((ext_vector_type(8)));
typedef short s16x4 __attribute__((ext_vector_type(4)));
typedef float f32x2 __attribute__((ext_vector_type(2)));
typedef float f32x4 __attribute__((ext_vector_type(4)));
typedef float f32x16 __attribute__((ext_vector_type(16)));
typedef unsigned u32x2 __attribute__((ext_vector_type(2)));
typedef unsigned u32x4 __attribute__((ext_vector_type(4)));
typedef unsigned long long u64;

constexpr int DM = 2048, NB = 8, SEQ = 4096, MTOK = NB * SEQ, DFF = 5632, NH = 16, HD = 128, NMEM = 256, MEMW = 512, OUTIN = 2560;
constexpr float RMS_EPS = 1e-6f;
constexpr float LOG2E = 1.4426950408889634f;

__device__ __forceinline__ unsigned cvt_pk_bf16(float lo, float hi) { unsigned r; asm volatile("v_cvt_pk_bf16_f32 %0, %1, %2" : "=v"(r) : "v"(lo), "v"(hi)); return r; }
__device__ __forceinline__ float bf_lo(unsigned w) { return __uint_as_float(w << 16); }
__device__ __forceinline__ float bf_hi(unsigned w) { return __uint_as_float(w & 0xffff0000u); }

__device__ __forceinline__ int tid_opaque(int wave_id) {
    int l; asm volatile("v_mbcnt_lo_u32_b32 %0, -1, 0\n\tv_mbcnt_hi_u32_b32 %0, -1, %0" : "=v"(l)); return wave_id * 64 + l; }

namespace pg8 {
constexpr int BM = 256, BK = 64, HALF = 128, HTB = HALF * BK * 2, STAGE_BYTES = 8 * HTB, NXCD = 8, WGM = 8;
__host__ __device__ __forceinline__ int lds_byte(int r, int c) { const int st = (r >> 4) * 2 + (c >> 5), rr = r & 15, cc = c & 31, ob = rr * 64 + cc * 2; return st * 1024 + (ob ^ (((ob >> 9) & 1) << 5)); }
__host__ __device__ __forceinline__ void stage_rc(int b, int& R, int& C) { const int st = b / 1024, sb = b % 1024, swz = sb ^ (((sb >> 9) & 1) << 5); R = (st >> 1) * 16 + swz / 64; C = (st & 1) * 32 + (swz % 64) / 2; }
__host__ __device__ __forceinline__ int perm32(int rho) { const int n = rho >> 4, i = rho & 15; return 8 * (i >> 2) + 4 * n + (i & 3); }

struct Unit { int pm, pn; };
struct Gemm { const bf16_t* A; const bf16_t* Bt; int M, N, K, lda, ldb; int a_tiled; };

struct StaticOrder {
    int nM, nN, nwg, G, c;
    __host__ __device__ void init(int M, int N, int G_, int c_) { nM = M / BM; nN = N / BM; nwg = nM * nN; G = G_; c = c_; }
    __host__ __device__ bool next(int i, Unit& u) const {
        const long L = (long)i * G + c; if (L >= nwg) return false;
        int wgid = (int)L; { const int q = nwg / NXCD, r = nwg % NXCD, xcd = wgid % NXCD, off = wgid / NXCD; wgid = (xcd < r ? xcd * (q + 1) : r * (q + 1) + (xcd - r) * q) + off; }
        const int nig = WGM * nN, gid = wgid / nig, fm = gid * WGM, gsz = (nM - fm) < WGM ? (nM - fm) : WGM;
        u.pm = fm + ((wgid % nig) % gsz); u.pn = (wgid % nig) / gsz; return true;
    }
};

constexpr float SSQ_SCALE = 16777216.0f;
__device__ __forceinline__ float rs_from_ssq(const u64 v) { return __builtin_amdgcn_rsqf((float)v * (1.0f / (SSQ_SCALE * DM)) + RMS_EPS); }
__device__ __forceinline__ float rs_of(const void* rsv, int row, int mode) { return mode ? rs_from_ssq(((const u64*)rsv)[row]) : ((const float*)rsv)[row]; }

struct EpiProj {
    bf16_t* O; int ldc; const void* rsv; int rs_mode;
    float* fgout; int fg_tile;
    const float* g0; int t0a, t0b; const float* g1; int t1a, t1b; const float* g2; int t2a, t2b;
    float oscale;
    int gper, gcnt, gstride;
    __device__ __forceinline__ void operator()(f32x4 (&acc)[2][2][4][2], const Unit& u, int wr, int wc, int fr, int fq, LAS unsigned char* xlds) const {
        const int row0 = u.pm * BM + wr * 64 + fr; const int col0 = u.pn * BM + wc * 32 + 8 * fq;
        const float* gain = (u.pn >= t0a && u.pn < t0b) ? g0 : (u.pn >= t1a && u.pn < t1b) ? g1 : (u.pn >= t2a && u.pn < t2b) ? g2 : nullptr;
        if (gper) gain = (u.pn % gper < gcnt) ? g0 + (size_t)(u.pn / gper) * gstride : nullptr;
        float rsa[2][4];
#pragma unroll
        for (int ai = 0; ai < 2; ++ai)
#pragma unroll
            for (int m = 0; m < 4; ++m) rsa[ai][m] = rs_of(rsv, row0 + ai * HALF + m * 16, rs_mode) * oscale;
#pragma unroll
        for (int ai = 0; ai < 2; ++ai)
#pragma unroll
            for (int m = 0; m < 4; ++m) { const float rs = rsa[ai][m];
#pragma unroll
                for (int bj = 0; bj < 2; ++bj) { acc[ai][bj][m][0] *= rs; acc[ai][bj][m][1] *= rs; } }
        if (gain) {
            LAS float* part = (LAS float*)xlds;
#pragma unroll
            for (int ai = 0; ai < 2; ++ai)
#pragma unroll
                for (int m = 0; m < 4; ++m)
#pragma unroll
                    for (int bj = 0; bj < 2; ++bj) { const f32x4 a = acc[ai][bj][m][0], b = acc[ai][bj][m][1];
                        float ss = ((a[0] * a[0] + a[1] * a[1]) + (a[2] * a[2] + a[3] * a[3])) + ((b[0] * b[0] + b[1] * b[1]) + (b[2] * b[2] + b[3] * b[3]));
                        ss += __shfl_xor(ss, 16); ss += __shfl_xor(ss, 32);
                        if (fq == 0) part[((ai * HALF + wr * 64 + m * 16 + fr) * 2 + bj) * 4 + wc] = ss; }
            asm volatile("s_waitcnt lgkmcnt(0)" ::: "memory"); __builtin_amdgcn_s_barrier(); asm volatile("" ::: "memory");
            const f32x4 gv0 = *(const f32x4*)(gain + wc * 32 + 8 * fq), gv1 = *(const f32x4*)(gain + wc * 32 + 8 * fq + 4);
#pragma unroll
            for (int ai = 0; ai < 2; ++ai)
#pragma unroll
                for (int m = 0; m < 4; ++m)
#pragma unroll
                    for (int bj = 0; bj < 2; ++bj) { const f32x4 p4 = *(const LAS f32x4*)(part + ((ai * HALF + wr * 64 + m * 16 + fr) * 2 + bj) * 4);
                        const float r2 = __builtin_amdgcn_rsqf(((p4[0] + p4[1]) + (p4[2] + p4[3])) * (1.0f / 128.0f) + RMS_EPS);
                        acc[ai][bj][m][0] *= gv0 * r2; acc[ai][bj][m][1] *= gv1 * r2; }
        }
#pragma unroll
        for (int ai = 0; ai < 2; ++ai)
#pragma unroll
            for (int m = 0; m < 4; ++m) { const int row = row0 + ai * HALF + m * 16;
                bf16_t* rowp = O + (size_t)row * ldc + col0;
#pragma unroll
                for (int bj = 0; bj < 2; ++bj) { const f32x4 v0 = acc[ai][bj][m][0], v1 = acc[ai][bj][m][1];
                    u32x4 w; w.x = cvt_pk_bf16(v0[0], v0[1]); w.y = cvt_pk_bf16(v0[2], v0[3]); w.z = cvt_pk_bf16(v1[0], v1[1]); w.w = cvt_pk_bf16(v1[2], v1[3]);
                    *(u32x4*)(rowp + bj * HALF) = w;
                    if (fgout && bj == 0 && u.pn == fg_tile && wc == 0 && fq < 2) { float* fp = fgout + (size_t)row * 16 + 8 * fq; *(f32x4*)fp = v0; *(f32x4*)(fp + 4) = v1; } } }
    }
};
struct EpiSwiGLU {
    bf16_t* O; int ldc; const u64* ssq;
    __device__ __forceinline__ void operator()(f32x4 (&acc)[2][2][4][2], const Unit& u, int wr, int wc, int fr, int fq, LAS unsigned char*) const {
        const int row0 = u.pm * BM + wr * 64 + fr; const int col0 = u.pn * HALF + wc * 32 + 8 * fq;
        float rsv[2][4];
#pragma unroll
        for (int ai = 0; ai < 2; ++ai)
#pragma unroll
            for (int m = 0; m < 4; ++m) rsv[ai][m] = rs_from_ssq(ssq[row0 + ai * HALF + m * 16]);
#pragma unroll
        for (int ai = 0; ai < 2; ++ai)
#pragma unroll
            for (int m = 0; m < 4; ++m) { const int row = row0 + ai * HALF + m * 16; const float rs = rsv[ai][m];
                float h[8];
#pragma unroll
                for (int n = 0; n < 2; ++n)
#pragma unroll
                    for (int j = 0; j < 4; ++j) { const float g = acc[ai][0][m][n][j] * rs, uu = acc[ai][1][m][n][j] * rs;
                        const float e = __builtin_amdgcn_exp2f(-g * LOG2E); h[n * 4 + j] = g * __builtin_amdgcn_rcpf(1.0f + e) * uu; }
                u32x4 w; w.x = cvt_pk_bf16(h[0], h[1]); w.y = cvt_pk_bf16(h[2], h[3]); w.z = cvt_pk_bf16(h[4], h[5]); w.w = cvt_pk_bf16(h[6], h[7]);
                const int kt = col0 >> 6, hh = (row >> 7) & 1;
                __builtin_nontemporal_store(w, (u32x4*)(O + ((size_t)((size_t)u.pm * (ldc >> 6) + kt) * 2 + hh) * (HALF * BK) + (size_t)(row & 127) * BK + (col0 & 63))); }
    }
};
struct EpiResid {
    const float* xin; float* xout; bf16_t* xb; u64* ssq_out; unsigned char* xb8; float alpha;
    __device__ __forceinline__ void operator()(f32x4 (&acc)[2][2][4][2], const Unit& u, int wr, int wc, int fr, int fq, LAS unsigned char*) const {
        const int row0 = u.pm * BM + wr * 64 + fr; const int col0 = u.pn * BM + wc * 32 + 8 * fq;
#pragma unroll
        for (int ai = 0; ai < 2; ++ai) {
            f32x4 xi[4][2][2];
#pragma unroll
            for (int m = 0; m < 4; ++m) { const size_t off = (size_t)(row0 + ai * HALF + m * 16) * DM + col0;
#pragma unroll
                for (int bj = 0; bj < 2; ++bj) { xi[m][bj][0] = __builtin_nontemporal_load((const f32x4*)(xin + off + bj * HALF)); xi[m][bj][1] = __builtin_nontemporal_load((const f32x4*)(xin + off + bj * HALF + 4)); } }
            asm volatile("" ::: "memory");
#pragma unroll
            for (int m = 0; m < 4; ++m) { const int row = row0 + ai * HALF + m * 16; const size_t off = (size_t)row * DM + col0; float ss = 0.f;
#pragma unroll
                for (int bj = 0; bj < 2; ++bj) {
                    const f32x4 v0 = xi[m][bj][0] + acc[ai][bj][m][0] * alpha, v1 = xi[m][bj][1] + acc[ai][bj][m][1] * alpha;
                    __builtin_nontemporal_store(v0, (f32x4*)(xout + off + bj * HALF)); __builtin_nontemporal_store(v1, (f32x4*)(xout + off + bj * HALF + 4));
                    u32x4 w; w.x = cvt_pk_bf16(v0[0], v0[1]); w.y = cvt_pk_bf16(v0[2], v0[3]); w.z = cvt_pk_bf16(v1[0], v1[1]); w.w = cvt_pk_bf16(v1[2], v1[3]);
                    *(u32x4*)(xb + off + bj * HALF) = w;
                    if (xb8) { int q0 = __builtin_amdgcn_cvt_pk_fp8_f32(v0[0], v0[1], 0, false); q0 = __builtin_amdgcn_cvt_pk_fp8_f32(v0[2], v0[3], q0, true);
                               int q1 = __builtin_amdgcn_cvt_pk_fp8_f32(v1[0], v1[1], 0, false); q1 = __builtin_amdgcn_cvt_pk_fp8_f32(v1[2], v1[3], q1, true);
                               *(u32x2*)(xb8 + off + bj * HALF) = (u32x2){(unsigned)q0, (unsigned)q1}; }
                    ss += (v0[0] * v0[0] + v0[1] * v0[1]) + (v0[2] * v0[2] + v0[3] * v0[3]) + (v1[0] * v1[0] + v1[1] * v1[1]) + (v1[2] * v1[2] + v1[3] * v1[3]); }
                if (ssq_out) { ss += __shfl_xor(ss, 16); ss += __shfl_xor(ss, 32); if (fq == 0) atomicAdd(ssq_out + row, (u64)(ss * SSQ_SCALE)); } }
            asm volatile("" ::: "memory");
        }
    }
};

template <bool FP8 = false, class Epi, class Sched>
__device__ __forceinline__ void gemm_phase(LAS unsigned char* lds, const Gemm g, const Sched& S, const Epi& E, const int tid) {
    const int wid = __builtin_amdgcn_readfirstlane(tid >> 6), lane = tid & 63, wr = wid >> 2, wc = wid & 3, fr = lane & 15, fq = lane >> 4;
    const int K = g.K, nt = K / BK;
    unsigned voffA[2], voffB[2];
#pragma unroll
    for (int i = 0; i < 2; ++i) { int R, C; stage_rc(tid * 16 + i * 8192, R, C); const int Rb = (R & ~31) + perm32(R & 31);
        voffA[i] = (unsigned)(R * (g.a_tiled ? BK : g.lda) + C) * 2u; voffB[i] = (unsigned)(Rb * g.ldb + C) * 2u; }
    const size_t kstep = (size_t)(BK * 2), kstepA = g.a_tiled ? (size_t)(2 * HTB) : kstep;
    const size_t hstepA = g.a_tiled ? (size_t)HTB : (size_t)HALF * g.lda * 2, hstepB = (size_t)HALF * g.ldb * 2;
    const size_t tstepA = g.a_tiled ? (size_t)nt * 2 * HTB : 2 * hstepA, tstepB = 2 * hstepB;
    const unsigned ldsw = (unsigned)wid * 1024u;
    const int aoff = lds_byte(wr * 64 + fr, fq * 8), boff = lds_byte(wc * 32 + fr, fq * 8);
#define PG8_SA(b, h) (((b) * 2 + (h)) * HTB)
#define PG8_SB(b, h) ((4 + (b) * 2 + (h)) * HTB)
#define PG8_STAGE(bufoff, gbase, voff) do { _Pragma("unroll") for (int _i = 0; _i < 2; ++_i) \
        __builtin_amdgcn_global_load_lds((const unsigned*)((const char*)(gbase) + (voff)[_i]), (LAS unsigned*)(lds + (bufoff) + ldsw + _i * 8192), 16, 0, 0); } while (0)
#define PG8_LDA(dst, b, h) do { _Pragma("unroll") for (int m = 0; m < 4; ++m) _Pragma("unroll") for (int k = 0; k < 2; ++k) dst[m][k] = *(const LAS bf16x8*)(lds + PG8_SA(b, h) + aoff + m * 2048 + k * 1024); } while (0)
#define PG8_LDB(dst, b, h) do { _Pragma("unroll") for (int n = 0; n < 2; ++n) _Pragma("unroll") for (int k = 0; k < 2; ++k) dst[n][k] = *(const LAS bf16x8*)(lds + PG8_SB(b, h) + boff + n * 2048 + k * 1024); } while (0)
typedef long i64x2_t __attribute__((ext_vector_type(2)));
#define PG8_MMA(ai, bj, At, Bt) do { __builtin_amdgcn_s_setprio(1); \
        if constexpr (FP8) { _Pragma("unroll") for (int m = 0; m < 4; ++m) _Pragma("unroll") for (int n = 0; n < 2; ++n) _Pragma("unroll") for (int k = 0; k < 2; ++k) { \
            const i64x2_t b_ = __builtin_bit_cast(i64x2_t, Bt[n][k]), a_ = __builtin_bit_cast(i64x2_t, At[m][k]); \
            acc[ai][bj][m][n] = __builtin_amdgcn_mfma_f32_16x16x32_fp8_fp8(b_[0], a_[0], acc[ai][bj][m][n], 0, 0, 0); \
            acc[ai][bj][m][n] = __builtin_amdgcn_mfma_f32_16x16x32_fp8_fp8(b_[1], a_[1], acc[ai][bj][m][n], 0, 0, 0); } } \
        else { _Pragma("unroll") for (int m = 0; m < 4; ++m) _Pragma("unroll") for (int n = 0; n < 2; ++n) _Pragma("unroll") for (int k = 0; k < 2; ++k) \
            acc[ai][bj][m][n] = __builtin_amdgcn_mfma_f32_16x16x32_bf16(Bt[n][k], At[m][k], acc[ai][bj][m][n], 0, 0, 0); } \
        __builtin_amdgcn_s_setprio(0); } while (0)
#define PG8_WAIT_V(n) asm volatile("s_waitcnt vmcnt(" #n ")" ::: "memory")
#define PG8_WAIT_L(n) asm volatile("s_waitcnt lgkmcnt(" #n ")" ::: "memory")
#define PG8_BAR __builtin_amdgcn_s_barrier()
#define PG8_SCHED __builtin_amdgcn_sched_barrier(0)
    Unit cur, nxt; int ui = 0;
    if (!S.next(0, cur)) return;
    f32x4 acc[2][2][4][2];
#pragma unroll
    for (int a = 0; a < 2; ++a)
#pragma unroll
        for (int b = 0; b < 2; ++b)
#pragma unroll
            for (int m = 0; m < 4; ++m)
#pragma unroll
                for (int n = 0; n < 2; ++n) acc[a][b][m][n] = (f32x4){0.f, 0.f, 0.f, 0.f};
    bf16x8 At[4][2], B0[2][2], B1[2][2];
    const char* cA = (const char*)g.A + (size_t)cur.pm * tstepA; const char* cB = (const char*)g.Bt + (size_t)cur.pn * tstepB;
    PG8_STAGE(PG8_SB(0, 0), cB, voffB); PG8_STAGE(PG8_SB(0, 1), cB + hstepB, voffB); PG8_STAGE(PG8_SA(0, 0), cA, voffA); PG8_STAGE(PG8_SA(0, 1), cA + hstepA, voffA);
    if (wr == 1) PG8_BAR;
    PG8_WAIT_V(2); PG8_BAR;
    PG8_STAGE(PG8_SB(1, 0), cB + kstep, voffB); PG8_STAGE(PG8_SA(1, 0), cA + kstepA, voffA); PG8_STAGE(PG8_SB(1, 1), cB + hstepB + kstep, voffB);
    PG8_WAIT_V(6); PG8_BAR;
    for (;;) {
        const bool has_next = S.next(ui + 1, nxt);
        const char* nA = has_next ? (const char*)g.A + (size_t)nxt.pm * tstepA : cA; const char* nB = has_next ? (const char*)g.Bt + (size_t)nxt.pn * tstepB : cB;
        for (int t = 0; t < nt; t += 2) {
            const bool last = (t == nt - 2);
            const char* a1 = cA + (size_t)(t + 1) * kstepA;
            const char* a2 = last ? nA : cA + (size_t)(t + 2) * kstepA; const char* b2 = last ? nB : cB + (size_t)(t + 2) * kstep;
            const char* a3 = a2 + kstepA; const char* b3 = b2 + kstep;
            PG8_LDB(B0, 0, 0); PG8_LDB(B1, 0, 1); PG8_SCHED; PG8_LDA(At, 0, 0); PG8_STAGE(PG8_SA(1, 1), a1 + hstepA, voffA);
            PG8_WAIT_V(8); PG8_WAIT_L(0); PG8_BAR; PG8_MMA(0, 0, At, B0); PG8_MMA(0, 1, At, B1); PG8_BAR; PG8_SCHED;
            PG8_LDA(At, 0, 1); PG8_STAGE(PG8_SB(0, 0), b2, voffB); PG8_STAGE(PG8_SB(0, 1), b2 + hstepB, voffB); PG8_STAGE(PG8_SA(0, 0), a2, voffA);
            PG8_WAIT_V(8); PG8_WAIT_L(0); PG8_BAR; PG8_MMA(1, 0, At, B0); PG8_MMA(1, 1, At, B1); PG8_BAR; PG8_SCHED;
            PG8_LDB(B0, 1, 0); PG8_LDB(B1, 1, 1); PG8_SCHED; PG8_LDA(At, 1, 0); PG8_STAGE(PG8_SA(0, 1), a2 + hstepA, voffA);
            PG8_WAIT_V(8); PG8_WAIT_L(0); PG8_BAR; PG8_MMA(0, 0, At, B0); PG8_MMA(0, 1, At, B1); PG8_BAR; PG8_SCHED;
            PG8_LDA(At, 1, 1); PG8_STAGE(PG8_SB(1, 0), b3, voffB); PG8_STAGE(PG8_SB(1, 1), b3 + hstepB, voffB); PG8_STAGE(PG8_SA(1, 0), a3, voffA);
            PG8_WAIT_V(8); PG8_WAIT_L(0); PG8_BAR; PG8_MMA(1, 0, At, B0); PG8_MMA(1, 1, At, B1); PG8_BAR; PG8_SCHED;
        }
        if (wr == 0) PG8_BAR;
        E(acc, cur, wr, wc, fr, fq, lds + STAGE_BYTES);
        if (!has_next) break;
#pragma unroll
        for (int a = 0; a < 2; ++a)
#pragma unroll
            for (int b = 0; b < 2; ++b)
#pragma unroll
                for (int m = 0; m < 4; ++m)
#pragma unroll
                    for (int n = 0; n < 2; ++n) acc[a][b][m][n] = (f32x4){0.f, 0.f, 0.f, 0.f};
        cur = nxt; cA = nA; cB = nB; ++ui;
        if (wr == 1) PG8_BAR;
    }
    PG8_WAIT_V(0);
    PG8_BAR;
#undef PG8_SA
#undef PG8_SB
#undef PG8_STAGE
#undef PG8_LDA
#undef PG8_LDB
#undef PG8_MMA
#undef PG8_WAIT_V
#undef PG8_WAIT_L
#undef PG8_BAR
#undef PG8_SCHED
}
}

#define XB_TMO      128
#define XB_XCNT(j)  (256  + 64 * (j))
#define XB_XSUB(j)  (1280 + 64 * (j))
#define XB_XGEN(j)  (2304 + 64 * (j))
#define XB_TOP      3328
#define XB_TOPGEN   3392
#define XCD_BAR_WORDS 3456
#define XB_SPIN_CAP (1u << 22)

__device__ __forceinline__ unsigned xb_ld(unsigned* p)              { return __hip_atomic_load(p, __ATOMIC_RELAXED, __HIP_MEMORY_SCOPE_AGENT); }
__device__ __forceinline__ unsigned xb_add(unsigned* p, unsigned v) { return __hip_atomic_fetch_add(p, v, __ATOMIC_RELAXED, __HIP_MEMORY_SCOPE_AGENT); }
__device__ __forceinline__ unsigned xb_xcc_id() { return (unsigned)__builtin_amdgcn_s_getreg((3 << 11) | 20) & 0xFu; }
#define XB_SPIN(cond, bar) do { unsigned _sp = 0; while (cond) { __builtin_amdgcn_s_sleep(1); \
    if ((++_sp & 255u) == 0u) { if (xb_ld(&(bar)[XB_TMO])) break; if (_sp > XB_SPIN_CAP) { atomicAdd(&(bar)[XB_TMO], 1u); break; } } } } while (0)

struct XcdBarrier { unsigned* bar; unsigned x; volatile LAS unsigned* st; };

__device__ __forceinline__ XcdBarrier xcd_barrier_post(unsigned* bar, volatile LAS unsigned* st) {
    XcdBarrier b; b.bar = bar; b.x = xb_xcc_id(); b.st = st;
    if (threadIdx.x == 0) (void)xb_add(&bar[XB_XCNT(b.x)], 1u);
    return b;
}
__device__ __forceinline__ void xcd_barrier_complete(unsigned* bar, unsigned x, unsigned& nloc, unsigned& nx) {
    const unsigned G = gridDim.x * gridDim.y * gridDim.z;
    unsigned sum, cnt, mine, sp = 0u;
    for (;;) {
        sum = 0u; cnt = 0u; mine = 0u;
#pragma unroll
        for (unsigned j = 0; j < 16; ++j) { const unsigned c = xb_ld(&bar[XB_XCNT(j)]); sum += c; cnt += (c > 0u) ? 1u : 0u; mine = (j == x) ? c : mine; }
        if (sum == G) break;
        __builtin_amdgcn_s_sleep(1);
        if ((++sp & 255u) == 0u) { if (xb_ld(&bar[XB_TMO])) break; if (sp > XB_SPIN_CAP) { atomicAdd(&bar[XB_TMO], 1u); break; } }
    }
    nloc = mine > 0u ? mine : 1u; nx = cnt > 0u ? cnt : 1u;
}
__device__ __forceinline__ void xcd_barrier(const XcdBarrier& b) {
    asm volatile("s_waitcnt vmcnt(0)" ::: "memory");
    __syncthreads();
    if (threadIdx.x == 0) {
        unsigned* bar = b.bar; unsigned bx_ = b.x; asm volatile("" : "+s"(bar), "+s"(bx_));
        __builtin_amdgcn_s_waitcnt(0);
        unsigned nloc = b.st[0], nx = b.st[1];
        if (nloc == 0u) { xcd_barrier_complete(bar, bx_, nloc, nx); b.st[0] = nloc; b.st[1] = nx; }
        const unsigned old = xb_add(&bar[XB_XSUB(bx_)], 1u);
        const unsigned gen = old / nloc;
        if (old + 1u == (gen + 1u) * nloc) {
            __builtin_amdgcn_fence(__ATOMIC_RELEASE, "agent");
            asm volatile("s_waitcnt vmcnt(0)" ::: "memory");
            const unsigned og = xb_add(&bar[XB_TOP], 1u);
            const unsigned tg = og / nx;
            if (og + 1u == (tg + 1u) * nx) xb_add(&bar[XB_TOPGEN], 1u);
            else XB_SPIN(xb_ld(&bar[XB_TOPGEN]) == tg, bar);
            __builtin_amdgcn_fence(__ATOMIC_ACQUIRE, "agent");
            xb_add(&bar[XB_XGEN(bx_)], 1u);
            asm volatile("s_waitcnt vmcnt(0)" ::: "memory");
        } else {
            XB_SPIN(xb_ld(&bar[XB_XGEN(bx_)]) == gen, bar);
            __builtin_amdgcn_fence(__ATOMIC_ACQUIRE, "agent");
            asm volatile("s_waitcnt vmcnt(0)" ::: "memory");
        }
    }
    __syncthreads();
}

namespace att {
constexpr int NW = 8, QBLK = 32, KVBLK = 64;
constexpr float THR2 = 8.f * LOG2E;
enum { K_MEM = 0, K_FOX = 1, K_MLA = 2, K_DIL = 3, K_DSA = 4 };
constexpr int L_V = 0, L_K = 49152, L_XB = 100352, L_TBL = 106496, L_END = 141312, VB = 16384;

struct AP {
    const bf16_t* Q; const bf16_t* K; const bf16_t* V; bf16_t* O;
    long qs, ks, vs, os;
    int kt0, nt;
    int q0;
    float C;
    const float* cum; long cums;
    const u64* msk;
    float* ost; long osts;
    float* mst; long msts;
    int carry_in, carry_out;
    const float* t5; int head, dil;
};

#define ATT_SBAR() __builtin_amdgcn_sched_barrier(0)
__device__ __forceinline__ int crow(int r, int hi) { return (r & 3) + 8 * (r >> 2) + 4 * hi; }
__device__ __forceinline__ int t5_bucket(int dist) {
    const int n = dist < 0 ? 0 : dist; if (n < 16) return n;
    const float v = __log2f((float)n * 0.0625f) * (16.0f / 7.0f); int b = 16 + (int)v; return b > 31 ? 31 : b;
}
__device__ __forceinline__ void rowmax_decide(const f32x16& p0, const f32x16& p1, float& m_reg, float& alpha) {
    float pmax = p0[0];
#pragma unroll
    for (int r = 1; r < 16; ++r) pmax = fmaxf(pmax, p0[r]);
#pragma unroll
    for (int r = 0; r < 16; ++r) pmax = fmaxf(pmax, p1[r]);
    { auto rr = __builtin_amdgcn_permlane32_swap(__float_as_uint(pmax), __float_as_uint(pmax), false, false); pmax = fmaxf(__uint_as_float(rr[0]), __uint_as_float(rr[1])); }
    if (__builtin_expect(__all(pmax - m_reg <= THR2), 1)) { alpha = 1.f; }
    else { const float mn = fmaxf(m_reg, pmax); alpha = __builtin_amdgcn_exp2f(m_reg - mn); m_reg = mn; }
}
__device__ __forceinline__ float half_sum(float ps) {
    auto rr = __builtin_amdgcn_permlane32_swap(__float_as_uint(ps), __float_as_uint(ps), false, false); return __uint_as_float(rr[0]) + __uint_as_float(rr[1]);
}
__device__ __forceinline__ void pack_p(const f32x16& p0, const f32x16& p1, bf16x8& pa0, bf16x8& pa1, bf16x8& pa2, bf16x8& pa3) {
#define ATT_PK4(P, BASE, OUT) do { unsigned a0 = cvt_pk_bf16(P[BASE + 0], P[BASE + 1]), a1 = cvt_pk_bf16(P[BASE + 2], P[BASE + 3]);   \
    unsigned b0 = cvt_pk_bf16(P[BASE + 4], P[BASE + 5]), b1 = cvt_pk_bf16(P[BASE + 6], P[BASE + 7]);                              \
    auto r0 = __builtin_amdgcn_permlane32_swap(a0, b0, false, false); auto r1 = __builtin_amdgcn_permlane32_swap(a1, b1, false, false); \
    u32x4 w = {r0[0], r1[0], r0[1], r1[1]}; OUT = __builtin_bit_cast(bf16x8, w); } while (0)
    ATT_PK4(p0, 0, pa0); ATT_PK4(p0, 8, pa1); ATT_PK4(p1, 0, pa2); ATT_PK4(p1, 8, pa3);
#undef ATT_PK4
}
template <int DK, int NQL>
__device__ __forceinline__ void qkt(f32x16& p0, f32x16& p1, const LAS unsigned char* Ks, const int (&kad)[4], const bf16x8* qr, const LAS unsigned char* qsp) {
    p0 = f32x16{}; p1 = f32x16{};
    constexpr int ND = DK / 16, NQR = ND - NQL;
#define ATT_LDK(d, hf) (*(const LAS bf16x8*)(Ks + ((DK == 128) ? (kad[(d) & 3] ^ (((d) >> 2) ? 128 : 0)) : (kad[(d) & 3] + 128 * ((d) >> 2))) + (hf) * 32 * DK * 2))
#define ATT_LDQ(d) (((d) < NQR) ? qr[(d) < NQR ? (d) : 0] : *(const LAS bf16x8*)(qsp + ((d) - NQR) * 1024))
    bf16x8 b0 = ATT_LDK(0, 0), b1 = ATT_LDK(0, 1), qf = ATT_LDQ(0);
#pragma unroll
    for (int d0 = 0; d0 < ND; ++d0) {
        bf16x8 c0 = b0, c1 = b1, qn = qf;
        if (d0 + 1 < ND) { c0 = ATT_LDK(d0 + 1, 0); c1 = ATT_LDK(d0 + 1, 1); qn = ATT_LDQ(d0 + 1); }
        ATT_SBAR();
        p0 = __builtin_amdgcn_mfma_f32_32x32x16_bf16(b0, qf, p0, 0, 0, 0);
        p1 = __builtin_amdgcn_mfma_f32_32x32x16_bf16(b1, qf, p1, 0, 0, 0);
        ATT_SBAR();
        b0 = c0; b1 = c1; qf = qn; }
#undef ATT_LDK
#undef ATT_LDQ
}
__device__ __forceinline__ int v_st(int k, int c) { const int kk = (k & ~0xC) | ((k & 4) << 1) | ((k & 8) >> 1); return ((kk >> 3) * 4 + (c >> 5)) * 512 + ((kk & 7) * 32 + (c & 31)) * 2; }
__device__ __forceinline__ int v_rd_base(int lane) { return ((lane & 3) << 3) | (((lane >> 2) & 3) << 6) | (((lane >> 4) & 1) << 5) | (((lane >> 5) & 1) << 8); }
constexpr int v_rd_off(int d0, int ks, int half) { return d0 * 512 + ks * 4096 + half * 2048; }
template <int OFF> __device__ __forceinline__ s16x4 tr_read(int vb) { s16x4 r; asm volatile("ds_read_b64_tr_b16 %0, %1 offset:%2" : "=&v"(r) : "v"(vb), "i"(OFF) : "memory"); return r; }
struct VF { s16x4 l0, h0, l1, h1, l2, h2, l3, h3; };
template <int D0> __device__ __forceinline__ void pv_read(VF& f, int vb) {
    f.l0 = tr_read<v_rd_off(D0, 0, 0)>(vb); f.h0 = tr_read<v_rd_off(D0, 0, 1)>(vb); f.l1 = tr_read<v_rd_off(D0, 1, 0)>(vb); f.h1 = tr_read<v_rd_off(D0, 1, 1)>(vb);
    f.l2 = tr_read<v_rd_off(D0, 2, 0)>(vb); f.h2 = tr_read<v_rd_off(D0, 2, 1)>(vb); f.l3 = tr_read<v_rd_off(D0, 3, 0)>(vb); f.h3 = tr_read<v_rd_off(D0, 3, 1)>(vb);
}
#define ATT_VWAIT(n, f) asm volatile("s_waitcnt lgkmcnt(" #n ")" : "+v"(f.l0), "+v"(f.h0), "+v"(f.l1), "+v"(f.h1), "+v"(f.l2), "+v"(f.h2), "+v"(f.l3), "+v"(f.h3) :: "memory")
#define ATT_PK(L, H) (bf16x8){L[0], L[1], L[2], L[3], H[0], H[1], H[2], H[3]}
__device__ __forceinline__ void pv_only(f32x16* o, int vb, bf16x8 pa0, bf16x8 pa1, bf16x8 pa2, bf16x8 pa3) {
    VF fa, fb;
#define ATT_MMA4(od, f) do { od = __builtin_amdgcn_mfma_f32_32x32x16_bf16(pa0, ATT_PK(f.l0, f.h0), od, 0, 0, 0); od = __builtin_amdgcn_mfma_f32_32x32x16_bf16(pa1, ATT_PK(f.l1, f.h1), od, 0, 0, 0); \
        od = __builtin_amdgcn_mfma_f32_32x32x16_bf16(pa2, ATT_PK(f.l2, f.h2), od, 0, 0, 0); od = __builtin_amdgcn_mfma_f32_32x32x16_bf16(pa3, ATT_PK(f.l3, f.h3), od, 0, 0, 0); } while (0)
    pv_read<0>(fa, vb); pv_read<1>(fb, vb);
    ATT_VWAIT(8, fa); ATT_SBAR(); ATT_MMA4(o[0], fa); ATT_SBAR(); pv_read<2>(fa, vb);
    ATT_VWAIT(8, fb); ATT_SBAR(); ATT_MMA4(o[1], fb); ATT_SBAR(); pv_read<3>(fb, vb);
    ATT_VWAIT(8, fa); ATT_SBAR(); ATT_MMA4(o[2], fa); ATT_SBAR();
    ATT_VWAIT(0, fb); ATT_SBAR(); ATT_MMA4(o[3], fb);
#undef ATT_MMA4
}
__device__ __forceinline__ float sm_only(f32x16& p0, f32x16& p1, float m) {
    float s = 0.f;
#pragma unroll
    for (int r = 0; r < 16; ++r) { p0[r] = __builtin_amdgcn_exp2f(p0[r] - m); s += p0[r]; }
#pragma unroll
    for (int r = 0; r < 16; ++r) { p1[r] = __builtin_amdgcn_exp2f(p1[r] - m); s += p1[r]; }
    return s;
}
__device__ __forceinline__ float pv_sm(f32x16* o, int vb, bf16x8 pa0, bf16x8 pa1, bf16x8 pa2, bf16x8 pa3, f32x16& p0, f32x16& p1, float m) {
    VF fa, fb; float s = 0.f;
#define ATT_GAP(od, pa, L, H, X, B) do { od = __builtin_amdgcn_mfma_f32_32x32x16_bf16(pa, ATT_PK(L, H), od, 0, 0, 0); \
        { float t0_ = X[B] - m, t1_ = X[B + 1] - m, e0_, e1_; asm volatile("v_exp_f32 %0, %1" : "=v"(e0_) : "v"(t0_)); asm volatile("v_exp_f32 %0, %1" : "=v"(e1_) : "v"(t1_));     \
          X[B] = e0_; X[B + 1] = e1_; s += e0_; s += e1_; } ATT_SBAR(); } while (0)
    pv_read<0>(fa, vb); pv_read<1>(fb, vb);
    ATT_VWAIT(8, fa); ATT_SBAR();
    ATT_GAP(o[0], pa0, fa.l0, fa.h0, p0, 0); ATT_GAP(o[0], pa1, fa.l1, fa.h1, p0, 2); ATT_GAP(o[0], pa2, fa.l2, fa.h2, p0, 4); ATT_GAP(o[0], pa3, fa.l3, fa.h3, p0, 6);
    pv_read<2>(fa, vb); ATT_VWAIT(8, fb); ATT_SBAR();
    ATT_GAP(o[1], pa0, fb.l0, fb.h0, p0, 8); ATT_GAP(o[1], pa1, fb.l1, fb.h1, p0, 10); ATT_GAP(o[1], pa2, fb.l2, fb.h2, p0, 12); ATT_GAP(o[1], pa3, fb.l3, fb.h3, p0, 14);
    pv_read<3>(fb, vb); ATT_VWAIT(8, fa); ATT_SBAR();
    ATT_GAP(o[2], pa0, fa.l0, fa.h0, p1, 0); ATT_GAP(o[2], pa1, fa.l1, fa.h1, p1, 2); ATT_GAP(o[2], pa2, fa.l2, fa.h2, p1, 4); ATT_GAP(o[2], pa3, fa.l3, fa.h3, p1, 6);
    ATT_VWAIT(0, fb); ATT_SBAR();
    ATT_GAP(o[3], pa0, fb.l0, fb.h0, p1, 8); ATT_GAP(o[3], pa1, fb.l1, fb.h1, p1, 10); ATT_GAP(o[3], pa2, fb.l2, fb.h2, p1, 12); ATT_GAP(o[3], pa3, fb.l3, fb.h3, p1, 14);
#undef ATT_GAP
    return s;
}

template <int KIND>
__device__ __forceinline__ void score(f32x16& p0, f32x16& p1, const AP& a, int t, int buf, LAS unsigned char* lds, int wid, int r32, int hi, float cq) {
    const float C = a.C; const int k0 = t * 64; const int q = a.q0 + wid * 32 + r32; const float NEG = -INFINITY;
    if constexpr (KIND == K_FOX) {
        const LAS f32x4* cb = (const LAS f32x4*)(lds + L_XB + buf * 2048) + hi;
#pragma unroll
        for (int g = 0; g < 4; ++g) { const f32x4 c4 = cb[2 * g], c4b = cb[2 * g + 8];
#pragma unroll
            for (int j = 0; j < 4; ++j) { p0[4 * g + j] = fmaf(p0[4 * g + j], C, cq - c4[j]); p1[4 * g + j] = fmaf(p1[4 * g + j], C, cq - c4b[j]); } }
    } else if constexpr (KIND == K_DSA || KIND == K_DIL) {
        const LAS float* tb = (const LAS float*)(lds + L_TBL) + (q - k0 - 4 * hi + 256 - 59);
#pragma unroll
        for (int r = 0; r < 16; ++r) { const int cc = (r & 3) + 8 * (r >> 2); p0[r] = fmaf(p0[r], C, tb[59 - cc]); p1[r] = fmaf(p1[r], C, tb[59 - cc - 32]); }
        if constexpr (KIND == K_DSA) {
            const LAS unsigned* mb = (const LAS unsigned*)(lds + L_XB + buf * 2048) + wid * 64;
            const unsigned wl = mb[r32] >> (4 * hi), wh = mb[32 + r32] >> (4 * hi);
#pragma unroll
            for (int r = 0; r < 16; ++r) { const int cc = (r & 3) + 8 * (r >> 2); p0[r] = ((wl >> cc) & 1u) ? p0[r] : NEG; p1[r] = ((wh >> cc) & 1u) ? p1[r] : NEG; }
        }
    } else {
#pragma unroll
        for (int r = 0; r < 16; ++r) { p0[r] *= C; p1[r] *= C; }
    }
    if constexpr (KIND == K_FOX || KIND == K_MLA) {
        if (k0 + 63 > a.q0) {
            const int kb = k0 + 4 * hi;
#pragma unroll
            for (int r = 0; r < 16; ++r) { const int kv = kb + (r & 3) + 8 * (r >> 2); if (kv > q) p0[r] = NEG; if (kv + 32 > q) p1[r] = NEG; }
        }
    }
}

template <int KIND, int DK>
__device__ __forceinline__ void attn_unit(LAS unsigned char* lds, const AP& a, const int wave_id) {
    const int tid = tid_opaque(wave_id);
    const int lane = tid & 63, r32 = lane & 31, hi = lane >> 5; const int wid = __builtin_amdgcn_readfirstlane(tid >> 6);
    constexpr bool HAS_TBL = (KIND == K_DSA || KIND == K_DIL), HAS_X = (KIND == K_FOX || KIND == K_DSA);
    constexpr int KB = KVBLK * DK * 2, NKC = DK / 8, NKL = (64 * NKC) / 512, ND0 = DK / 16;
    constexpr int NQL = (DK == 192) ? 2 : (HAS_TBL ? 2 : 4), NQR = ND0 - NQL, NLD = NKL + 2 + (HAS_X ? 1 : 0);
    constexpr int LWS = (DK == 192) ? 122880 : 98304, LQSP = (DK == 192) ? 124928 : (HAS_TBL ? 123904 : 106496);
    LAS unsigned char* V_lds = lds + L_V; LAS unsigned char* K_lds = lds + L_K;
    LAS float* wsf = (LAS float*)(lds + LWS) + wid * 64; LAS float* li_l = wsf; LAS float* al_l = wsf + 32;
    LAS unsigned char* qsp = lds + LQSP + wid * (NQL * 1024) + lane * 16;
    float m_reg = -1e30f, l_reg = 0.f; f32x16 o[4] = {}; bf16x8 qr[NQR];
    const int qi = wid * 32 + r32;
    const bf16_t* Qw = a.Q + (long)qi * a.qs + hi * 8;
#pragma unroll
    for (int d0 = 0; d0 < ND0; ++d0) { const bf16x8 qv = *(const bf16x8*)(Qw + d0 * 16); if (d0 < NQR) qr[d0 < NQR ? d0 : 0] = qv; else *(LAS bf16x8*)(qsp + (d0 - NQR) * 1024) = qv; }
    float cq = 0.f;
    if constexpr (KIND == K_FOX) cq = a.cum[(long)(a.q0 + qi) * a.cums];
    if constexpr (KIND == K_DIL) {
        if (a.carry_in) {
            m_reg = a.mst[(long)qi * a.msts]; l_reg = a.mst[(long)qi * a.msts + 1];
#pragma unroll
            for (int r = 0; r < 16; ++r) { const float* orow = a.ost + (long)(wid * 32 + crow(r, hi)) * a.osts + r32;
#pragma unroll
                for (int d0 = 0; d0 < 4; ++d0) o[d0][r] = __builtin_nontemporal_load(orow + d0 * 32); }
        }
    }
    if constexpr (KIND == K_DSA) {
        LAS float* tbl = (LAS float*)(lds + L_TBL);
        for (int i = tid; i < 4352; i += 512) { const int dist = i - 256; tbl[i] = dist < 0 ? -INFINITY : a.t5[t5_bucket(dist) * 16 + a.head] * LOG2E; }
    }
    if constexpr (KIND == K_DIL) {
        LAS float* tbl = (LAS float*)(lds + L_TBL);
        for (int i = tid; i < 640; i += 512) { const int rel = i - 256; tbl[i] = (rel < 0 || rel > 128) ? -INFINITY : a.t5[t5_bucket(rel * a.dil) * 16 + a.head] * LOG2E; }
    }
    int ksrc[NKL], vsrc[2];
#pragma unroll
    for (int c = 0; c < NKL; ++c) { const int Lb = (wid * NKL + c) * 1024 + lane * 16, row = Lb / (DK * 2), chp = (Lb % (DK * 2)) / 16; ksrc[c] = row * (int)a.ks + ((DK == 128) ? (chp ^ (row & 15)) : ((chp & ~7) | ((chp & 7) ^ (row & 7)))) * 8; }
#pragma unroll
    for (int c = 0; c < 2; ++c) { const int sl = (2 * wid + c) * 64 + lane, st = sl >> 5, wi = sl & 31, kk = ((st >> 2) << 3) | (wi >> 2), k = (kk & ~0xC) | ((kk & 4) << 1) | ((kk & 8) >> 1); vsrc[c] = k * (int)a.vs + (st & 3) * 32 + (wi & 3) * 8; }
    const int vb0 = (int)(unsigned)(uintptr_t)V_lds + v_rd_base(lane);
    int kad[4];
#pragma unroll
    for (int j = 0; j < 4; ++j) kad[j] = r32 * (DK * 2) + (((hi | (j << 1)) ^ (r32 & 7)) << 4) + ((DK == 128) ? 128 * ((r32 >> 3) & 1) : 0);
#define ATT_DMA(t, sl) do { const long kb_ = (long)(t) * 64; \
        _Pragma("unroll") for (int c_ = 0; c_ < NKL; ++c_) __builtin_amdgcn_global_load_lds((const unsigned*)(a.K + kb_ * a.ks + ksrc[c_]), (LAS unsigned*)(K_lds + (sl) * KB + (wid * NKL + c_) * 1024), 16, 0, 0); \
        _Pragma("unroll") for (int c_ = 0; c_ < 2; ++c_) __builtin_amdgcn_global_load_lds((const unsigned*)(a.V + kb_ * a.vs + vsrc[c_]), (LAS unsigned*)(V_lds + (sl) * VB + (2 * wid + c_) * 1024), 16, 0, 0); \
        if constexpr (KIND == K_FOX) __builtin_amdgcn_global_load_lds((const unsigned*)(a.cum + (kb_ + lane) * a.cums), (LAS unsigned*)(lds + L_XB + (sl) * 2048), 4, 0, 0);     \
        if constexpr (KIND == K_DSA) __builtin_amdgcn_global_load_lds((const unsigned*)(a.msk + (long)(wid * 32 + r32) * 64 + (t)) + hi, (LAS unsigned*)(lds + L_XB + (sl) * 2048 + wid * 256), 4, 0, 0); } while (0)
#define ATT_RESC(al) do { if (__any((al) < 1.f)) { if (hi == 0) al_l[r32] = (al); asm volatile("s_waitcnt lgkmcnt(0)" ::: "memory"); \
        _Pragma("unroll") for (int d = 0; d < 4; ++d) _Pragma("unroll") for (int r = 0; r < 16; ++r) o[d][r] *= al_l[crow(r, hi)]; } } while (0)
#define ATT_BAR() do { asm volatile("s_waitcnt lgkmcnt(0)" ::: "memory"); __builtin_amdgcn_s_barrier(); asm volatile("" ::: "memory"); } while (0)
    f32x16 p0, p1; float al = 1.f; bf16x8 pa0, pa1, pa2, pa3; const int NT = a.nt, T0 = a.kt0;
    asm volatile("s_waitcnt vmcnt(0) lgkmcnt(0)" ::: "memory");
    ATT_DMA(T0, 0);
    if (NT > 1) { ATT_DMA(T0 + 1, 1); asm volatile("s_waitcnt vmcnt(%0)" :: "n"(NLD) : "memory"); } else { asm volatile("s_waitcnt vmcnt(0)" ::: "memory"); }
    ATT_BAR();
    int sl = 0, sl2 = 2;
    for (int jj = 0; jj < NT; ++jj) {
        const int t = T0 + jj;
        if (jj + 2 < NT) ATT_DMA(t + 2, sl2);
        bool lv = true; { const int k0_ = t * 64, qw_ = a.q0 + wid * 32;
            if constexpr (KIND == K_FOX || KIND == K_MLA || KIND == K_DSA) lv = k0_ <= qw_ + 31;
            if constexpr (KIND == K_DIL) lv = (k0_ <= qw_ + 31) && (k0_ + 63 >= qw_ - 128); }
        if (lv) {
            ATT_SBAR(); qkt<DK, NQL>(p0, p1, K_lds + sl * KB, kad, qr, qsp);
            score<KIND>(p0, p1, a, t, sl, lds, wid, r32, hi, cq);
            rowmax_decide(p0, p1, m_reg, al);
            const float ps = sm_only(p0, p1, m_reg);
            l_reg = l_reg * al + half_sum(ps);
            ATT_RESC(al);
            pack_p(p0, p1, pa0, pa1, pa2, pa3); ATT_SBAR();
            pv_only(o, vb0 + sl * VB, pa0, pa1, pa2, pa3);
        }
        if (jj + 2 < NT) asm volatile("s_waitcnt vmcnt(%0)" :: "n"(NLD) : "memory"); else asm volatile("s_waitcnt vmcnt(0)" ::: "memory");
        ATT_BAR();
        sl = (sl == 2) ? 0 : sl + 1; sl2 = (sl2 == 2) ? 0 : sl2 + 1;
    }
    bool stateout = false;
    if constexpr (KIND == K_DIL) stateout = a.carry_out != 0;
    if (stateout) {
        int qi2 = qi; asm volatile("" : "+v"(qi2));
        if (hi == 0) { a.mst[(long)qi2 * a.msts] = m_reg; a.mst[(long)qi2 * a.msts + 1] = l_reg; }
#pragma unroll
        for (int r = 0; r < 16; ++r) { float* orow = a.ost + (long)(wid * 32 + crow(r, hi)) * a.osts + r32;
#pragma unroll
            for (int d0 = 0; d0 < 4; ++d0) __builtin_nontemporal_store(o[d0][r], orow + d0 * 32); }
        __syncthreads();
    } else {
        if (hi == 0) li_l[r32] = l_reg;
        asm volatile("s_waitcnt lgkmcnt(0)" ::: "memory");
        float rli[16];
#pragma unroll
        for (int r = 0; r < 16; ++r) rli[r] = __builtin_amdgcn_rcpf(li_l[crow(r, hi)]);
        __syncthreads();
        LAS unsigned short* ost = (LAS unsigned short*)(lds + wid * 8192);
#pragma unroll
        for (int r = 0; r < 16; ++r) { const int orow = crow(r, hi);
#pragma unroll
            for (int d0 = 0; d0 < 4; ++d0) { const unsigned w = cvt_pk_bf16(o[d0][r] * rli[r], 0.f); ost[orow * 128 + d0 * 32 + r32] = (unsigned short)w; } }
        asm volatile("s_waitcnt lgkmcnt(0)" ::: "memory");
#pragma unroll
        for (int i = 0; i < 8; ++i) { const int ch = lane + 64 * i, row = ch >> 4, c16 = ch & 15;
            const u32x4 v = *(const LAS u32x4*)(lds + wid * 8192 + row * 256 + c16 * 16);
            *(u32x4*)(a.O + (long)(wid * 32 + row) * a.os + c16 * 8) = v; }
        __syncthreads();
    }
#undef ATT_DMA
#undef ATT_RESC
#undef ATT_BAR
}
#undef ATT_VWAIT
#undef ATT_PK
}

struct Fr { LAS unsigned char* lds; int tid, lane, wave, vcu, G, gw, ngw; };

__device__ __forceinline__ float wave_sum(float v) {
#pragma unroll
    for (int o = 1; o < 64; o <<= 1) v += __shfl_xor(v, o);
    return v;
}
__device__ __forceinline__ void unpack8(const u32x4 w, float (&v)[8]) {
    v[0] = bf_lo(w.x); v[1] = bf_hi(w.x); v[2] = bf_lo(w.y); v[3] = bf_hi(w.y); v[4] = bf_lo(w.z); v[5] = bf_hi(w.z); v[6] = bf_lo(w.w); v[7] = bf_hi(w.w);
}
__device__ __forceinline__ u32x4 pack8(const float (&v)[8]) {
    u32x4 w; w.x = cvt_pk_bf16(v[0], v[1]); w.y = cvt_pk_bf16(v[2], v[3]); w.z = cvt_pk_bf16(v[4], v[5]); w.w = cvt_pk_bf16(v[6], v[7]); return w;
}
__device__ __forceinline__ float sumsq8(const float (&v)[8]) { return ((v[0] * v[0] + v[1] * v[1]) + (v[2] * v[2] + v[3] * v[3])) + ((v[4] * v[4] + v[5] * v[5]) + (v[6] * v[6] + v[7] * v[7])); }

__device__ __forceinline__ int map_col(int kind, int n) {
    switch (kind) {
        case 1: return 256 * (n >> 7) + (n & 127);
        case 2: return 256 * (n >> 7) + 128 + (n & 127);
        case 3: return n < 6144 ? n : (n < 6160 ? 6656 + (n - 6144) : 6144 + (n - 6160));
        case 4: return n < 1088 ? n : 1280 + (n - 1088);
        case 5: return n < 6144 ? n : (n < 18432 ? n + 512 : 6144 + (n - 18432));
        case 6: return n < 4176 ? n : 4352 + (n - 4176);
        default: return n;
    }
}
struct TrDesc { const float* W; const float* gain; bf16_t* WT; int K, N, ldt, kind, r, f8; };
__device__ __forceinline__ void tr_load(const TrDesc& d, int lane, f32x4 (&v)[16]) {
    const int nblk = (d.N + 63) / 64, kb = d.r / nblk, nb = d.r % nblk, k0 = 64 * kb, n = 64 * nb + 4 * (lane & 15); const bool ok = n < d.N;
    const float* src = d.W + (size_t)(k0 + (lane >> 4)) * d.N + (ok ? n : 0); const size_t rs = (size_t)4 * d.N;
#pragma unroll
    for (int j = 0; j < 16; ++j) v[j] = __builtin_nontemporal_load((const f32x4*)(src + (size_t)j * rs));
}
__device__ __forceinline__ void tr_store(const TrDesc& d, int lane, const f32x4 (&v)[16], LAS float* scr) {
    const int nblk = (d.N + 63) / 64, kb = d.r / nblk, nb = d.r % nblk, k0 = 64 * kb, n0 = 64 * nb;
    { LAS float* w = scr + (lane >> 4) * 65 + 4 * (lane & 15);
#pragma unroll
      for (int j = 0; j < 16; ++j) { w[j * 260 + 0] = v[j][0]; w[j * 260 + 1] = v[j][1]; w[j * 260 + 2] = v[j][2]; w[j * 260 + 3] = v[j][3]; } }
    const int c = lane >> 3, nn = lane & 7; float g[8];
#pragma unroll
    for (int jj = 0; jj < 8; ++jj) g[jj] = d.gain ? d.gain[k0 + 8 * c + jj] : 1.f;
    asm volatile("s_waitcnt lgkmcnt(0)" ::: "memory");
#pragma unroll
    for (int it = 0; it < 8; ++it) { const int nl = nn + 8 * it; const LAS float* rp = scr + (8 * c) * 65 + nl;
        u32x4 o; o.x = cvt_pk_bf16(rp[0 * 65] * g[0], rp[1 * 65] * g[1]); o.y = cvt_pk_bf16(rp[2 * 65] * g[2], rp[3 * 65] * g[3]); o.z = cvt_pk_bf16(rp[4 * 65] * g[4], rp[5 * 65] * g[5]); o.w = cvt_pk_bf16(rp[6 * 65] * g[6], rp[7 * 65] * g[7]);
        if (n0 + nl < d.N) {
            if (d.f8) { int q0 = __builtin_amdgcn_cvt_pk_fp8_f32(rp[0 * 65] * g[0] * 64.f, rp[1 * 65] * g[1] * 64.f, 0, false); q0 = __builtin_amdgcn_cvt_pk_fp8_f32(rp[2 * 65] * g[2] * 64.f, rp[3 * 65] * g[3] * 64.f, q0, true);
                        int q1 = __builtin_amdgcn_cvt_pk_fp8_f32(rp[4 * 65] * g[4] * 64.f, rp[5 * 65] * g[5] * 64.f, 0, false); q1 = __builtin_amdgcn_cvt_pk_fp8_f32(rp[6 * 65] * g[6] * 64.f, rp[7 * 65] * g[7] * 64.f, q1, true);
                        *(u32x2*)((unsigned char*)d.WT + (size_t)map_col(d.kind, n0 + nl) * d.ldt + k0 + 8 * c) = (u32x2){(unsigned)q0, (unsigned)q1}; }
            else *(u32x4*)(d.WT + (size_t)map_col(d.kind, n0 + nl) * d.ldt + k0 + 8 * c) = o; } }
    asm volatile("s_waitcnt lgkmcnt(0)" ::: "memory");
}

__device__ __forceinline__ void rows2048(const Fr& F, const float* x, int nrows, bf16_t* xb, void* out, int mode) {
    for (int m = F.gw; m < nrows; m += F.ngw) {
        const f32x4* xr = (const f32x4*)(x + (size_t)m * DM) + F.lane; f32x4 v[8]; float s = 0.f;
#pragma unroll
        for (int j = 0; j < 8; ++j) { v[j] = xr[64 * j]; s += (v[j].x * v[j].x + v[j].y * v[j].y) + (v[j].z * v[j].z + v[j].w * v[j].w); }
        s = wave_sum(s);
        if (F.lane == 0) { if (mode) ((float*)out)[m] = __builtin_amdgcn_rsqf(s * (1.0f / DM) + RMS_EPS); else ((u64*)out)[m] = (u64)(s * pg8::SSQ_SCALE); }
        if (xb) { u32x2* o8 = (u32x2*)(xb + (size_t)m * DM) + F.lane;
#pragma unroll
            for (int j = 0; j < 8; ++j) { u32x2 w; w.x = cvt_pk_bf16(v[j].x, v[j].y); w.y = cvt_pk_bf16(v[j].z, v[j].w); o8[64 * j] = w; } }
    }
}

__device__ __forceinline__ void hn_step(bf16_t* p, const float (&g)[8]) {
    float v[8]; unpack8(*(const u32x4*)p, v); float ss = sumsq8(v);
    ss += __shfl_xor(ss, 1); ss += __shfl_xor(ss, 2); ss += __shfl_xor(ss, 4); ss += __shfl_xor(ss, 8);
    const float rs = __builtin_amdgcn_rsqf(ss * (1.0f / 128.0f) + RMS_EPS);
#pragma unroll
    for (int j = 0; j < 8; ++j) v[j] = v[j] * rs * g[j];
    *(u32x4*)p = pack8(v);
}
__device__ __forceinline__ void load_gain8(const float* g, int lane, float (&o)[8]) {
#pragma unroll
    for (int j = 0; j < 8; ++j) o[j] = g ? g[(lane & 15) * 8 + j] : 1.f;
}
__device__ __forceinline__ void prep_rows(const Fr& F, bf16_t* P, long ld, int nrows, int c0, int n0, const float* g0, int c1, int n1, const float* g1, int c2, int n2, const float* g2) {
    float ga[8], gb[8], gc[8]; load_gain8(g0, F.lane, ga); load_gain8(g1, F.lane, gb); load_gain8(g2, F.lane, gc);
    for (int m = F.gw; m < nrows; m += F.ngw) {
        bf16_t* row = P + (size_t)m * ld + F.lane * 8;
        for (int s = 0; s < n0; ++s) hn_step(row + c0 + s * 512, ga);
        for (int s = 0; s < n1; ++s) hn_step(row + c1 + s * 512, gb);
        for (int s = 0; s < n2; ++s) hn_step(row + c2 + s * 512, gc);
    }
}

__device__ __forceinline__ void fox_cumsum(const Fr& F, const float* FG, const float* b_f, float* CUM) {
    for (int task = F.gw; task < NB * NH; task += F.ngw) {
        const int b = task >> 4, h = task & 15; const float bias = b_f[h];
        const float* src = FG + ((size_t)b * SEQ + (size_t)F.lane * 64) * 16 + h; float v[64]; float run = 0.f;
#pragma unroll
        for (int i = 0; i < 64; ++i) { const float xg = src[(size_t)i * 16] + bias;
            const float e = __expf(-fabsf(xg)); const float ls = fminf(xg, 0.f) - __logf(1.0f + e);
            run += ls; v[i] = run; }
        float incl = run;
#pragma unroll
        for (int o = 1; o < 64; o <<= 1) { const float t = __shfl_up(incl, o); if (F.lane >= o) incl += t; }
        const float excl = incl - run;
        float* dst = CUM + ((size_t)b * SEQ + (size_t)F.lane * 64) * 16 + h;
#pragma unroll
        for (int i = 0; i < 64; ++i) dst[(size_t)i * 16] = (v[i] + excl) * LOG2E;
    }
}

__device__ const double ROPE_INV[32] = {
    1.0, 0.7498942093324559, 0.5623413251903491, 0.4216965034285822, 0.31622776601683794, 0.23713737056616552, 0.1778279410038923, 0.1333521432163324,
    0.1, 0.07498942093324558, 0.05623413251903491, 0.04216965034285822, 0.03162277660168379, 0.023713737056616554, 0.01778279410038923, 0.01333521432163324,
    0.01, 0.007498942093324558, 0.005623413251903491, 0.004216965034285823, 0.0031622776601683794, 0.0023713737056616554, 0.001778279410038923, 0.001333521432163324,
    0.001, 0.0007498942093324559, 0.0005623413251903491, 0.0004216965034285823, 0.00031622776601683794, 0.00023713737056616554, 0.0001778279410038923, 0.0001333521432163324};
__device__ __forceinline__ void rope_table(const Fr& F, const int* pos, float* COS, float* SIN) {
    const int gt = F.vcu * 512 + F.tid, ngt = F.G * 512;
    for (int i = gt; i < MTOK * 32; i += ngt) { const int m = i >> 5, f = i & 31;
        const double a = (double)pos[m] * (double)(float)ROPE_INV[f]; const double rev = a * 0.15915494309189535; const float fr = (float)(rev - floor(rev));
        COS[i] = __builtin_amdgcn_cosf(fr); SIN[i] = __builtin_amdgcn_sinf(fr); }
}

__device__ __forceinline__ void mla_prep_a(const Fr& F, bf16_t* P, float* RSQ, float* RSKV, bf16_t* KR, const float* rope_g1, const float* gmem, const float* COS, const float* SIN) {
    const int lane = F.lane; float gr[8];
#pragma unroll
    for (int j = 0; j < 8; ++j) gr[j] = rope_g1[(lane & 7) * 8 + j];
    for (int m = F.gw; m < MTOK; m += F.ngw) {
        bf16_t* pr = P + (size_t)m * 1792; float v[8];
        const u32x4 wq = *(const u32x4*)(pr + lane * 8), wk = *(const u32x4*)(pr + 512 + lane * 8);
        u32x4 w = (u32x4){0u, 0u, 0u, 0u}; if (lane < 8) w = *(const u32x4*)(pr + 1024 + lane * 8);
        const float* cp = COS + (size_t)m * 32 + (lane & 3) * 8; const float* sp = SIN + (size_t)m * 32 + (lane & 3) * 8; float cs[8], sn[8];
#pragma unroll
        for (int j = 0; j < 8; ++j) { cs[j] = cp[j]; sn[j] = sp[j]; }
        asm volatile("" ::: "memory");
        unpack8(wq, v); float ss = wave_sum(sumsq8(v)); if (lane == 0) RSQ[m] = __builtin_amdgcn_rsqf(ss * (1.0f / 512.0f) + RMS_EPS);
        unpack8(wk, v); ss = wave_sum(sumsq8(v)); if (lane == 0) RSKV[m] = __builtin_amdgcn_rsqf(ss * (1.0f / 512.0f) + RMS_EPS);
        unpack8(w, v); ss = sumsq8(v); ss += __shfl_xor(ss, 1); ss += __shfl_xor(ss, 2); ss += __shfl_xor(ss, 4);
        const float rs = __builtin_amdgcn_rsqf(ss * (1.0f / 64.0f) + RMS_EPS); float o[8];
#pragma unroll
        for (int j = 0; j < 8; ++j) { const float x = v[j] * rs * gr[j]; const float y = __shfl_xor(x, 4); o[j] = (lane & 4) ? (y * sn[j] + x * cs[j]) : (x * cs[j] - y * sn[j]); }
        if (lane < 8) *(u32x4*)(KR + (size_t)m * 64 + lane * 8) = pack8(o);
    }
}
__device__ __forceinline__ void mla_prep_b(const Fr& F, bf16_t* Q, const bf16_t* KV, bf16_t* KF, const bf16_t* KR, const float* nope_g, const float* rope_g, const float* COS, const float* SIN) {
    const int lane = F.lane, half = lane >> 5, l5 = lane & 31; float gqn[8], gqr[8], gkn[8];
#pragma unroll
    for (int j = 0; j < 8; ++j) { gqn[j] = nope_g[(l5 & 15) * 8 + j]; gkn[j] = nope_g[128 + (l5 & 15) * 8 + j]; gqr[j] = rope_g[(l5 & 7) * 8 + j]; }
    for (int m = F.gw; m < MTOK; m += F.ngw) {
        const float* cp = COS + (size_t)m * 32 + (l5 & 3) * 8; const float* sp = SIN + (size_t)m * 32 + (l5 & 3) * 8; float cs[8], sn[8];
#pragma unroll
        for (int j = 0; j < 8; ++j) { cs[j] = cp[j]; sn[j] = sp[j]; }
        u32x4 krw = (u32x4){0u, 0u, 0u, 0u}; if (l5 >= 16 && l5 < 24) krw = *(const u32x4*)(KR + (size_t)m * 64 + (l5 - 16) * 8);
        u32x4 qw[8], kw[8];
#pragma unroll
        for (int it = 0; it < 8; ++it) { const int h = 2 * it + half;
            qw[it] = (u32x4){0u, 0u, 0u, 0u}; if (l5 < 24) qw[it] = *(const u32x4*)(Q + (size_t)m * 3072 + h * 192 + l5 * 8);
            kw[it] = (u32x4){0u, 0u, 0u, 0u}; if (l5 < 16) kw[it] = *(const u32x4*)(KV + (size_t)m * 4096 + h * 256 + l5 * 8); }
        asm volatile("" ::: "memory");
#pragma unroll
        for (int it = 0; it < 8; ++it) { const int h = 2 * it + half;
            bf16_t* qrow = Q + (size_t)m * 3072 + h * 192 + l5 * 8; float v[8];
            unpack8(qw[it], v); float s8 = sumsq8(v); s8 += __shfl_xor(s8, 1); s8 += __shfl_xor(s8, 2); s8 += __shfl_xor(s8, 4); const float s16 = s8 + __shfl_xor(s8, 8);
            const float rs = (l5 < 16) ? __builtin_amdgcn_rsqf(s16 * (1.0f / 128.0f) + RMS_EPS) : __builtin_amdgcn_rsqf(s8 * (1.0f / 64.0f) + RMS_EPS);
            float o[8];
#pragma unroll
            for (int j = 0; j < 8; ++j) { const float x = v[j] * rs * ((l5 < 16) ? gqn[j] : gqr[j]); const float y = __shfl_xor(x, 4);
                const float rot = (l5 & 4) ? (y * sn[j] + x * cs[j]) : (x * cs[j] - y * sn[j]); o[j] = (l5 < 16) ? x : rot; }
            if (l5 < 24) *(u32x4*)qrow = pack8(o);
            bf16_t* kfrow = KF + (size_t)m * 3072 + h * 192;
            unpack8(kw[it], v); float k16 = sumsq8(v); k16 += __shfl_xor(k16, 1); k16 += __shfl_xor(k16, 2); k16 += __shfl_xor(k16, 4); k16 += __shfl_xor(k16, 8);
            const float krs = __builtin_amdgcn_rsqf(k16 * (1.0f / 128.0f) + RMS_EPS);
#pragma unroll
            for (int j = 0; j < 8; ++j) o[j] = v[j] * krs * gkn[j];
            if (l5 < 16) *(u32x4*)(kfrow + l5 * 8) = pack8(o);
            else if (l5 < 24) *(u32x4*)(kfrow + 128 + (l5 - 16) * 8) = krw;
        }
    }
}

__device__ __forceinline__ void dsa_indexer(const Fr& F, const bf16_t* P, float* SC) {
    constexpr int LDP = 4864, CQI = 3072, CKI = 4096, CWI = 4160;
    const int lane = F.lane, r32 = lane & 31, hg = lane >> 5;
    for (int ui = blockIdx.x; ui < 512; ui += F.G) {
        const int c = ui & 255, second = ui >> 8, b = c >> 5, qb0 = c & 31, qb = second ? 63 - qb0 : qb0;
        const size_t tok0 = (size_t)b * SEQ + qb * 64 + F.wave * 8;
        bf16x8 aq[4][4]; float wv[4][16];
#pragma unroll
        for (int g = 0; g < 4; ++g) { const size_t tok = tok0 + 2 * g + (r32 >> 4); const bf16_t* qp = P + tok * LDP + CQI + (r32 & 15) * 64 + 8 * hg;
#pragma unroll
            for (int ks = 0; ks < 4; ++ks) aq[g][ks] = *(const bf16x8*)(qp + 16 * ks);
#pragma unroll
            for (int r = 0; r < 16; ++r) { const int head = (r & 3) + 8 * ((r >> 2) & 1) + 4 * hg; const size_t tq = tok0 + 2 * g + (r >> 3);
                wv[g][r] = bf_lo((unsigned)P[tq * LDP + CWI + head]) * (0.25f * 0.125f); } }
        const int ntile = 2 * (qb + 1);
        const bf16_t* kp = P + ((size_t)b * SEQ + r32) * LDP + CKI + 8 * hg;
        bf16x8 bk[4], bn[4];
#pragma unroll
        for (int ks = 0; ks < 4; ++ks) bk[ks] = *(const bf16x8*)(kp + 16 * ks);
        for (int t = 0; t < ntile; ++t) {
            if (t + 1 < ntile) {
#pragma unroll
                for (int ks = 0; ks < 4; ++ks) bn[ks] = *(const bf16x8*)(kp + (size_t)(t + 1) * 32 * LDP + 16 * ks);
            }
#pragma unroll
            for (int g = 0; g < 4; ++g) {
                f32x16 d = f32x16{};
#pragma unroll
                for (int ks = 0; ks < 4; ++ks) d = __builtin_amdgcn_mfma_f32_32x32x16_bf16(aq[g][ks], bk[ks], d, 0, 0, 0);
                float s0 = 0.f, s1 = 0.f;
#pragma unroll
                for (int r = 0; r < 8; ++r) { s0 = fmaf(wv[g][r], fmaxf(d[r], 0.f), s0); s1 = fmaf(wv[g][r + 8], fmaxf(d[r + 8], 0.f), s1); }
                auto rr = __builtin_amdgcn_permlane32_swap(__float_as_uint(s0), __float_as_uint(s1), false, false);
                const float tot = __uint_as_float(rr[0]) + __uint_as_float(rr[1]);
                __builtin_nontemporal_store(tot, &SC[(tok0 + 2 * g + hg) * (size_t)SEQ + t * 32 + r32]);
            }
#pragma unroll
            for (int ks = 0; ks < 4; ++ks) bk[ks] = bn[ks];
        }
    }
}

__device__ __forceinline__ void dsa_select(const Fr& F, const float* SC, u64* MSK) {
    const int lane = F.lane;
    for (int qidx = F.gw; qidx < MTOK; qidx += F.ngw) {
        const int s = qidx & (SEQ - 1); const float* row = SC + (size_t)qidx * SEQ; u64* mrow = MSK + (size_t)qidx * 64;
        if (s < 256) { const int lo = 64 * lane; u64 w = 0ull; if (s >= lo + 63) w = ~0ull; else if (s >= lo) w = (2ull << (s - lo)) - 1ull; mrow[lane] = w; continue; }
        unsigned u[64];
#pragma unroll
        for (int i = 0; i < 64; ++i) { unsigned ov = 0u;
            if (64 * i <= s) { const int key = 64 * i + lane; const unsigned bits = __float_as_uint(__builtin_nontemporal_load(row + key)); const unsigned ord = (bits & 0x80000000u) ? ~bits : (bits | 0x80000000u); ov = (key <= s) ? ord : 0u; }
            u[i] = ov; }
        unsigned T = 0u;
        for (int bit = 31; bit >= 0; --bit) { const unsigned cand = T | (1u << bit); int cl = 0;
#pragma unroll
            for (int i0 = 0; i0 < 64; i0 += 8) {
#pragma unroll
                for (int i = i0; i < i0 + 8; ++i) cl += __popcll(__ballot(u[i] >= cand));
                __builtin_amdgcn_sched_barrier(0); }
            if (cl >= 256) T = cand; }
        int cgt = 0;
#pragma unroll
        for (int i0 = 0; i0 < 64; i0 += 8) {
#pragma unroll
            for (int i = i0; i < i0 + 8; ++i) cgt += __popcll(__ballot(u[i] > T));
            __builtin_amdgcn_sched_barrier(0); }
        int need = 256 - cgt; unsigned mlo = 0u, mhi = 0u;
#pragma unroll
        for (int i = 0; i < 64; ++i) { const u64 gt = __ballot(u[i] > T), eq = __ballot(u[i] == T); u64 take = 0ull;
            if (need > 0 && eq != 0ull) { const int c = __popcll(eq);
                if (c <= need) { take = eq; need -= c; }
                else { u64 e = eq; for (int n = 0; n < need; ++n) { const u64 low = e & (0ull - e); take |= low; e ^= low; } need = 0; } }
            const u64 w = gt | take; { const unsigned wl = __builtin_amdgcn_readfirstlane((unsigned)w), wh = __builtin_amdgcn_readfirstlane((unsigned)(w >> 32));
                asm volatile("s_nop 4\n\tv_writelane_b32 %0, %1, %2\n\ts_nop 1" : "+v"(mlo) : "s"(wl), "n"(i)); asm volatile("s_nop 4\n\tv_writelane_b32 %0, %1, %2\n\ts_nop 1" : "+v"(mhi) : "s"(wh), "n"(i)); } }
        mrow[lane] = ((u64)mhi << 32) | (u64)mlo;
    }
}

constexpr size_t MiB = 1u << 20;
constexpr size_t WS_CTL = 0, CTL_ZERO_BYTES = 8 * MiB;
constexpr int CW_BAR = 4096;
constexpr size_t WS_SSQ = 1 * MiB;
constexpr size_t WS_WB = 8 * MiB;
constexpr size_t WS_XB = 236 * MiB;
constexpr size_t WS_MEMB = 364 * MiB;
constexpr size_t WS_MEMKV = 372 * MiB;
constexpr size_t WS_COS = 388 * MiB, WS_SIN = 392 * MiB, WS_RSMEM = 396 * MiB, WS_RSQ = 397 * MiB, WS_RSKV = 398 * MiB;
constexpr size_t WS_XB8 = 560 * MiB;
constexpr size_t WS_MIX = 400 * MiB;
constexpr size_t WS_SCR = 624 * MiB;
constexpr size_t WS_END = (624 + 832) * MiB;
constexpr size_t WB_GU0 = 0, WB_GU1 = 23068672, WB_D0 = 46137344, WB_D1 = 57671680, WB_IN = 69206016, WB_OUT = 108003328, WB_MKV = 113246208, WB_UQ = 115343360, WB_UKV = 116916224;
constexpr int RING_BYTES = 146944, MISC_OFF = RING_BYTES + 64, LDS_BYTES = 147456;
static_assert(att::L_END <= RING_BYTES && pg8::STAGE_BYTES <= RING_BYTES, "LDS map");
constexpr int NPHASES = 44;
#ifndef F8MASK
#define F8MASK 4
#endif
#define F8LAYER(L) (((F8MASK) >> (L)) & 1)
#ifndef RG
#define RG 1
#endif
#ifndef RD
#define RD 1
#endif
#ifndef RI
#define RI 1
#endif
#ifndef RA
#define RA 1
#endif
#ifndef RC
#define RC 1
#endif
#define REP(n) for (int rep_ = 0; rep_ < (n); ++rep_)

struct Args { const void* in[27]; float* out; unsigned char* ws; int ph_lo, ph_hi; };

typedef const __attribute__((address_space(4))) struct Args* ArgsPc;
__device__ __forceinline__ TrDesc tr_desc(ArgsPc A, int L, bf16_t* WB, int it) {
    const float* w_gate = (const float*)A->in[5]; const float* w_up = (const float*)A->in[6]; const float* w_down = (const float*)A->in[7];
    const float* ffn_norm = (const float*)A->in[4]; const float* attn_norm = (const float*)A->in[8];
    const float* w_out = (const float*)A->in[12];
    const float* w_in = (const float*)(L == 0 ? A->in[13] : L == 1 ? A->in[16] : L == 2 ? A->in[23] : A->in[25]);
    const int nin = (L == 0 ? 6672 : L == 1 ? 1600 : L == 2 ? 18944 : 4688);
    const int I_GU = 32 * 88, I_D = 88 * 32, I_IN = 32 * ((nin + 63) / 64), I_OUT = 40 * 32, I_UQ = (L == 1) ? 8 * 48 : 0;
    TrDesc d; d.f8 = 0; int r = it;
    if (r < 4 * I_GU) { const int s = r / I_GU; r -= s * I_GU; const int f = s >> 1, up = s & 1;
        d.W = (up ? w_up : w_gate) + (size_t)(L * 2 + f) * DM * DFF; d.K = DM; d.N = DFF; d.gain = ffn_norm + (size_t)(L * 2 + f) * DM; d.WT = WB + (f ? WB_GU1 : WB_GU0); d.ldt = DM; d.kind = up ? 2 : 1; }
    else { r -= 4 * I_GU;
        if (r < 2 * I_D) { const int f = r / I_D; r -= f * I_D; d.W = w_down + (size_t)(L * 2 + f) * DFF * DM; d.K = DFF; d.N = DM; d.gain = nullptr; d.WT = WB + (f ? WB_D1 : WB_D0); d.ldt = DFF; d.kind = 0; }
        else { r -= 2 * I_D;
            if (r < I_IN) { d.W = w_in; d.K = DM; d.N = nin; d.gain = attn_norm + (size_t)L * DM; d.WT = WB + WB_IN; d.ldt = DM; d.kind = 3 + L; d.f8 = F8LAYER(L) ? 1 : 0; }
            else { r -= I_IN;
                if (r < I_OUT) { d.W = w_out + (size_t)L * OUTIN * DM; d.K = OUTIN; d.N = DM; d.gain = nullptr; d.WT = WB + WB_OUT; d.ldt = OUTIN; d.kind = 0; }
                else { r -= I_OUT;
                    if (r < I_UQ) { d.W = (const float*)A->in[18]; d.K = 512; d.N = 3072; d.gain = (const float*)A->in[17]; d.WT = WB + WB_UQ; d.ldt = 512; d.kind = 0; }
                    else { r -= I_UQ; d.W = (const float*)A->in[20]; d.K = 512; d.N = 4096; d.gain = (const float*)A->in[19]; d.WT = WB + WB_UKV; d.ldt = 512; d.kind = 0; } } } } }
    d.r = r; return d;
}
__device__ __forceinline__ void convert_layer(const Fr& F, ArgsPc A, int L, bf16_t* WB) {
    const int nin = (L == 0 ? 6672 : L == 1 ? 1600 : L == 2 ? 18944 : 4688);
    const int total = 4 * 32 * 88 + 2 * 88 * 32 + 32 * ((nin + 63) / 64) + 40 * 32 + ((L == 1) ? 8 * 48 + 8 * 64 : 0);
    LAS float* scr = (LAS float*)(F.lds + F.wave * 16640);
    f32x4 va[16], vb[16]; int it = F.gw;
    if (it >= total) return;
    TrDesc da = tr_desc(A, L, WB, it), db = da; tr_load(da, F.lane, va);
    for (;;) {
        const bool nb_ = it + F.ngw < total; if (nb_) { db = tr_desc(A, L, WB, it + F.ngw); tr_load(db, F.lane, vb); }
        tr_store(da, F.lane, va, scr); it += F.ngw; if (!nb_) break;
        const bool na_ = it + F.ngw < total; if (na_) { da = tr_desc(A, L, WB, it + F.ngw); tr_load(da, F.lane, va); }
        tr_store(db, F.lane, vb, scr); it += F.ngw; if (!na_) break;
    }
}

__device__ __forceinline__ void mem_attn_units(const Fr& F, const bf16_t* P, long ldp, int memq_col, const bf16_t* MEMKV, bf16_t* MIX) {
    for (int i = blockIdx.x; i < 512; i += F.G) {
        const int b = i >> 6, mh = (i >> 4) & 3, qb = i & 15; const size_t tok = (size_t)b * SEQ + qb * 256;
        att::AP a{}; a.Q = P + tok * ldp + memq_col + mh * 128; a.qs = ldp; a.K = MEMKV + (size_t)b * NMEM * 4096 + mh * 128; a.ks = 4096; a.V = a.K + 512; a.vs = 4096;
        a.O = MIX + tok * OUTIN + 2048 + mh * 128; a.os = OUTIN; a.kt0 = 0; a.nt = 4; a.q0 = 0; a.C = 0.08838834764831845f * LOG2E;
        att::attn_unit<att::K_MEM, 128>(F.lds, a, F.wave);
    }
}
__device__ __forceinline__ void causal_unit_ids(int i, int& b, int& h, int& qb) {
    const int slot = i >> 8, c = i & 255, bh = (c >> 4) * 8 + (c & 7), half = (c >> 3) & 1;
    qb = half ? ((slot & 1) ? slot : 14 - slot) : ((slot & 1) ? slot - 1 : 15 - slot); b = bh >> 4; h = bh & 15;
}

__device__ __forceinline__ Fr mk_frame(unsigned char* lds_raw, int wave_id) {
    Fr F; F.lds = (LAS unsigned char*)lds_raw; F.tid = tid_opaque(wave_id); F.lane = F.tid & 63; F.wave = __builtin_amdgcn_readfirstlane(F.tid >> 6);
    F.G = gridDim.x; { const int bx = blockIdx.x; F.vcu = (F.G % 8 == 0) ? (bx % 8) * (F.G / 8) + bx / 8 : bx; }
    F.gw = F.vcu * 8 + F.wave; F.ngw = F.G * 8; return F;
}
typedef const __attribute__((address_space(4))) Args* ArgsP;
__device__ __forceinline__ ArgsP args_ptr() { auto p = __builtin_amdgcn_kernarg_segment_ptr(); asm volatile("" : "+s"(p)); return (ArgsP)p; }
#define WSP(T, off) ((T*)(AP_->ws + (off)))
#define SCRP(T, mib) ((T*)(AP_->ws + WS_SCR + (size_t)(mib) * MiB))

__global__ void __launch_bounds__(512, 2) fwd(Args A) {
    extern __shared__ __attribute__((aligned(16))) unsigned char lds_raw[];
    { LAS unsigned* z = (LAS unsigned*)((LAS unsigned char*)lds_raw + RING_BYTES); for (int u = threadIdx.x; u < (LDS_BYTES - RING_BYTES) / 4; u += 512) z[u] = 0u; }
    __syncthreads();
    const int lo = A.ph_lo, hi = A.ph_hi; const int wave_id = __builtin_amdgcn_readfirstlane((int)threadIdx.x >> 6);
    XcdBarrier bar; bar.bar = (unsigned*)(A.ws + WS_CTL) + CW_BAR; bar.x = 0; bar.st = nullptr;
    if (hi - lo > 1) bar = xcd_barrier_post((unsigned*)(A.ws + WS_CTL) + CW_BAR, (volatile LAS unsigned*)((LAS unsigned char*)lds_raw + MISC_OFF) + 8);
    int ph = 0;
#define PH_BEGIN if (ph >= lo && ph < hi) { const Fr F = mk_frame(lds_raw, wave_id); const ArgsP AP_ = args_ptr();
#define PH_END   if (ph + 1 < hi) xcd_barrier(bar); } ++ph;
    const float SC128 = 0.08838834764831845f * LOG2E, SC192 = 0.07216878364870323f * LOG2E;

    PH_BEGIN
        rows2048(F, (const float*)AP_->in[1], NB * NMEM, WSP(bf16_t, WS_MEMB), WSP(float, WS_RSMEM), 1);
        rope_table(F, (const int*)AP_->in[2], WSP(float, WS_COS), WSP(float, WS_SIN));
        rows2048(F, (const float*)AP_->in[0], MTOK, WSP(bf16_t, WS_XB), WSP(u64, WS_SSQ), 0);
#ifdef RZ
        { u32x4* z = WSP(u32x4, WS_END); for (size_t i = (size_t)F.vcu * 512 + F.tid; i < (size_t)2 * DFF * DM * 2 / 16; i += (size_t)F.G * 512) z[i] = (u32x4){0u, 0u, 0u, 0u}; }
#endif
        { LAS float* scr = (LAS float*)(F.lds + F.wave * 16640);
          for (int it = F.gw; it < 4 * 512; it += F.ngw) { const int Lm = it >> 9; TrDesc d; d.W = (const float*)AP_->in[10] + (size_t)Lm * DM * 1024; d.K = DM; d.N = 1024; d.gain = (const float*)AP_->in[9] + (size_t)Lm * DM;
              d.WT = SCRP(bf16_t, 0) + (size_t)Lm * 1024 * DM; d.ldt = DM; d.kind = 0; d.f8 = 0; d.r = it & 511; f32x4 v[16]; tr_load(d, F.lane, v); tr_store(d, F.lane, v, scr); } }
    PH_END
    PH_BEGIN { pg8::Gemm g{WSP(bf16_t, WS_MEMB), SCRP(bf16_t, 0), NB * NMEM, 4096, DM, DM, DM, 0}; pg8::StaticOrder S; S.init(g.M, g.N, F.G, (int)blockIdx.x);
        pg8::EpiProj E{WSP(bf16_t, WS_MEMKV), 4096, WSP(float, WS_RSMEM), 0, nullptr, -1, (const float*)AP_->in[11] + 128, 0, 0, nullptr, 0, 0, nullptr, 0, 0, 1.0f, 4, 2, 256}; pg8::gemm_phase(F.lds, g, S, E, F.tid); } PH_END

    int ver = 0;
#pragma clang loop unroll(full)
    for (int hl = 0; hl < 8; ++hl) {
        const int L = hl >> 1, f = hl & 1;
        if (f == 0) {
            PH_BEGIN REP(RC) convert_layer(F, AP_, L, WSP(bf16_t, WS_WB)); PH_END

        }
        PH_BEGIN
#ifdef RZ
            { pg8::Gemm g{WSP(bf16_t, WS_XB), WSP(bf16_t, WS_END), MTOK, 2 * DFF, DM, DM, DM, 0}; pg8::StaticOrder S; S.init(g.M, g.N, F.G, (int)blockIdx.x);
              pg8::EpiSwiGLU E{SCRP(bf16_t, 0), DFF, WSP(u64, WS_SSQ) + (size_t)ver * MTOK}; pg8::gemm_phase(F.lds, g, S, E, F.tid); }
#endif
            REP(RG) { pg8::Gemm g{WSP(bf16_t, WS_XB), WSP(bf16_t, WS_WB) + (f ? WB_GU1 : WB_GU0), MTOK, 2 * DFF, DM, DM, DM, 0}; pg8::StaticOrder S; S.init(g.M, g.N, F.G, (int)blockIdx.x);
            pg8::EpiSwiGLU E{SCRP(bf16_t, 0), DFF, WSP(u64, WS_SSQ) + (size_t)ver * MTOK}; pg8::gemm_phase(F.lds, g, S, E, F.tid); } PH_END
        PH_BEGIN { pg8::Gemm g{SCRP(bf16_t, 0), WSP(bf16_t, WS_WB) + (f ? WB_D1 : WB_D0), MTOK, DM, DFF, DFF, DFF, 1}; pg8::StaticOrder S; S.init(g.M, g.N, F.G, (int)blockIdx.x);
            if (RD > 1) { pg8::EpiResid E0{ver == 0 ? (const float*)AP_->in[0] : AP_->out, SCRP(float, 400), SCRP(bf16_t, 660), nullptr, nullptr, 0.5f}; pg8::gemm_phase(F.lds, g, S, E0, F.tid); }
            pg8::EpiResid E{ver == 0 ? (const float*)AP_->in[0] : AP_->out, AP_->out, WSP(bf16_t, WS_XB), WSP(u64, WS_SSQ) + (size_t)(ver + 1) * MTOK, (f == 0 && F8LAYER(L)) ? WSP(unsigned char, WS_XB8) : nullptr, 0.5f}; pg8::gemm_phase(F.lds, g, S, E, F.tid); } PH_END
        ++ver;
        if (f != 0) continue;
        const int ngrp = (L == 2) ? 3 : 1;
#pragma clang loop unroll(full)
        for (int g = 0; g < ngrp; ++g) {
            PH_BEGIN REP(RI) { const int ldp = (L == 0) ? 6912 : (L == 1) ? 1792 : (L == 2) ? 6656 : 4864;
                const int nproj = (L == 2) ? (g == 0 ? 6656 : 6144) : ldp; const size_t roff = (L == 2) ? (g == 0 ? 0 : (g == 1 ? 6656 : 12800)) : 0;
                pg8::Gemm gm = F8LAYER(L) ? pg8::Gemm{WSP(bf16_t, WS_XB8), (const bf16_t*)((const unsigned char*)(WSP(bf16_t, WS_WB) + WB_IN) + roff * DM), MTOK, nproj, DM / 2, DM / 2, DM / 2, 0}
                                       : pg8::Gemm{WSP(bf16_t, WS_XB), WSP(bf16_t, WS_WB) + WB_IN + roff * DM, MTOK, nproj, DM, DM, DM, 0};
                pg8::StaticOrder S; S.init(gm.M, gm.N, F.G, (int)blockIdx.x);
                const float* gmq = (const float*)AP_->in[11] + (size_t)L * 256;
                const float* qg = (L == 0) ? (const float*)AP_->in[15] : (L == 2) ? (const float*)AP_->in[24] + (size_t)g * 256 : (L == 3) ? (const float*)AP_->in[26] : nullptr;
                const int kt_hi = (L == 3) ? 10 : 16, mq_lo = (L == 0 || L == 2) ? 24 : (L == 1) ? 5 : 17, mq_hi = (L == 2 && g > 0) ? mq_lo : mq_lo + 2;
                pg8::EpiProj E{SCRP(bf16_t, 0), ldp, WSP(u64, WS_SSQ) + (size_t)ver * MTOK, 1, (L == 0) ? SCRP(float, 432) : nullptr, 26,
                               qg, 0, (L == 1) ? 0 : 8, qg ? qg + 128 : nullptr, 8, (L == 1) ? 8 : kt_hi, gmq, mq_lo, mq_hi, F8LAYER(L) ? (1.0f / 64.0f) : 1.0f, 0, 0, 0}; if (F8LAYER(L)) pg8::gemm_phase<true>(F.lds, gm, S, E, F.tid); else pg8::gemm_phase<false>(F.lds, gm, S, E, F.tid); } PH_END
            if (L == 0) { PH_BEGIN fox_cumsum(F, SCRP(const float, 432), (const float*)AP_->in[14], SCRP(float, 434)); PH_END }
            if (L == 1) { PH_BEGIN mla_prep_a(F, SCRP(bf16_t, 0), WSP(float, WS_RSQ), WSP(float, WS_RSKV), SCRP(bf16_t, 752), (const float*)AP_->in[22] + 64, nullptr, WSP(float, WS_COS), WSP(float, WS_SIN)); PH_END }
            if (L == 1) {
                PH_BEGIN
                    REP(RI) for (int i = 0; i < 2; ++i) { pg8::Gemm gm{SCRP(bf16_t, 0) + (i ? 512 : 0), WSP(bf16_t, WS_WB) + (i ? WB_UKV : WB_UQ), MTOK, i ? 4096 : 3072, 512, 1792, 512, 0}; pg8::StaticOrder S; S.init(gm.M, gm.N, F.G, (int)blockIdx.x);
                        pg8::EpiProj E{i ? SCRP(bf16_t, 304) : SCRP(bf16_t, 112), i ? 4096 : 3072, i ? WSP(float, WS_RSKV) : WSP(float, WS_RSQ), 0, nullptr, -1, nullptr, 0, 0, nullptr, 0, 0, nullptr, 0, 0, 1.0f, 0, 0, 0}; pg8::gemm_phase(F.lds, gm, S, E, F.tid); }
                PH_END
                PH_BEGIN mla_prep_b(F, SCRP(bf16_t, 112), SCRP(const bf16_t, 304), SCRP(bf16_t, 560), SCRP(const bf16_t, 752), (const float*)AP_->in[21], (const float*)AP_->in[22], WSP(float, WS_COS), WSP(float, WS_SIN)); PH_END
            }
            if (L == 3) {
                PH_BEGIN REP(RC) dsa_indexer(F, SCRP(const bf16_t, 0), SCRP(float, 304)); PH_END
                PH_BEGIN REP(RC) dsa_select(F, SCRP(const float, 304), SCRP(u64, 816)); PH_END
            }
            PH_BEGIN
                bf16_t* P = SCRP(bf16_t, 0); bf16_t* MIX = WSP(bf16_t, WS_MIX);
                const long ldp = (L == 0) ? 6912 : (L == 1) ? 1792 : (L == 2) ? 6656 : 4864;
                REP(L == 2 ? 1 : RA) {
                if (L == 0) {
                    const float* CUM = SCRP(const float, 434);
                    for (int i = blockIdx.x; i < 2048; i += F.G) { int b, h, qb; causal_unit_ids(i, b, h, qb); const size_t t0 = (size_t)b * SEQ;
                        att::AP a{}; a.Q = P + (t0 + qb * 256) * ldp + h * 128; a.qs = ldp; a.K = P + t0 * ldp + 2048 + h * 128; a.ks = ldp; a.V = a.K + 2048; a.vs = ldp;
                        a.O = MIX + (t0 + qb * 256) * OUTIN + h * 128; a.os = OUTIN; a.kt0 = 0; a.nt = 4 * (qb + 1); a.q0 = qb * 256; a.C = SC128; a.cum = CUM + t0 * 16 + h; a.cums = 16;
                        att::attn_unit<att::K_FOX, 128>(F.lds, a, F.wave); }
                }
                if (L == 1) {
                    const bf16_t* Qb = SCRP(const bf16_t, 112); const bf16_t* KVb = SCRP(const bf16_t, 304); const bf16_t* KF = SCRP(const bf16_t, 560);
                    for (int i = blockIdx.x; i < 2048; i += F.G) { int b, h, qb; causal_unit_ids(i, b, h, qb); const size_t t0 = (size_t)b * SEQ;
                        att::AP a{}; a.Q = Qb + (t0 + qb * 256) * 3072 + h * 192; a.qs = 3072; a.K = KF + t0 * 3072 + h * 192; a.ks = 3072; a.V = KVb + t0 * 4096 + h * 256 + 128; a.vs = 4096;
                        a.O = MIX + (t0 + qb * 256) * OUTIN + h * 128; a.os = OUTIN; a.kt0 = 0; a.nt = 4 * (qb + 1); a.q0 = qb * 256; a.C = SC192;
                        att::attn_unit<att::K_MLA, 192>(F.lds, a, F.wave); }
                }
                if (L == 2) {
                    const int dil = (g == 0) ? 1 : (g == 1 ? 4 : 16), nblk = 16 / dil; float* OST = SCRP(float, 416); float* ML = SCRP(float, 672);
                    for (int i = blockIdx.x; i < 2048; i += F.G) { const int h = i & 15, rest = i >> 4, b = rest >> 4, rj = rest & 15, r = rj / nblk, jb = rj % nblk;
                        const size_t tokz = (size_t)b * SEQ + r, tokq = tokz + (size_t)jb * 256 * dil;
                        att::AP a{}; a.Q = P + tokq * ldp + h * 128; a.qs = (long)dil * ldp; a.K = P + tokz * ldp + 2048 + h * 128; a.ks = (long)dil * ldp; a.V = a.K + 2048; a.vs = a.ks;
                        a.O = MIX + tokq * OUTIN + h * 128; a.os = (long)dil * OUTIN; a.q0 = jb * 256; a.kt0 = jb == 0 ? 0 : 4 * jb - 2; a.nt = jb == 0 ? 4 : 6; a.C = SC128;
                        a.ost = OST + tokq * 2048 + h * 128; a.osts = (long)dil * 2048; a.mst = ML + (tokq * 16 + h) * 2; a.msts = (long)dil * 32; a.carry_in = g > 0; a.carry_out = g < 2;
                        a.t5 = (const float*)AP_->in[3]; a.head = h; a.dil = dil;
                        att::attn_unit<att::K_DIL, 128>(F.lds, a, F.wave); }
                }
                if (L == 3) {
                    const u64* MSK = SCRP(const u64, 816);
                    for (int i = blockIdx.x; i < 2048; i += F.G) { int b, h, qb; causal_unit_ids(i, b, h, qb); const size_t t0 = (size_t)b * SEQ;
                        att::AP a{}; a.Q = P + (t0 + qb * 256) * ldp + h * 128; a.qs = ldp; a.K = P + t0 * ldp + 2048 + (h >> 2) * 128; a.ks = ldp; a.V = a.K + 512; a.vs = ldp;
                        a.O = MIX + (t0 + qb * 256) * OUTIN + h * 128; a.os = OUTIN; a.kt0 = 0; a.nt = 4 * (qb + 1); a.q0 = qb * 256; a.C = SC128; a.msk = MSK + (t0 + qb * 256) * 64; a.t5 = (const float*)AP_->in[3]; a.head = h;
                        att::attn_unit<att::K_DSA, 128>(F.lds, a, F.wave); }
                }
                if (g == 0) { const int memq_col = (L == 0) ? 6144 : (L == 1) ? 1280 : (L == 2) ? 6144 : 4352; mem_attn_units(F, P, ldp, memq_col, WSP(const bf16_t, WS_MEMKV) + L * 1024, MIX); }
                }
            PH_END
        }
        PH_BEGIN { pg8::Gemm gm{WSP(bf16_t, WS_MIX), WSP(bf16_t, WS_WB) + WB_OUT, MTOK, DM, OUTIN, OUTIN, OUTIN, 0}; pg8::StaticOrder S; S.init(gm.M, gm.N, F.G, (int)blockIdx.x);
            if (RD > 1) { pg8::EpiResid E0{AP_->out, SCRP(float, 400), SCRP(bf16_t, 660), nullptr, nullptr, 1.0f}; pg8::gemm_phase(F.lds, gm, S, E0, F.tid); }
            pg8::EpiResid E{AP_->out, AP_->out, WSP(bf16_t, WS_XB), WSP(u64, WS_SSQ) + (size_t)(ver + 1) * MTOK, nullptr, 1.0f}; pg8::gemm_phase(F.lds, gm, S, E, F.tid); } PH_END
        ++ver;
    }
#undef PH_BEGIN
#undef PH_END
}

#ifndef MK_ONE_LAUNCH
#define MK_ONE_LAUNCH 0
#endif
extern "C" void kernel_launch(void* const* d_in, const int* in_sizes, int n_in, void* d_out, int out_size, void* d_ws, size_t ws_size, hipStream_t stream) {
    static int grid = 0;
    if (grid == 0) {
        if (n_in != 27 || in_sizes[0] != MTOK * DM || out_size != MTOK * DM || ws_size < WS_END) {
            fprintf(stderr, "kernel_launch: unexpected shapes: n_in %d in0 %d out %d ws %zu (need >= %zu); nothing launched\n", n_in, n_in > 0 ? in_sizes[0] : -1, out_size, ws_size, (size_t)WS_END); grid = -1; return; }
        int dev = 0, cus = 0, per_cu = 0;
        if (hipGetDevice(&dev) != hipSuccess || hipDeviceGetAttribute(&cus, hipDeviceAttributeMultiprocessorCount, dev) != hipSuccess) { fprintf(stderr, "kernel_launch: device query failed\n"); grid = -1; return; }
        if (hipFuncSetAttribute((const void*)fwd, hipFuncAttributeMaxDynamicSharedMemorySize, LDS_BYTES) != hipSuccess) { fprintf(stderr, "kernel_launch: hipFuncSetAttribute failed\n"); grid = -1; return; }
        if (hipOccupancyMaxActiveBlocksPerMultiprocessor(&per_cu, (const void*)fwd, 512, LDS_BYTES) != hipSuccess || per_cu < 1)
            fprintf(stderr, "kernel_launch: note: occupancy query reports %d workgroups per CU\n", per_cu);
        (void)hipGetLastError();
        grid = cus;
    }
    if (grid < 0) return;
    if (hipMemsetAsync((char*)d_ws + WS_CTL, 0, CTL_ZERO_BYTES, stream) != hipSuccess) { fprintf(stderr, "kernel_launch: memset failed\n"); return; }
    Args a{};
    for (int i = 0; i < 27; ++i) a.in[i] = d_in[i];
    a.out = (float*)d_out; a.ws = (unsigned char*)d_ws;
#if MK_ONE_LAUNCH
    a.ph_lo = 0; a.ph_hi = NPHASES;
    hipLaunchKernelGGL(fwd, dim3(grid), dim3(512), LDS_BYTES, stream, a);
#else
#ifndef NPH_LIMIT
#define NPH_LIMIT NPHASES
#endif
    for (int p = 0; p < NPH_LIMIT; ++p) { a.ph_lo = p; a.ph_hi = p + 1; hipLaunchKernelGGL(fwd, dim3(grid), dim3(512), LDS_BYTES, stream, a); }
#endif
    const hipError_t le = hipPeekAtLastError();
    if (le != hipSuccess) fprintf(stderr, "kernel_launch: launch failed: %s\n", hipGetErrorName(le));
}
```

```cpp
#define MK_ONE_LAUNCH 1
#include <hip/hip_runtime.h>
#include <cstdio>
#include <cstdint>

#define LAS __attribute__((address_space(3)))
#define GAS __attribute__((address_space(1)))
typedef unsigned short bf16_t;
typedef short bf16x8 __attribute__((ext_vector_type(8)));
typedef short s16x4 __attribute__((ext_vector_type(4)));
typedef float f32x2 __attribute__((ext_vector_type(2)));
typedef float f32x4 __attribute__((ext_vector_type(4)));
typedef float f32x16 __attribute__((ext_vector_type(16)));
typedef unsigned u32x2 __attribute__((ext_vector_type(2)));
typedef unsigned u32x4 __attribute__((ext_vector_type(4)));
typedef unsigned long long u64;

constexpr int DM = 2048, NB = 8, SEQ = 4096, MTOK = NB * SEQ, DFF = 5632, NH = 16, HD = 128, NMEM = 256, MEMW = 512, OUTIN = 2560;
constexpr float RMS_EPS = 1e-6f;
constexpr float LOG2E = 1.4426950408889634f;

__device__ __forceinline__ unsigned cvt_pk_bf16(float lo, float hi) { unsigned r; asm volatile("v_cvt_pk_bf16_f32 %0, %1, %2" : "=v"(r) : "v"(lo), "v"(hi)); return r; }
__device__ __forceinline__ float bf_lo(unsigned w) { return __uint_as_float(w << 16); }
__device__ __forceinline__ float bf_hi(unsigned w) { return __uint_as_float(w & 0xffff0000u); }

__device__ __forceinline__ int tid_opaque(int wave_id) {
    int l; asm volatile("v_mbcnt_lo_u32_b32 %0, -1, 0\n\tv_mbcnt_hi_u32_b32 %0, -1, %0" : "=v"(l)); return wave_id * 64 + l; }

namespace pg8 {
constexpr int BM = 256, BK = 64, HALF = 128, HTB = HALF * BK * 2, STAGE_BYTES = 8 * HTB, NXCD = 8, WGM = 8;
__host__ __device__ __forceinline__ int lds_byte(int r, int c) { const int st = (r >> 4) * 2 + (c >> 5), rr = r & 15, cc = c & 31, ob = rr * 64 + cc * 2; return st * 1024 + (ob ^ (((ob >> 9) & 1) << 5)); }
__host__ __device__ __forceinline__ void stage_rc(int b, int& R, int& C) { const int st = b / 1024, sb = b % 1024, swz = sb ^ (((sb >> 9) & 1) << 5); R = (st >> 1) * 16 + swz / 64; C = (st & 1) * 32 + (swz % 64) / 2; }
__host__ __device__ __forceinline__ int perm32(int rho) { const int n = rho >> 4, i = rho & 15; return 8 * (i >> 2) + 4 * n + (i & 3); }

struct Unit { int pm, pn; };
struct Gemm { const bf16_t* A; const bf16_t* Bt; int M, N, K, lda, ldb; int a_tiled; };

struct StaticOrder {
    int nM, nN, nwg, G, c;
    __host__ __device__ void init(int M, int N, int G_, int c_) { nM = M / BM; nN = N / BM; nwg = nM * nN; G = G_; c = c_; }
    __host__ __device__ bool next(int i, Unit& u) const {
        const long L = (long)i * G + c; if (L >= nwg) return false;
        int wgid = (int)L; { const int q = nwg / NXCD, r = nwg % NXCD, xcd = wgid % NXCD, off = wgid / NXCD; wgid = (xcd < r ? xcd * (q + 1) : r * (q + 1) + (xcd - r) * q) + off; }
        const int nig = WGM * nN, gid = wgid / nig, fm = gid * WGM, gsz = (nM - fm) < WGM ? (nM - fm) : WGM;
        u.pm = fm + ((wgid % nig) % gsz); u.pn = (wgid % nig) / gsz; return true;
    }
};

constexpr float SSQ_SCALE = 16777216.0f;
__device__ __forceinline__ float rs_from_ssq(const u64 v) { return __builtin_amdgcn_rsqf((float)v * (1.0f / (SSQ_SCALE * DM)) + RMS_EPS); }
__device__ __forceinline__ float rs_of(const void* rsv, int row, int mode) { return mode ? rs_from_ssq(((const u64*)rsv)[row]) : ((const float*)rsv)[row]; }

struct EpiProj {
    bf16_t* O; int ldc; const void* rsv; int rs_mode;
    float* fgout; int fg_tile;
    const float* g0; int t0a, t0b; const float* g1; int t1a, t1b; const float* g2; int t2a, t2b;
    float oscale;
    int gper, gcnt, gstride;
    __device__ __forceinline__ void operator()(f32x4 (&acc)[2][2][4][2], const Unit& u, int wr, int wc, int fr, int fq, LAS unsigned char* xlds) const {
        const int row0 = u.pm * BM + wr * 64 + fr; const int col0 = u.pn * BM + wc * 32 + 8 * fq;
        const float* gain = (u.pn >= t0a && u.pn < t0b) ? g0 : (u.pn >= t1a && u.pn < t1b) ? g1 : (u.pn >= t2a && u.pn < t2b) ? g2 : nullptr;
        if (gper) gain = (u.pn % gper < gcnt) ? g0 + (size_t)(u.pn / gper) * gstride : nullptr;
        float rsa[2][4];
#pragma unroll
        for (int ai = 0; ai < 2; ++ai)
#pragma unroll
            for (int m = 0; m < 4; ++m) rsa[ai][m] = rs_of(rsv, row0 + ai * HALF + m * 16, rs_mode) * oscale;
#pragma unroll
        for (int ai = 0; ai < 2; ++ai)
#pragma unroll
            for (int m = 0; m < 4; ++m) { const float rs = rsa[ai][m];
#pragma unroll
                for (int bj = 0; bj < 2; ++bj) { acc[ai][bj][m][0] *= rs; acc[ai][bj][m][1] *= rs; } }
        if (gain) {
            LAS float* part = (LAS float*)xlds;
#pragma unroll
            for (int ai = 0; ai < 2; ++ai)
#pragma unroll
                for (int m = 0; m < 4; ++m)
#pragma unroll
                    for (int bj = 0; bj < 2; ++bj) { const f32x4 a = acc[ai][bj][m][0], b = acc[ai][bj][m][1];
                        float ss = ((a[0] * a[0] + a[1] * a[1]) + (a[2] * a[2] + a[3] * a[3])) + ((b[0] * b[0] + b[1] * b[1]) + (b[2] * b[2] + b[3] * b[3]));
                        ss += __shfl_xor(ss, 16); ss += __shfl_xor(ss, 32);
                        if (fq == 0) part[((ai * HALF + wr * 64 + m * 16 + fr) * 2 + bj) * 4 + wc] = ss; }
            asm volatile("s_waitcnt lgkmcnt(0)" ::: "memory"); __builtin_amdgcn_s_barrier(); asm volatile("" ::: "memory");
            const f32x4 gv0 = *(const f32x4*)(gain + wc * 32 + 8 * fq), gv1 = *(const f32x4*)(gain + wc * 32 + 8 * fq + 4);
#pragma unroll
            for (int ai = 0; ai < 2; ++ai)
#pragma unroll
                for (int m = 0; m < 4; ++m)
#pragma unroll
                    for (int bj = 0; bj < 2; ++bj) { const f32x4 p4 = *(const LAS f32x4*)(part + ((ai * HALF + wr * 64 + m * 16 + fr) * 2 + bj) * 4);
                        const float r2 = __builtin_amdgcn_rsqf(((p4[0] + p4[1]) + (p4[2] + p4[3])) * (1.0f / 128.0f) + RMS_EPS);
                        acc[ai][bj][m][0] *= gv0 * r2; acc[ai][bj][m][1] *= gv1 * r2; }
        }
#pragma unroll
        for (int ai = 0; ai < 2; ++ai)
#pragma unroll
            for (int m = 0; m < 4; ++m) { const int row = row0 + ai * HALF + m * 16;
                bf16_t* rowp = O + (size_t)row * ldc + col0;
#pragma unroll
                for (int bj = 0; bj < 2; ++bj) { const f32x4 v0 = acc[ai][bj][m][0], v1 = acc[ai][bj][m][1];
                    u32x4 w; w.x = cvt_pk_bf16(v0[0], v0[1]); w.y = cvt_pk_bf16(v0[2], v0[3]); w.z = cvt_pk_bf16(v1[0], v1[1]); w.w = cvt_pk_bf16(v1[2], v1[3]);
                    *(u32x4*)(rowp + bj * HALF) = w;
                    if (fgout && bj == 0 && u.pn == fg_tile && wc == 0 && fq < 2) { float* fp = fgout + (size_t)row * 16 + 8 * fq; *(f32x4*)fp = v0; *(f32x4*)(fp + 4) = v1; } } }
    }
};
struct EpiSwiGLU {
    bf16_t* O; int ldc; const u64* ssq;
    __device__ __forceinline__ void operator()(f32x4 (&acc)[2][2][4][2], const Unit& u, int wr, int wc, int fr, int fq, LAS unsigned char*) const {
        const int row0 = u.pm * BM + wr * 64 + fr; const int col0 = u.pn * HALF + wc * 32 + 8 * fq;
        float rsv[2][4];
#pragma unroll
        for (int ai = 0; ai < 2; ++ai)
#pragma unroll
            for (int m = 0; m < 4; ++m) rsv[ai][m] = rs_from_ssq(ssq[row0 + ai * HALF + m * 16]);
#pragma unroll
        for (int ai = 0; ai < 2; ++ai)
#pragma unroll
            for (int m = 0; m < 4; ++m) { const int row = row0 + ai * HALF + m * 16; const float rs = rsv[ai][m];
                float h[8];
#pragma unroll
                for (int n = 0; n < 2; ++n)
#pragma unroll
                    for (int j = 0; j < 4; ++j) { const float g = acc[ai][0][m][n][j] * rs, uu = acc[ai][1][m][n][j] * rs;
                        const float e = __builtin_amdgcn_exp2f(-g * LOG2E); h[n * 4 + j] = g * __builtin_amdgcn_rcpf(1.0f + e) * uu; }
                u32x4 w; w.x = cvt_pk_bf16(h[0], h[1]); w.y = cvt_pk_bf16(h[2], h[3]); w.z = cvt_pk_bf16(h[4], h[5]); w.w = cvt_pk_bf16(h[6], h[7]);
                const int kt = col0 >> 6, hh = (row >> 7) & 1;
                __builtin_nontemporal_store(w, (u32x4*)(O + ((size_t)((size_t)u.pm * (ldc >> 6) + kt) * 2 + hh) * (HALF * BK) + (size_t)(row & 127) * BK + (col0 & 63))); }
    }
};
struct EpiResid {
    const float* xin; float* xout; bf16_t* xb; u64* ssq_out; unsigned char* xb8; float alpha;
    __device__ __forceinline__ void operator()(f32x4 (&acc)[2][2][4][2], const Unit& u, int wr, int wc, int fr, int fq, LAS unsigned char*) const {
        const int row0 = u.pm * BM + wr * 64 + fr; const int col0 = u.pn * BM + wc * 32 + 8 * fq;
#pragma unroll
        for (int ai = 0; ai < 2; ++ai) {
            f32x4 xi[4][2][2];
#pragma unroll
            for (int m = 0; m < 4; ++m) { const size_t off = (size_t)(row0 + ai * HALF + m * 16) * DM + col0;
#pragma unroll
                for (int bj = 0; bj < 2; ++bj) { xi[m][bj][0] = __builtin_nontemporal_load((const f32x4*)(xin + off + bj * HALF)); xi[m][bj][1] = __builtin_nontemporal_load((const f32x4*)(xin + off + bj * HALF + 4)); } }
            asm volatile("" ::: "memory");
#pragma unroll
            for (int m = 0; m < 4; ++m) { const int row = row0 + ai * HALF + m * 16; const size_t off = (size_t)row * DM + col0; float ss = 0.f;
#pragma unroll
                for (int bj = 0; bj < 2; ++bj) {
                    const f32x4 v0 = xi[m][bj][0] + acc[ai][bj][m][0] * alpha, v1 = xi[m][bj][1] + acc[ai][bj][m][1] * alpha;
                    __builtin_nontemporal_store(v0, (f32x4*)(xout + off + bj * HALF)); __builtin_nontemporal_store(v1, (f32x4*)(xout + off + bj * HALF + 4));
                    u32x4 w; w.x = cvt_pk_bf16(v0[0], v0[1]); w.y = cvt_pk_bf16(v0[2], v0[3]); w.z = cvt_pk_bf16(v1[0], v1[1]); w.w = cvt_pk_bf16(v1[2], v1[3]);
                    *(u32x4*)(xb + off + bj * HALF) = w;
                    if (xb8) { int q0 = __builtin_amdgcn_cvt_pk_fp8_f32(v0[0], v0[1], 0, false); q0 = __builtin_amdgcn_cvt_pk_fp8_f32(v0[2], v0[3], q0, true);
                               int q1 = __builtin_amdgcn_cvt_pk_fp8_f32(v1[0], v1[1], 0, false); q1 = __builtin_amdgcn_cvt_pk_fp8_f32(v1[2], v1[3], q1, true);
                               *(u32x2*)(xb8 + off + bj * HALF) = (u32x2){(unsigned)q0, (unsigned)q1}; }
                    ss += (v0[0] * v0[0] + v0[1] * v0[1]) + (v0[2] * v0[2] + v0[3] * v0[3]) + (v1[0] * v1[0] + v1[1] * v1[1]) + (v1[2] * v1[2] + v1[3] * v1[3]); }
                if (ssq_out) { ss += __shfl_xor(ss, 16); ss += __shfl_xor(ss, 32); if (fq == 0) atomicAdd(ssq_out + row, (u64)(ss * SSQ_SCALE)); } }
            asm volatile("" ::: "memory");
        }
    }
};

template <bool FP8 = false, class Epi, class Sched>
__device__ __forceinline__ void gemm_phase(LAS unsigned char* lds, const Gemm g, const Sched& S, const Epi& E, const int tid) {
    const int wid = __builtin_amdgcn_readfirstlane(tid >> 6), lane = tid & 63, wr = wid >> 2, wc = wid & 3, fr = lane & 15, fq = lane >> 4;
    const int K = g.K, nt = K / BK;
    unsigned voffA[2], voffB[2];
#pragma unroll
    for (int i = 0; i < 2; ++i) { int R, C; stage_rc(tid * 16 + i * 8192, R, C); const int Rb = (R & ~31) + perm32(R & 31);
        voffA[i] = (unsigned)(R * (g.a_tiled ? BK : g.lda) + C) * 2u; voffB[i] = (unsigned)(Rb * g.ldb + C) * 2u; }
    const size_t kstep = (size_t)(BK * 2), kstepA = g.a_tiled ? (size_t)(2 * HTB) : kstep;
    const size_t hstepA = g.a_tiled ? (size_t)HTB : (size_t)HALF * g.lda * 2, hstepB = (size_t)HALF * g.ldb * 2;
    const size_t tstepA = g.a_tiled ? (size_t)nt * 2 * HTB : 2 * hstepA, tstepB = 2 * hstepB;
    const unsigned ldsw = (unsigned)wid * 1024u;
    const int aoff = lds_byte(wr * 64 + fr, fq * 8), boff = lds_byte(wc * 32 + fr, fq * 8);
#define PG8_SA(b, h) (((b) * 2 + (h)) * HTB)
#define PG8_SB(b, h) ((4 + (b) * 2 + (h)) * HTB)
#define PG8_STAGE(bufoff, gbase, voff) do { _Pragma("unroll") for (int _i = 0; _i < 2; ++_i) \
        __builtin_amdgcn_global_load_lds((const unsigned*)((const char*)(gbase) + (voff)[_i]), (LAS unsigned*)(lds + (bufoff) + ldsw + _i * 8192), 16, 0, 0); } while (0)
#define PG8_LDA(dst, b, h) do { _Pragma("unroll") for (int m = 0; m < 4; ++m) _Pragma("unroll") for (int k = 0; k < 2; ++k) dst[m][k] = *(const LAS bf16x8*)(lds + PG8_SA(b, h) + aoff + m * 2048 + k * 1024); } while (0)
#define PG8_LDB(dst, b, h) do { _Pragma("unroll") for (int n = 0; n < 2; ++n) _Pragma("unroll") for (int k = 0; k < 2; ++k) dst[n][k] = *(const LAS bf16x8*)(lds + PG8_SB(b, h) + boff + n * 2048 + k * 1024); } while (0)
typedef long i64x2_t __attribute__((ext_vector_type(2)));
#define PG8_MMA(ai, bj, At, Bt) do { __builtin_amdgcn_s_setprio(1); \
        if constexpr (FP8) { _Pragma("unroll") for (int m = 0; m < 4; ++m) _Pragma("unroll") for (int n = 0; n < 2; ++n) _Pragma("unroll") for (int k = 0; k < 2; ++k) { \
            const i64x2_t b_ = __builtin_bit_cast(i64x2_t, Bt[n][k]), a_ = __builtin_bit_cast(i64x2_t, At[m][k]); \
            acc[ai][bj][m][n] = __builtin_amdgcn_mfma_f32_16x16x32_fp8_fp8(b_[0], a_[0], acc[ai][bj][m][n], 0, 0, 0); \
            acc[ai][bj][m][n] = __builtin_amdgcn_mfma_f32_16x16x32_fp8_fp8(b_[1], a_[1], acc[ai][bj][m][n], 0, 0, 0); } } \
        else { _Pragma("unroll") for (int m = 0; m < 4; ++m) _Pragma("unroll") for (int n = 0; n < 2; ++n) _Pragma("unroll") for (int k = 0; k < 2; ++k) \
            acc[ai][bj][m][n] = __builtin_amdgcn_mfma_f32_16x16x32_bf16(Bt[n][k], At[m][k], acc[ai][bj][m][n], 0, 0, 0); } \
        __builtin_amdgcn_s_setprio(0); } while (0)
#define PG8_WAIT_V(n) asm volatile("s_waitcnt vmcnt(" #n ")" ::: "memory")
#define PG8_WAIT_L(n) asm volatile("s_waitcnt lgkmcnt(" #n ")" ::: "memory")
#define PG8_BAR __builtin_amdgcn_s_barrier()
#define PG8_SCHED __builtin_amdgcn_sched_barrier(0)
    Unit cur, nxt; int ui = 0;
    if (!S.next(0, cur)) return;
    f32x4 acc[2][2][4][2];
#pragma unroll
    for (int a = 0; a < 2; ++a)
#pragma unroll
        for (int b = 0; b < 2; ++b)
#pragma unroll
            for (int m = 0; m < 4; ++m)
#pragma unroll
                for (int n = 0; n < 2; ++n) acc[a][b][m][n] = (f32x4){0.f, 0.f, 0.f, 0.f};
    bf16x8 At[4][2], B0[2][2], B1[2][2];
    const char* cA = (const char*)g.A + (size_t)cur.pm * tstepA; const char* cB = (const char*)g.Bt + (size_t)cur.pn * tstepB;
    PG8_STAGE(PG8_SB(0, 0), cB, voffB); PG8_STAGE(PG8_SB(0, 1), cB + hstepB, voffB); PG8_STAGE(PG8_SA(0, 0), cA, voffA); PG8_STAGE(PG8_SA(0, 1), cA + hstepA, voffA);
    if (wr == 1) PG8_BAR;
    PG8_WAIT_V(2); PG8_BAR;
    PG8_STAGE(PG8_SB(1, 0), cB + kstep, voffB); PG8_STAGE(PG8_SA(1, 0), cA + kstepA, voffA); PG8_STAGE(PG8_SB(1, 1), cB + hstepB + kstep, voffB);
    PG8_WAIT_V(6); PG8_BAR;
    for (;;) {
        const bool has_next = S.next(ui + 1, nxt);
        const char* nA = has_next ? (const char*)g.A + (size_t)nxt.pm * tstepA : cA; const char* nB = has_next ? (const char*)g.Bt + (size_t)nxt.pn * tstepB : cB;
        for (int t = 0; t < nt; t += 2) {
            const bool last = (t == nt - 2);
            const char* a1 = cA + (size_t)(t + 1) * kstepA;
            const char* a2 = last ? nA : cA + (size_t)(t + 2) * kstepA; const char* b2 = last ? nB : cB + (size_t)(t + 2) * kstep;
            const char* a3 = a2 + kstepA; const char* b3 = b2 + kstep;
            PG8_LDB(B0, 0, 0); PG8_LDB(B1, 0, 1); PG8_SCHED; PG8_LDA(At, 0, 0); PG8_STAGE(PG8_SA(1, 1), a1 + hstepA, voffA);
            PG8_WAIT_V(8); PG8_WAIT_L(0); PG8_BAR; PG8_MMA(0, 0, At, B0); PG8_MMA(0, 1, At, B1); PG8_BAR; PG8_SCHED;
            PG8_LDA(At, 0, 1); PG8_STAGE(PG8_SB(0, 0), b2, voffB); PG8_STAGE(PG8_SB(0, 1), b2 + hstepB, voffB); PG8_STAGE(PG8_SA(0, 0), a2, voffA);
            PG8_WAIT_V(8); PG8_WAIT_L(0); PG8_BAR; PG8_MMA(1, 0, At, B0); PG8_MMA(1, 1, At, B1); PG8_BAR; PG8_SCHED;
            PG8_LDB(B0, 1, 0); PG8_LDB(B1, 1, 1); PG8_SCHED; PG8_LDA(At, 1, 0); PG8_STAGE(PG8_SA(0, 1), a2 + hstepA, voffA);
            PG8_WAIT_V(8); PG8_WAIT_L(0); PG8_BAR; PG8_MMA(0, 0, At, B0); PG8_MMA(0, 1, At, B1); PG8_BAR; PG8_SCHED;
            PG8_LDA(At, 1, 1); PG8_STAGE(PG8_SB(1, 0), b3, voffB); PG8_STAGE(PG8_SB(1, 1), b3 + hstepB, voffB); PG8_STAGE(PG8_SA(1, 0), a3, voffA);
            PG8_WAIT_V(8); PG8_WAIT_L(0); PG8_BAR; PG8_MMA(1, 0, At, B0); PG8_MMA(1, 1, At, B1); PG8_BAR; PG8_SCHED;
        }
        if (wr == 0) PG8_BAR;
        E(acc, cur, wr, wc, fr, fq, lds + STAGE_BYTES);
        if (!has_next) break;
#pragma unroll
        for (int a = 0; a < 2; ++a)
#pragma unroll
            for (int b = 0; b < 2; ++b)
#pragma unroll
                for (int m = 0; m < 4; ++m)
#pragma unroll
                    for (int n = 0; n < 2; ++n) acc[a][b][m][n] = (f32x4){0.f, 0.f, 0.f, 0.f};
        cur = nxt; cA = nA; cB = nB; ++ui;
        if (wr == 1) PG8_BAR;
    }
    PG8_WAIT_V(0);
    PG8_BAR;
#undef PG8_SA
#undef PG8_SB
#undef PG8_STAGE
#undef PG8_LDA
#undef PG8_LDB
#undef PG8_MMA
#undef PG8_WAIT_V
#undef PG8_WAIT_L
#undef PG8_BAR
#undef PG8_SCHED
}
}

#define XB_TMO      128
#define XB_XCNT(j)  (256  + 64 * (j))
#define XB_XSUB(j)  (1280 + 64 * (j))
#define XB_XGEN(j)  (2304 + 64 * (j))
#define XB_TOP      3328
#define XB_TOPGEN   3392
#define XCD_BAR_WORDS 3456
#define XB_SPIN_CAP (1u << 22)

__device__ __forceinline__ unsigned xb_ld(unsigned* p)              { return __hip_atomic_load(p, __ATOMIC_RELAXED, __HIP_MEMORY_SCOPE_AGENT); }
__device__ __forceinline__ unsigned xb_add(unsigned* p, unsigned v) { return __hip_atomic_fetch_add(p, v, __ATOMIC_RELAXED, __HIP_MEMORY_SCOPE_AGENT); }
__device__ __forceinline__ unsigned xb_xcc_id() { return (unsigned)__builtin_amdgcn_s_getreg((3 << 11) | 20) & 0xFu; }
#define XB_SPIN(cond, bar) do { unsigned _sp = 0; while (cond) { __builtin_amdgcn_s_sleep(1); \
    if ((++_sp & 255u) == 0u) { if (xb_ld(&(bar)[XB_TMO])) break; if (_sp > XB_SPIN_CAP) { atomicAdd(&(bar)[XB_TMO], 1u); break; } } } } while (0)

struct XcdBarrier { unsigned* bar; unsigned x; volatile LAS unsigned* st; };

__device__ __forceinline__ XcdBarrier xcd_barrier_post(unsigned* bar, volatile LAS unsigned* st) {
    XcdBarrier b; b.bar = bar; b.x = xb_xcc_id(); b.st = st;
    if (threadIdx.x == 0) (void)xb_add(&bar[XB_XCNT(b.x)], 1u);
    return b;
}
__device__ __forceinline__ void xcd_barrier_complete(unsigned* bar, unsigned x, unsigned& nloc, unsigned& nx) {
    const unsigned G = gridDim.x * gridDim.y * gridDim.z;
    unsigned sum, cnt, mine, sp = 0u;
    for (;;) {
        sum = 0u; cnt = 0u; mine = 0u;
#pragma unroll
        for (unsigned j = 0; j < 16; ++j) { const unsigned c = xb_ld(&bar[XB_XCNT(j)]); sum += c; cnt += (c > 0u) ? 1u : 0u; mine = (j == x) ? c : mine; }
        if (sum == G) break;
        __builtin_amdgcn_s_sleep(1);
        if ((++sp & 255u) == 0u) { if (xb_ld(&bar[XB_TMO])) break; if (sp > XB_SPIN_CAP) { atomicAdd(&bar[XB_TMO], 1u); break; } }
    }
    nloc = mine > 0u ? mine : 1u; nx = cnt > 0u ? cnt : 1u;
}
__device__ __forceinline__ void xcd_barrier(const XcdBarrier& b) {
    asm volatile("s_waitcnt vmcnt(0)" ::: "memory");
    __syncthreads();
    if (threadIdx.x == 0) {
        unsigned* bar = b.bar; unsigned bx_ = b.x; asm volatile("" : "+s"(bar), "+s"(bx_));
        __builtin_amdgcn_s_waitcnt(0);
        unsigned nloc = b.st[0], nx = b.st[1];
        if (nloc == 0u) { xcd_barrier_complete(bar, bx_, nloc, nx); b.st[0] = nloc; b.st[1] = nx; }
        const unsigned old = xb_add(&bar[XB_XSUB(bx_)], 1u);
        const unsigned gen = old / nloc;
        if (old + 1u == (gen + 1u) * nloc) {
            __builtin_amdgcn_fence(__ATOMIC_RELEASE, "agent");
            asm volatile("s_waitcnt vmcnt(0)" ::: "memory");
            const unsigned og = xb_add(&bar[XB_TOP], 1u);
            const unsigned tg = og / nx;
            if (og + 1u == (tg + 1u) * nx) xb_add(&bar[XB_TOPGEN], 1u);
            else XB_SPIN(xb_ld(&bar[XB_TOPGEN]) == tg, bar);
            __builtin_amdgcn_fence(__ATOMIC_ACQUIRE, "agent");
            xb_add(&bar[XB_XGEN(bx_)], 1u);
            asm volatile("s_waitcnt vmcnt(0)" ::: "memory");
        } else {
            XB_SPIN(xb_ld(&bar[XB_XGEN(bx_)]) == gen, bar);
            __builtin_amdgcn_fence(__ATOMIC_ACQUIRE, "agent");
            asm volatile("s_waitcnt vmcnt(0)" ::: "memory");
        }
    }
    __syncthreads();
}

namespace att {
constexpr int NW = 8, QBLK = 32, KVBLK = 64;
constexpr float THR2 = 8.f * LOG2E;
enum { K_MEM = 0, K_FOX = 1, K_MLA = 2, K_DIL = 3, K_DSA = 4 };
constexpr int L_V = 0, L_K = 49152, L_XB = 100352, L_TBL = 106496, L_END = 141312, VB = 16384;

struct AP {
    const bf16_t* Q; const bf16_t* K; const bf16_t* V; bf16_t* O;
    long qs, ks, vs, os;
    int kt0, nt;
    int q0;
    float C;
    const float* cum; long cums;
    const u64* msk;
    float* ost; long osts;
    float* mst; long msts;
    int carry_in, carry_out;
    const float* t5; int head, dil;
};

#define ATT_SBAR() __builtin_amdgcn_sched_barrier(0)
__device__ __forceinline__ int crow(int r, int hi) { return (r & 3) + 8 * (r >> 2) + 4 * hi; }
__device__ __forceinline__ int t5_bucket(int dist) {
    const int n = dist < 0 ? 0 : dist; if (n < 16) return n;
    const float v = __log2f((float)n * 0.0625f) * (16.0f / 7.0f); int b = 16 + (int)v; return b > 31 ? 31 : b;
}
__device__ __forceinline__ void rowmax_decide(const f32x16& p0, const f32x16& p1, float& m_reg, float& alpha) {
    float pmax = p0[0];
#pragma unroll
    for (int r = 1; r < 16; ++r) pmax = fmaxf(pmax, p0[r]);
#pragma unroll
    for (int r = 0; r < 16; ++r) pmax = fmaxf(pmax, p1[r]);
    { auto rr = __builtin_amdgcn_permlane32_swap(__float_as_uint(pmax), __float_as_uint(pmax), false, false); pmax = fmaxf(__uint_as_float(rr[0]), __uint_as_float(rr[1])); }
    if (__builtin_expect(__all(pmax - m_reg <= THR2), 1)) { alpha = 1.f; }
    else { const float mn = fmaxf(m_reg, pmax); alpha = __builtin_amdgcn_exp2f(m_reg - mn); m_reg = mn; }
}
__device__ __forceinline__ float half_sum(float ps) {
    auto rr = __builtin_amdgcn_permlane32_swap(__float_as_uint(ps), __float_as_uint(ps), false, false); return __uint_as_float(rr[0]) + __uint_as_float(rr[1]);
}
__device__ __forceinline__ void pack_p(const f32x16& p0, const f32x16& p1, bf16x8& pa0, bf16x8& pa1, bf16x8& pa2, bf16x8& pa3) {
#define ATT_PK4(P, BASE, OUT) do { unsigned a0 = cvt_pk_bf16(P[BASE + 0], P[BASE + 1]), a1 = cvt_pk_bf16(P[BASE + 2], P[BASE + 3]);   \
    unsigned b0 = cvt_pk_bf16(P[BASE + 4], P[BASE + 5]), b1 = cvt_pk_bf16(P[BASE + 6], P[BASE + 7]);                              \
    auto r0 = __builtin_amdgcn_permlane32_swap(a0, b0, false, false); auto r1 = __builtin_amdgcn_permlane32_swap(a1, b1, false, false); \
    u32x4 w = {r0[0], r1[0], r0[1], r1[1]}; OUT = __builtin_bit_cast(bf16x8, w); } while (0)
    ATT_PK4(p0, 0, pa0); ATT_PK4(p0, 8, pa1); ATT_PK4(p1, 0, pa2); ATT_PK4(p1, 8, pa3);
#undef ATT_PK4
}
template <int DK, int NQL>
__device__ __forceinline__ void qkt(f32x16& p0, f32x16& p1, const LAS unsigned char* Ks, const int (&kad)[4], const bf16x8* qr, const LAS unsigned char* qsp) {
    p0 = f32x16{}; p1 = f32x16{};
    constexpr int ND = DK / 16, NQR = ND - NQL;
#define ATT_LDK(d, hf) (*(const LAS bf16x8*)(Ks + ((DK == 128) ? (kad[(d) & 3] ^ (((d) >> 2) ? 128 : 0)) : (kad[(d) & 3] + 128 * ((d) >> 2))) + (hf) * 32 * DK * 2))
#define ATT_LDQ(d) (((d) < NQR) ? qr[(d) < NQR ? (d) : 0] : *(const LAS bf16x8*)(qsp + ((d) - NQR) * 1024))
    bf16x8 b0 = ATT_LDK(0, 0), b1 = ATT_LDK(0, 1), qf = ATT_LDQ(0);
#pragma unroll
    for (int d0 = 0; d0 < ND; ++d0) {
        bf16x8 c0 = b0, c1 = b1, qn = qf;
        if (d0 + 1 < ND) { c0 = ATT_LDK(d0 + 1, 0); c1 = ATT_LDK(d0 + 1, 1); qn = ATT_LDQ(d0 + 1); }
        ATT_SBAR();
        p0 = __builtin_amdgcn_mfma_f32_32x32x16_bf16(b0, qf, p0, 0, 0, 0);
        p1 = __builtin_amdgcn_mfma_f32_32x32x16_bf16(b1, qf, p1, 0, 0, 0);
        ATT_SBAR();
        b0 = c0; b1 = c1; qf = qn; }
#undef ATT_LDK
#undef ATT_LDQ
}
__device__ __forceinline__ int v_st(int k, int c) { const int kk = (k & ~0xC) | ((k & 4) << 1) | ((k & 8) >> 1); return ((kk >> 3) * 4 + (c >> 5)) * 512 + ((kk & 7) * 32 + (c & 31)) * 2; }
__device__ __forceinline__ int v_rd_base(int lane) { return ((lane & 3) << 3) | (((lane >> 2) & 3) << 6) | (((lane >> 4) & 1) << 5) | (((lane >> 5) & 1) << 8); }
constexpr int v_rd_off(int d0, int ks, int half) { return d0 * 512 + ks * 4096 + half * 2048; }
template <int OFF> __device__ __forceinline__ s16x4 tr_read(int vb) { s16x4 r; asm volatile("ds_read_b64_tr_b16 %0, %1 offset:%2" : "=&v"(r) : "v"(vb), "i"(OFF) : "memory"); return r; }
struct VF { s16x4 l0, h0, l1, h1, l2, h2, l3, h3; };
template <int D0> __device__ __forceinline__ void pv_read(VF& f, int vb) {
    f.l0 = tr_read<v_rd_off(D0, 0, 0)>(vb); f.h0 = tr_read<v_rd_off(D0, 0, 1)>(vb); f.l1 = tr_read<v_rd_off(D0, 1, 0)>(vb); f.h1 = tr_read<v_rd_off(D0, 1, 1)>(vb);
    f.l2 = tr_read<v_rd_off(D0, 2, 0)>(vb); f.h2 = tr_read<v_rd_off(D0, 2, 1)>(vb); f.l3 = tr_read<v_rd_off(D0, 3, 0)>(vb); f.h3 = tr_read<v_rd_off(D0, 3, 1)>(vb);
}
#define ATT_VWAIT(n, f) asm volatile("s_waitcnt lgkmcnt(" #n ")" : "+v"(f.l0), "+v"(f.h0), "+v"(f.l1), "+v"(f.h1), "+v"(f.l2), "+v"(f.h2), "+v"(f.l3), "+v"(f.h3) :: "memory")
#define ATT_PK(L, H) (bf16x8){L[0], L[1], L[2], L[3], H[0], H[1], H[2], H[3]}
__device__ __forceinline__ void pv_only(f32x16* o, int vb, bf16x8 pa0, bf16x8 pa1, bf16x8 pa2, bf16x8 pa3) {
    VF fa, fb;
#define ATT_MMA4(od, f) do { od = __builtin_amdgcn_mfma_f32_32x32x16_bf16(pa0, ATT_PK(f.l0, f.h0), od, 0, 0, 0); od = __builtin_amdgcn_mfma_f32_32x32x16_bf16(pa1, ATT_PK(f.l1, f.h1), od, 0, 0, 0); \
        od = __builtin_amdgcn_mfma_f32_32x32x16_bf16(pa2, ATT_PK(f.l2, f.h2), od, 0, 0, 0); od = __builtin_amdgcn_mfma_f32_32x32x16_bf16(pa3, ATT_PK(f.l3, f.h3), od, 0, 0, 0); } while (0)
    pv_read<0>(fa, vb); pv_read<1>(fb, vb);
    ATT_VWAIT(8, fa); ATT_SBAR(); ATT_MMA4(o[0], fa); ATT_SBAR(); pv_read<2>(fa, vb);
    ATT_VWAIT(8, fb); ATT_SBAR(); ATT_MMA4(o[1], fb); ATT_SBAR(); pv_read<3>(fb, vb);
    ATT_VWAIT(8, fa); ATT_SBAR(); ATT_MMA4(o[2], fa); ATT_SBAR();
    ATT_VWAIT(0, fb); ATT_SBAR(); ATT_MMA4(o[3], fb);
#undef ATT_MMA4
}
__device__ __forceinline__ float sm_only(f32x16& p0, f32x16& p1, float m) {
    float s = 0.f;
#pragma unroll
    for (int r = 0; r < 16; ++r) { p0[r] = __builtin_amdgcn_exp2f(p0[r] - m); s += p0[r]; }
#pragma unroll
    for (int r = 0; r < 16; ++r) { p1[r] = __builtin_amdgcn_exp2f(p1[r] - m); s += p1[r]; }
    return s;
}
__device__ __forceinline__ float pv_sm(f32x16* o, int vb, bf16x8 pa0, bf16x8 pa1, bf16x8 pa2, bf16x8 pa3, f32x16& p0, f32x16& p1, float m) {
    VF fa, fb; float s = 0.f;
#define ATT_GAP(od, pa, L, H, X, B) do { od = __builtin_amdgcn_mfma_f32_32x32x16_bf16(pa, ATT_PK(L, H), od, 0, 0, 0); \
        { float t0_ = X[B] - m, t1_ = X[B + 1] - m, e0_, e1_; asm volatile("v_exp_f32 %0, %1" : "=v"(e0_) : "v"(t0_)); asm volatile("v_exp_f32 %0, %1" : "=v"(e1_) : "v"(t1_));     \
          X[B] = e0_; X[B + 1] = e1_; s += e0_; s += e1_; } ATT_SBAR(); } while (0)
    pv_read<0>(fa, vb); pv_read<1>(fb, vb);
    ATT_VWAIT(8, fa); ATT_SBAR();
    ATT_GAP(o[0], pa0, fa.l0, fa.h0, p0, 0); ATT_GAP(o[0], pa1, fa.l1, fa.h1, p0, 2); ATT_GAP(o[0], pa2, fa.l2, fa.h2, p0, 4); ATT_GAP(o[0], pa3, fa.l3, fa.h3, p0, 6);
    pv_read<2>(fa, vb); ATT_VWAIT(8, fb); ATT_SBAR();
    ATT_GAP(o[1], pa0, fb.l0, fb.h0, p0, 8); ATT_GAP(o[1], pa1, fb.l1, fb.h1, p0, 10); ATT_GAP(o[1], pa2, fb.l2, fb.h2, p0, 12); ATT_GAP(o[1], pa3, fb.l3, fb.h3, p0, 14);
    pv_read<3>(fb, vb); ATT_VWAIT(8, fa); ATT_SBAR();
    ATT_GAP(o[2], pa0, fa.l0, fa.h0, p1, 0); ATT_GAP(o[2], pa1, fa.l1, fa.h1, p1, 2); ATT_GAP(o[2], pa2, fa.l2, fa.h2, p1, 4); ATT_GAP(o[2], pa3, fa.l3, fa.h3, p1, 6);
    ATT_VWAIT(0, fb); ATT_SBAR();
    ATT_GAP(o[3], pa0, fb.l0, fb.h0, p1, 8); ATT_GAP(o[3], pa1, fb.l1, fb.h1, p1, 10); ATT_GAP(o[3], pa2, fb.l2, fb.h2, p1, 12); ATT_GAP(o[3], pa3, fb.l3, fb.h3, p1, 14);
#undef ATT_GAP
    return s;
}

template <int KIND>
__device__ __forceinline__ void score(f32x16& p0, f32x16& p1, const AP& a, int t, int buf, LAS unsigned char* lds, int wid, int r32, int hi, float cq) {
    const float C = a.C; const int k0 = t * 64; const int q = a.q0 + wid * 32 + r32; const float NEG = -INFINITY;
    if constexpr (KIND == K_FOX) {
        const LAS f32x4* cb = (const LAS f32x4*)(lds + L_XB + buf * 2048) + hi;
#pragma unroll
        for (int g = 0; g < 4; ++g) { const f32x4 c4 = cb[2 * g], c4b = cb[2 * g + 8];
#pragma unroll
            for (int j = 0; j < 4; ++j) { p0[4 * g + j] = fmaf(p0[4 * g + j], C, cq - c4[j]); p1[4 * g + j] = fmaf(p1[4 * g + j], C, cq - c4b[j]); } }
    } else if constexpr (KIND == K_DSA || KIND == K_DIL) {
        const LAS float* tb = (const LAS float*)(lds + L_TBL) + (q - k0 - 4 * hi + 256 - 59);
#pragma unroll
        for (int r = 0; r < 16; ++r) { const int cc = (r & 3) + 8 * (r >> 2); p0[r] = fmaf(p0[r], C, tb[59 - cc]); p1[r] = fmaf(p1[r], C, tb[59 - cc - 32]); }
        if constexpr (KIND == K_DSA) {
            const LAS unsigned* mb = (const LAS unsigned*)(lds + L_XB + buf * 2048) + wid * 64;
            const unsigned wl = mb[r32] >> (4 * hi), wh = mb[32 + r32] >> (4 * hi);
#pragma unroll
            for (int r = 0; r < 16; ++r) { const int cc = (r & 3) + 8 * (r >> 2); p0[r] = ((wl >> cc) & 1u) ? p0[r] : NEG; p1[r] = ((wh >> cc) & 1u) ? p1[r] : NEG; }
        }
    } else {
#pragma unroll
        for (int r = 0; r < 16; ++r) { p0[r] *= C; p1[r] *= C; }
    }
    if constexpr (KIND == K_FOX || KIND == K_MLA) {
        if (k0 + 63 > a.q0) {
            const int kb = k0 + 4 * hi;
#pragma unroll
            for (int r = 0; r < 16; ++r) { const int kv = kb + (r & 3) + 8 * (r >> 2); if (kv > q) p0[r] = NEG; if (kv + 32 > q) p1[r] = NEG; }
        }
    }
}

template <int KIND, int DK>
__device__ __forceinline__ void attn_unit(LAS unsigned char* lds, const AP& a, const int wave_id) {
    const int tid = tid_opaque(wave_id);
    const int lane = tid & 63, r32 = lane & 31, hi = lane >> 5; const int wid = __builtin_amdgcn_readfirstlane(tid >> 6);
    constexpr bool HAS_TBL = (KIND == K_DSA || KIND == K_DIL), HAS_X = (KIND == K_FOX || KIND == K_DSA);
    constexpr int KB = KVBLK * DK * 2, NKC = DK / 8, NKL = (64 * NKC) / 512, ND0 = DK / 16;
    constexpr int NQL = (DK == 192) ? 2 : (HAS_TBL ? 2 : 4), NQR = ND0 - NQL, NLD = NKL + 2 + (HAS_X ? 1 : 0);
    constexpr int LWS = (DK == 192) ? 122880 : 98304, LQSP = (DK == 192) ? 124928 : (HAS_TBL ? 123904 : 106496);
    LAS unsigned char* V_lds = lds + L_V; LAS unsigned char* K_lds = lds + L_K;
    LAS float* wsf = (LAS float*)(lds + LWS) + wid * 64; LAS float* li_l = wsf; LAS float* al_l = wsf + 32;
    LAS unsigned char* qsp = lds + LQSP + wid * (NQL * 1024) + lane * 16;
    float m_reg = -1e30f, l_reg = 0.f; f32x16 o[4] = {}; bf16x8 qr[NQR];
    const int qi = wid * 32 + r32;
    const bf16_t* Qw = a.Q + (long)qi * a.qs + hi * 8;
#pragma unroll
    for (int d0 = 0; d0 < ND0; ++d0) { const bf16x8 qv = *(const bf16x8*)(Qw + d0 * 16); if (d0 < NQR) qr[d0 < NQR ? d0 : 0] = qv; else *(LAS bf16x8*)(qsp + (d0 - NQR) * 1024) = qv; }
    float cq = 0.f;
    if constexpr (KIND == K_FOX) cq = a.cum[(long)(a.q0 + qi) * a.cums];
    if constexpr (KIND == K_DIL) {
        if (a.carry_in) {
            m_reg = a.mst[(long)qi * a.msts]; l_reg = a.mst[(long)qi * a.msts + 1];
#pragma unroll
            for (int r = 0; r < 16; ++r) { const float* orow = a.ost + (long)(wid * 32 + crow(r, hi)) * a.osts + r32;
#pragma unroll
                for (int d0 = 0; d0 < 4; ++d0) o[d0][r] = __builtin_nontemporal_load(orow + d0 * 32); }
        }
    }
    if constexpr (KIND == K_DSA) {
        LAS float* tbl = (LAS float*)(lds + L_TBL);
        for (int i = tid; i < 4352; i += 512) { const int dist = i - 256; tbl[i] = dist < 0 ? -INFINITY : a.t5[t5_bucket(dist) * 16 + a.head] * LOG2E; }
    }
    if constexpr (KIND == K_DIL) {
        LAS float* tbl = (LAS float*)(lds + L_TBL);
        for (int i = tid; i < 640; i += 512) { const int rel = i - 256; tbl[i] = (rel < 0 || rel > 128) ? -INFINITY : a.t5[t5_bucket(rel * a.dil) * 16 + a.head] * LOG2E; }
    }
    int ksrc[NKL], vsrc[2];
#pragma unroll
    for (int c = 0; c < NKL; ++c) { const int Lb = (wid * NKL + c) * 1024 + lane * 16, row = Lb / (DK * 2), chp = (Lb % (DK * 2)) / 16; ksrc[c] = row * (int)a.ks + ((DK == 128) ? (chp ^ (row & 15)) : ((chp & ~7) | ((chp & 7) ^ (row & 7)))) * 8; }
#pragma unroll
    for (int c = 0; c < 2; ++c) { const int sl = (2 * wid + c) * 64 + lane, st = sl >> 5, wi = sl & 31, kk = ((st >> 2) << 3) | (wi >> 2), k = (kk & ~0xC) | ((kk & 4) << 1) | ((kk & 8) >> 1); vsrc[c] = k * (int)a.vs + (st & 3) * 32 + (wi & 3) * 8; }
    const int vb0 = (int)(unsigned)(uintptr_t)V_lds + v_rd_base(lane);
    int kad[4];
#pragma unroll
    for (int j = 0; j < 4; ++j) kad[j] = r32 * (DK * 2) + (((hi | (j << 1)) ^ (r32 & 7)) << 4) + ((DK == 128) ? 128 * ((r32 >> 3) & 1) : 0);
#define ATT_DMA(t, sl) do { const long kb_ = (long)(t) * 64; \
        _Pragma("unroll") for (int c_ = 0; c_ < NKL; ++c_) __builtin_amdgcn_global_load_lds((const unsigned*)(a.K + kb_ * a.ks + ksrc[c_]), (LAS unsigned*)(K_lds + (sl) * KB + (wid * NKL + c_) * 1024), 16, 0, 0); \
        _Pragma("unroll") for (int c_ = 0; c_ < 2; ++c_) __builtin_amdgcn_global_load_lds((const unsigned*)(a.V + kb_ * a.vs + vsrc[c_]), (LAS unsigned*)(V_lds + (sl) * VB + (2 * wid + c_) * 1024), 16, 0, 0); \
        if constexpr (KIND == K_FOX) __builtin_amdgcn_global_load_lds((const unsigned*)(a.cum + (kb_ + lane) * a.cums), (LAS unsigned*)(lds + L_XB + (sl) * 2048), 4, 0, 0);     \
        if constexpr (KIND == K_DSA) __builtin_amdgcn_global_load_lds((const unsigned*)(a.msk + (long)(wid * 32 + r32) * 64 + (t)) + hi, (LAS unsigned*)(lds + L_XB + (sl) * 2048 + wid * 256), 4, 0, 0); } while (0)
#define ATT_RESC(al) do { if (__any((al) < 1.f)) { if (hi == 0) al_l[r32] = (al); asm volatile("s_waitcnt lgkmcnt(0)" ::: "memory"); \
        _Pragma("unroll") for (int d = 0; d < 4; ++d) _Pragma("unroll") for (int r = 0; r < 16; ++r) o[d][r] *= al_l[crow(r, hi)]; } } while (0)
#define ATT_BAR() do { asm volatile("s_waitcnt lgkmcnt(0)" ::: "memory"); __builtin_amdgcn_s_barrier(); asm volatile("" ::: "memory"); } while (0)
    f32x16 p0, p1; float al = 1.f; bf16x8 pa0, pa1, pa2, pa3; const int NT = a.nt, T0 = a.kt0;
    asm volatile("s_waitcnt vmcnt(0) lgkmcnt(0)" ::: "memory");
    ATT_DMA(T0, 0);
    if (NT > 1) { ATT_DMA(T0 + 1, 1); asm volatile("s_waitcnt vmcnt(%0)" :: "n"(NLD) : "memory"); } else { asm volatile("s_waitcnt vmcnt(0)" ::: "memory"); }
    ATT_BAR();
    int sl = 0, sl2 = 2;
    for (int jj = 0; jj < NT; ++jj) {
        const int t = T0 + jj;
        if (jj + 2 < NT) ATT_DMA(t + 2, sl2);
        bool lv = true; { const int k0_ = t * 64, qw_ = a.q0 + wid * 32;
            if constexpr (KIND == K_FOX || KIND == K_MLA || KIND == K_DSA) lv = k0_ <= qw_ + 31;
            if constexpr (KIND == K_DIL) lv = (k0_ <= qw_ + 31) && (k0_ + 63 >= qw_ - 128); }
        if (lv) {
            ATT_SBAR(); qkt<DK, NQL>(p0, p1, K_lds + sl * KB, kad, qr, qsp);
            score<KIND>(p0, p1, a, t, sl, lds, wid, r32, hi, cq);
            rowmax_decide(p0, p1, m_reg, al);
            const float ps = sm_only(p0, p1, m_reg);
            l_reg = l_reg * al + half_sum(ps);
            ATT_RESC(al);
            pack_p(p0, p1, pa0, pa1, pa2, pa3); ATT_SBAR();
            pv_only(o, vb0 + sl * VB, pa0, pa1, pa2, pa3);
        }
        if (jj + 2 < NT) asm volatile("s_waitcnt vmcnt(%0)" :: "n"(NLD) : "memory"); else asm volatile("s_waitcnt vmcnt(0)" ::: "memory");
        ATT_BAR();
        sl = (sl == 2) ? 0 : sl + 1; sl2 = (sl2 == 2) ? 0 : sl2 + 1;
    }
    bool stateout = false;
    if constexpr (KIND == K_DIL) stateout = a.carry_out != 0;
    if (stateout) {
        int qi2 = qi; asm volatile("" : "+v"(qi2));
        if (hi == 0) { a.mst[(long)qi2 * a.msts] = m_reg; a.mst[(long)qi2 * a.msts + 1] = l_reg; }
#pragma unroll
        for (int r = 0; r < 16; ++r) { float* orow = a.ost + (long)(wid * 32 + crow(r, hi)) * a.osts + r32;
#pragma unroll
            for (int d0 = 0; d0 < 4; ++d0) __builtin_nontemporal_store(o[d0][r], orow + d0 * 32); }
        __syncthreads();
    } else {
        if (hi == 0) li_l[r32] = l_reg;
        asm volatile("s_waitcnt lgkmcnt(0)" ::: "memory");
        float rli[16];
#pragma unroll
        for (int r = 0; r < 16; ++r) rli[r] = __builtin_amdgcn_rcpf(li_l[crow(r, hi)]);
        __syncthreads();
        LAS unsigned short* ost = (LAS unsigned short*)(lds + wid * 8192);
#pragma unroll
        for (int r = 0; r < 16; ++r) { const int orow = crow(r, hi);
#pragma unroll
            for (int d0 = 0; d0 < 4; ++d0) { const unsigned w = cvt_pk_bf16(o[d0][r] * rli[r], 0.f); ost[orow * 128 + d0 * 32 + r32] = (unsigned short)w; } }
        asm volatile("s_waitcnt lgkmcnt(0)" ::: "memory");
#pragma unroll
        for (int i = 0; i < 8; ++i) { const int ch = lane + 64 * i, row = ch >> 4, c16 = ch & 15;
            const u32x4 v = *(const LAS u32x4*)(lds + wid * 8192 + row * 256 + c16 * 16);
            *(u32x4*)(a.O + (long)(wid * 32 + row) * a.os + c16 * 8) = v; }
        __syncthreads();
    }
#undef ATT_DMA
#undef ATT_RESC
#undef ATT_BAR
}
#undef ATT_VWAIT
#undef ATT_PK
}

struct Fr { LAS unsigned char* lds; int tid, lane, wave, vcu, G, gw, ngw; };

__device__ __forceinline__ float wave_sum(float v) {
#pragma unroll
    for (int o = 1; o < 64; o <<= 1) v += __shfl_xor(v, o);
    return v;
}
__device__ __forceinline__ void unpack8(const u32x4 w, float (&v)[8]) {
    v[0] = bf_lo(w.x); v[1] = bf_hi(w.x); v[2] = bf_lo(w.y); v[3] = bf_hi(w.y); v[4] = bf_lo(w.z); v[5] = bf_hi(w.z); v[6] = bf_lo(w.w); v[7] = bf_hi(w.w);
}
__device__ __forceinline__ u32x4 pack8(const float (&v)[8]) {
    u32x4 w; w.x = cvt_pk_bf16(v[0], v[1]); w.y = cvt_pk_bf16(v[2], v[3]); w.z = cvt_pk_bf16(v[4], v[5]); w.w = cvt_pk_bf16(v[6], v[7]); return w;
}
__device__ __forceinline__ float sumsq8(const float (&v)[8]) { return ((v[0] * v[0] + v[1] * v[1]) + (v[2] * v[2] + v[3] * v[3])) + ((v[4] * v[4] + v[5] * v[5]) + (v[6] * v[6] + v[7] * v[7])); }

__device__ __forceinline__ int map_col(int kind, int n) {
    switch (kind) {
        case 1: return 256 * (n >> 7) + (n & 127);
        case 2: return 256 * (n >> 7) + 128 + (n & 127);
        case 3: return n < 6144 ? n : (n < 6160 ? 6656 + (n - 6144) : 6144 + (n - 6160));
        case 4: return n < 1088 ? n : 1280 + (n - 1088);
        case 5: return n < 6144 ? n : (n < 18432 ? n + 512 : 6144 + (n - 18432));
        case 6: return n < 4176 ? n : 4352 + (n - 4176);
        default: return n;
    }
}
struct TrDesc { const float* W; const float* gain; bf16_t* WT; int K, N, ldt, kind, r, f8; };
__device__ __forceinline__ void tr_load(const TrDesc& d, int lane, f32x4 (&v)[16]) {
    const int nblk = (d.N + 63) / 64, kb = d.r / nblk, nb = d.r % nblk, k0 = 64 * kb, n = 64 * nb + 4 * (lane & 15); const bool ok = n < d.N;
    const float* src = d.W + (size_t)(k0 + (lane >> 4)) * d.N + (ok ? n : 0); const size_t rs = (size_t)4 * d.N;
#pragma unroll
    for (int j = 0; j < 16; ++j) v[j] = __builtin_nontemporal_load((const f32x4*)(src + (size_t)j * rs));
}
__device__ __forceinline__ void tr_store(const TrDesc& d, int lane, const f32x4 (&v)[16], LAS float* scr) {
    const int nblk = (d.N + 63) / 64, kb = d.r / nblk, nb = d.r % nblk, k0 = 64 * kb, n0 = 64 * nb;
    { LAS float* w = scr + (lane >> 4) * 65 + 4 * (lane & 15);
#pragma unroll
      for (int j = 0; j < 16; ++j) { w[j * 260 + 0] = v[j][0]; w[j * 260 + 1] = v[j][1]; w[j * 260 + 2] = v[j][2]; w[j * 260 + 3] = v[j][3]; } }
    const int c = lane & 7, nn = lane >> 3; float g[8];
#pragma unroll
    for (int jj = 0; jj < 8; ++jj) g[jj] = d.gain ? d.gain[k0 + 8 * c + jj] : 1.f;
    asm volatile("s_waitcnt lgkmcnt(0)" ::: "memory");
#pragma unroll
    for (int it = 0; it < 8; ++it) { const int nl = nn + 8 * it; const LAS float* rp = scr + (8 * c) * 65 + nl;
        u32x4 o; o.x = cvt_pk_bf16(rp[0 * 65] * g[0], rp[1 * 65] * g[1]); o.y = cvt_pk_bf16(rp[2 * 65] * g[2], rp[3 * 65] * g[3]); o.z = cvt_pk_bf16(rp[4 * 65] * g[4], rp[5 * 65] * g[5]); o.w = cvt_pk_bf16(rp[6 * 65] * g[6], rp[7 * 65] * g[7]);
        if (n0 + nl < d.N) {
            if (d.f8) { int q0 = __builtin_amdgcn_cvt_pk_fp8_f32(rp[0 * 65] * g[0] * 64.f, rp[1 * 65] * g[1] * 64.f, 0, false); q0 = __builtin_amdgcn_cvt_pk_fp8_f32(rp[2 * 65] * g[2] * 64.f, rp[3 * 65] * g[3] * 64.f, q0, true);
                        int q1 = __builtin_amdgcn_cvt_pk_fp8_f32(rp[4 * 65] * g[4] * 64.f, rp[5 * 65] * g[5] * 64.f, 0, false); q1 = __builtin_amdgcn_cvt_pk_fp8_f32(rp[6 * 65] * g[6] * 64.f, rp[7 * 65] * g[7] * 64.f, q1, true);
                        *(u32x2*)((unsigned char*)d.WT + (size_t)map_col(d.kind, n0 + nl) * d.ldt + k0 + 8 * c) = (u32x2){(unsigned)q0, (unsigned)q1}; }
            else *(u32x4*)(d.WT + (size_t)map_col(d.kind, n0 + nl) * d.ldt + k0 + 8 * c) = o; } }
    asm volatile("s_waitcnt lgkmcnt(0)" ::: "memory");
}

__device__ __forceinline__ void rows2048(const Fr& F, const float* x, int nrows, bf16_t* xb, void* out, int mode) {
    for (int m = F.gw; m < nrows; m += F.ngw) {
        const f32x4* xr = (const f32x4*)(x + (size_t)m * DM) + F.lane; f32x4 v[8]; float s = 0.f;
#pragma unroll
        for (int j = 0; j < 8; ++j) { v[j] = xr[64 * j]; s += (v[j].x * v[j].x + v[j].y * v[j].y) + (v[j].z * v[j].z + v[j].w * v[j].w); }
        s = wave_sum(s);
        if (F.lane == 0) { if (mode) ((float*)out)[m] = __builtin_amdgcn_rsqf(s * (1.0f / DM) + RMS_EPS); else ((u64*)out)[m] = (u64)(s * pg8::SSQ_SCALE); }
        if (xb) { u32x2* o8 = (u32x2*)(xb + (size_t)m * DM) + F.lane;
#pragma unroll
            for (int j = 0; j < 8; ++j) { u32x2 w; w.x = cvt_pk_bf16(v[j].x, v[j].y); w.y = cvt_pk_bf16(v[j].z, v[j].w); o8[64 * j] = w; } }
    }
}

__device__ __forceinline__ void hn_step(bf16_t* p, const float (&g)[8]) {
    float v[8]; unpack8(*(const u32x4*)p, v); float ss = sumsq8(v);
    ss += __shfl_xor(ss, 1); ss += __shfl_xor(ss, 2); ss += __shfl_xor(ss, 4); ss += __shfl_xor(ss, 8);
    const float rs = __builtin_amdgcn_rsqf(ss * (1.0f / 128.0f) + RMS_EPS);
#pragma unroll
    for (int j = 0; j < 8; ++j) v[j] = v[j] * rs * g[j];
    *(u32x4*)p = pack8(v);
}
__device__ __forceinline__ void load_gain8(const float* g, int lane, float (&o)[8]) {
#pragma unroll
    for (int j = 0; j < 8; ++j) o[j] = g ? g[(lane & 15) * 8 + j] : 1.f;
}
__device__ __forceinline__ void prep_rows(const Fr& F, bf16_t* P, long ld, int nrows, int c0, int n0, const float* g0, int c1, int n1, const float* g1, int c2, int n2, const float* g2) {
    float ga[8], gb[8], gc[8]; load_gain8(g0, F.lane, ga); load_gain8(g1, F.lane, gb); load_gain8(g2, F.lane, gc);
    for (int m = F.gw; m < nrows; m += F.ngw) {
        bf16_t* row = P + (size_t)m * ld + F.lane * 8;
        for (int s = 0; s < n0; ++s) hn_step(row + c0 + s * 512, ga);
        for (int s = 0; s < n1; ++s) hn_step(row + c1 + s * 512, gb);
        for (int s = 0; s < n2; ++s) hn_step(row + c2 + s * 512, gc);
    }
}

__device__ __forceinline__ void fox_cumsum(const Fr& F, const float* FG, const float* b_f, float* CUM) {
    for (int task = F.gw; task < NB * NH; task += F.ngw) {
        const int b = task >> 4, h = task & 15; const float bias = b_f[h];
        const float* src = FG + ((size_t)b * SEQ + (size_t)F.lane * 64) * 16 + h; float v[64]; float run = 0.f;
#pragma unroll
        for (int i = 0; i < 64; ++i) { const float xg = src[(size_t)i * 16] + bias;
            const float e = __expf(-fabsf(xg)); const float ls = fminf(xg, 0.f) - __logf(1.0f + e);
            run += ls; v[i] = run; }
        float incl = run;
#pragma unroll
        for (int o = 1; o < 64; o <<= 1) { const float t = __shfl_up(incl, o); if (F.lane >= o) incl += t; }
        const float excl = incl - run;
        float* dst = CUM + ((size_t)b * SEQ + (size_t)F.lane * 64) * 16 + h;
#pragma unroll
        for (int i = 0; i < 64; ++i) dst[(size_t)i * 16] = (v[i] + excl) * LOG2E;
    }
}

__device__ const double ROPE_INV[32] = {
    1.0, 0.7498942093324559, 0.5623413251903491, 0.4216965034285822, 0.31622776601683794, 0.23713737056616552, 0.1778279410038923, 0.1333521432163324,
    0.1, 0.07498942093324558, 0.05623413251903491, 0.04216965034285822, 0.03162277660168379, 0.023713737056616554, 0.01778279410038923, 0.01333521432163324,
    0.01, 0.007498942093324558, 0.005623413251903491, 0.004216965034285823, 0.0031622776601683794, 0.0023713737056616554, 0.001778279410038923, 0.001333521432163324,
    0.001, 0.0007498942093324559, 0.0005623413251903491, 0.0004216965034285823, 0.00031622776601683794, 0.00023713737056616554, 0.0001778279410038923, 0.0001333521432163324};
__device__ __forceinline__ void rope_table(const Fr& F, const int* pos, float* COS, float* SIN) {
    const int gt = F.vcu * 512 + F.tid, ngt = F.G * 512;
    for (int i = gt; i < MTOK * 32; i += ngt) { const int m = i >> 5, f = i & 31;
        const double a = (double)pos[m] * (double)(float)ROPE_INV[f]; const double rev = a * 0.15915494309189535; const float fr = (float)(rev - floor(rev));
        COS[i] = __builtin_amdgcn_cosf(fr); SIN[i] = __builtin_amdgcn_sinf(fr); }
}

__device__ __forceinline__ void mla_prep_a(const Fr& F, bf16_t* P, float* RSQ, float* RSKV, bf16_t* KR, const float* rope_g1, const float* gmem, const float* COS, const float* SIN) {
    const int lane = F.lane; float gr[8];
#pragma unroll
    for (int j = 0; j < 8; ++j) gr[j] = rope_g1[(lane & 7) * 8 + j];
    for (int m = F.gw; m < MTOK; m += F.ngw) {
        bf16_t* pr = P + (size_t)m * 1792; float v[8];
        const u32x4 wq = *(const u32x4*)(pr + lane * 8), wk = *(const u32x4*)(pr + 512 + lane * 8);
        u32x4 w = (u32x4){0u, 0u, 0u, 0u}; if (lane < 8) w = *(const u32x4*)(pr + 1024 + lane * 8);
        const float* cp = COS + (size_t)m * 32 + (lane & 3) * 8; const float* sp = SIN + (size_t)m * 32 + (lane & 3) * 8; float cs[8], sn[8];
#pragma unroll
        for (int j = 0; j < 8; ++j) { cs[j] = cp[j]; sn[j] = sp[j]; }
        asm volatile("" ::: "memory");
        unpack8(wq, v); float ss = wave_sum(sumsq8(v)); if (lane == 0) RSQ[m] = __builtin_amdgcn_rsqf(ss * (1.0f / 512.0f) + RMS_EPS);
        unpack8(wk, v); ss = wave_sum(sumsq8(v)); if (lane == 0) RSKV[m] = __builtin_amdgcn_rsqf(ss * (1.0f / 512.0f) + RMS_EPS);
        unpack8(w, v); ss = sumsq8(v); ss += __shfl_xor(ss, 1); ss += __shfl_xor(ss, 2); ss += __shfl_xor(ss, 4);
        const float rs = __builtin_amdgcn_rsqf(ss * (1.0f / 64.0f) + RMS_EPS); float o[8];
#pragma unroll
        for (int j = 0; j < 8; ++j) { const float x = v[j] * rs * gr[j]; const float y = __shfl_xor(x, 4); o[j] = (lane & 4) ? (y * sn[j] + x * cs[j]) : (x * cs[j] - y * sn[j]); }
        if (lane < 8) *(u32x4*)(KR + (size_t)m * 64 + lane * 8) = pack8(o);
    }
}
__device__ __forceinline__ void mla_prep_b(const Fr& F, bf16_t* Q, const bf16_t* KV, bf16_t* KF, const bf16_t* KR, const float* nope_g, const float* rope_g, const float* COS, const float* SIN) {
    const int lane = F.lane, half = lane >> 5, l5 = lane & 31; float gqn[8], gqr[8], gkn[8];
#pragma unroll
    for (int j = 0; j < 8; ++j) { gqn[j] = nope_g[(l5 & 15) * 8 + j]; gkn[j] = nope_g[128 + (l5 & 15) * 8 + j]; gqr[j] = rope_g[(l5 & 7) * 8 + j]; }
    for (int m = F.gw; m < MTOK; m += F.ngw) {
        const float* cp = COS + (size_t)m * 32 + (l5 & 3) * 8; const float* sp = SIN + (size_t)m * 32 + (l5 & 3) * 8; float cs[8], sn[8];
#pragma unroll
        for (int j = 0; j < 8; ++j) { cs[j] = cp[j]; sn[j] = sp[j]; }
        u32x4 krw = (u32x4){0u, 0u, 0u, 0u}; if (l5 >= 16 && l5 < 24) krw = *(const u32x4*)(KR + (size_t)m * 64 + (l5 - 16) * 8);
        u32x4 qw[8], kw[8];
#pragma unroll
        for (int it = 0; it < 8; ++it) { const int h = 2 * it + half;
            qw[it] = (u32x4){0u, 0u, 0u, 0u}; if (l5 < 24) qw[it] = *(const u32x4*)(Q + (size_t)m * 3072 + h * 192 + l5 * 8);
            kw[it] = (u32x4){0u, 0u, 0u, 0u}; if (l5 < 16) kw[it] = *(const u32x4*)(KV + (size_t)m * 4096 + h * 256 + l5 * 8); }
        asm volatile("" ::: "memory");
#pragma unroll
        for (int it = 0; it < 8; ++it) { const int h = 2 * it + half;
            bf16_t* qrow = Q + (size_t)m * 3072 + h * 192 + l5 * 8; float v[8];
            unpack8(qw[it], v); float s8 = sumsq8(v); s8 += __shfl_xor(s8, 1); s8 += __shfl_xor(s8, 2); s8 += __shfl_xor(s8, 4); const float s16 = s8 + __shfl_xor(s8, 8);
            const float rs = (l5 < 16) ? __builtin_amdgcn_rsqf(s16 * (1.0f / 128.0f) + RMS_EPS) : __builtin_amdgcn_rsqf(s8 * (1.0f / 64.0f) + RMS_EPS);
            float o[8];
#pragma unroll
            for (int j = 0; j < 8; ++j) { const float x = v[j] * rs * ((l5 < 16) ? gqn[j] : gqr[j]); const float y = __shfl_xor(x, 4);
                const float rot = (l5 & 4) ? (y * sn[j] + x * cs[j]) : (x * cs[j] - y * sn[j]); o[j] = (l5 < 16) ? x : rot; }
            if (l5 < 24) *(u32x4*)qrow = pack8(o);
            bf16_t* kfrow = KF + (size_t)m * 3072 + h * 192;
            unpack8(kw[it], v); float k16 = sumsq8(v); k16 += __shfl_xor(k16, 1); k16 += __shfl_xor(k16, 2); k16 += __shfl_xor(k16, 4); k16 += __shfl_xor(k16, 8);
            const float krs = __builtin_amdgcn_rsqf(k16 * (1.0f / 128.0f) + RMS_EPS);
#pragma unroll
            for (int j = 0; j < 8; ++j) o[j] = v[j] * krs * gkn[j];
            if (l5 < 16) *(u32x4*)(kfrow + l5 * 8) = pack8(o);
            else if (l5 < 24) *(u32x4*)(kfrow + 128 + (l5 - 16) * 8) = krw;
        }
    }
}

__device__ __forceinline__ void dsa_indexer(const Fr& F, const bf16_t* P, float* SC) {
    constexpr int LDP = 4864, CQI = 3072, CKI = 4096, CWI = 4160;
    const int lane = F.lane, r32 = lane & 31, hg = lane >> 5;
    for (int ui = blockIdx.x; ui < 512; ui += F.G) {
        const int c = ui & 255, second = ui >> 8, b = c >> 5, qb0 = c & 31, qb = second ? 63 - qb0 : qb0;
        const size_t tok0 = (size_t)b * SEQ + qb * 64 + F.wave * 8;
        bf16x8 aq[4][4]; float wv[4][16];
#pragma unroll
        for (int g = 0; g < 4; ++g) { const size_t tok = tok0 + 2 * g + (r32 >> 4); const bf16_t* qp = P + tok * LDP + CQI + (r32 & 15) * 64 + 8 * hg;
#pragma unroll
            for (int ks = 0; ks < 4; ++ks) aq[g][ks] = *(const bf16x8*)(qp + 16 * ks);
#pragma unroll
            for (int r = 0; r < 16; ++r) { const int head = (r & 3) + 8 * ((r >> 2) & 1) + 4 * hg; const size_t tq = tok0 + 2 * g + (r >> 3);
                wv[g][r] = bf_lo((unsigned)P[tq * LDP + CWI + head]) * (0.25f * 0.125f); } }
        const int ntile = 2 * (qb + 1);
        const bf16_t* kp = P + ((size_t)b * SEQ + r32) * LDP + CKI + 8 * hg;
        bf16x8 bk[4], bn[4];
#pragma unroll
        for (int ks = 0; ks < 4; ++ks) bk[ks] = *(const bf16x8*)(kp + 16 * ks);
        for (int t = 0; t < ntile; ++t) {
            if (t + 1 < ntile) {
#pragma unroll
                for (int ks = 0; ks < 4; ++ks) bn[ks] = *(const bf16x8*)(kp + (size_t)(t + 1) * 32 * LDP + 16 * ks);
            }
#pragma unroll
            for (int g = 0; g < 4; ++g) {
                f32x16 d = f32x16{};
#pragma unroll
                for (int ks = 0; ks < 4; ++ks) d = __builtin_amdgcn_mfma_f32_32x32x16_bf16(aq[g][ks], bk[ks], d, 0, 0, 0);
                float s0 = 0.f, s1 = 0.f;
#pragma unroll
                for (int r = 0; r < 8; ++r) { s0 = fmaf(wv[g][r], fmaxf(d[r], 0.f), s0); s1 = fmaf(wv[g][r + 8], fmaxf(d[r + 8], 0.f), s1); }
                auto rr = __builtin_amdgcn_permlane32_swap(__float_as_uint(s0), __float_as_uint(s1), false, false);
                const float tot = __uint_as_float(rr[0]) + __uint_as_float(rr[1]);
                __builtin_nontemporal_store(tot, &SC[(tok0 + 2 * g + hg) * (size_t)SEQ + t * 32 + r32]);
            }
#pragma unroll
            for (int ks = 0; ks < 4; ++ks) bk[ks] = bn[ks];
        }
    }
}

__device__ __forceinline__ void dsa_select(const Fr& F, const float* SC, u64* MSK) {
    const int lane = F.lane;
    for (int qidx = F.gw; qidx < MTOK; qidx += F.ngw) {
        const int s = qidx & (SEQ - 1); const float* row = SC + (size_t)qidx * SEQ; u64* mrow = MSK + (size_t)qidx * 64;
        if (s < 256) { const int lo = 64 * lane; u64 w = 0ull; if (s >= lo + 63) w = ~0ull; else if (s >= lo) w = (2ull << (s - lo)) - 1ull; mrow[lane] = w; continue; }
        unsigned u[64];
#pragma unroll
        for (int c4 = 0; c4 < 4; ++c4) {
            if (1024 * c4 <= s) {
#pragma unroll
                for (int i = 16 * c4; i < 16 * c4 + 16; ++i) u[i] = __float_as_uint(__builtin_nontemporal_load(row + 64 * i + lane)); }
            else {
#pragma unroll
                for (int i = 16 * c4; i < 16 * c4 + 16; ++i) u[i] = 0u; } }
#pragma unroll
        for (int i = 0; i < 64; ++i) { const int key = 64 * i + lane; const unsigned bits = u[i]; const unsigned ord = (bits & 0x80000000u) ? ~bits : (bits | 0x80000000u); u[i] = (key <= s) ? ord : 0u; }
        unsigned T = 0u;
        for (int bit = 31; bit >= 0; --bit) { const unsigned cand = T | (1u << bit); int cl = 0;
#pragma unroll
            for (int i0 = 0; i0 < 64; i0 += 8) {
#pragma unroll
                for (int i = i0; i < i0 + 8; ++i) cl += __popcll(__ballot(u[i] >= cand));
                __builtin_amdgcn_sched_barrier(0); }
            if (cl >= 256) T = cand; }
        int cgt = 0;
#pragma unroll
        for (int i0 = 0; i0 < 64; i0 += 8) {
#pragma unroll
            for (int i = i0; i < i0 + 8; ++i) cgt += __popcll(__ballot(u[i] > T));
            __builtin_amdgcn_sched_barrier(0); }
        int need = 256 - cgt; unsigned mlo = 0u, mhi = 0u;
#pragma unroll
        for (int i = 0; i < 64; ++i) { const u64 gt = __ballot(u[i] > T), eq = __ballot(u[i] == T); u64 take = 0ull;
            if (need > 0 && eq != 0ull) { const int c = __popcll(eq);
                if (c <= need) { take = eq; need -= c; }
                else { u64 e = eq; for (int n = 0; n < need; ++n) { const u64 low = e & (0ull - e); take |= low; e ^= low; } need = 0; } }
            const u64 w = gt | take; { const unsigned wl = __builtin_amdgcn_readfirstlane((unsigned)w), wh = __builtin_amdgcn_readfirstlane((unsigned)(w >> 32));
                asm volatile("s_nop 4\n\tv_writelane_b32 %0, %1, %2\n\ts_nop 1" : "+v"(mlo) : "s"(wl), "n"(i)); asm volatile("s_nop 4\n\tv_writelane_b32 %0, %1, %2\n\ts_nop 1" : "+v"(mhi) : "s"(wh), "n"(i)); } }
        mrow[lane] = ((u64)mhi << 32) | (u64)mlo;
    }
}

constexpr size_t MiB = 1u << 20;
constexpr size_t WS_CTL = 0, CTL_ZERO_BYTES = 8 * MiB;
constexpr int CW_BAR = 4096;
constexpr size_t WS_SSQ = 1 * MiB;
constexpr size_t WS_WB = 8 * MiB;
constexpr size_t WS_XB = 236 * MiB;
constexpr size_t WS_MEMB = 364 * MiB;
constexpr size_t WS_MEMKV = 372 * MiB;
constexpr size_t WS_COS = 388 * MiB, WS_SIN = 392 * MiB, WS_RSMEM = 396 * MiB, WS_RSQ = 397 * MiB, WS_RSKV = 398 * MiB;
constexpr size_t WS_XB8 = 560 * MiB;
constexpr size_t WS_MIX = 400 * MiB;
constexpr size_t WS_SCR = 624 * MiB;
constexpr size_t WS_END = (624 + 832) * MiB;
constexpr size_t WB_GU0 = 0, WB_GU1 = 23068672, WB_D0 = 46137344, WB_D1 = 57671680, WB_IN = 69206016, WB_OUT = 108003328, WB_MKV = 113246208, WB_UQ = 115343360, WB_UKV = 116916224;
constexpr int RING_BYTES = 146944, MISC_OFF = RING_BYTES + 64, LDS_BYTES = 147456;
static_assert(att::L_END <= RING_BYTES && pg8::STAGE_BYTES <= RING_BYTES, "LDS map");
constexpr int NPHASES = 44;
#ifndef F8MASK
#define F8MASK 4
#endif
#define F8LAYER(L) (((F8MASK) >> (L)) & 1)
#ifndef RG
#define RG 1
#endif
#ifndef RD
#define RD 1
#endif
#ifndef RI
#define RI 1
#endif
#ifndef RA
#define RA 1
#endif
#ifndef RCV
#define RCV 1
#endif
#ifndef RIX
#define RIX 1
#endif
#ifndef RSL
#define RSL 1
#endif
#ifndef RC
#define RC 1
#endif
#define REP(n) for (int rep_ = 0; rep_ < (n); ++rep_)

struct Args { const void* in[27]; float* out; unsigned char* ws; int ph_lo, ph_hi; };

typedef const __attribute__((address_space(4))) struct Args* ArgsPc;
__device__ __forceinline__ TrDesc tr_desc(ArgsPc A, int L, bf16_t* WB, int it) {
    const float* w_gate = (const float*)A->in[5]; const float* w_up = (const float*)A->in[6]; const float* w_down = (const float*)A->in[7];
    const float* ffn_norm = (const float*)A->in[4]; const float* attn_norm = (const float*)A->in[8];
    const float* w_out = (const float*)A->in[12];
    const float* w_in = (const float*)(L == 0 ? A->in[13] : L == 1 ? A->in[16] : L == 2 ? A->in[23] : A->in[25]);
    const int nin = (L == 0 ? 6672 : L == 1 ? 1600 : L == 2 ? 18944 : 4688);
    const int I_GU = 32 * 88, I_D = 88 * 32, I_IN = 32 * ((nin + 63) / 64), I_OUT = 40 * 32, I_UQ = (L == 1) ? 8 * 48 : 0;
    TrDesc d; d.f8 = 0; int r = it;
    if (r < 4 * I_GU) { const int s = r / I_GU; r -= s * I_GU; const int f = s >> 1, up = s & 1;
        d.W = (up ? w_up : w_gate) + (size_t)(L * 2 + f) * DM * DFF; d.K = DM; d.N = DFF; d.gain = ffn_norm + (size_t)(L * 2 + f) * DM; d.WT = WB + (f ? WB_GU1 : WB_GU0); d.ldt = DM; d.kind = up ? 2 : 1; }
    else { r -= 4 * I_GU;
        if (r < 2 * I_D) { const int f = r / I_D; r -= f * I_D; d.W = w_down + (size_t)(L * 2 + f) * DFF * DM; d.K = DFF; d.N = DM; d.gain = nullptr; d.WT = WB + (f ? WB_D1 : WB_D0); d.ldt = DFF; d.kind = 0; }
        else { r -= 2 * I_D;
            if (r < I_IN) { d.W = w_in; d.K = DM; d.N = nin; d.gain = attn_norm + (size_t)L * DM; d.WT = WB + WB_IN; d.ldt = DM; d.kind = 3 + L; d.f8 = F8LAYER(L) ? 1 : 0; }
            else { r -= I_IN;
                if (r < I_OUT) { d.W = w_out + (size_t)L * OUTIN * DM; d.K = OUTIN; d.N = DM; d.gain = nullptr; d.WT = WB + WB_OUT; d.ldt = OUTIN; d.kind = 0; }
                else { r -= I_OUT;
                    if (r < I_UQ) { d.W = (const float*)A->in[18]; d.K = 512; d.N = 3072; d.gain = (const float*)A->in[17]; d.WT = WB + WB_UQ; d.ldt = 512; d.kind = 0; }
                    else { r -= I_UQ; d.W = (const float*)A->in[20]; d.K = 512; d.N = 4096; d.gain = (const float*)A->in[19]; d.WT = WB + WB_UKV; d.ldt = 512; d.kind = 0; } } } } }
    d.r = r; return d;
}
__device__ __forceinline__ void convert_layer(const Fr& F, ArgsPc A, int L, bf16_t* WB) {
    const int nin = (L == 0 ? 6672 : L == 1 ? 1600 : L == 2 ? 18944 : 4688);
    const int total = 4 * 32 * 88 + 2 * 88 * 32 + 32 * ((nin + 63) / 64) + 40 * 32 + ((L == 1) ? 8 * 48 + 8 * 64 : 0);
    LAS float* scr = (LAS float*)(F.lds + F.wave * 16640);
    f32x4 va[16], vb[16]; int it = F.gw;
    if (it >= total) return;
    TrDesc da = tr_desc(A, L, WB, it), db = da; tr_load(da, F.lane, va);
    for (;;) {
        const bool nb_ = it + F.ngw < total; if (nb_) { db = tr_desc(A, L, WB, it + F.ngw); tr_load(db, F.lane, vb); }
        tr_store(da, F.lane, va, scr); it += F.ngw; if (!nb_) break;
        const bool na_ = it + F.ngw < total; if (na_) { da = tr_desc(A, L, WB, it + F.ngw); tr_load(da, F.lane, va); }
        tr_store(db, F.lane, vb, scr); it += F.ngw; if (!na_) break;
    }
}

__device__ __forceinline__ void mem_attn_units(const Fr& F, const bf16_t* P, long ldp, int memq_col, const bf16_t* MEMKV, bf16_t* MIX) {
    for (int i = blockIdx.x; i < 512; i += F.G) {
        const int b = i >> 6, mh = (i >> 4) & 3, qb = i & 15; const size_t tok = (size_t)b * SEQ + qb * 256;
        att::AP a{}; a.Q = P + tok * ldp + memq_col + mh * 128; a.qs = ldp; a.K = MEMKV + (size_t)b * NMEM * 4096 + mh * 128; a.ks = 4096; a.V = a.K + 512; a.vs = 4096;
        a.O = MIX + tok * OUTIN + 2048 + mh * 128; a.os = OUTIN; a.kt0 = 0; a.nt = 4; a.q0 = 0; a.C = 0.08838834764831845f * LOG2E;
        att::attn_unit<att::K_MEM, 128>(F.lds, a, F.wave);
    }
}
__device__ __forceinline__ void causal_unit_ids(int i, int& b, int& h, int& qb) {
    const int slot = i >> 8, c = i & 255, bh = (c >> 4) * 8 + (c & 7), half = (c >> 3) & 1;
    qb = half ? ((slot & 1) ? slot : 14 - slot) : ((slot & 1) ? slot - 1 : 15 - slot); b = bh >> 4; h = bh & 15;
}

__device__ __forceinline__ Fr mk_frame(unsigned char* lds_raw, int wave_id) {
    Fr F; F.lds = (LAS unsigned char*)lds_raw; F.tid = tid_opaque(wave_id); F.lane = F.tid & 63; F.wave = __builtin_amdgcn_readfirstlane(F.tid >> 6);
    F.G = gridDim.x; { const int bx = blockIdx.x; F.vcu = (F.G % 8 == 0) ? (bx % 8) * (F.G / 8) + bx / 8 : bx; }
    F.gw = F.vcu * 8 + F.wave; F.ngw = F.G * 8; return F;
}
typedef const __attribute__((address_space(4))) Args* ArgsP;
__device__ __forceinline__ ArgsP args_ptr() { auto p = __builtin_amdgcn_kernarg_segment_ptr(); asm volatile("" : "+s"(p)); return (ArgsP)p; }
#define WSP(T, off) ((T*)(AP_->ws + (off)))
#define SCRP(T, mib) ((T*)(AP_->ws + WS_SCR + (size_t)(mib) * MiB))

__global__ void __launch_bounds__(512, 2) fwd(Args A) {
    extern __shared__ __attribute__((aligned(16))) unsigned char lds_raw[];
    { LAS unsigned* z = (LAS unsigned*)((LAS unsigned char*)lds_raw + RING_BYTES); for (int u = threadIdx.x; u < (LDS_BYTES - RING_BYTES) / 4; u += 512) z[u] = 0u; }
    __syncthreads();
    const int lo = A.ph_lo, hi = A.ph_hi; const int wave_id = __builtin_amdgcn_readfirstlane((int)threadIdx.x >> 6);
    XcdBarrier bar; bar.bar = (unsigned*)(A.ws + WS_CTL) + CW_BAR; bar.x = 0; bar.st = nullptr;
    if (hi - lo > 1) bar = xcd_barrier_post((unsigned*)(A.ws + WS_CTL) + CW_BAR, (volatile LAS unsigned*)((LAS unsigned char*)lds_raw + MISC_OFF) + 8);
    int ph = 0;
#define PH_BEGIN if (ph >= lo && ph < hi) { const Fr F = mk_frame(lds_raw, wave_id); const ArgsP AP_ = args_ptr();
#define PH_END   if (ph + 1 < hi) xcd_barrier(bar); } ++ph;
    const float SC128 = 0.08838834764831845f * LOG2E, SC192 = 0.07216878364870323f * LOG2E;

    PH_BEGIN
        rows2048(F, (const float*)AP_->in[1], NB * NMEM, WSP(bf16_t, WS_MEMB), WSP(float, WS_RSMEM), 1);
        rope_table(F, (const int*)AP_->in[2], WSP(float, WS_COS), WSP(float, WS_SIN));
        rows2048(F, (const float*)AP_->in[0], MTOK, WSP(bf16_t, WS_XB), WSP(u64, WS_SSQ), 0);
#ifdef RZ
        { u32x4* z = WSP(u32x4, WS_END); for (size_t i = (size_t)F.vcu * 512 + F.tid; i < (size_t)2 * DFF * DM * 2 / 16; i += (size_t)F.G * 512) z[i] = (u32x4){0u, 0u, 0u, 0u}; }
#endif
        { LAS float* scr = (LAS float*)(F.lds + F.wave * 16640);
          for (int it = F.gw; it < 4 * 512; it += F.ngw) { const int Lm = it >> 9; TrDesc d; d.W = (const float*)AP_->in[10] + (size_t)Lm * DM * 1024; d.K = DM; d.N = 1024; d.gain = (const float*)AP_->in[9] + (size_t)Lm * DM;
              d.WT = SCRP(bf16_t, 0) + (size_t)Lm * 1024 * DM; d.ldt = DM; d.kind = 0; d.f8 = 0; d.r = it & 511; f32x4 v[16]; tr_load(d, F.lane, v); tr_store(d, F.lane, v, scr); } }
    PH_END
    PH_BEGIN { pg8::Gemm g{WSP(bf16_t, WS_MEMB), SCRP(bf16_t, 0), NB * NMEM, 4096, DM, DM, DM, 0}; pg8::StaticOrder S; S.init(g.M, g.N, F.G, (int)blockIdx.x);
        pg8::EpiProj E{WSP(bf16_t, WS_MEMKV), 4096, WSP(float, WS_RSMEM), 0, nullptr, -1, (const float*)AP_->in[11] + 128, 0, 0, nullptr, 0, 0, nullptr, 0, 0, 1.0f, 4, 2, 256}; pg8::gemm_phase(F.lds, g, S, E, F.tid); } PH_END

    int ver = 0;
#pragma clang loop unroll(full)
    for (int hl = 0; hl < 8; ++hl) {
        const int L = hl >> 1, f = hl & 1;
        if (f == 0) {
            PH_BEGIN REP(RCV) convert_layer(F, AP_, L, WSP(bf16_t, WS_WB)); PH_END

        }
        PH_BEGIN
#ifdef RZ
            { pg8::Gemm g{WSP(bf16_t, WS_XB), WSP(bf16_t, WS_END), MTOK, 2 * DFF, DM, DM, DM, 0}; pg8::StaticOrder S; S.init(g.M, g.N, F.G, (int)blockIdx.x);
              pg8::EpiSwiGLU E{SCRP(bf16_t, 0), DFF, WSP(u64, WS_SSQ) + (size_t)ver * MTOK}; pg8::gemm_phase(F.lds, g, S, E, F.tid); }
#endif
            REP(RG) { pg8::Gemm g{WSP(bf16_t, WS_XB), WSP(bf16_t, WS_WB) + (f ? WB_GU1 : WB_GU0), MTOK, 2 * DFF, DM, DM, DM, 0}; pg8::StaticOrder S; S.init(g.M, g.N, F.G, (int)blockIdx.x);
            pg8::EpiSwiGLU E{SCRP(bf16_t, 0), DFF, WSP(u64, WS_SSQ) + (size_t)ver * MTOK}; pg8::gemm_phase(F.lds, g, S, E, F.tid); } PH_END
        PH_BEGIN { pg8::Gemm g{SCRP(bf16_t, 0), WSP(bf16_t, WS_WB) + (f ? WB_D1 : WB_D0), MTOK, DM, DFF, DFF, DFF, 1}; pg8::StaticOrder S; S.init(g.M, g.N, F.G, (int)blockIdx.x);
            if (RD > 1) { pg8::EpiResid E0{ver == 0 ? (const float*)AP_->in[0] : AP_->out, SCRP(float, 400), SCRP(bf16_t, 660), nullptr, nullptr, 0.5f}; pg8::gemm_phase(F.lds, g, S, E0, F.tid); }
            pg8::EpiResid E{ver == 0 ? (const float*)AP_->in[0] : AP_->out, AP_->out, WSP(bf16_t, WS_XB), WSP(u64, WS_SSQ) + (size_t)(ver + 1) * MTOK, (f == 0 && F8LAYER(L)) ? WSP(unsigned char, WS_XB8) : nullptr, 0.5f}; pg8::gemm_phase(F.lds, g, S, E, F.tid); } PH_END
        ++ver;
        if (f != 0) continue;
        const int ngrp = (L == 2) ? 3 : 1;
#pragma clang loop unroll(full)
        for (int g = 0; g < ngrp; ++g) {
            PH_BEGIN REP(RI) { const int ldp = (L == 0) ? 6912 : (L == 1) ? 1792 : (L == 2) ? 6656 : 4864;
                const int nproj = (L == 2) ? (g == 0 ? 6656 : 6144) : ldp; const size_t roff = (L == 2) ? (g == 0 ? 0 : (g == 1 ? 6656 : 12800)) : 0;
                pg8::Gemm gm = F8LAYER(L) ? pg8::Gemm{WSP(bf16_t, WS_XB8), (const bf16_t*)((const unsigned char*)(WSP(bf16_t, WS_WB) + WB_IN) + roff * DM), MTOK, nproj, DM / 2, DM / 2, DM / 2, 0}
                                       : pg8::Gemm{WSP(bf16_t, WS_XB), WSP(bf16_t, WS_WB) + WB_IN + roff * DM, MTOK, nproj, DM, DM, DM, 0};
                pg8::StaticOrder S; S.init(gm.M, gm.N, F.G, (int)blockIdx.x);
                const float* gmq = (const float*)AP_->in[11] + (size_t)L * 256;
                const float* qg = (L == 0) ? (const float*)AP_->in[15] : (L == 2) ? (const float*)AP_->in[24] + (size_t)g * 256 : (L == 3) ? (const float*)AP_->in[26] : nullptr;
                const int kt_hi = (L == 3) ? 10 : 16, mq_lo = (L == 0 || L == 2) ? 24 : (L == 1) ? 5 : 17, mq_hi = (L == 2 && g > 0) ? mq_lo : mq_lo + 2;
                pg8::EpiProj E{SCRP(bf16_t, 0), ldp, WSP(u64, WS_SSQ) + (size_t)ver * MTOK, 1, (L == 0) ? SCRP(float, 432) : nullptr, 26,
                               qg, 0, (L == 1) ? 0 : 8, qg ? qg + 128 : nullptr, 8, (L == 1) ? 8 : kt_hi, gmq, mq_lo, mq_hi, F8LAYER(L) ? (1.0f / 64.0f) : 1.0f, 0, 0, 0}; if (F8LAYER(L)) pg8::gemm_phase<true>(F.lds, gm, S, E, F.tid); else pg8::gemm_phase<false>(F.lds, gm, S, E, F.tid); } PH_END
            if (L == 0) { PH_BEGIN fox_cumsum(F, SCRP(const float, 432), (const float*)AP_->in[14], SCRP(float, 434)); PH_END }
            if (L == 1) { PH_BEGIN mla_prep_a(F, SCRP(bf16_t, 0), WSP(float, WS_RSQ), WSP(float, WS_RSKV), SCRP(bf16_t, 752), (const float*)AP_->in[22] + 64, nullptr, WSP(float, WS_COS), WSP(float, WS_SIN)); PH_END }
            if (L == 1) {
                PH_BEGIN
                    REP(RI) for (int i = 0; i < 2; ++i) { pg8::Gemm gm{SCRP(bf16_t, 0) + (i ? 512 : 0), WSP(bf16_t, WS_WB) + (i ? WB_UKV : WB_UQ), MTOK, i ? 4096 : 3072, 512, 1792, 512, 0}; pg8::StaticOrder S; S.init(gm.M, gm.N, F.G, (int)blockIdx.x);
                        pg8::EpiProj E{i ? SCRP(bf16_t, 304) : SCRP(bf16_t, 112), i ? 4096 : 3072, i ? WSP(float, WS_RSKV) : WSP(float, WS_RSQ), 0, nullptr, -1, nullptr, 0, 0, nullptr, 0, 0, nullptr, 0, 0, 1.0f, 0, 0, 0}; pg8::gemm_phase(F.lds, gm, S, E, F.tid); }
                PH_END
                PH_BEGIN mla_prep_b(F, SCRP(bf16_t, 112), SCRP(const bf16_t, 304), SCRP(bf16_t, 560), SCRP(const bf16_t, 752), (const float*)AP_->in[21], (const float*)AP_->in[22], WSP(float, WS_COS), WSP(float, WS_SIN)); PH_END
            }
            if (L == 3) {
                PH_BEGIN REP(RIX) dsa_indexer(F, SCRP(const bf16_t, 0), SCRP(float, 304)); PH_END
                PH_BEGIN REP(RSL) dsa_select(F, SCRP(const float, 304), SCRP(u64, 816)); PH_END
            }
            PH_BEGIN
                bf16_t* P = SCRP(bf16_t, 0); bf16_t* MIX = WSP(bf16_t, WS_MIX);
                const long ldp = (L == 0) ? 6912 : (L == 1) ? 1792 : (L == 2) ? 6656 : 4864;
                REP(L == 2 ? 1 : RA) {
                if (L == 0) {
                    const float* CUM = SCRP(const float, 434);
                    for (int i = blockIdx.x; i < 2048; i += F.G) { int b, h, qb; causal_unit_ids(i, b, h, qb); const size_t t0 = (size_t)b * SEQ;
                        att::AP a{}; a.Q = P + (t0 + qb * 256) * ldp + h * 128; a.qs = ldp; a.K = P + t0 * ldp + 2048 + h * 128; a.ks = ldp; a.V = a.K + 2048; a.vs = ldp;
                        a.O = MIX + (t0 + qb * 256) * OUTIN + h * 128; a.os = OUTIN; a.kt0 = 0; a.nt = 4 * (qb + 1); a.q0 = qb * 256; a.C = SC128; a.cum = CUM + t0 * 16 + h; a.cums = 16;
                        att::attn_unit<att::K_FOX, 128>(F.lds, a, F.wave); }
                }
                if (L == 1) {
                    const bf16_t* Qb = SCRP(const bf16_t, 112); const bf16_t* KVb = SCRP(const bf16_t, 304); const bf16_t* KF = SCRP(const bf16_t, 560);
                    for (int i = blockIdx.x; i < 2048; i += F.G) { int b, h, qb; causal_unit_ids(i, b, h, qb); const size_t t0 = (size_t)b * SEQ;
                        att::AP a{}; a.Q = Qb + (t0 + qb * 256) * 3072 + h * 192; a.qs = 3072; a.K = KF + t0 * 3072 + h * 192; a.ks = 3072; a.V = KVb + t0 * 4096 + h * 256 + 128; a.vs = 4096;
                        a.O = MIX + (t0 + qb * 256) * OUTIN + h * 128; a.os = OUTIN; a.kt0 = 0; a.nt = 4 * (qb + 1); a.q0 = qb * 256; a.C = SC192;
                        att::attn_unit<att::K_MLA, 192>(F.lds, a, F.wave); }
                }
                if (L == 2) {
                    const int dil = (g == 0) ? 1 : (g == 1 ? 4 : 16), nblk = 16 / dil; float* OST = SCRP(float, 416); float* ML = SCRP(float, 672);
                    for (int i = blockIdx.x; i < 2048; i += F.G) { const int h = i & 15, rest = i >> 4, b = rest >> 4, rj = rest & 15, r = rj / nblk, jb = rj % nblk;
                        const size_t tokz = (size_t)b * SEQ + r, tokq = tokz + (size_t)jb * 256 * dil;
                        att::AP a{}; a.Q = P + tokq * ldp + h * 128; a.qs = (long)dil * ldp; a.K = P + tokz * ldp + 2048 + h * 128; a.ks = (long)dil * ldp; a.V = a.K + 2048; a.vs = a.ks;
                        a.O = MIX + tokq * OUTIN + h * 128; a.os = (long)dil * OUTIN; a.q0 = jb * 256; a.kt0 = jb == 0 ? 0 : 4 * jb - 2; a.nt = jb == 0 ? 4 : 6; a.C = SC128;
                        a.ost = OST + tokq * 2048 + h * 128; a.osts = (long)dil * 2048; a.mst = ML + (tokq * 16 + h) * 2; a.msts = (long)dil * 32; a.carry_in = g > 0; a.carry_out = g < 2;
                        a.t5 = (const float*)AP_->in[3]; a.head = h; a.dil = dil;
                        att::attn_unit<att::K_DIL, 128>(F.lds, a, F.wave); }
                }
                if (L == 3) {
                    const u64* MSK = SCRP(const u64, 816);
                    for (int i = blockIdx.x; i < 2048; i += F.G) { int b, h, qb; causal_unit_ids(i, b, h, qb); const size_t t0 = (size_t)b * SEQ;
                        att::AP a{}; a.Q = P + (t0 + qb * 256) * ldp + h * 128; a.qs = ldp; a.K = P + t0 * ldp + 2048 + (h >> 2) * 128; a.ks = ldp; a.V = a.K + 512; a.vs = ldp;
                        a.O = MIX + (t0 + qb * 256) * OUTIN + h * 128; a.os = OUTIN; a.kt0 = 0; a.nt = 4 * (qb + 1); a.q0 = qb * 256; a.C = SC128; a.msk = MSK + (t0 + qb * 256) * 64; a.t5 = (const float*)AP_->in[3]; a.head = h;
                        att::attn_unit<att::K_DSA, 128>(F.lds, a, F.wave); }
                }
                if (g == 0) { const int memq_col = (L == 0) ? 6144 : (L == 1) ? 1280 : (L == 2) ? 6144 : 4352; mem_attn_units(F, P, ldp, memq_col, WSP(const bf16_t, WS_MEMKV) + L * 1024, MIX); }
                }
            PH_END
        }
        PH_BEGIN { pg8::Gemm gm{WSP(bf16_t, WS_MIX), WSP(bf16_t, WS_WB) + WB_OUT, MTOK, DM, OUTIN, OUTIN, OUTIN, 0}; pg8::StaticOrder S; S.init(gm.M, gm.N, F.G, (int)blockIdx.x);
            if (RD > 1) { pg8::EpiResid E0{AP_->out, SCRP(float, 400), SCRP(bf16_t, 660), nullptr, nullptr, 1.0f}; pg8::gemm_phase(F.lds, gm, S, E0, F.tid); }
            pg8::EpiResid E{AP_->out, AP_->out, WSP(bf16_t, WS_XB), WSP(u64, WS_SSQ) + (size_t)(ver + 1) * MTOK, nullptr, 1.0f}; pg8::gemm_phase(F.lds, gm, S, E, F.tid); } PH_END
        ++ver;
    }
#undef PH_BEGIN
#undef PH_END
}

#ifndef MK_ONE_LAUNCH
#define MK_ONE_LAUNCH 0
#endif
extern "C" void kernel_launch(void* const* d_in, const int* in_sizes, int n_in, void* d_out, int out_size, void* d_ws, size_t ws_size, hipStream_t stream) {
    static int grid = 0;
    if (grid == 0) {
        if (n_in != 27 || in_sizes[0] != MTOK * DM || out_size != MTOK * DM || ws_size < WS_END) {
            fprintf(stderr, "kernel_launch: unexpected shapes: n_in %d in0 %d out %d ws %zu (need >= %zu); nothing launched\n", n_in, n_in > 0 ? in_sizes[0] : -1, out_size, ws_size, (size_t)WS_END); grid = -1; return; }
        int dev = 0, cus = 0, per_cu = 0;
        if (hipGetDevice(&dev) != hipSuccess || hipDeviceGetAttribute(&cus, hipDeviceAttributeMultiprocessorCount, dev) != hipSuccess) { fprintf(stderr, "kernel_launch: device query failed\n"); grid = -1; return; }
        if (hipFuncSetAttribute((const void*)fwd, hipFuncAttributeMaxDynamicSharedMemorySize, LDS_BYTES) != hipSuccess) { fprintf(stderr, "kernel_launch: hipFuncSetAttribute failed\n"); grid = -1; return; }
        if (hipOccupancyMaxActiveBlocksPerMultiprocessor(&per_cu, (const void*)fwd, 512, LDS_BYTES) != hipSuccess || per_cu < 1)
            fprintf(stderr, "kernel_launch: note: occupancy query reports %d workgroups per CU\n", per_cu);
        (void)hipGetLastError();
        grid = cus;
    }
    if (grid < 0) return;
    if (hipMemsetAsync((char*)d_ws + WS_CTL, 0, CTL_ZERO_BYTES, stream) != hipSuccess) { fprintf(stderr, "kernel_launch: memset failed\n"); return; }
    Args a{};
    for (int i = 0; i < 27; ++i) a.in[i] = d_in[i];
    a.out = (float*)d_out; a.ws = (unsigned char*)d_ws;
#if MK_ONE_LAUNCH
    a.ph_lo = 0; a.ph_hi = NPHASES;
    hipLaunchKernelGGL(fwd, dim3(grid), dim3(512), LDS_BYTES, stream, a);
#else
#ifndef NPH_LIMIT
#define NPH_LIMIT NPHASES
#endif
    for (int p = 0; p < NPH_LIMIT; ++p) { a.ph_lo = p; a.ph_hi = p + 1; hipLaunchKernelGGL(fwd, dim3(grid), dim3(512), LDS_BYTES, stream, a); }
#endif
    const hipError_t le = hipPeekAtLastError();
    if (le != hipSuccess) fprintf(stderr, "kernel_launch: launch failed: %s\n", hipGetErrorName(le));
}
```

```cpp
#define MK_ONE_LAUNCH 1
#include <hip/hip_runtime.h>
#include <cstdio>
#include <cstdint>

#define LAS __attribute__((address_space(3)))
#define GAS __attribute__((address_space(1)))
typedef unsigned short bf16_t;
typedef short bf16x8 __attribute__((ext_vector_type(8)));
typedef short s16x4 __attribute__((ext_vector_type(4)));
typedef float f32x2 __attribute__((ext_vector_type(2)));
typedef float f32x4 __attribute__((ext_vector_type(4)));
typedef float f32x16 __attribute__((ext_vector_type(16)));
typedef unsigned u32x2 __attribute__((ext_vector_type(2)));
typedef unsigned u32x4 __attribute__((ext_vector_type(4)));
typedef unsigned long long u64;

constexpr int DM = 2048, NB = 8, SEQ = 4096, MTOK = NB * SEQ, DFF = 5632, NH = 16, HD = 128, NMEM = 256, MEMW = 512, OUTIN = 2560;
constexpr float RMS_EPS = 1e-6f;
constexpr float LOG2E = 1.4426950408889634f;

__device__ __forceinline__ unsigned cvt_pk_bf16(float lo, float hi) { unsigned r; asm volatile("v_cvt_pk_bf16_f32 %0, %1, %2" : "=v"(r) : "v"(lo), "v"(hi)); return r; }
__device__ __forceinline__ float bf_lo(unsigned w) { return __uint_as_float(w << 16); }
__device__ __forceinline__ float bf_hi(unsigned w) { return __uint_as_float(w & 0xffff0000u); }

__device__ __forceinline__ int tid_opaque(int wave_id) {
    int l; asm volatile("v_mbcnt_lo_u32_b32 %0, -1, 0\n\tv_mbcnt_hi_u32_b32 %0, -1, %0" : "=v"(l)); return wave_id * 64 + l; }

namespace pg8 {
constexpr int BM = 256, BK = 64, HALF = 128, HTB = HALF * BK * 2, STAGE_BYTES = 8 * HTB, NXCD = 8, WGM = 8;
__host__ __device__ __forceinline__ int lds_byte(int r, int c) { const int st = (r >> 4) * 2 + (c >> 5), rr = r & 15, cc = c & 31, ob = rr * 64 + cc * 2; return st * 1024 + (ob ^ (((ob >> 9) & 1) << 5)); }
__host__ __device__ __forceinline__ void stage_rc(int b, int& R, int& C) { const int st = b / 1024, sb = b % 1024, swz = sb ^ (((sb >> 9) & 1) << 5); R = (st >> 1) * 16 + swz / 64; C = (st & 1) * 32 + (swz % 64) / 2; }
__host__ __device__ __forceinline__ int perm32(int rho) { const int n = rho >> 4, i = rho & 15; return 8 * (i >> 2) + 4 * n + (i & 3); }

struct Unit { int pm, pn; };
struct Gemm { const bf16_t* A; const bf16_t* Bt; int M, N, K, lda, ldb; int a_tiled; };

struct StaticOrder {
    int nM, nN, nwg, G, c;
    __host__ __device__ void init(int M, int N, int G_, int c_) { nM = M / BM; nN = N / BM; nwg = nM * nN; G = G_; c = c_; }
    __host__ __device__ bool next(int i, Unit& u) const {
        const long L = (long)i * G + c; if (L >= nwg) return false;
        int wgid = (int)L; { const int q = nwg / NXCD, r = nwg % NXCD, xcd = wgid % NXCD, off = wgid / NXCD; wgid = (xcd < r ? xcd * (q + 1) : r * (q + 1) + (xcd - r) * q) + off; }
        const int nig = WGM * nN, gid = wgid / nig, fm = gid * WGM, gsz = (nM - fm) < WGM ? (nM - fm) : WGM;
        u.pm = fm + ((wgid % nig) % gsz); u.pn = (wgid % nig) / gsz; return true;
    }
};

constexpr float SSQ_SCALE = 16777216.0f;
__device__ __forceinline__ float rs_from_ssq(const u64 v) { return __builtin_amdgcn_rsqf((float)v * (1.0f / (SSQ_SCALE * DM)) + RMS_EPS); }
__device__ __forceinline__ float rs_of(const void* rsv, int row, int mode) { return mode ? rs_from_ssq(((const u64*)rsv)[row]) : ((const float*)rsv)[row]; }

struct EpiProj {
    bf16_t* O; int ldc; const void* rsv; int rs_mode;
    float* fgout; int fg_tile;
    const float* g0; int t0a, t0b; const float* g1; int t1a, t1b; const float* g2; int t2a, t2b;
    float oscale;
    int gper, gcnt, gstride;
    __device__ __forceinline__ void operator()(f32x4 (&acc)[2][2][4][2], const Unit& u, int wr, int wc, int fr, int fq, LAS unsigned char* xlds) const {
        const int row0 = u.pm * BM + wr * 64 + fr; const int col0 = u.pn * BM + wc * 32 + 8 * fq;
        const float* gain = (u.pn >= t0a && u.pn < t0b) ? g0 : (u.pn >= t1a && u.pn < t1b) ? g1 : (u.pn >= t2a && u.pn < t2b) ? g2 : nullptr;
        if (gper) gain = (u.pn % gper < gcnt) ? g0 + (size_t)(u.pn / gper) * gstride : nullptr;
        float rsa[2][4];
#pragma unroll
        for (int ai = 0; ai < 2; ++ai)
#pragma unroll
            for (int m = 0; m < 4; ++m) rsa[ai][m] = rs_of(rsv, row0 + ai * HALF + m * 16, rs_mode) * oscale;
#pragma unroll
        for (int ai = 0; ai < 2; ++ai)
#pragma unroll
            for (int m = 0; m < 4; ++m) { const float rs = rsa[ai][m];
#pragma unroll
                for (int bj = 0; bj < 2; ++bj) { acc[ai][bj][m][0] *= rs; acc[ai][bj][m][1] *= rs; } }
        if (gain) {
            LAS float* part = (LAS float*)xlds;
#pragma unroll
            for (int ai = 0; ai < 2; ++ai)
#pragma unroll
                for (int m = 0; m < 4; ++m)
#pragma unroll
                    for (int bj = 0; bj < 2; ++bj) { const f32x4 a = acc[ai][bj][m][0], b = acc[ai][bj][m][1];
                        float ss = ((a[0] * a[0] + a[1] * a[1]) + (a[2] * a[2] + a[3] * a[3])) + ((b[0] * b[0] + b[1] * b[1]) + (b[2] * b[2] + b[3] * b[3]));
                        ss += __shfl_xor(ss, 16); ss += __shfl_xor(ss, 32);
                        if (fq == 0) part[((ai * HALF + wr * 64 + m * 16 + fr) * 2 + bj) * 4 + wc] = ss; }
            asm volatile("s_waitcnt lgkmcnt(0)" ::: "memory"); __builtin_amdgcn_s_barrier(); asm volatile("" ::: "memory");
            const f32x4 gv0 = *(const f32x4*)(gain + wc * 32 + 8 * fq), gv1 = *(const f32x4*)(gain + wc * 32 + 8 * fq + 4);
#pragma unroll
            for (int ai = 0; ai < 2; ++ai)
#pragma unroll
                for (int m = 0; m < 4; ++m)
#pragma unroll
                    for (int bj = 0; bj < 2; ++bj) { const f32x4 p4 = *(const LAS f32x4*)(part + ((ai * HALF + wr * 64 + m * 16 + fr) * 2 + bj) * 4);
                        const float r2 = __builtin_amdgcn_rsqf(((p4[0] + p4[1]) + (p4[2] + p4[3])) * (1.0f / 128.0f) + RMS_EPS);
                        acc[ai][bj][m][0] *= gv0 * r2; acc[ai][bj][m][1] *= gv1 * r2; }
        }
#pragma unroll
        for (int ai = 0; ai < 2; ++ai)
#pragma unroll
            for (int m = 0; m < 4; ++m) { const int row = row0 + ai * HALF + m * 16;
                bf16_t* rowp = O + (size_t)row * ldc + col0;
#pragma unroll
                for (int bj = 0; bj < 2; ++bj) { const f32x4 v0 = acc[ai][bj][m][0], v1 = acc[ai][bj][m][1];
                    u32x4 w; w.x = cvt_pk_bf16(v0[0], v0[1]); w.y = cvt_pk_bf16(v0[2], v0[3]); w.z = cvt_pk_bf16(v1[0], v1[1]); w.w = cvt_pk_bf16(v1[2], v1[3]);
                    *(u32x4*)(rowp + bj * HALF) = w;
                    if (fgout && bj == 0 && u.pn == fg_tile && wc == 0 && fq < 2) { float* fp = fgout + (size_t)row * 16 + 8 * fq; *(f32x4*)fp = v0; *(f32x4*)(fp + 4) = v1; } } }
    }
};
struct EpiSwiGLU {
    bf16_t* O; int ldc; const u64* ssq;
    __device__ __forceinline__ void operator()(f32x4 (&acc)[2][2][4][2], const Unit& u, int wr, int wc, int fr, int fq, LAS unsigned char*) const {
        const int row0 = u.pm * BM + wr * 64 + fr; const int col0 = u.pn * HALF + wc * 32 + 8 * fq;
        float rsv[2][4];
#pragma unroll
        for (int ai = 0; ai < 2; ++ai)
#pragma unroll
            for (int m = 0; m < 4; ++m) rsv[ai][m] = rs_from_ssq(ssq[row0 + ai * HALF + m * 16]);
#pragma unroll
        for (int ai = 0; ai < 2; ++ai)
#pragma unroll
            for (int m = 0; m < 4; ++m) { const int row = row0 + ai * HALF + m * 16; const float rs = rsv[ai][m];
                float h[8];
#pragma unroll
                for (int n = 0; n < 2; ++n)
#pragma unroll
                    for (int j = 0; j < 4; ++j) { const float g = acc[ai][0][m][n][j] * rs, uu = acc[ai][1][m][n][j] * rs;
                        const float e = __builtin_amdgcn_exp2f(-g * LOG2E); h[n * 4 + j] = g * __builtin_amdgcn_rcpf(1.0f + e) * uu; }
                u32x4 w; w.x = cvt_pk_bf16(h[0], h[1]); w.y = cvt_pk_bf16(h[2], h[3]); w.z = cvt_pk_bf16(h[4], h[5]); w.w = cvt_pk_bf16(h[6], h[7]);
                const int kt = col0 >> 6, hh = (row >> 7) & 1;
                __builtin_nontemporal_store(w, (u32x4*)(O + ((size_t)((size_t)u.pm * (ldc >> 6) + kt) * 2 + hh) * (HALF * BK) + (size_t)(row & 127) * BK + (col0 & 63))); }
    }
};
struct EpiResid {
    const float* xin; float* xout; bf16_t* xb; u64* ssq_out; unsigned char* xb8; float alpha;
    __device__ __forceinline__ void operator()(f32x4 (&acc)[2][2][4][2], const Unit& u, int wr, int wc, int fr, int fq, LAS unsigned char*) const {
        const int row0 = u.pm * BM + wr * 64 + fr; const int col0 = u.pn * BM + wc * 32 + 8 * fq;
#pragma unroll
        for (int ai = 0; ai < 2; ++ai) {
            f32x4 xi[4][2][2];
#pragma unroll
            for (int m = 0; m < 4; ++m) { const size_t off = (size_t)(row0 + ai * HALF + m * 16) * DM + col0;
#pragma unroll
                for (int bj = 0; bj < 2; ++bj) { xi[m][bj][0] = __builtin_nontemporal_load((const f32x4*)(xin + off + bj * HALF)); xi[m][bj][1] = __builtin_nontemporal_load((const f32x4*)(xin + off + bj * HALF + 4)); } }
            asm volatile("" ::: "memory");
#pragma unroll
            for (int m = 0; m < 4; ++m) { const int row = row0 + ai * HALF + m * 16; const size_t off = (size_t)row * DM + col0; float ss = 0.f;
#pragma unroll
                for (int bj = 0; bj < 2; ++bj) {
                    const f32x4 v0 = xi[m][bj][0] + acc[ai][bj][m][0] * alpha, v1 = xi[m][bj][1] + acc[ai][bj][m][1] * alpha;
                    __builtin_nontemporal_store(v0, (f32x4*)(xout + off + bj * HALF)); __builtin_nontemporal_store(v1, (f32x4*)(xout + off + bj * HALF + 4));
                    u32x4 w; w.x = cvt_pk_bf16(v0[0], v0[1]); w.y = cvt_pk_bf16(v0[2], v0[3]); w.z = cvt_pk_bf16(v1[0], v1[1]); w.w = cvt_pk_bf16(v1[2], v1[3]);
                    *(u32x4*)(xb + off + bj * HALF) = w;
                    if (xb8) { int q0 = __builtin_amdgcn_cvt_pk_fp8_f32(v0[0], v0[1], 0, false); q0 = __builtin_amdgcn_cvt_pk_fp8_f32(v0[2], v0[3], q0, true);
                               int q1 = __builtin_amdgcn_cvt_pk_fp8_f32(v1[0], v1[1], 0, false); q1 = __builtin_amdgcn_cvt_pk_fp8_f32(v1[2], v1[3], q1, true);
                               *(u32x2*)(xb8 + off + bj * HALF) = (u32x2){(unsigned)q0, (unsigned)q1}; }
                    ss += (v0[0] * v0[0] + v0[1] * v0[1]) + (v0[2] * v0[2] + v0[3] * v0[3]) + (v1[0] * v1[0] + v1[1] * v1[1]) + (v1[2] * v1[2] + v1[3] * v1[3]); }
                if (ssq_out) { ss += __shfl_xor(ss, 16); ss += __shfl_xor(ss, 32); if (fq == 0) atomicAdd(ssq_out + row, (u64)(ss * SSQ_SCALE)); } }
            asm volatile("" ::: "memory");
        }
    }
};

template <bool FP8 = false, class Epi, class Sched>
__device__ __forceinline__ void gemm_phase(LAS unsigned char* lds, const Gemm g, const Sched& S, const Epi& E, const int tid) {
    const int wid = __builtin_amdgcn_readfirstlane(tid >> 6), lane = tid & 63, wr = wid >> 2, wc = wid & 3, fr = lane & 15, fq = lane >> 4;
    const int K = g.K, nt = K / BK;
    unsigned voffA[2], voffB[2];
#pragma unroll
    for (int i = 0; i < 2; ++i) { int R, C; stage_rc(tid * 16 + i * 8192, R, C); const int Rb = (R & ~31) + perm32(R & 31);
        voffA[i] = (unsigned)(R * (g.a_tiled ? BK : g.lda) + C) * 2u; voffB[i] = (unsigned)(Rb * g.ldb + C) * 2u; }
    const size_t kstep = (size_t)(BK * 2), kstepA = g.a_tiled ? (size_t)(2 * HTB) : kstep;
    const size_t hstepA = g.a_tiled ? (size_t)HTB : (size_t)HALF * g.lda * 2, hstepB = (size_t)HALF * g.ldb * 2;
    const size_t tstepA = g.a_tiled ? (size_t)nt * 2 * HTB : 2 * hstepA, tstepB = 2 * hstepB;
    const unsigned ldsw = (unsigned)wid * 1024u;
    const int aoff = lds_byte(wr * 64 + fr, fq * 8), boff = lds_byte(wc * 32 + fr, fq * 8);
#define PG8_SA(b, h) (((b) * 2 + (h)) * HTB)
#define PG8_SB(b, h) ((4 + (b) * 2 + (h)) * HTB)
#define PG8_STAGE(bufoff, gbase, voff) do { _Pragma("unroll") for (int _i = 0; _i < 2; ++_i) \
        __builtin_amdgcn_global_load_lds((const unsigned*)((const char*)(gbase) + (voff)[_i]), (LAS unsigned*)(lds + (bufoff) + ldsw + _i * 8192), 16, 0, 0); } while (0)
#define PG8_LDA(dst, b, h) do { _Pragma("unroll") for (int m = 0; m < 4; ++m) _Pragma("unroll") for (int k = 0; k < 2; ++k) dst[m][k] = *(const LAS bf16x8*)(lds + PG8_SA(b, h) + aoff + m * 2048 + k * 1024); } while (0)
#define PG8_LDB(dst, b, h) do { _Pragma("unroll") for (int n = 0; n < 2; ++n) _Pragma("unroll") for (int k = 0; k < 2; ++k) dst[n][k] = *(const LAS bf16x8*)(lds + PG8_SB(b, h) + boff + n * 2048 + k * 1024); } while (0)
typedef long i64x2_t __attribute__((ext_vector_type(2)));
#define PG8_MMA(ai, bj, At, Bt) do { __builtin_amdgcn_s_setprio(1); \
        if constexpr (FP8) { _Pragma("unroll") for (int m = 0; m < 4; ++m) _Pragma("unroll") for (int n = 0; n < 2; ++n) _Pragma("unroll") for (int k = 0; k < 2; ++k) { \
            const i64x2_t b_ = __builtin_bit_cast(i64x2_t, Bt[n][k]), a_ = __builtin_bit_cast(i64x2_t, At[m][k]); \
            acc[ai][bj][m][n] = __builtin_amdgcn_mfma_f32_16x16x32_fp8_fp8(b_[0], a_[0], acc[ai][bj][m][n], 0, 0, 0); \
            acc[ai][bj][m][n] = __builtin_amdgcn_mfma_f32_16x16x32_fp8_fp8(b_[1], a_[1], acc[ai][bj][m][n], 0, 0, 0); } } \
        else { _Pragma("unroll") for (int m = 0; m < 4; ++m) _Pragma("unroll") for (int n = 0; n < 2; ++n) _Pragma("unroll") for (int k = 0; k < 2; ++k) \
            acc[ai][bj][m][n] = __builtin_amdgcn_mfma_f32_16x16x32_bf16(Bt[n][k], At[m][k], acc[ai][bj][m][n], 0, 0, 0); } \
        __builtin_amdgcn_s_setprio(0); } while (0)
#define PG8_WAIT_V(n) asm volatile("s_waitcnt vmcnt(" #n ")" ::: "memory")
#define PG8_WAIT_L(n) asm volatile("s_waitcnt lgkmcnt(" #n ")" ::: "memory")
#define PG8_BAR __builtin_amdgcn_s_barrier()
#define PG8_SCHED __builtin_amdgcn_sched_barrier(0)
    Unit cur, nxt; int ui = 0;
    if (!S.next(0, cur)) return;
    f32x4 acc[2][2][4][2];
#pragma unroll
    for (int a = 0; a < 2; ++a)
#pragma unroll
        for (int b = 0; b < 2; ++b)
#pragma unroll
            for (int m = 0; m < 4; ++m)
#pragma unroll
                for (int n = 0; n < 2; ++n) acc[a][b][m][n] = (f32x4){0.f, 0.f, 0.f, 0.f};
    bf16x8 At[4][2], B0[2][2], B1[2][2];
    const char* cA = (const char*)g.A + (size_t)cur.pm * tstepA; const char* cB = (const char*)g.Bt + (size_t)cur.pn * tstepB;
    PG8_STAGE(PG8_SB(0, 0), cB, voffB); PG8_STAGE(PG8_SB(0, 1), cB + hstepB, voffB); PG8_STAGE(PG8_SA(0, 0), cA, voffA); PG8_STAGE(PG8_SA(0, 1), cA + hstepA, voffA);
    if (wr == 1) PG8_BAR;
    PG8_WAIT_V(2); PG8_BAR;
    PG8_STAGE(PG8_SB(1, 0), cB + kstep, voffB); PG8_STAGE(PG8_SA(1, 0), cA + kstepA, voffA); PG8_STAGE(PG8_SB(1, 1), cB + hstepB + kstep, voffB);
    PG8_WAIT_V(6); PG8_BAR;
    for (;;) {
        const bool has_next = S.next(ui + 1, nxt);
        const char* nA = has_next ? (const char*)g.A + (size_t)nxt.pm * tstepA : cA; const char* nB = has_next ? (const char*)g.Bt + (size_t)nxt.pn * tstepB : cB;
        for (int t = 0; t < nt; t += 2) {
            const bool last = (t == nt - 2);
            const char* a1 = cA + (size_t)(t + 1) * kstepA;
            const char* a2 = last ? nA : cA + (size_t)(t + 2) * kstepA; const char* b2 = last ? nB : cB + (size_t)(t + 2) * kstep;
            const char* a3 = a2 + kstepA; const char* b3 = b2 + kstep;
            PG8_LDB(B0, 0, 0); PG8_LDB(B1, 0, 1); PG8_SCHED; PG8_LDA(At, 0, 0); PG8_STAGE(PG8_SA(1, 1), a1 + hstepA, voffA);
            PG8_WAIT_V(8); PG8_WAIT_L(0); PG8_BAR; PG8_MMA(0, 0, At, B0); PG8_MMA(0, 1, At, B1); PG8_BAR; PG8_SCHED;
            PG8_LDA(At, 0, 1); PG8_STAGE(PG8_SB(0, 0), b2, voffB); PG8_STAGE(PG8_SB(0, 1), b2 + hstepB, voffB); PG8_STAGE(PG8_SA(0, 0), a2, voffA);
            PG8_WAIT_V(8); PG8_WAIT_L(0); PG8_BAR; PG8_MMA(1, 0, At, B0); PG8_MMA(1, 1, At, B1); PG8_BAR; PG8_SCHED;
            PG8_LDB(B0, 1, 0); PG8_LDB(B1, 1, 1); PG8_SCHED; PG8_LDA(At, 1, 0); PG8_STAGE(PG8_SA(0, 1), a2 + hstepA, voffA);
            PG8_WAIT_V(8); PG8_WAIT_L(0); PG8_BAR; PG8_MMA(0, 0, At, B0); PG8_MMA(0, 1, At, B1); PG8_BAR; PG8_SCHED;
            PG8_LDA(At, 1, 1); PG8_STAGE(PG8_SB(1, 0), b3, voffB); PG8_STAGE(PG8_SB(1, 1), b3 + hstepB, voffB); PG8_STAGE(PG8_SA(1, 0), a3, voffA);
            PG8_WAIT_V(8); PG8_WAIT_L(0); PG8_BAR; PG8_MMA(1, 0, At, B0); PG8_MMA(1, 1, At, B1); PG8_BAR; PG8_SCHED;
        }
        if (wr == 0) PG8_BAR;
        E(acc, cur, wr, wc, fr, fq, lds + STAGE_BYTES);
        if (!has_next) break;
#pragma unroll
        for (int a = 0; a < 2; ++a)
#pragma unroll
            for (int b = 0; b < 2; ++b)
#pragma unroll
                for (int m = 0; m < 4; ++m)
#pragma unroll
                    for (int n = 0; n < 2; ++n) acc[a][b][m][n] = (f32x4){0.f, 0.f, 0.f, 0.f};
        cur = nxt; cA = nA; cB = nB; ++ui;
        if (wr == 1) PG8_BAR;
    }
    PG8_WAIT_V(0);
    PG8_BAR;
#undef PG8_SA
#undef PG8_SB
#undef PG8_STAGE
#undef PG8_LDA
#undef PG8_LDB
#undef PG8_MMA
#undef PG8_WAIT_V
#undef PG8_WAIT_L
#undef PG8_BAR
#undef PG8_SCHED
}
}

#define XB_TMO      128
#define XB_XCNT(j)  (256  + 64 * (j))
#define XB_XSUB(j)  (1280 + 64 * (j))
#define XB_XGEN(j)  (2304 + 64 * (j))
#define XB_TOP      3328
#define XB_TOPGEN   3392
#define XCD_BAR_WORDS 3456
#define XB_SPIN_CAP (1u << 22)

__device__ __forceinline__ unsigned xb_ld(unsigned* p)              { return __hip_atomic_load(p, __ATOMIC_RELAXED, __HIP_MEMORY_SCOPE_AGENT); }
__device__ __forceinline__ unsigned xb_add(unsigned* p, unsigned v) { return __hip_atomic_fetch_add(p, v, __ATOMIC_RELAXED, __HIP_MEMORY_SCOPE_AGENT); }
__device__ __forceinline__ unsigned xb_xcc_id() { return (unsigned)__builtin_amdgcn_s_getreg((3 << 11) | 20) & 0xFu; }
#define XB_SPIN(cond, bar) do { unsigned _sp = 0; while (cond) { __builtin_amdgcn_s_sleep(1); \
    if ((++_sp & 255u) == 0u) { if (xb_ld(&(bar)[XB_TMO])) break; if (_sp > XB_SPIN_CAP) { atomicAdd(&(bar)[XB_TMO], 1u); break; } } } } while (0)

struct XcdBarrier { unsigned* bar; unsigned x; volatile LAS unsigned* st; };

__device__ __forceinline__ XcdBarrier xcd_barrier_post(unsigned* bar, volatile LAS unsigned* st) {
    XcdBarrier b; b.bar = bar; b.x = xb_xcc_id(); b.st = st;
    if (threadIdx.x == 0) (void)xb_add(&bar[XB_XCNT(b.x)], 1u);
    return b;
}
__device__ __forceinline__ void xcd_barrier_complete(unsigned* bar, unsigned x, unsigned& nloc, unsigned& nx) {
    const unsigned G = gridDim.x * gridDim.y * gridDim.z;
    unsigned sum, cnt, mine, sp = 0u;
    for (;;) {
        sum = 0u; cnt = 0u; mine = 0u;
#pragma unroll
        for (unsigned j = 0; j < 16; ++j) { const unsigned c = xb_ld(&bar[XB_XCNT(j)]); sum += c; cnt += (c > 0u) ? 1u : 0u; mine = (j == x) ? c : mine; }
        if (sum == G) break;
        __builtin_amdgcn_s_sleep(1);
        if ((++sp & 255u) == 0u) { if (xb_ld(&bar[XB_TMO])) break; if (sp > XB_SPIN_CAP) { atomicAdd(&bar[XB_TMO], 1u); break; } }
    }
    nloc = mine > 0u ? mine : 1u; nx = cnt > 0u ? cnt : 1u;
}
__device__ __forceinline__ void xcd_barrier(const XcdBarrier& b) {
    asm volatile("s_waitcnt vmcnt(0)" ::: "memory");
    __syncthreads();
    if (threadIdx.x == 0) {
        unsigned* bar = b.bar; unsigned bx_ = b.x; asm volatile("" : "+s"(bar), "+s"(bx_));
        __builtin_amdgcn_s_waitcnt(0);
        unsigned nloc = b.st[0], nx = b.st[1];
        if (nloc == 0u) { xcd_barrier_complete(bar, bx_, nloc, nx); b.st[0] = nloc; b.st[1] = nx; }
        const unsigned old = xb_add(&bar[XB_XSUB(bx_)], 1u);
        const unsigned gen = old / nloc;
        if (old + 1u == (gen + 1u) * nloc) {
            __builtin_amdgcn_fence(__ATOMIC_RELEASE, "agent");
            asm volatile("s_waitcnt vmcnt(0)" ::: "memory");
            const unsigned og = xb_add(&bar[XB_TOP], 1u);
            const unsigned tg = og / nx;
            if (og + 1u == (tg + 1u) * nx) xb_add(&bar[XB_TOPGEN], 1u);
            else XB_SPIN(xb_ld(&bar[XB_TOPGEN]) == tg, bar);
            __builtin_amdgcn_fence(__ATOMIC_ACQUIRE, "agent");
            xb_add(&bar[XB_XGEN(bx_)], 1u);
            asm volatile("s_waitcnt vmcnt(0)" ::: "memory");
        } else {
            XB_SPIN(xb_ld(&bar[XB_XGEN(bx_)]) == gen, bar);
            __builtin_amdgcn_fence(__ATOMIC_ACQUIRE, "agent");
            asm volatile("s_waitcnt vmcnt(0)" ::: "memory");
        }
    }
    __syncthreads();
}

namespace att {
constexpr int NW = 8, QBLK = 32, KVBLK = 64;
constexpr float THR2 = 8.f * LOG2E;
enum { K_MEM = 0, K_FOX = 1, K_MLA = 2, K_DIL = 3, K_DSA = 4 };
constexpr int L_V = 0, L_K = 49152, L_XB = 100352, L_TBL = 106496, L_END = 141312, VB = 16384;

struct AP {
    const bf16_t* Q; const bf16_t* K; const bf16_t* V; bf16_t* O;
    long qs, ks, vs, os;
    int kt0, nt;
    int q0;
    float C;
    const float* cum; long cums;
    const u64* msk;
    float* ost; long osts;
    float* mst; long msts;
    int carry_in, carry_out;
    const float* t5; int head, dil;
};

#define ATT_SBAR() __builtin_amdgcn_sched_barrier(0)
__device__ __forceinline__ int crow(int r, int hi) { return (r & 3) + 8 * (r >> 2) + 4 * hi; }
__device__ __forceinline__ int t5_bucket(int dist) {
    const int n = dist < 0 ? 0 : dist; if (n < 16) return n;
    const float v = __log2f((float)n * 0.0625f) * (16.0f / 7.0f); int b = 16 + (int)v; return b > 31 ? 31 : b;
}
__device__ __forceinline__ void rowmax_decide(const f32x16& p0, const f32x16& p1, float& m_reg, float& alpha) {
    float pmax = p0[0];
#pragma unroll
    for (int r = 1; r < 16; ++r) pmax = fmaxf(pmax, p0[r]);
#pragma unroll
    for (int r = 0; r < 16; ++r) pmax = fmaxf(pmax, p1[r]);
    { auto rr = __builtin_amdgcn_permlane32_swap(__float_as_uint(pmax), __float_as_uint(pmax), false, false); pmax = fmaxf(__uint_as_float(rr[0]), __uint_as_float(rr[1])); }
    if (__builtin_expect(__all(pmax - m_reg <= THR2), 1)) { alpha = 1.f; }
    else { const float mn = fmaxf(m_reg, pmax); alpha = __builtin_amdgcn_exp2f(m_reg - mn); m_reg = mn; }
}
__device__ __forceinline__ float half_sum(float ps) {
    auto rr = __builtin_amdgcn_permlane32_swap(__float_as_uint(ps), __float_as_uint(ps), false, false); return __uint_as_float(rr[0]) + __uint_as_float(rr[1]);
}
__device__ __forceinline__ void pack_p(const f32x16& p0, const f32x16& p1, bf16x8& pa0, bf16x8& pa1, bf16x8& pa2, bf16x8& pa3) {
#define ATT_PK4(P, BASE, OUT) do { unsigned a0 = cvt_pk_bf16(P[BASE + 0], P[BASE + 1]), a1 = cvt_pk_bf16(P[BASE + 2], P[BASE + 3]);   \
    unsigned b0 = cvt_pk_bf16(P[BASE + 4], P[BASE + 5]), b1 = cvt_pk_bf16(P[BASE + 6], P[BASE + 7]);                              \
    auto r0 = __builtin_amdgcn_permlane32_swap(a0, b0, false, false); auto r1 = __builtin_amdgcn_permlane32_swap(a1, b1, false, false); \
    u32x4 w = {r0[0], r1[0], r0[1], r1[1]}; OUT = __builtin_bit_cast(bf16x8, w); } while (0)
    ATT_PK4(p0, 0, pa0); ATT_PK4(p0, 8, pa1); ATT_PK4(p1, 0, pa2); ATT_PK4(p1, 8, pa3);
#undef ATT_PK4
}
template <int DK, int NQL>
__device__ __forceinline__ void qkt(f32x16& p0, f32x16& p1, const LAS unsigned char* Ks, const int (&kad)[4], const bf16x8* qr, const LAS unsigned char* qsp) {
    p0 = f32x16{}; p1 = f32x16{};
    constexpr int ND = DK / 16, NQR = ND - NQL;
#define ATT_LDK(d, hf) (*(const LAS bf16x8*)(Ks + ((DK == 128) ? (kad[(d) & 3] ^ (((d) >> 2) ? 128 : 0)) : (kad[(d) & 3] + 128 * ((d) >> 2))) + (hf) * 32 * DK * 2))
#define ATT_LDQ(d) (((d) < NQR) ? qr[(d) < NQR ? (d) : 0] : *(const LAS bf16x8*)(qsp + ((d) - NQR) * 1024))
    bf16x8 b0 = ATT_LDK(0, 0), b1 = ATT_LDK(0, 1), qf = ATT_LDQ(0);
#pragma unroll
    for (int d0 = 0; d0 < ND; ++d0) {
        bf16x8 c0 = b0, c1 = b1, qn = qf;
        if (d0 + 1 < ND) { c0 = ATT_LDK(d0 + 1, 0); c1 = ATT_LDK(d0 + 1, 1); qn = ATT_LDQ(d0 + 1); }
        ATT_SBAR();
        p0 = __builtin_amdgcn_mfma_f32_32x32x16_bf16(b0, qf, p0, 0, 0, 0);
        p1 = __builtin_amdgcn_mfma_f32_32x32x16_bf16(b1, qf, p1, 0, 0, 0);
        ATT_SBAR();
        b0 = c0; b1 = c1; qf = qn; }
#undef ATT_LDK
#undef ATT_LDQ
}
__device__ __forceinline__ int v_st(int k, int c) { const int kk = (k & ~0xC) | ((k & 4) << 1) | ((k & 8) >> 1); return ((kk >> 3) * 4 + (c >> 5)) * 512 + ((kk & 7) * 32 + (c & 31)) * 2; }
__device__ __forceinline__ int v_rd_base(int lane) { return ((lane & 3) << 3) | (((lane >> 2) & 3) << 6) | (((lane >> 4) & 1) << 5) | (((lane >> 5) & 1) << 8); }
constexpr int v_rd_off(int d0, int ks, int half) { return d0 * 512 + ks * 4096 + half * 2048; }
template <int OFF> __device__ __forceinline__ s16x4 tr_read(int vb) { s16x4 r; asm volatile("ds_read_b64_tr_b16 %0, %1 offset:%2" : "=&v"(r) : "v"(vb), "i"(OFF) : "memory"); return r; }
struct VF { s16x4 l0, h0, l1, h1, l2, h2, l3, h3; };
template <int D0> __device__ __forceinline__ void pv_read(VF& f, int vb) {
    f.l0 = tr_read<v_rd_off(D0, 0, 0)>(vb); f.h0 = tr_read<v_rd_off(D0, 0, 1)>(vb); f.l1 = tr_read<v_rd_off(D0, 1, 0)>(vb); f.h1 = tr_read<v_rd_off(D0, 1, 1)>(vb);
    f.l2 = tr_read<v_rd_off(D0, 2, 0)>(vb); f.h2 = tr_read<v_rd_off(D0, 2, 1)>(vb); f.l3 = tr_read<v_rd_off(D0, 3, 0)>(vb); f.h3 = tr_read<v_rd_off(D0, 3, 1)>(vb);
}
#define ATT_VWAIT(n, f) asm volatile("s_waitcnt lgkmcnt(" #n ")" : "+v"(f.l0), "+v"(f.h0), "+v"(f.l1), "+v"(f.h1), "+v"(f.l2), "+v"(f.h2), "+v"(f.l3), "+v"(f.h3) :: "memory")
#define ATT_PK(L, H) (bf16x8){L[0], L[1], L[2], L[3], H[0], H[1], H[2], H[3]}
__device__ __forceinline__ void pv_only(f32x16* o, int vb, bf16x8 pa0, bf16x8 pa1, bf16x8 pa2, bf16x8 pa3) {
    VF fa, fb;
#define ATT_MMA4(od, f) do { od = __builtin_amdgcn_mfma_f32_32x32x16_bf16(pa0, ATT_PK(f.l0, f.h0), od, 0, 0, 0); od = __builtin_amdgcn_mfma_f32_32x32x16_bf16(pa1, ATT_PK(f.l1, f.h1), od, 0, 0, 0); \
        od = __builtin_amdgcn_mfma_f32_32x32x16_bf16(pa2, ATT_PK(f.l2, f.h2), od, 0, 0, 0); od = __builtin_amdgcn_mfma_f32_32x32x16_bf16(pa3, ATT_PK(f.l3, f.h3), od, 0, 0, 0); } while (0)
    pv_read<0>(fa, vb); pv_read<1>(fb, vb);
    ATT_VWAIT(8, fa); ATT_SBAR(); ATT_MMA4(o[0], fa); ATT_SBAR(); pv_read<2>(fa, vb);
    ATT_VWAIT(8, fb); ATT_SBAR(); ATT_MMA4(o[1], fb); ATT_SBAR(); pv_read<3>(fb, vb);
    ATT_VWAIT(8, fa); ATT_SBAR(); ATT_MMA4(o[2], fa); ATT_SBAR();
    ATT_VWAIT(0, fb); ATT_SBAR(); ATT_MMA4(o[3], fb);
#undef ATT_MMA4
}
__device__ __forceinline__ float sm_only(f32x16& p0, f32x16& p1, float m) {
    float s = 0.f;
#pragma unroll
    for (int r = 0; r < 16; ++r) { p0[r] = __builtin_amdgcn_exp2f(p0[r] - m); s += p0[r]; }
#pragma unroll
    for (int r = 0; r < 16; ++r) { p1[r] = __builtin_amdgcn_exp2f(p1[r] - m); s += p1[r]; }
    return s;
}
__device__ __forceinline__ float pv_sm(f32x16* o, int vb, bf16x8 pa0, bf16x8 pa1, bf16x8 pa2, bf16x8 pa3, f32x16& p0, f32x16& p1, float m) {
    VF fa, fb; float s = 0.f;
#define ATT_GAP(od, pa, L, H, X, B) do { od = __builtin_amdgcn_mfma_f32_32x32x16_bf16(pa, ATT_PK(L, H), od, 0, 0, 0); \
        { float t0_ = X[B] - m, t1_ = X[B + 1] - m, e0_, e1_; asm volatile("v_exp_f32 %0, %1" : "=v"(e0_) : "v"(t0_)); asm volatile("v_exp_f32 %0, %1" : "=v"(e1_) : "v"(t1_));     \
          X[B] = e0_; X[B + 1] = e1_; s += e0_; s += e1_; } ATT_SBAR(); } while (0)
    pv_read<0>(fa, vb); pv_read<1>(fb, vb);
    ATT_VWAIT(8, fa); ATT_SBAR();
    ATT_GAP(o[0], pa0, fa.l0, fa.h0, p0, 0); ATT_GAP(o[0], pa1, fa.l1, fa.h1, p0, 2); ATT_GAP(o[0], pa2, fa.l2, fa.h2, p0, 4); ATT_GAP(o[0], pa3, fa.l3, fa.h3, p0, 6);
    pv_read<2>(fa, vb); ATT_VWAIT(8, fb); ATT_SBAR();
    ATT_GAP(o[1], pa0, fb.l0, fb.h0, p0, 8); ATT_GAP(o[1], pa1, fb.l1, fb.h1, p0, 10); ATT_GAP(o[1], pa2, fb.l2, fb.h2, p0, 12); ATT_GAP(o[1], pa3, fb.l3, fb.h3, p0, 14);
    pv_read<3>(fb, vb); ATT_VWAIT(8, fa); ATT_SBAR();
    ATT_GAP(o[2], pa0, fa.l0, fa.h0, p1, 0); ATT_GAP(o[2], pa1, fa.l1, fa.h1, p1, 2); ATT_GAP(o[2], pa2, fa.l2, fa.h2, p1, 4); ATT_GAP(o[2], pa3, fa.l3, fa.h3, p1, 6);
    ATT_VWAIT(0, fb); ATT_SBAR();
    ATT_GAP(o[3], pa0, fb.l0, fb.h0, p1, 8); ATT_GAP(o[3], pa1, fb.l1, fb.h1, p1, 10); ATT_GAP(o[3], pa2, fb.l2, fb.h2, p1, 12); ATT_GAP(o[3], pa3, fb.l3, fb.h3, p1, 14);
#undef ATT_GAP
    return s;
}

template <int KIND>
__device__ __forceinline__ void score(f32x16& p0, f32x16& p1, const AP& a, int t, int buf, LAS unsigned char* lds, int wid, int r32, int hi, float cq) {
    const float C = a.C; const int k0 = t * 64; const int q = a.q0 + wid * 32 + r32; const float NEG = -INFINITY;
    if constexpr (KIND == K_FOX) {
        const LAS f32x4* cb = (const LAS f32x4*)(lds + L_XB + buf * 2048) + hi;
#pragma unroll
        for (int g = 0; g < 4; ++g) { const f32x4 c4 = cb[2 * g], c4b = cb[2 * g + 8];
#pragma unroll
            for (int j = 0; j < 4; ++j) { p0[4 * g + j] = fmaf(p0[4 * g + j], C, cq - c4[j]); p1[4 * g + j] = fmaf(p1[4 * g + j], C, cq - c4b[j]); } }
    } else if constexpr (KIND == K_DSA || KIND == K_DIL) {
        const LAS float* tb = (const LAS float*)(lds + L_TBL) + (q - k0 - 4 * hi + 256 - 59);
#pragma unroll
        for (int r = 0; r < 16; ++r) { const int cc = (r & 3) + 8 * (r >> 2); p0[r] = fmaf(p0[r], C, tb[59 - cc]); p1[r] = fmaf(p1[r], C, tb[59 - cc - 32]); }
        if constexpr (KIND == K_DSA) {
            const LAS unsigned* mb = (const LAS unsigned*)(lds + L_XB + buf * 2048) + wid * 64;
            const unsigned wl = mb[r32] >> (4 * hi), wh = mb[32 + r32] >> (4 * hi);
#pragma unroll
            for (int r = 0; r < 16; ++r) { const int cc = (r & 3) + 8 * (r >> 2); p0[r] = ((wl >> cc) & 1u) ? p0[r] : NEG; p1[r] = ((wh >> cc) & 1u) ? p1[r] : NEG; }
        }
    } else {
#pragma unroll
        for (int r = 0; r < 16; ++r) { p0[r] *= C; p1[r] *= C; }
    }
    if constexpr (KIND == K_FOX || KIND == K_MLA) {
        if (k0 + 63 > a.q0) {
            const int kb = k0 + 4 * hi;
#pragma unroll
            for (int r = 0; r < 16; ++r) { const int kv = kb + (r & 3) + 8 * (r >> 2); if (kv > q) p0[r] = NEG; if (kv + 32 > q) p1[r] = NEG; }
        }
    }
}

template <int KIND, int DK>
__device__ __forceinline__ void attn_unit(LAS unsigned char* lds, const AP& a, const int wave_id) {
    const int tid = tid_opaque(wave_id);
    const int lane = tid & 63, r32 = lane & 31, hi = lane >> 5; const int wid = __builtin_amdgcn_readfirstlane(tid >> 6);
    constexpr bool HAS_TBL = (KIND == K_DSA || KIND == K_DIL), HAS_X = (KIND == K_FOX || KIND == K_DSA);
    constexpr int KB = KVBLK * DK * 2, NKC = DK / 8, NKL = (64 * NKC) / 512, ND0 = DK / 16;
    constexpr int NQL = (DK == 192) ? 2 : (HAS_TBL ? 2 : 4), NQR = ND0 - NQL, NLD = NKL + 2 + (HAS_X ? 1 : 0);
    constexpr int LWS = (DK == 192) ? 122880 : 98304, LQSP = (DK == 192) ? 124928 : (HAS_TBL ? 123904 : 106496);
    LAS unsigned char* V_lds = lds + L_V; LAS unsigned char* K_lds = lds + L_K;
    LAS float* wsf = (LAS float*)(lds + LWS) + wid * 64; LAS float* li_l = wsf; LAS float* al_l = wsf + 32;
    LAS unsigned char* qsp = lds + LQSP + wid * (NQL * 1024) + lane * 16;
    float m_reg = -1e30f, l_reg = 0.f; f32x16 o[4] = {}; bf16x8 qr[NQR];
    const int qi = wid * 32 + r32;
    const bf16_t* Qw = a.Q + (long)qi * a.qs + hi * 8;
#pragma unroll
    for (int d0 = 0; d0 < ND0; ++d0) { const bf16x8 qv = *(const bf16x8*)(Qw + d0 * 16); if (d0 < NQR) qr[d0 < NQR ? d0 : 0] = qv; else *(LAS bf16x8*)(qsp + (d0 - NQR) * 1024) = qv; }
    float cq = 0.f;
    if constexpr (KIND == K_FOX) cq = a.cum[(long)(a.q0 + qi) * a.cums];
    if constexpr (KIND == K_DIL) {
        if (a.carry_in) {
            m_reg = a.mst[(long)qi * a.msts]; l_reg = a.mst[(long)qi * a.msts + 1];
#pragma unroll
            for (int r = 0; r < 16; ++r) { const float* orow = a.ost + (long)(wid * 32 + crow(r, hi)) * a.osts + r32;
#pragma unroll
                for (int d0 = 0; d0 < 4; ++d0) o[d0][r] = __builtin_nontemporal_load(orow + d0 * 32); }
        }
    }
    if constexpr (KIND == K_DSA) {
        LAS float* tbl = (LAS float*)(lds + L_TBL);
        for (int i = tid; i < 4352; i += 512) { const int dist = i - 256; tbl[i] = dist < 0 ? -INFINITY : a.t5[t5_bucket(dist) * 16 + a.head] * LOG2E; }
    }
    if constexpr (KIND == K_DIL) {
        LAS float* tbl = (LAS float*)(lds + L_TBL);
        for (int i = tid; i < 640; i += 512) { const int rel = i - 256; tbl[i] = (rel < 0 || rel > 128) ? -INFINITY : a.t5[t5_bucket(rel * a.dil) * 16 + a.head] * LOG2E; }
    }
    int ksrc[NKL], vsrc[2];
#pragma unroll
    for (int c = 0; c < NKL; ++c) { const int Lb = (wid * NKL + c) * 1024 + lane * 16, row = Lb / (DK * 2), chp = (Lb % (DK * 2)) / 16; ksrc[c] = row * (int)a.ks + ((DK == 128) ? (chp ^ (row & 15)) : ((chp & ~7) | ((chp & 7) ^ (row & 7)))) * 8; }
#pragma unroll
    for (int c = 0; c < 2; ++c) { const int sl = (2 * wid + c) * 64 + lane, st = sl >> 5, wi = sl & 31, kk = ((st >> 2) << 3) | (wi >> 2), k = (kk & ~0xC) | ((kk & 4) << 1) | ((kk & 8) >> 1); vsrc[c] = k * (int)a.vs + (st & 3) * 32 + (wi & 3) * 8; }
    const int vb0 = (int)(unsigned)(uintptr_t)V_lds + v_rd_base(lane);
    int kad[4];
#pragma unroll
    for (int j = 0; j < 4; ++j) kad[j] = r32 * (DK * 2) + (((hi | (j << 1)) ^ (r32 & 7)) << 4) + ((DK == 128) ? 128 * ((r32 >> 3) & 1) : 0);
#define ATT_DMA(t, sl) do { const long kb_ = (long)(t) * 64; \
        _Pragma("unroll") for (int c_ = 0; c_ < NKL; ++c_) __builtin_amdgcn_global_load_lds((const unsigned*)(a.K + kb_ * a.ks + ksrc[c_]), (LAS unsigned*)(K_lds + (sl) * KB + (wid * NKL + c_) * 1024), 16, 0, 0); \
        _Pragma("unroll") for (int c_ = 0; c_ < 2; ++c_) __builtin_amdgcn_global_load_lds((const unsigned*)(a.V + kb_ * a.vs + vsrc[c_]), (LAS unsigned*)(V_lds + (sl) * VB + (2 * wid + c_) * 1024), 16, 0, 0); \
        if constexpr (KIND == K_FOX) __builtin_amdgcn_global_load_lds((const unsigned*)(a.cum + (kb_ + lane) * a.cums), (LAS unsigned*)(lds + L_XB + (sl) * 2048), 4, 0, 0);     \
        if constexpr (KIND == K_DSA) __builtin_amdgcn_global_load_lds((const unsigned*)(a.msk + (long)(wid * 32 + r32) * 64 + (t)) + hi, (LAS unsigned*)(lds + L_XB + (sl) * 2048 + wid * 256), 4, 0, 0); } while (0)
#define ATT_RESC(al) do { if (__any((al) < 1.f)) { if (hi == 0) al_l[r32] = (al); asm volatile("s_waitcnt lgkmcnt(0)" ::: "memory"); \
        _Pragma("unroll") for (int d = 0; d < 4; ++d) _Pragma("unroll") for (int r = 0; r < 16; ++r) o[d][r] *= al_l[crow(r, hi)]; } } while (0)
#define ATT_BAR() do { asm volatile("s_waitcnt lgkmcnt(0)" ::: "memory"); __builtin_amdgcn_s_barrier(); asm volatile("" ::: "memory"); } while (0)
    f32x16 p0, p1; float al = 1.f; bf16x8 pa0, pa1, pa2, pa3; const int NT = a.nt, T0 = a.kt0;
    asm volatile("s_waitcnt vmcnt(0) lgkmcnt(0)" ::: "memory");
    ATT_DMA(T0, 0);
    if (NT > 1) { ATT_DMA(T0 + 1, 1); asm volatile("s_waitcnt vmcnt(%0)" :: "n"(NLD) : "memory"); } else { asm volatile("s_waitcnt vmcnt(0)" ::: "memory"); }
    ATT_BAR();
    int sl = 0, sl2 = 2;
    for (int jj = 0; jj < NT; ++jj) {
        const int t = T0 + jj;
        if (jj + 2 < NT) ATT_DMA(t + 2, sl2);
        bool lv = true; { const int k0_ = t * 64, qw_ = a.q0 + wid * 32;
            if constexpr (KIND == K_FOX || KIND == K_MLA || KIND == K_DSA) lv = k0_ <= qw_ + 31;
            if constexpr (KIND == K_DIL) lv = (k0_ <= qw_ + 31) && (k0_ + 63 >= qw_ - 128); }
        if (lv) {
            ATT_SBAR(); qkt<DK, NQL>(p0, p1, K_lds + sl * KB, kad, qr, qsp);
            score<KIND>(p0, p1, a, t, sl, lds, wid, r32, hi, cq);
            rowmax_decide(p0, p1, m_reg, al);
            const float ps = sm_only(p0, p1, m_reg);
            l_reg = l_reg * al + half_sum(ps);
            ATT_RESC(al);
            pack_p(p0, p1, pa0, pa1, pa2, pa3); ATT_SBAR();
            pv_only(o, vb0 + sl * VB, pa0, pa1, pa2, pa3);
        }
        if (jj + 2 < NT) asm volatile("s_waitcnt vmcnt(%0)" :: "n"(NLD) : "memory"); else asm volatile("s_waitcnt vmcnt(0)" ::: "memory");
        ATT_BAR();
        sl = (sl == 2) ? 0 : sl + 1; sl2 = (sl2 == 2) ? 0 : sl2 + 1;
    }
    bool stateout = false;
    if constexpr (KIND == K_DIL) stateout = a.carry_out != 0;
    if (stateout) {
        int qi2 = qi; asm volatile("" : "+v"(qi2));
        if (hi == 0) { a.mst[(long)qi2 * a.msts] = m_reg; a.mst[(long)qi2 * a.msts + 1] = l_reg; }
#pragma unroll
        for (int r = 0; r < 16; ++r) { float* orow = a.ost + (long)(wid * 32 + crow(r, hi)) * a.osts + r32;
#pragma unroll
            for (int d0 = 0; d0 < 4; ++d0) __builtin_nontemporal_store(o[d0][r], orow + d0 * 32); }
        __syncthreads();
    } else {
        if (hi == 0) li_l[r32] = l_reg;
        asm volatile("s_waitcnt lgkmcnt(0)" ::: "memory");
        float rli[16];
#pragma unroll
        for (int r = 0; r < 16; ++r) rli[r] = __builtin_amdgcn_rcpf(li_l[crow(r, hi)]);
        __syncthreads();
        LAS unsigned short* ost = (LAS unsigned short*)(lds + wid * 8192);
#pragma unroll
        for (int r = 0; r < 16; ++r) { const int orow = crow(r, hi);
#pragma unroll
            for (int d0 = 0; d0 < 4; ++d0) { const unsigned w = cvt_pk_bf16(o[d0][r] * rli[r], 0.f); ost[orow * 128 + d0 * 32 + r32] = (unsigned short)w; } }
        asm volatile("s_waitcnt lgkmcnt(0)" ::: "memory");
#pragma unroll
        for (int i = 0; i < 8; ++i) { const int ch = lane + 64 * i, row = ch >> 4, c16 = ch & 15;
            const u32x4 v = *(const LAS u32x4*)(lds + wid * 8192 + row * 256 + c16 * 16);
            *(u32x4*)(a.O + (long)(wid * 32 + row) * a.os + c16 * 8) = v; }
        __syncthreads();
    }
#undef ATT_DMA
#undef ATT_RESC
#undef ATT_BAR
}
#undef ATT_VWAIT
#undef ATT_PK
}

struct Fr { LAS unsigned char* lds; int tid, lane, wave, vcu, G, gw, ngw; };

__device__ __forceinline__ float wave_sum(float v) {
#pragma unroll
    for (int o = 1; o < 64; o <<= 1) v += __shfl_xor(v, o);
    return v;
}
__device__ __forceinline__ void unpack8(const u32x4 w, float (&v)[8]) {
    v[0] = bf_lo(w.x); v[1] = bf_hi(w.x); v[2] = bf_lo(w.y); v[3] = bf_hi(w.y); v[4] = bf_lo(w.z); v[5] = bf_hi(w.z); v[6] = bf_lo(w.w); v[7] = bf_hi(w.w);
}
__device__ __forceinline__ u32x4 pack8(const float (&v)[8]) {
    u32x4 w; w.x = cvt_pk_bf16(v[0], v[1]); w.y = cvt_pk_bf16(v[2], v[3]); w.z = cvt_pk_bf16(v[4], v[5]); w.w = cvt_pk_bf16(v[6], v[7]); return w;
}
__device__ __forceinline__ float sumsq8(const float (&v)[8]) { return ((v[0] * v[0] + v[1] * v[1]) + (v[2] * v[2] + v[3] * v[3])) + ((v[4] * v[4] + v[5] * v[5]) + (v[6] * v[6] + v[7] * v[7])); }

__device__ __forceinline__ int map_col(int kind, int n) {
    switch (kind) {
        case 1: return 256 * (n >> 7) + (n & 127);
        case 2: return 256 * (n >> 7) + 128 + (n & 127);
        case 3: return n < 6144 ? n : (n < 6160 ? 6656 + (n - 6144) : 6144 + (n - 6160));
        case 4: return n < 1088 ? n : 1280 + (n - 1088);
        case 5: return n < 6144 ? n : (n < 18432 ? n + 512 : 6144 + (n - 18432));
        case 6: return n < 4176 ? n : 4352 + (n - 4176);
        default: return n;
    }
}
struct TrDesc { const float* W; const float* gain; bf16_t* WT; int K, N, ldt, kind, r, f8; };
__device__ __forceinline__ void tr_load(const TrDesc& d, int lane, f32x4 (&v)[16]) {
    const int nblk = (d.N + 63) / 64, kb = d.r / nblk, nb = d.r % nblk, k0 = 64 * kb, n = 64 * nb + 4 * (lane & 15); const bool ok = n < d.N;
    const float* src = d.W + (size_t)(k0 + (lane >> 4)) * d.N + (ok ? n : 0); const size_t rs = (size_t)4 * d.N;
#pragma unroll
    for (int j = 0; j < 16; ++j) v[j] = __builtin_nontemporal_load((const f32x4*)(src + (size_t)j * rs));
}
__device__ __forceinline__ void tr_store(const TrDesc& d, int lane, const f32x4 (&v)[16], LAS float* scr) {
    const int nblk = (d.N + 63) / 64, kb = d.r / nblk, nb = d.r % nblk, k0 = 64 * kb, n0 = 64 * nb;
    { LAS float* w = scr + (lane >> 4) * 65 + 4 * (lane & 15);
#pragma unroll
      for (int j = 0; j < 16; ++j) { w[j * 260 + 0] = v[j][0]; w[j * 260 + 1] = v[j][1]; w[j * 260 + 2] = v[j][2]; w[j * 260 + 3] = v[j][3]; } }
    const int c = lane & 7, nn = lane >> 3; float g[8];
#pragma unroll
    for (int jj = 0; jj < 8; ++jj) g[jj] = d.gain ? d.gain[k0 + 8 * c + jj] : 1.f;
    asm volatile("s_waitcnt lgkmcnt(0)" ::: "memory");
#pragma unroll
    for (int it = 0; it < 8; ++it) { const int nl = nn + 8 * it; const LAS float* rp = scr + (8 * c) * 65 + nl;
        u32x4 o; o.x = cvt_pk_bf16(rp[0 * 65] * g[0], rp[1 * 65] * g[1]); o.y = cvt_pk_bf16(rp[2 * 65] * g[2], rp[3 * 65] * g[3]); o.z = cvt_pk_bf16(rp[4 * 65] * g[4], rp[5 * 65] * g[5]); o.w = cvt_pk_bf16(rp[6 * 65] * g[6], rp[7 * 65] * g[7]);
        if (n0 + nl < d.N) {
            if (d.f8) { int q0 = __builtin_amdgcn_cvt_pk_fp8_f32(rp[0 * 65] * g[0] * 64.f, rp[1 * 65] * g[1] * 64.f, 0, false); q0 = __builtin_amdgcn_cvt_pk_fp8_f32(rp[2 * 65] * g[2] * 64.f, rp[3 * 65] * g[3] * 64.f, q0, true);
                        int q1 = __builtin_amdgcn_cvt_pk_fp8_f32(rp[4 * 65] * g[4] * 64.f, rp[5 * 65] * g[5] * 64.f, 0, false); q1 = __builtin_amdgcn_cvt_pk_fp8_f32(rp[6 * 65] * g[6] * 64.f, rp[7 * 65] * g[7] * 64.f, q1, true);
                        *(u32x2*)((unsigned char*)d.WT + (size_t)map_col(d.kind, n0 + nl) * d.ldt + k0 + 8 * c) = (u32x2){(unsigned)q0, (unsigned)q1}; }
            else *(u32x4*)(d.WT + (size_t)map_col(d.kind, n0 + nl) * d.ldt + k0 + 8 * c) = o; } }
    asm volatile("s_waitcnt lgkmcnt(0)" ::: "memory");
}

__device__ __forceinline__ void rows2048(const Fr& F, const float* x, int nrows, bf16_t* xb, void* out, int mode) {
    for (int m = F.gw; m < nrows; m += F.ngw) {
        const f32x4* xr = (const f32x4*)(x + (size_t)m * DM) + F.lane; f32x4 v[8]; float s = 0.f;
#pragma unroll
        for (int j = 0; j < 8; ++j) { v[j] = xr[64 * j]; s += (v[j].x * v[j].x + v[j].y * v[j].y) + (v[j].z * v[j].z + v[j].w * v[j].w); }
        s = wave_sum(s);
        if (F.lane == 0) { if (mode) ((float*)out)[m] = __builtin_amdgcn_rsqf(s * (1.0f / DM) + RMS_EPS); else ((u64*)out)[m] = (u64)(s * pg8::SSQ_SCALE); }
        if (xb) { u32x2* o8 = (u32x2*)(xb + (size_t)m * DM) + F.lane;
#pragma unroll
            for (int j = 0; j < 8; ++j) { u32x2 w; w.x = cvt_pk_bf16(v[j].x, v[j].y); w.y = cvt_pk_bf16(v[j].z, v[j].w); o8[64 * j] = w; } }
    }
}

__device__ __forceinline__ void hn_step(bf16_t* p, const float (&g)[8]) {
    float v[8]; unpack8(*(const u32x4*)p, v); float ss = sumsq8(v);
    ss += __shfl_xor(ss, 1); ss += __shfl_xor(ss, 2); ss += __shfl_xor(ss, 4); ss += __shfl_xor(ss, 8);
    const float rs = __builtin_amdgcn_rsqf(ss * (1.0f / 128.0f) + RMS_EPS);
#pragma unroll
    for (int j = 0; j < 8; ++j) v[j] = v[j] * rs * g[j];
    *(u32x4*)p = pack8(v);
}
__device__ __forceinline__ void load_gain8(const float* g, int lane, float (&o)[8]) {
#pragma unroll
    for (int j = 0; j < 8; ++j) o[j] = g ? g[(lane & 15) * 8 + j] : 1.f;
}
__device__ __forceinline__ void prep_rows(const Fr& F, bf16_t* P, long ld, int nrows, int c0, int n0, const float* g0, int c1, int n1, const float* g1, int c2, int n2, const float* g2) {
    float ga[8], gb[8], gc[8]; load_gain8(g0, F.lane, ga); load_gain8(g1, F.lane, gb); load_gain8(g2, F.lane, gc);
    for (int m = F.gw; m < nrows; m += F.ngw) {
        bf16_t* row = P + (size_t)m * ld + F.lane * 8;
        for (int s = 0; s < n0; ++s) hn_step(row + c0 + s * 512, ga);
        for (int s = 0; s < n1; ++s) hn_step(row + c1 + s * 512, gb);
        for (int s = 0; s < n2; ++s) hn_step(row + c2 + s * 512, gc);
    }
}

__device__ __forceinline__ void fox_cumsum(const Fr& F, const float* FG, const float* b_f, float* CUM) {
    for (int task = F.gw; task < NB * NH; task += F.ngw) {
        const int b = task >> 4, h = task & 15; const float bias = b_f[h];
        const float* src = FG + ((size_t)b * SEQ + (size_t)F.lane * 64) * 16 + h; float v[64]; float run = 0.f;
#pragma unroll
        for (int i = 0; i < 64; ++i) { const float xg = src[(size_t)i * 16] + bias;
            const float e = __expf(-fabsf(xg)); const float ls = fminf(xg, 0.f) - __logf(1.0f + e);
            run += ls; v[i] = run; }
        float incl = run;
#pragma unroll
        for (int o = 1; o < 64; o <<= 1) { const float t = __shfl_up(incl, o); if (F.lane >= o) incl += t; }
        const float excl = incl - run;
        float* dst = CUM + ((size_t)b * SEQ + (size_t)F.lane * 64) * 16 + h;
#pragma unroll
        for (int i = 0; i < 64; ++i) dst[(size_t)i * 16] = (v[i] + excl) * LOG2E;
    }
}

__device__ const double ROPE_INV[32] = {
    1.0, 0.7498942093324559, 0.5623413251903491, 0.4216965034285822, 0.31622776601683794, 0.23713737056616552, 0.1778279410038923, 0.1333521432163324,
    0.1, 0.07498942093324558, 0.05623413251903491, 0.04216965034285822, 0.03162277660168379, 0.023713737056616554, 0.01778279410038923, 0.01333521432163324,
    0.01, 0.007498942093324558, 0.005623413251903491, 0.004216965034285823, 0.0031622776601683794, 0.0023713737056616554, 0.001778279410038923, 0.001333521432163324,
    0.001, 0.0007498942093324559, 0.0005623413251903491, 0.0004216965034285823, 0.00031622776601683794, 0.00023713737056616554, 0.0001778279410038923, 0.0001333521432163324};
__device__ __forceinline__ void rope_table(const Fr& F, const int* pos, float* COS, float* SIN) {
    const int gt = F.vcu * 512 + F.tid, ngt = F.G * 512;
    for (int i = gt; i < MTOK * 32; i += ngt) { const int m = i >> 5, f = i & 31;
        const double a = (double)pos[m] * (double)(float)ROPE_INV[f]; const double rev = a * 0.15915494309189535; const float fr = (float)(rev - floor(rev));
        COS[i] = __builtin_amdgcn_cosf(fr); SIN[i] = __builtin_amdgcn_sinf(fr); }
}

__device__ __forceinline__ void mla_prep_a(const Fr& F, bf16_t* P, float* RSQ, float* RSKV, bf16_t* KR, const float* rope_g1, const float* gmem, const float* COS, const float* SIN) {
    const int lane = F.lane; float gr[8];
#pragma unroll
    for (int j = 0; j < 8; ++j) gr[j] = rope_g1[(lane & 7) * 8 + j];
    for (int m = F.gw; m < MTOK; m += F.ngw) {
        bf16_t* pr = P + (size_t)m * 1792; float v[8];
        const u32x4 wq = *(const u32x4*)(pr + lane * 8), wk = *(const u32x4*)(pr + 512 + lane * 8);
        u32x4 w = (u32x4){0u, 0u, 0u, 0u}; if (lane < 8) w = *(const u32x4*)(pr + 1024 + lane * 8);
        const float* cp = COS + (size_t)m * 32 + (lane & 3) * 8; const float* sp = SIN + (size_t)m * 32 + (lane & 3) * 8; float cs[8], sn[8];
#pragma unroll
        for (int j = 0; j < 8; ++j) { cs[j] = cp[j]; sn[j] = sp[j]; }
        asm volatile("" ::: "memory");
        unpack8(wq, v); float ss = wave_sum(sumsq8(v)); if (lane == 0) RSQ[m] = __builtin_amdgcn_rsqf(ss * (1.0f / 512.0f) + RMS_EPS);
        unpack8(wk, v); ss = wave_sum(sumsq8(v)); if (lane == 0) RSKV[m] = __builtin_amdgcn_rsqf(ss * (1.0f / 512.0f) + RMS_EPS);
        unpack8(w, v); ss = sumsq8(v); ss += __shfl_xor(ss, 1); ss += __shfl_xor(ss, 2); ss += __shfl_xor(ss, 4);
        const float rs = __builtin_amdgcn_rsqf(ss * (1.0f / 64.0f) + RMS_EPS); float o[8];
#pragma unroll
        for (int j = 0; j < 8; ++j) { const float x = v[j] * rs * gr[j]; const float y = __shfl_xor(x, 4); o[j] = (lane & 4) ? (y * sn[j] + x * cs[j]) : (x * cs[j] - y * sn[j]); }
        if (lane < 8) *(u32x4*)(KR + (size_t)m * 64 + lane * 8) = pack8(o);
    }
}
__device__ __forceinline__ void mla_prep_b(const Fr& F, bf16_t* Q, const bf16_t* KV, bf16_t* KF, const bf16_t* KR, const float* nope_g, const float* rope_g, const float* COS, const float* SIN) {
    const int lane = F.lane, half = lane >> 5, l5 = lane & 31; float gqn[8], gqr[8], gkn[8];
#pragma unroll
    for (int j = 0; j < 8; ++j) { gqn[j] = nope_g[(l5 & 15) * 8 + j]; gkn[j] = nope_g[128 + (l5 & 15) * 8 + j]; gqr[j] = rope_g[(l5 & 7) * 8 + j]; }
    for (int m = F.gw; m < MTOK; m += F.ngw) {
        const float* cp = COS + (size_t)m * 32 + (l5 & 3) * 8; const float* sp = SIN + (size_t)m * 32 + (l5 & 3) * 8; float cs[8], sn[8];
#pragma unroll
        for (int j = 0; j < 8; ++j) { cs[j] = cp[j]; sn[j] = sp[j]; }
        u32x4 krw = (u32x4){0u, 0u, 0u, 0u}; if (l5 >= 16 && l5 < 24) krw = *(const u32x4*)(KR + (size_t)m * 64 + (l5 - 16) * 8);
        u32x4 qw[8], kw[8];
#pragma unroll
        for (int it = 0; it < 8; ++it) { const int h = 2 * it + half;
            qw[it] = (u32x4){0u, 0u, 0u, 0u}; if (l5 < 24) qw[it] = *(const u32x4*)(Q + (size_t)m * 3072 + h * 192 + l5 * 8);
            kw[it] = (u32x4){0u, 0u, 0u, 0u}; if (l5 < 16) kw[it] = *(const u32x4*)(KV + (size_t)m * 4096 + h * 256 + l5 * 8); }
        asm volatile("" ::: "memory");
#pragma unroll
        for (int it = 0; it < 8; ++it) { const int h = 2 * it + half;
            bf16_t* qrow = Q + (size_t)m * 3072 + h * 192 + l5 * 8; float v[8];
            unpack8(qw[it], v); float s8 = sumsq8(v); s8 += __shfl_xor(s8, 1); s8 += __shfl_xor(s8, 2); s8 += __shfl_xor(s8, 4); const float s16 = s8 + __shfl_xor(s8, 8);
            const float rs = (l5 < 16) ? __builtin_amdgcn_rsqf(s16 * (1.0f / 128.0f) + RMS_EPS) : __builtin_amdgcn_rsqf(s8 * (1.0f / 64.0f) + RMS_EPS);
            float o[8];
#pragma unroll
            for (int j = 0; j < 8; ++j) { const float x = v[j] * rs * ((l5 < 16) ? gqn[j] : gqr[j]); const float y = __shfl_xor(x, 4);
                const float rot = (l5 & 4) ? (y * sn[j] + x * cs[j]) : (x * cs[j] - y * sn[j]); o[j] = (l5 < 16) ? x : rot; }
            if (l5 < 24) *(u32x4*)qrow = pack8(o);
            bf16_t* kfrow = KF + (size_t)m * 3072 + h * 192;
            unpack8(kw[it], v); float k16 = sumsq8(v); k16 += __shfl_xor(k16, 1); k16 += __shfl_xor(k16, 2); k16 += __shfl_xor(k16, 4); k16 += __shfl_xor(k16, 8);
            const float krs = __builtin_amdgcn_rsqf(k16 * (1.0f / 128.0f) + RMS_EPS);
#pragma unroll
            for (int j = 0; j < 8; ++j) o[j] = v[j] * krs * gkn[j];
            if (l5 < 16) *(u32x4*)(kfrow + l5 * 8) = pack8(o);
            else if (l5 < 24) *(u32x4*)(kfrow + 128 + (l5 - 16) * 8) = krw;
        }
    }
}

__device__ __forceinline__ void dsa_indexer(const Fr& F, const bf16_t* P, float* SC) {
    constexpr int LDP = 4864, CQI = 3072, CKI = 4096, CWI = 4160;
    const int lane = F.lane, r32 = lane & 31, hg = lane >> 5;
    for (int ui = blockIdx.x; ui < 512; ui += F.G) {
        const int c = ui & 255, second = ui >> 8, b = c >> 5, qb0 = c & 31, qb = second ? 63 - qb0 : qb0;
        const size_t tok0 = (size_t)b * SEQ + qb * 64 + F.wave * 8;
        bf16x8 aq[4][4]; float wv[4][16];
#pragma unroll
        for (int g = 0; g < 4; ++g) { const size_t tok = tok0 + 2 * g + (r32 >> 4); const bf16_t* qp = P + tok * LDP + CQI + (r32 & 15) * 64 + 8 * hg;
#pragma unroll
            for (int ks = 0; ks < 4; ++ks) aq[g][ks] = *(const bf16x8*)(qp + 16 * ks);
#pragma unroll
            for (int r = 0; r < 16; ++r) { const int head = (r & 3) + 8 * ((r >> 2) & 1) + 4 * hg; const size_t tq = tok0 + 2 * g + (r >> 3);
                wv[g][r] = bf_lo((unsigned)P[tq * LDP + CWI + head]) * (0.25f * 0.125f); } }
        const int ntile = 2 * (qb + 1);
        const bf16_t* kp = P + ((size_t)b * SEQ + r32) * LDP + CKI + 8 * hg;
        bf16x8 bk[4], bn[4];
#pragma unroll
        for (int ks = 0; ks < 4; ++ks) bk[ks] = *(const bf16x8*)(kp + 16 * ks);
        for (int t = 0; t < ntile; ++t) {
            if (t + 1 < ntile) {
#pragma unroll
                for (int ks = 0; ks < 4; ++ks) bn[ks] = *(const bf16x8*)(kp + (size_t)(t + 1) * 32 * LDP + 16 * ks);
            }
#pragma unroll
            for (int g = 0; g < 4; ++g) {
                f32x16 d = f32x16{};
#pragma unroll
                for (int ks = 0; ks < 4; ++ks) d = __builtin_amdgcn_mfma_f32_32x32x16_bf16(aq[g][ks], bk[ks], d, 0, 0, 0);
                float s0 = 0.f, s1 = 0.f;
#pragma unroll
                for (int r = 0; r < 8; ++r) { s0 = fmaf(wv[g][r], fmaxf(d[r], 0.f), s0); s1 = fmaf(wv[g][r + 8], fmaxf(d[r + 8], 0.f), s1); }
                auto rr = __builtin_amdgcn_permlane32_swap(__float_as_uint(s0), __float_as_uint(s1), false, false);
                const float tot = __uint_as_float(rr[0]) + __uint_as_float(rr[1]);
                __builtin_nontemporal_store(tot, &SC[(tok0 + 2 * g + hg) * (size_t)SEQ + t * 32 + r32]);
            }
#pragma unroll
            for (int ks = 0; ks < 4; ++ks) bk[ks] = bn[ks];
        }
    }
}

__device__ __forceinline__ void dsa_select(const Fr& F, const float* SC, u64* MSK) {
    const int lane = F.lane;
    for (int qidx = F.gw; qidx < MTOK; qidx += F.ngw) {
        const int s = qidx & (SEQ - 1); const float* row = SC + (size_t)qidx * SEQ; u64* mrow = MSK + (size_t)qidx * 64;
        if (s < 256) { const int lo = 64 * lane; u64 w = 0ull; if (s >= lo + 63) w = ~0ull; else if (s >= lo) w = (2ull << (s - lo)) - 1ull; mrow[lane] = w; continue; }
        unsigned u[64];
#pragma unroll
        for (int c4 = 0; c4 < 4; ++c4) {
            if (1024 * c4 <= s) {
#pragma unroll
                for (int i = 16 * c4; i < 16 * c4 + 16; ++i) u[i] = __float_as_uint(__builtin_nontemporal_load(row + 64 * i + lane)); }
            else {
#pragma unroll
                for (int i = 16 * c4; i < 16 * c4 + 16; ++i) u[i] = 0u; } }
#pragma unroll
        for (int i = 0; i < 64; ++i) { const int key = 64 * i + lane; const unsigned bits = u[i]; const unsigned ord = (bits & 0x80000000u) ? ~bits : (bits | 0x80000000u); u[i] = (key <= s) ? ord : 0u; }
        unsigned T = 0u; const int ng = (s >> 9) + 1;
        for (int bit = 31; bit >= 0; --bit) { const unsigned cand = T | (1u << bit); int cl = 0;
#pragma unroll
            for (int g8 = 0; g8 < 8; ++g8) { if (g8 >= ng) break;
                u64 m[8];
#pragma unroll
                for (int j = 0; j < 8; ++j) asm("v_cmp_le_u32_e64 %0, %1, %2" : "=s"(m[j]) : "s"(cand), "v"(u[8 * g8 + j]));
#pragma unroll
                for (int j = 0; j < 8; ++j) cl += __popcll(m[j]); }
            if (cl >= 256) { T = cand; if (cl == 256) break; } }
        int cgt = 0;
#pragma unroll
        for (int g8 = 0; g8 < 8; ++g8) { if (g8 >= ng) break;
            u64 m[8];
#pragma unroll
            for (int j = 0; j < 8; ++j) asm("v_cmp_lt_u32_e64 %0, %1, %2" : "=s"(m[j]) : "s"(T), "v"(u[8 * g8 + j]));
#pragma unroll
            for (int j = 0; j < 8; ++j) cgt += __popcll(m[j]); }
        int need = 256 - cgt; unsigned mlo = 0u, mhi = 0u;
#pragma unroll
        for (int i = 0; i < 64; ++i) { if ((i & 7) == 0 && (i >> 3) >= ng) break;
            const u64 gt = __ballot(u[i] > T), eq = __ballot(u[i] == T); u64 take = 0ull;
            if (need > 0 && eq != 0ull) { const int c = __popcll(eq);
                if (c <= need) { take = eq; need -= c; }
                else { u64 e = eq; for (int n = 0; n < need; ++n) { const u64 low = e & (0ull - e); take |= low; e ^= low; } need = 0; } }
            const u64 w = gt | take; { const unsigned wl = __builtin_amdgcn_readfirstlane((unsigned)w), wh = __builtin_amdgcn_readfirstlane((unsigned)(w >> 32));
                asm volatile("s_nop 4\n\tv_writelane_b32 %0, %1, %2\n\ts_nop 1" : "+v"(mlo) : "s"(wl), "n"(i)); asm volatile("s_nop 4\n\tv_writelane_b32 %0, %1, %2\n\ts_nop 1" : "+v"(mhi) : "s"(wh), "n"(i)); } }
        mrow[lane] = ((u64)mhi << 32) | (u64)mlo;
    }
}

constexpr size_t MiB = 1u << 20;
constexpr size_t WS_CTL = 0, CTL_ZERO_BYTES = 8 * MiB;
constexpr int CW_BAR = 4096;
constexpr size_t WS_SSQ = 1 * MiB;
constexpr size_t WS_WB = 8 * MiB;
constexpr size_t WS_XB = 236 * MiB;
constexpr size_t WS_MEMB = 364 * MiB;
constexpr size_t WS_MEMKV = 372 * MiB;
constexpr size_t WS_COS = 388 * MiB, WS_SIN = 392 * MiB, WS_RSMEM = 396 * MiB, WS_RSQ = 397 * MiB, WS_RSKV = 398 * MiB;
constexpr size_t WS_XB8 = 560 * MiB;
constexpr size_t WS_MIX = 400 * MiB;
constexpr size_t WS_SCR = 624 * MiB;
constexpr size_t WS_END = (624 + 832) * MiB;
constexpr size_t WB_GU0 = 0, WB_GU1 = 23068672, WB_D0 = 46137344, WB_D1 = 57671680, WB_IN = 69206016, WB_OUT = 108003328, WB_MKV = 113246208, WB_UQ = 115343360, WB_UKV = 116916224;
constexpr int RING_BYTES = 146944, MISC_OFF = RING_BYTES + 64, LDS_BYTES = 147456;
static_assert(att::L_END <= RING_BYTES && pg8::STAGE_BYTES <= RING_BYTES, "LDS map");
constexpr int NPHASES = 44;
#ifndef F8MASK
#define F8MASK 4
#endif
#define F8LAYER(L) (((F8MASK) >> (L)) & 1)
#ifndef RG
#define RG 1
#endif
#ifndef RD
#define RD 1
#endif
#ifndef RI
#define RI 1
#endif
#ifndef RA
#define RA 1
#endif
#ifndef RCV
#define RCV 1
#endif
#ifndef RIX
#define RIX 1
#endif
#ifndef RSL
#define RSL 1
#endif
#ifndef RC
#define RC 1
#endif
#define REP(n) for (int rep_ = 0; rep_ < (n); ++rep_)

struct Args { const void* in[27]; float* out; unsigned char* ws; int ph_lo, ph_hi; };

typedef const __attribute__((address_space(4))) struct Args* ArgsPc;
__device__ __forceinline__ TrDesc tr_desc(ArgsPc A, int L, bf16_t* WB, int it) {
    const float* w_gate = (const float*)A->in[5]; const float* w_up = (const float*)A->in[6]; const float* w_down = (const float*)A->in[7];
    const float* ffn_norm = (const float*)A->in[4]; const float* attn_norm = (const float*)A->in[8];
    const float* w_out = (const float*)A->in[12];
    const float* w_in = (const float*)(L == 0 ? A->in[13] : L == 1 ? A->in[16] : L == 2 ? A->in[23] : A->in[25]);
    const int nin = (L == 0 ? 6672 : L == 1 ? 1600 : L == 2 ? 18944 : 4688);
    const int I_GU = 32 * 88, I_D = 88 * 32, I_IN = 32 * ((nin + 63) / 64), I_OUT = 40 * 32, I_UQ = (L == 1) ? 8 * 48 : 0;
    TrDesc d; d.f8 = 0; int r = it;
    if (r < 4 * I_GU) { const int s = r / I_GU; r -= s * I_GU; const int f = s >> 1, up = s & 1;
        d.W = (up ? w_up : w_gate) + (size_t)(L * 2 + f) * DM * DFF; d.K = DM; d.N = DFF; d.gain = ffn_norm + (size_t)(L * 2 + f) * DM; d.WT = WB + (f ? WB_GU1 : WB_GU0); d.ldt = DM; d.kind = up ? 2 : 1; }
    else { r -= 4 * I_GU;
        if (r < 2 * I_D) { const int f = r / I_D; r -= f * I_D; d.W = w_down + (size_t)(L * 2 + f) * DFF * DM; d.K = DFF; d.N = DM; d.gain = nullptr; d.WT = WB + (f ? WB_D1 : WB_D0); d.ldt = DFF; d.kind = 0; }
        else { r -= 2 * I_D;
            if (r < I_IN) { d.W = w_in; d.K = DM; d.N = nin; d.gain = attn_norm + (size_t)L * DM; d.WT = WB + WB_IN; d.ldt = DM; d.kind = 3 + L; d.f8 = F8LAYER(L) ? 1 : 0; }
            else { r -= I_IN;
                if (r < I_OUT) { d.W = w_out + (size_t)L * OUTIN * DM; d.K = OUTIN; d.N = DM; d.gain = nullptr; d.WT = WB + WB_OUT; d.ldt = OUTIN; d.kind = 0; }
                else { r -= I_OUT;
                    if (r < I_UQ) { d.W = (const float*)A->in[18]; d.K = 512; d.N = 3072; d.gain = (const float*)A->in[17]; d.WT = WB + WB_UQ; d.ldt = 512; d.kind = 0; }
                    else { r -= I_UQ; d.W = (const float*)A->in[20]; d.K = 512; d.N = 4096; d.gain = (const float*)A->in[19]; d.WT = WB + WB_UKV; d.ldt = 512; d.kind = 0; } } } } }
    d.r = r; return d;
}
__device__ __forceinline__ void convert_layer(const Fr& F, ArgsPc A, int L, bf16_t* WB) {
    const int nin = (L == 0 ? 6672 : L == 1 ? 1600 : L == 2 ? 18944 : 4688);
    const int total = 4 * 32 * 88 + 2 * 88 * 32 + 32 * ((nin + 63) / 64) + 40 * 32 + ((L == 1) ? 8 * 48 + 8 * 64 : 0);
    LAS float* scr = (LAS float*)(F.lds + F.wave * 16640);
    f32x4 va[16], vb[16]; int it = F.gw;
    if (it >= total) return;
    TrDesc da = tr_desc(A, L, WB, it), db = da; tr_load(da, F.lane, va);
    for (;;) {
        const bool nb_ = it + F.ngw < total; if (nb_) { db = tr_desc(A, L, WB, it + F.ngw); tr_load(db, F.lane, vb); }
        tr_store(da, F.lane, va, scr); it += F.ngw; if (!nb_) break;
        const bool na_ = it + F.ngw < total; if (na_) { da = tr_desc(A, L, WB, it + F.ngw); tr_load(da, F.lane, va); }
        tr_store(db, F.lane, vb, scr); it += F.ngw; if (!na_) break;
    }
}

__device__ __forceinline__ void mem_attn_units(const Fr& F, const bf16_t* P, long ldp, int memq_col, const bf16_t* MEMKV, bf16_t* MIX) {
    for (int i = blockIdx.x; i < 512; i += F.G) {
        const int b = i >> 6, mh = (i >> 4) & 3, qb = i & 15; const size_t tok = (size_t)b * SEQ + qb * 256;
        att::AP a{}; a.Q = P + tok * ldp + memq_col + mh * 128; a.qs = ldp; a.K = MEMKV + (size_t)b * NMEM * 4096 + mh * 128; a.ks = 4096; a.V = a.K + 512; a.vs = 4096;
        a.O = MIX + tok * OUTIN + 2048 + mh * 128; a.os = OUTIN; a.kt0 = 0; a.nt = 4; a.q0 = 0; a.C = 0.08838834764831845f * LOG2E;
        att::attn_unit<att::K_MEM, 128>(F.lds, a, F.wave);
    }
}
__device__ __forceinline__ void causal_unit_ids(int i, int& b, int& h, int& qb) {
    const int slot = i >> 8, c = i & 255, bh = (c >> 4) * 8 + (c & 7), half = (c >> 3) & 1;
    qb = half ? ((slot & 1) ? slot : 14 - slot) : ((slot & 1) ? slot - 1 : 15 - slot); b = bh >> 4; h = bh & 15;
}

__device__ __forceinline__ Fr mk_frame(unsigned char* lds_raw, int wave_id) {
    Fr F; F.lds = (LAS unsigned char*)lds_raw; F.tid = tid_opaque(wave_id); F.lane = F.tid & 63; F.wave = __builtin_amdgcn_readfirstlane(F.tid >> 6);
    F.G = gridDim.x; { const int bx = blockIdx.x; F.vcu = (F.G % 8 == 0) ? (bx % 8) * (F.G / 8) + bx / 8 : bx; }
    F.gw = F.vcu * 8 + F.wave; F.ngw = F.G * 8; return F;
}
typedef const __attribute__((address_space(4))) Args* ArgsP;
__device__ __forceinline__ ArgsP args_ptr() { auto p = __builtin_amdgcn_kernarg_segment_ptr(); asm volatile("" : "+s"(p)); return (ArgsP)p; }
#define WSP(T, off) ((T*)(AP_->ws + (off)))
#define SCRP(T, mib) ((T*)(AP_->ws + WS_SCR + (size_t)(mib) * MiB))

__global__ void __launch_bounds__(512, 2) fwd(Args A) {
    extern __shared__ __attribute__((aligned(16))) unsigned char lds_raw[];
    { LAS unsigned* z = (LAS unsigned*)((LAS unsigned char*)lds_raw + RING_BYTES); for (int u = threadIdx.x; u < (LDS_BYTES - RING_BYTES) / 4; u += 512) z[u] = 0u; }
    __syncthreads();
    const int lo = A.ph_lo, hi = A.ph_hi; const int wave_id = __builtin_amdgcn_readfirstlane((int)threadIdx.x >> 6);
    XcdBarrier bar; bar.bar = (unsigned*)(A.ws + WS_CTL) + CW_BAR; bar.x = 0; bar.st = nullptr;
    if (hi - lo > 1) bar = xcd_barrier_post((unsigned*)(A.ws + WS_CTL) + CW_BAR, (volatile LAS unsigned*)((LAS unsigned char*)lds_raw + MISC_OFF) + 8);
    int ph = 0;
#define PH_BEGIN if (ph >= lo && ph < hi) { const Fr F = mk_frame(lds_raw, wave_id); const ArgsP AP_ = args_ptr();
#define PH_END   if (ph + 1 < hi) xcd_barrier(bar); } ++ph;
    const float SC128 = 0.08838834764831845f * LOG2E, SC192 = 0.07216878364870323f * LOG2E;

    PH_BEGIN
        rows2048(F, (const float*)AP_->in[1], NB * NMEM, WSP(bf16_t, WS_MEMB), WSP(float, WS_RSMEM), 1);
        rope_table(F, (const int*)AP_->in[2], WSP(float, WS_COS), WSP(float, WS_SIN));
        rows2048(F, (const float*)AP_->in[0], MTOK, WSP(bf16_t, WS_XB), WSP(u64, WS_SSQ), 0);
#ifdef RZ
        { u32x4* z = WSP(u32x4, WS_END); for (size_t i = (size_t)F.vcu * 512 + F.tid; i < (size_t)2 * DFF * DM * 2 / 16; i += (size_t)F.G * 512) z[i] = (u32x4){0u, 0u, 0u, 0u}; }
#endif
        { LAS float* scr = (LAS float*)(F.lds + F.wave * 16640);
          for (int it = F.gw; it < 4 * 512; it += F.ngw) { const int Lm = it >> 9; TrDesc d; d.W = (const float*)AP_->in[10] + (size_t)Lm * DM * 1024; d.K = DM; d.N = 1024; d.gain = (const float*)AP_->in[9] + (size_t)Lm * DM;
              d.WT = SCRP(bf16_t, 0) + (size_t)Lm * 1024 * DM; d.ldt = DM; d.kind = 0; d.f8 = 0; d.r = it & 511; f32x4 v[16]; tr_load(d, F.lane, v); tr_store(d, F.lane, v, scr); } }
    PH_END
    PH_BEGIN { pg8::Gemm g{WSP(bf16_t, WS_MEMB), SCRP(bf16_t, 0), NB * NMEM, 4096, DM, DM, DM, 0}; pg8::StaticOrder S; S.init(g.M, g.N, F.G, (int)blockIdx.x);
        pg8::EpiProj E{WSP(bf16_t, WS_MEMKV), 4096, WSP(float, WS_RSMEM), 0, nullptr, -1, (const float*)AP_->in[11] + 128, 0, 0, nullptr, 0, 0, nullptr, 0, 0, 1.0f, 4, 2, 256}; pg8::gemm_phase(F.lds, g, S, E, F.tid); } PH_END

    int ver = 0;
#pragma clang loop unroll(full)
    for (int hl = 0; hl < 8; ++hl) {
        const int L = hl >> 1, f = hl & 1;
        if (f == 0) {
            PH_BEGIN REP(RCV) convert_layer(F, AP_, L, WSP(bf16_t, WS_WB)); PH_END

        }
        PH_BEGIN
#ifdef RZ
            { pg8::Gemm g{WSP(bf16_t, WS_XB), WSP(bf16_t, WS_END), MTOK, 2 * DFF, DM, DM, DM, 0}; pg8::StaticOrder S; S.init(g.M, g.N, F.G, (int)blockIdx.x);
              pg8::EpiSwiGLU E{SCRP(bf16_t, 0), DFF, WSP(u64, WS_SSQ) + (size_t)ver * MTOK}; pg8::gemm_phase(F.lds, g, S, E, F.tid); }
#endif
            REP(RG) { pg8::Gemm g{WSP(bf16_t, WS_XB), WSP(bf16_t, WS_WB) + (f ? WB_GU1 : WB_GU0), MTOK, 2 * DFF, DM, DM, DM, 0}; pg8::StaticOrder S; S.init(g.M, g.N, F.G, (int)blockIdx.x);
            pg8::EpiSwiGLU E{SCRP(bf16_t, 0), DFF, WSP(u64, WS_SSQ) + (size_t)ver * MTOK}; pg8::gemm_phase(F.lds, g, S, E, F.tid); } PH_END
        PH_BEGIN { pg8::Gemm g{SCRP(bf16_t, 0), WSP(bf16_t, WS_WB) + (f ? WB_D1 : WB_D0), MTOK, DM, DFF, DFF, DFF, 1}; pg8::StaticOrder S; S.init(g.M, g.N, F.G, (int)blockIdx.x);
            if (RD > 1) { pg8::EpiResid E0{ver == 0 ? (const float*)AP_->in[0] : AP_->out, SCRP(float, 400), SCRP(bf16_t, 660), nullptr, nullptr, 0.5f}; pg8::gemm_phase(F.lds, g, S, E0, F.tid); }
            pg8::EpiResid E{ver == 0 ? (const float*)AP_->in[0] : AP_->out, AP_->out, WSP(bf16_t, WS_XB), WSP(u64, WS_SSQ) + (size_t)(ver + 1) * MTOK, (f == 0 && F8LAYER(L)) ? WSP(unsigned char, WS_XB8) : nullptr, 0.5f}; pg8::gemm_phase(F.lds, g, S, E, F.tid); } PH_END
        ++ver;
        if (f != 0) continue;
        const int ngrp = (L == 2) ? 3 : 1;
#pragma clang loop unroll(full)
        for (int g = 0; g < ngrp; ++g) {
            PH_BEGIN REP(RI) { const int ldp = (L == 0) ? 6912 : (L == 1) ? 1792 : (L == 2) ? 6656 : 4864;
                const int nproj = (L == 2) ? (g == 0 ? 6656 : 6144) : ldp; const size_t roff = (L == 2) ? (g == 0 ? 0 : (g == 1 ? 6656 : 12800)) : 0;
                pg8::Gemm gm = F8LAYER(L) ? pg8::Gemm{WSP(bf16_t, WS_XB8), (const bf16_t*)((const unsigned char*)(WSP(bf16_t, WS_WB) + WB_IN) + roff * DM), MTOK, nproj, DM / 2, DM / 2, DM / 2, 0}
                                       : pg8::Gemm{WSP(bf16_t, WS_XB), WSP(bf16_t, WS_WB) + WB_IN + roff * DM, MTOK, nproj, DM, DM, DM, 0};
                pg8::StaticOrder S; S.init(gm.M, gm.N, F.G, (int)blockIdx.x);
                const float* gmq = (const float*)AP_->in[11] + (size_t)L * 256;
                const float* qg = (L == 0) ? (const float*)AP_->in[15] : (L == 2) ? (const float*)AP_->in[24] + (size_t)g * 256 : (L == 3) ? (const float*)AP_->in[26] : nullptr;
                const int kt_hi = (L == 3) ? 10 : 16, mq_lo = (L == 0 || L == 2) ? 24 : (L == 1) ? 5 : 17, mq_hi = (L == 2 && g > 0) ? mq_lo : mq_lo + 2;
                pg8::EpiProj E{SCRP(bf16_t, 0), ldp, WSP(u64, WS_SSQ) + (size_t)ver * MTOK, 1, (L == 0) ? SCRP(float, 432) : nullptr, 26,
                               qg, 0, (L == 1) ? 0 : 8, qg ? qg + 128 : nullptr, 8, (L == 1) ? 8 : kt_hi, gmq, mq_lo, mq_hi, F8LAYER(L) ? (1.0f / 64.0f) : 1.0f, 0, 0, 0}; if (F8LAYER(L)) pg8::gemm_phase<true>(F.lds, gm, S, E, F.tid); else pg8::gemm_phase<false>(F.lds, gm, S, E, F.tid); } PH_END
            if (L == 0) { PH_BEGIN fox_cumsum(F, SCRP(const float, 432), (const float*)AP_->in[14], SCRP(float, 434)); PH_END }
            if (L == 1) { PH_BEGIN mla_prep_a(F, SCRP(bf16_t, 0), WSP(float, WS_RSQ), WSP(float, WS_RSKV), SCRP(bf16_t, 752), (const float*)AP_->in[22] + 64, nullptr, WSP(float, WS_COS), WSP(float, WS_SIN)); PH_END }
            if (L == 1) {
                PH_BEGIN
                    REP(RI) for (int i = 0; i < 2; ++i) { pg8::Gemm gm{SCRP(bf16_t, 0) + (i ? 512 : 0), WSP(bf16_t, WS_WB) + (i ? WB_UKV : WB_UQ), MTOK, i ? 4096 : 3072, 512, 1792, 512, 0}; pg8::StaticOrder S; S.init(gm.M, gm.N, F.G, (int)blockIdx.x);
                        pg8::EpiProj E{i ? SCRP(bf16_t, 304) : SCRP(bf16_t, 112), i ? 4096 : 3072, i ? WSP(float, WS_RSKV) : WSP(float, WS_RSQ), 0, nullptr, -1, nullptr, 0, 0, nullptr, 0, 0, nullptr, 0, 0, 1.0f, 0, 0, 0}; pg8::gemm_phase(F.lds, gm, S, E, F.tid); }
                PH_END
                PH_BEGIN mla_prep_b(F, SCRP(bf16_t, 112), SCRP(const bf16_t, 304), SCRP(bf16_t, 560), SCRP(const bf16_t, 752), (const float*)AP_->in[21], (const float*)AP_->in[22], WSP(float, WS_COS), WSP(float, WS_SIN)); PH_END
            }
            if (L == 3) {
                PH_BEGIN REP(RIX) dsa_indexer(F, SCRP(const bf16_t, 0), SCRP(float, 304)); PH_END
                PH_BEGIN REP(RSL) dsa_select(F, SCRP(const float, 304), SCRP(u64, 816)); PH_END
            }
            PH_BEGIN
                bf16_t* P = SCRP(bf16_t, 0); bf16_t* MIX = WSP(bf16_t, WS_MIX);
                const long ldp = (L == 0) ? 6912 : (L == 1) ? 1792 : (L == 2) ? 6656 : 4864;
                REP(L == 2 ? 1 : RA) {
                if (L == 0) {
                    const float* CUM = SCRP(const float, 434);
                    for (int i = blockIdx.x; i < 2048; i += F.G) { int b, h, qb; causal_unit_ids(i, b, h, qb); const size_t t0 = (size_t)b * SEQ;
                        att::AP a{}; a.Q = P + (t0 + qb * 256) * ldp + h * 128; a.qs = ldp; a.K = P + t0 * ldp + 2048 + h * 128; a.ks = ldp; a.V = a.K + 2048; a.vs = ldp;
                        a.O = MIX + (t0 + qb * 256) * OUTIN + h * 128; a.os = OUTIN; a.kt0 = 0; a.nt = 4 * (qb + 1); a.q0 = qb * 256; a.C = SC128; a.cum = CUM + t0 * 16 + h; a.cums = 16;
                        att::attn_unit<att::K_FOX, 128>(F.lds, a, F.wave); }
                }
                if (L == 1) {
                    const bf16_t* Qb = SCRP(const bf16_t, 112); const bf16_t* KVb = SCRP(const bf16_t, 304); const bf16_t* KF = SCRP(const bf16_t, 560);
                    for (int i = blockIdx.x; i < 2048; i += F.G) { int b, h, qb; causal_unit_ids(i, b, h, qb); const size_t t0 = (size_t)b * SEQ;
                        att::AP a{}; a.Q = Qb + (t0 + qb * 256) * 3072 + h * 192; a.qs = 3072; a.K = KF + t0 * 3072 + h * 192; a.ks = 3072; a.V = KVb + t0 * 4096 + h * 256 + 128; a.vs = 4096;
                        a.O = MIX + (t0 + qb * 256) * OUTIN + h * 128; a.os = OUTIN; a.kt0 = 0; a.nt = 4 * (qb + 1); a.q0 = qb * 256; a.C = SC192;
                        att::attn_unit<att::K_MLA, 192>(F.lds, a, F.wave); }
                }
                if (L == 2) {
                    const int dil = (g == 0) ? 1 : (g == 1 ? 4 : 16), nblk = 16 / dil; float* OST = SCRP(float, 416); float* ML = SCRP(float, 672);
                    for (int i = blockIdx.x; i < 2048; i += F.G) { const int h = i & 15, rest = i >> 4, b = rest >> 4, rj = rest & 15, r = rj / nblk, jb = rj % nblk;
                        const size_t tokz = (size_t)b * SEQ + r, tokq = tokz + (size_t)jb * 256 * dil;
                        att::AP a{}; a.Q = P + tokq * ldp + h * 128; a.qs = (long)dil * ldp; a.K = P + tokz * ldp + 2048 + h * 128; a.ks = (long)dil * ldp; a.V = a.K + 2048; a.vs = a.ks;
                        a.O = MIX + tokq * OUTIN + h * 128; a.os = (long)dil * OUTIN; a.q0 = jb * 256; a.kt0 = jb == 0 ? 0 : 4 * jb - 2; a.nt = jb == 0 ? 4 : 6; a.C = SC128;
                        a.ost = OST + tokq * 2048 + h * 128; a.osts = (long)dil * 2048; a.mst = ML + (tokq * 16 + h) * 2; a.msts = (long)dil * 32; a.carry_in = g > 0; a.carry_out = g < 2;
                        a.t5 = (const float*)AP_->in[3]; a.head = h; a.dil = dil;
                        att::attn_unit<att::K_DIL, 128>(F.lds, a, F.wave); }
                }
                if (L == 3) {
                    const u64* MSK = SCRP(const u64, 816);
                    for (int i = blockIdx.x; i < 2048; i += F.G) { int b, h, qb; causal_unit_ids(i, b, h, qb); const size_t t0 = (size_t)b * SEQ;
                        att::AP a{}; a.Q = P + (t0 + qb * 256) * ldp + h * 128; a.qs = ldp; a.K = P + t0 * ldp + 2048 + (h >> 2) * 128; a.ks = ldp; a.V = a.K + 512; a.vs = ldp;
                        a.O = MIX + (t0 + qb * 256) * OUTIN + h * 128; a.os = OUTIN; a.kt0 = 0; a.nt = 4 * (qb + 1); a.q0 = qb * 256; a.C = SC128; a.msk = MSK + (t0 + qb * 256) * 64; a.t5 = (const float*)AP_->in[3]; a.head = h;
                        att::attn_unit<att::K_DSA, 128>(F.lds, a, F.wave); }
                }
                if (g == 0) { const int memq_col = (L == 0) ? 6144 : (L == 1) ? 1280 : (L == 2) ? 6144 : 4352; mem_attn_units(F, P, ldp, memq_col, WSP(const bf16_t, WS_MEMKV) + L * 1024, MIX); }
                }
            PH_END
        }
        PH_BEGIN { pg8::Gemm gm{WSP(bf16_t, WS_MIX), WSP(bf16_t, WS_WB) + WB_OUT, MTOK, DM, OUTIN, OUTIN, OUTIN, 0}; pg8::StaticOrder S; S.init(gm.M, gm.N, F.G, (int)blockIdx.x);
            if (RD > 1) { pg8::EpiResid E0{AP_->out, SCRP(float, 400), SCRP(bf16_t, 660), nullptr, nullptr, 1.0f}; pg8::gemm_phase(F.lds, gm, S, E0, F.tid); }
            pg8::EpiResid E{AP_->out, AP_->out, WSP(bf16_t, WS_XB), WSP(u64, WS_SSQ) + (size_t)(ver + 1) * MTOK, nullptr, 1.0f}; pg8::gemm_phase(F.lds, gm, S, E, F.tid); } PH_END
        ++ver;
    }
#undef PH_BEGIN
#undef PH_END
}

#ifndef MK_ONE_LAUNCH
#define MK_ONE_LAUNCH 0
#endif
extern "C" void kernel_launch(void* const* d_in, const int* in_sizes, int n_in, void* d_out, int out_size, void* d_ws, size_t ws_size, hipStream_t stream) {
    static int grid = 0;
    if (grid == 0) {
        if (n_in != 27 || in_sizes[0] != MTOK * DM || out_size != MTOK * DM || ws_size < WS_END) {
            fprintf(stderr, "kernel_launch: unexpected shapes: n_in %d in0 %d out %d ws %zu (need >= %zu); nothing launched\n", n_in, n_in > 0 ? in_sizes[0] : -1, out_size, ws_size, (size_t)WS_END); grid = -1; return; }
        int dev = 0, cus = 0, per_cu = 0;
        if (hipGetDevice(&dev) != hipSuccess || hipDeviceGetAttribute(&cus, hipDeviceAttributeMultiprocessorCount, dev) != hipSuccess) { fprintf(stderr, "kernel_launch: device query failed\n"); grid = -1; return; }
        if (hipFuncSetAttribute((const void*)fwd, hipFuncAttributeMaxDynamicSharedMemorySize, LDS_BYTES) != hipSuccess) { fprintf(stderr, "kernel_launch: hipFuncSetAttribute failed\n"); grid = -1; return; }
        if (hipOccupancyMaxActiveBlocksPerMultiprocessor(&per_cu, (const void*)fwd, 512, LDS_BYTES) != hipSuccess || per_cu < 1)
            fprintf(stderr, "kernel_launch: note: occupancy query reports %d workgroups per CU\n", per_cu);
        (void)hipGetLastError();
        grid = cus;
    }
    if (grid < 0) return;
    if (hipMemsetAsync((char*)d_ws + WS_CTL, 0, CTL_ZERO_BYTES, stream) != hipSuccess) { fprintf(stderr, "kernel_launch: memset failed\n"); return; }
    Args a{};
    for (int i = 0; i < 27; ++i) a.in[i] = d_in[i];
    a.out = (float*)d_out; a.ws = (unsigned char*)d_ws;
#if MK_ONE_LAUNCH
    a.ph_lo = 0; a.ph_hi = NPHASES;
    hipLaunchKernelGGL(fwd, dim3(grid), dim3(512), LDS_BYTES, stream, a);
#else
#ifndef NPH_LIMIT
#define NPH_LIMIT NPHASES
#endif
    for (int p = 0; p < NPH_LIMIT; ++p) { a.ph_lo = p; a.ph_hi = p + 1; hipLaunchKernelGGL(fwd, dim3(grid), dim3(512), LDS_BYTES, stream, a); }
#endif
    const hipError_t le = hipPeekAtLastError();
    if (le != hipSuccess) fprintf(stderr, "kernel_launch: launch failed: %s\n", hipGetErrorName(le));
}
```

```cpp
#define MK_ONE_LAUNCH 1
#define F8OUT 8
#include <hip/hip_runtime.h>
#include <cstdio>
#include <cstdint>

#define LAS __attribute__((address_space(3)))
#define GAS __attribute__((address_space(1)))
typedef unsigned short bf16_t;
typedef short bf16x8 __attribute__((ext_vector_type(8)));
typedef short s16x4 __attribute__((ext_vector_type(4)));
typedef float f32x2 __attribute__((ext_vector_type(2)));
typedef float f32x4 __attribute__((ext_vector_type(4)));
typedef float f32x16 __attribute__((ext_vector_type(16)));
typedef unsigned u32x2 __attribute__((ext_vector_type(2)));
typedef unsigned u32x4 __attribute__((ext_vector_type(4)));
typedef unsigned long long u64;

constexpr int DM = 2048, NB = 8, SEQ = 4096, MTOK = NB * SEQ, DFF = 5632, NH = 16, HD = 128, NMEM = 256, MEMW = 512, OUTIN = 2560;
constexpr float RMS_EPS = 1e-6f;
constexpr float LOG2E = 1.4426950408889634f;

__device__ __forceinline__ unsigned cvt_pk_bf16(float lo, float hi) { unsigned r; asm volatile("v_cvt_pk_bf16_f32 %0, %1, %2" : "=v"(r) : "v"(lo), "v"(hi)); return r; }
__device__ __forceinline__ float bf_lo(unsigned w) { return __uint_as_float(w << 16); }
__device__ __forceinline__ float bf_hi(unsigned w) { return __uint_as_float(w & 0xffff0000u); }

__device__ __forceinline__ int tid_opaque(int wave_id) {
    int l; asm volatile("v_mbcnt_lo_u32_b32 %0, -1, 0\n\tv_mbcnt_hi_u32_b32 %0, -1, %0" : "=v"(l)); return wave_id * 64 + l; }

namespace pg8 {
constexpr int BM = 256, BK = 64, HALF = 128, HTB = HALF * BK * 2, STAGE_BYTES = 8 * HTB, NXCD = 8, WGM = 8;
__host__ __device__ __forceinline__ int lds_byte(int r, int c) { const int st = (r >> 4) * 2 + (c >> 5), rr = r & 15, cc = c & 31, ob = rr * 64 + cc * 2; return st * 1024 + (ob ^ (((ob >> 9) & 1) << 5)); }
__host__ __device__ __forceinline__ void stage_rc(int b, int& R, int& C) { const int st = b / 1024, sb = b % 1024, swz = sb ^ (((sb >> 9) & 1) << 5); R = (st >> 1) * 16 + swz / 64; C = (st & 1) * 32 + (swz % 64) / 2; }
__host__ __device__ __forceinline__ int perm32(int rho) { const int n = rho >> 4, i = rho & 15; return 8 * (i >> 2) + 4 * n + (i & 3); }

struct Unit { int pm, pn; };
struct Gemm { const bf16_t* A; const bf16_t* Bt; int M, N, K, lda, ldb; int a_tiled; int b_tiled; int pm_and; };

struct StaticOrder {
    int nM, nN, nwg, G, c, wgm;
    __host__ __device__ void init(int M, int N, int G_, int c_) { nM = M / BM; nN = N / BM; nwg = nM * nN; G = G_; c = c_; wgm = (nN == 8) ? 4 : WGM; }
    __host__ __device__ bool next(int i, Unit& u) const {
        const long L = (long)i * G + c; if (L >= nwg) return false;
        int wgid = (int)L; { const int q = nwg / NXCD, r = nwg % NXCD, xcd = wgid % NXCD, off = wgid / NXCD; wgid = (xcd < r ? xcd * (q + 1) : r * (q + 1) + (xcd - r) * q) + off; }
        const int nig = wgm * nN, gid = wgid / nig, fm = gid * wgm, gsz = (nM - fm) < wgm ? (nM - fm) : wgm;
        u.pm = fm + ((wgid % nig) % gsz); u.pn = (wgid % nig) / gsz; return true;
    }
};

constexpr float SSQ_SCALE = 16777216.0f;
__device__ __forceinline__ float rs_from_ssq(const u64 v) { return __builtin_amdgcn_rsqf((float)v * (1.0f / (SSQ_SCALE * DM)) + RMS_EPS); }
__device__ __forceinline__ float rs_of(const void* rsv, int row, int mode) { return mode ? rs_from_ssq(((const u64*)rsv)[row]) : ((const float*)rsv)[row]; }

struct EpiProj {
    bf16_t* O; int ldc; const void* rsv; int rs_mode;
    float* fgout; int fg_tile;
    const float* g0; int t0a, t0b; const float* g1; int t1a, t1b; const float* g2; int t2a, t2b;
    float oscale;
    int gper, gcnt, gstride;
    __device__ __forceinline__ void operator()(f32x4 (&acc)[2][2][4][2], const Unit& u, int wr, int wc, int fr, int fq, LAS unsigned char* xlds) const {
        const int row0 = u.pm * BM + wr * 64 + fr; const int col0 = u.pn * BM + wc * 32 + 8 * fq;
        const float* gain = (u.pn >= t0a && u.pn < t0b) ? g0 : (u.pn >= t1a && u.pn < t1b) ? g1 : (u.pn >= t2a && u.pn < t2b) ? g2 : nullptr;
        if (gper) gain = (u.pn % gper < gcnt) ? g0 + (size_t)(u.pn / gper) * gstride : nullptr;
        float rsa[2][4];
#pragma unroll
        for (int ai = 0; ai < 2; ++ai)
#pragma unroll
            for (int m = 0; m < 4; ++m) rsa[ai][m] = rs_of(rsv, row0 + ai * HALF + m * 16, rs_mode) * oscale;
#pragma unroll
        for (int ai = 0; ai < 2; ++ai)
#pragma unroll
            for (int m = 0; m < 4; ++m) { const float rs = rsa[ai][m];
#pragma unroll
                for (int bj = 0; bj < 2; ++bj) { acc[ai][bj][m][0] *= rs; acc[ai][bj][m][1] *= rs; } }
        if (gain) {
            LAS float* part = (LAS float*)xlds;
#pragma unroll
            for (int ai = 0; ai < 2; ++ai)
#pragma unroll
                for (int m = 0; m < 4; ++m)
#pragma unroll
                    for (int bj = 0; bj < 2; ++bj) { const f32x4 a = acc[ai][bj][m][0], b = acc[ai][bj][m][1];
                        float ss = ((a[0] * a[0] + a[1] * a[1]) + (a[2] * a[2] + a[3] * a[3])) + ((b[0] * b[0] + b[1] * b[1]) + (b[2] * b[2] + b[3] * b[3]));
                        ss += __shfl_xor(ss, 16); ss += __shfl_xor(ss, 32);
                        if (fq == 0) part[((ai * HALF + wr * 64 + m * 16 + fr) * 2 + bj) * 4 + wc] = ss; }
            asm volatile("s_waitcnt lgkmcnt(0)" ::: "memory"); __builtin_amdgcn_s_barrier(); asm volatile("" ::: "memory");
            const f32x4 gv0 = *(const f32x4*)(gain + wc * 32 + 8 * fq), gv1 = *(const f32x4*)(gain + wc * 32 + 8 * fq + 4);
#pragma unroll
            for (int ai = 0; ai < 2; ++ai)
#pragma unroll
                for (int m = 0; m < 4; ++m)
#pragma unroll
                    for (int bj = 0; bj < 2; ++bj) { const f32x4 p4 = *(const LAS f32x4*)(part + ((ai * HALF + wr * 64 + m * 16 + fr) * 2 + bj) * 4);
                        const float r2 = __builtin_amdgcn_rsqf(((p4[0] + p4[1]) + (p4[2] + p4[3])) * (1.0f / 128.0f) + RMS_EPS);
                        acc[ai][bj][m][0] *= gv0 * r2; acc[ai][bj][m][1] *= gv1 * r2; }
        }
#pragma unroll
        for (int ai = 0; ai < 2; ++ai)
#pragma unroll
            for (int m = 0; m < 4; ++m) { const int row = row0 + ai * HALF + m * 16;
                bf16_t* rowp = O + (size_t)row * ldc + col0;
#pragma unroll
                for (int bj = 0; bj < 2; ++bj) { const f32x4 v0 = acc[ai][bj][m][0], v1 = acc[ai][bj][m][1];
                    u32x4 w; w.x = cvt_pk_bf16(v0[0], v0[1]); w.y = cvt_pk_bf16(v0[2], v0[3]); w.z = cvt_pk_bf16(v1[0], v1[1]); w.w = cvt_pk_bf16(v1[2], v1[3]);
                    *(u32x4*)(rowp + bj * HALF) = w;
                    if (fgout && bj == 0 && u.pn == fg_tile && wc == 0 && fq < 2) { float* fp = fgout + (size_t)row * 16 + 8 * fq; *(f32x4*)fp = v0; *(f32x4*)(fp + 4) = v1; } } }
    }
};
struct EpiSwiGLU {
    bf16_t* O; int ldc; const u64* ssq;
    __device__ __forceinline__ void operator()(f32x4 (&acc)[2][2][4][2], const Unit& u, int wr, int wc, int fr, int fq, LAS unsigned char*) const {
        const int row0 = u.pm * BM + wr * 64 + fr; const int col0 = u.pn * HALF + wc * 32 + 8 * fq;
        float rsv[2][4];
#pragma unroll
        for (int ai = 0; ai < 2; ++ai)
#pragma unroll
            for (int m = 0; m < 4; ++m) rsv[ai][m] = rs_from_ssq(ssq[row0 + ai * HALF + m * 16]);
#pragma unroll
        for (int ai = 0; ai < 2; ++ai)
#pragma unroll
            for (int m = 0; m < 4; ++m) { const int row = row0 + ai * HALF + m * 16; const float rs = rsv[ai][m];
                float h[8];
#pragma unroll
                for (int n = 0; n < 2; ++n)
#pragma unroll
                    for (int j = 0; j < 4; ++j) { const float g = acc[ai][0][m][n][j] * rs, uu = acc[ai][1][m][n][j] * rs;
                        const float e = __builtin_amdgcn_exp2f(-g * LOG2E); h[n * 4 + j] = g * __builtin_amdgcn_rcpf(1.0f + e) * uu; }
                u32x4 w; w.x = cvt_pk_bf16(h[0], h[1]); w.y = cvt_pk_bf16(h[2], h[3]); w.z = cvt_pk_bf16(h[4], h[5]); w.w = cvt_pk_bf16(h[6], h[7]);
                const int kt = col0 >> 6, hh = (row >> 7) & 1;
                __builtin_nontemporal_store(w, (u32x4*)(O + ((size_t)((size_t)u.pm * (ldc >> 6) + kt) * 2 + hh) * (HALF * BK) + (size_t)(row & 127) * BK + (col0 & 63))); }
    }
};
struct EpiResid {
    const float* xin; float* xout; bf16_t* xb; u64* ssq_out; unsigned char* xb8; float alpha;
    __device__ __forceinline__ void operator()(f32x4 (&acc)[2][2][4][2], const Unit& u, int wr, int wc, int fr, int fq, LAS unsigned char*) const {
        const int row0 = u.pm * BM + wr * 64 + fr; const int col0 = u.pn * BM + wc * 32 + 8 * fq;
#pragma unroll
        for (int ai = 0; ai < 2; ++ai) {
            f32x4 xi[4][2][2];
#pragma unroll
            for (int m = 0; m < 4; ++m) { const size_t off = (size_t)(row0 + ai * HALF + m * 16) * DM + col0;
#pragma unroll
                for (int bj = 0; bj < 2; ++bj) { xi[m][bj][0] = __builtin_nontemporal_load((const f32x4*)(xin + off + bj * HALF)); xi[m][bj][1] = __builtin_nontemporal_load((const f32x4*)(xin + off + bj * HALF + 4)); } }
            asm volatile("" ::: "memory");
#pragma unroll
            for (int m = 0; m < 4; ++m) { const int row = row0 + ai * HALF + m * 16; const size_t off = (size_t)row * DM + col0; float ss = 0.f;
#pragma unroll
                for (int bj = 0; bj < 2; ++bj) {
                    const f32x4 v0 = xi[m][bj][0] + acc[ai][bj][m][0] * alpha, v1 = xi[m][bj][1] + acc[ai][bj][m][1] * alpha;
                    __builtin_nontemporal_store(v0, (f32x4*)(xout + off + bj * HALF)); __builtin_nontemporal_store(v1, (f32x4*)(xout + off + bj * HALF + 4));
                    u32x4 w; w.x = cvt_pk_bf16(v0[0], v0[1]); w.y = cvt_pk_bf16(v0[2], v0[3]); w.z = cvt_pk_bf16(v1[0], v1[1]); w.w = cvt_pk_bf16(v1[2], v1[3]);
                    *(u32x4*)(xb + off + bj * HALF) = w;
                    if (xb8) { int q0 = __builtin_amdgcn_cvt_pk_fp8_f32(v0[0], v0[1], 0, false); q0 = __builtin_amdgcn_cvt_pk_fp8_f32(v0[2], v0[3], q0, true);
                               int q1 = __builtin_amdgcn_cvt_pk_fp8_f32(v1[0], v1[1], 0, false); q1 = __builtin_amdgcn_cvt_pk_fp8_f32(v1[2], v1[3], q1, true);
                               *(u32x2*)(xb8 + off + bj * HALF) = (u32x2){(unsigned)q0, (unsigned)q1}; }
                    ss += (v0[0] * v0[0] + v0[1] * v0[1]) + (v0[2] * v0[2] + v0[3] * v0[3]) + (v1[0] * v1[0] + v1[1] * v1[1]) + (v1[2] * v1[2] + v1[3] * v1[3]); }
                if (ssq_out) { ss += __shfl_xor(ss, 16); ss += __shfl_xor(ss, 32); if (fq == 0) atomicAdd(ssq_out + row, (u64)(ss * SSQ_SCALE)); } }
            asm volatile("" ::: "memory");
        }
    }
};

template <int FP8 = 0, class Epi, class Sched>
__device__ __forceinline__ void gemm_phase(LAS unsigned char* lds, const Gemm g, const Sched& S, const Epi& E, const int tid) {
    const int wid = __builtin_amdgcn_readfirstlane(tid >> 6), lane = tid & 63, wr = wid >> 2, wc = wid & 3, fr = lane & 15, fq = lane >> 4;
    const int K = g.K, nt = K / BK;
    unsigned voffA[2], voffB[2];
#pragma unroll
    for (int i = 0; i < 2; ++i) { int R, C; stage_rc(tid * 16 + i * 8192, R, C); const int Rb = (R & ~31) + perm32(R & 31);
        voffA[i] = (unsigned)(R * (g.a_tiled ? BK : g.lda) + C) * 2u; voffB[i] = (unsigned)(Rb * (g.b_tiled ? BK : g.ldb) + C) * 2u; }
    const size_t kstep = (size_t)(BK * 2), kstepA = g.a_tiled ? (size_t)(2 * HTB) : kstep, kstepB = g.b_tiled ? (size_t)(2 * HTB) : kstep;
    const size_t hstepA = g.a_tiled ? (size_t)HTB : (size_t)HALF * g.lda * 2, hstepB = g.b_tiled ? (size_t)HTB : (size_t)HALF * g.ldb * 2;
    const size_t tstepA = g.a_tiled ? (size_t)nt * 2 * HTB : 2 * hstepA, tstepB = g.b_tiled ? (size_t)nt * 2 * HTB : 2 * hstepB;
    const unsigned ldsw = (unsigned)wid * 1024u;
    const int aoff = lds_byte(wr * 64 + fr, fq * 8), boff = lds_byte(wc * 32 + fr, fq * 8);
#define PG8_SA(b, h) (((b) * 2 + (h)) * HTB)
#define PG8_SB(b, h) ((4 + (b) * 2 + (h)) * HTB)
#define PG8_STAGE(bufoff, gbase, voff) do { _Pragma("unroll") for (int _i = 0; _i < 2; ++_i) \
        __builtin_amdgcn_global_load_lds((const unsigned*)((const char*)(gbase) + (voff)[_i]), (LAS unsigned*)(lds + (bufoff) + ldsw + _i * 8192), 16, 0, 0); } while (0)
#define PG8_LD8(p_) __builtin_shufflevector(*(const LAS i32x4_t*)(p_), *(const LAS i32x4_t*)((p_) + 1024), 0, 1, 2, 3, 4, 5, 6, 7)
#define PG8_LDA(dst, b, h) do { if constexpr (FP8 == 2) { _Pragma("unroll") for (int m = 0; m < 4; ++m) dst##8[m] = PG8_LD8(lds + PG8_SA(b, h) + aoff + m * 2048); } \
        else { _Pragma("unroll") for (int m = 0; m < 4; ++m) _Pragma("unroll") for (int k = 0; k < 2; ++k) dst[m][k] = *(const LAS bf16x8*)(lds + PG8_SA(b, h) + aoff + m * 2048 + k * 1024); } } while (0)
#define PG8_LDB(dst, b, h) do { if constexpr (FP8 == 2) { _Pragma("unroll") for (int n = 0; n < 2; ++n) dst##8[n] = PG8_LD8(lds + PG8_SB(b, h) + boff + n * 2048); } \
        else { _Pragma("unroll") for (int n = 0; n < 2; ++n) _Pragma("unroll") for (int k = 0; k < 2; ++k) dst[n][k] = *(const LAS bf16x8*)(lds + PG8_SB(b, h) + boff + n * 2048 + k * 1024); } } while (0)
typedef long i64x2_t __attribute__((ext_vector_type(2)));
typedef int i32x4_t __attribute__((ext_vector_type(4)));
typedef int i32x8_t __attribute__((ext_vector_type(8)));
#define PG8_MMA(ai, bj, At, Bt) do { __builtin_amdgcn_s_setprio(1); \
        if constexpr (FP8 == 2) { _Pragma("unroll") for (int m = 0; m < 4; ++m) _Pragma("unroll") for (int n = 0; n < 2; ++n) \
            asm volatile("v_mfma_scale_f32_16x16x128_f8f6f4 %0, %1, %2, %0, %3, %3 op_sel_hi:[0,0,0]" : "+v"(acc[ai][bj][m][n]) : "v"(Bt##8[n]), "v"(At##8[m]), "v"(f8sc)); } \
        else if constexpr (FP8 == 1) { _Pragma("unroll") for (int m = 0; m < 4; ++m) _Pragma("unroll") for (int n = 0; n < 2; ++n) _Pragma("unroll") for (int k = 0; k < 2; ++k) { \
            const i64x2_t b_ = __builtin_bit_cast(i64x2_t, Bt[n][k]), a_ = __builtin_bit_cast(i64x2_t, At[m][k]); \
            acc[ai][bj][m][n] = __builtin_amdgcn_mfma_f32_16x16x32_fp8_fp8(b_[0], a_[0], acc[ai][bj][m][n], 0, 0, 0); \
            acc[ai][bj][m][n] = __builtin_amdgcn_mfma_f32_16x16x32_fp8_fp8(b_[1], a_[1], acc[ai][bj][m][n], 0, 0, 0); } } \
        else { _Pragma("unroll") for (int m = 0; m < 4; ++m) _Pragma("unroll") for (int n = 0; n < 2; ++n) _Pragma("unroll") for (int k = 0; k < 2; ++k) \
            acc[ai][bj][m][n] = __builtin_amdgcn_mfma_f32_16x16x32_bf16(Bt[n][k], At[m][k], acc[ai][bj][m][n], 0, 0, 0); } \
        __builtin_amdgcn_s_setprio(0); } while (0)
#define PG8_WAIT_V(n) asm volatile("s_waitcnt vmcnt(" #n ")" ::: "memory")
#define PG8_WAIT_L(n) asm volatile("s_waitcnt lgkmcnt(" #n ")" ::: "memory")
#define PG8_BAR __builtin_amdgcn_s_barrier()
#define PG8_SCHED __builtin_amdgcn_sched_barrier(0)
    Unit cur, nxt; int ui = 0;
    if (!S.next(0, cur)) return;
    f32x4 acc[2][2][4][2];
#pragma unroll
    for (int a = 0; a < 2; ++a)
#pragma unroll
        for (int b = 0; b < 2; ++b)
#pragma unroll
            for (int m = 0; m < 4; ++m)
#pragma unroll
                for (int n = 0; n < 2; ++n) acc[a][b][m][n] = (f32x4){0.f, 0.f, 0.f, 0.f};
    const int f8sc = 0x7f7f7f7f;
    bf16x8 At[4][2], B0[2][2], B1[2][2]; i32x8_t At8[4], B08[2], B18[2];
#ifdef PROBE_PM
#define PG8_PM(u_) ((g.pm_and & 1) ? ((u_).pm & 1) : (u_).pm)
#define PG8_PN(u_) ((g.pm_and & 2) ? ((u_).pn & 1) : (u_).pn)
#else
#define PG8_PM(u_) (u_).pm
#define PG8_PN(u_) (u_).pn
#endif
    const char* cA = (const char*)g.A + (size_t)PG8_PM(cur) * tstepA; const char* cB = (const char*)g.Bt + (size_t)PG8_PN(cur) * tstepB;
    PG8_STAGE(PG8_SB(0, 0), cB, voffB); PG8_STAGE(PG8_SB(0, 1), cB + hstepB, voffB); PG8_STAGE(PG8_SA(0, 0), cA, voffA); PG8_STAGE(PG8_SA(0, 1), cA + hstepA, voffA);
    if (wr == 1) PG8_BAR;
    PG8_WAIT_V(2); PG8_BAR;
    PG8_STAGE(PG8_SB(1, 0), cB + kstepB, voffB); PG8_STAGE(PG8_SA(1, 0), cA + kstepA, voffA); PG8_STAGE(PG8_SB(1, 1), cB + hstepB + kstepB, voffB);
    PG8_WAIT_V(6); PG8_BAR;
    for (;;) {
        const bool has_next = S.next(ui + 1, nxt);
        const char* nA = has_next ? (const char*)g.A + (size_t)PG8_PM(nxt) * tstepA : cA; const char* nB = has_next ? (const char*)g.Bt + (size_t)PG8_PN(nxt) * tstepB : cB;
        for (int t = 0; t < nt; t += 2) {
            const bool last = (t == nt - 2);
            const char* a1 = cA + (size_t)(t + 1) * kstepA;
            const char* a2 = last ? nA : cA + (size_t)(t + 2) * kstepA; const char* b2 = last ? nB : cB + (size_t)(t + 2) * kstepB;
            const char* a3 = a2 + kstepA; const char* b3 = b2 + kstepB;
            PG8_LDB(B0, 0, 0); PG8_LDB(B1, 0, 1); PG8_SCHED; PG8_LDA(At, 0, 0); PG8_STAGE(PG8_SA(1, 1), a1 + hstepA, voffA);
            PG8_WAIT_V(8); PG8_WAIT_L(0); PG8_BAR; PG8_MMA(0, 0, At, B0); PG8_MMA(0, 1, At, B1); PG8_BAR; PG8_SCHED;
            PG8_LDA(At, 0, 1); PG8_STAGE(PG8_SB(0, 0), b2, voffB); PG8_STAGE(PG8_SB(0, 1), b2 + hstepB, voffB); PG8_STAGE(PG8_SA(0, 0), a2, voffA);
            PG8_WAIT_V(8); PG8_WAIT_L(0); PG8_BAR; PG8_MMA(1, 0, At, B0); PG8_MMA(1, 1, At, B1); PG8_BAR; PG8_SCHED;
            PG8_LDB(B0, 1, 0); PG8_LDB(B1, 1, 1); PG8_SCHED; PG8_LDA(At, 1, 0); PG8_STAGE(PG8_SA(0, 1), a2 + hstepA, voffA);
            PG8_WAIT_V(8); PG8_WAIT_L(0); PG8_BAR; PG8_MMA(0, 0, At, B0); PG8_MMA(0, 1, At, B1); PG8_BAR; PG8_SCHED;
            PG8_LDA(At, 1, 1); PG8_STAGE(PG8_SB(1, 0), b3, voffB); PG8_STAGE(PG8_SB(1, 1), b3 + hstepB, voffB); PG8_STAGE(PG8_SA(1, 0), a3, voffA);
            PG8_WAIT_V(8); PG8_WAIT_L(0); PG8_BAR; PG8_MMA(1, 0, At, B0); PG8_MMA(1, 1, At, B1); PG8_BAR; PG8_SCHED;
        }
        if (wr == 0) PG8_BAR;
        if constexpr (FP8 == 2) { asm volatile("s_nop 7\n\ts_nop 7\n\ts_nop 7\n\ts_nop 7" ::: "memory"); PG8_SCHED; }
        E(acc, cur, wr, wc, fr, fq, lds + STAGE_BYTES);
        if (!has_next) break;
#pragma unroll
        for (int a = 0; a < 2; ++a)
#pragma unroll
            for (int b = 0; b < 2; ++b)
#pragma unroll
                for (int m = 0; m < 4; ++m)
#pragma unroll
                    for (int n = 0; n < 2; ++n) acc[a][b][m][n] = (f32x4){0.f, 0.f, 0.f, 0.f};
        cur = nxt; cA = nA; cB = nB; ++ui;
        if (wr == 1) PG8_BAR;
    }
    PG8_WAIT_V(0);
    PG8_BAR;
#undef PG8_SA
#undef PG8_SB
#undef PG8_STAGE
#undef PG8_LDA
#undef PG8_LD8
#undef PG8_LDB
#undef PG8_MMA
#undef PG8_WAIT_V
#undef PG8_WAIT_L
#undef PG8_BAR
#undef PG8_SCHED
}
}

#define XB_TMO      128
#define XB_XCNT(j)  (256  + 64 * (j))
#define XB_XSUB(j)  (1280 + 64 * (j))
#define XB_XGEN(j)  (2304 + 64 * (j))
#define XB_TOP      3328
#define XB_TOPGEN   3392
#define XCD_BAR_WORDS 3456
#define XB_SPIN_CAP (1u << 22)

__device__ __forceinline__ unsigned xb_ld(unsigned* p)              { return __hip_atomic_load(p, __ATOMIC_RELAXED, __HIP_MEMORY_SCOPE_AGENT); }
__device__ __forceinline__ unsigned xb_add(unsigned* p, unsigned v) { return __hip_atomic_fetch_add(p, v, __ATOMIC_RELAXED, __HIP_MEMORY_SCOPE_AGENT); }
__device__ __forceinline__ unsigned xb_xcc_id() { return (unsigned)__builtin_amdgcn_s_getreg((3 << 11) | 20) & 0xFu; }
#define XB_SPIN(cond, bar) do { unsigned _sp = 0; while (cond) { __builtin_amdgcn_s_sleep(1); \
    if ((++_sp & 255u) == 0u) { if (xb_ld(&(bar)[XB_TMO])) break; if (_sp > XB_SPIN_CAP) { atomicAdd(&(bar)[XB_TMO], 1u); break; } } } } while (0)

struct XcdBarrier { unsigned* bar; unsigned x; volatile LAS unsigned* st; };

__device__ __forceinline__ XcdBarrier xcd_barrier_post(unsigned* bar, volatile LAS unsigned* st) {
    XcdBarrier b; b.bar = bar; b.x = xb_xcc_id(); b.st = st;
    if (threadIdx.x == 0) (void)xb_add(&bar[XB_XCNT(b.x)], 1u);
    return b;
}
__device__ __forceinline__ void xcd_barrier_complete(unsigned* bar, unsigned x, unsigned& nloc, unsigned& nx) {
    const unsigned G = gridDim.x * gridDim.y * gridDim.z;
    unsigned sum, cnt, mine, sp = 0u;
    for (;;) {
        sum = 0u; cnt = 0u; mine = 0u;
#pragma unroll
        for (unsigned j = 0; j < 16; ++j) { const unsigned c = xb_ld(&bar[XB_XCNT(j)]); sum += c; cnt += (c > 0u) ? 1u : 0u; mine = (j == x) ? c : mine; }
        if (sum == G) break;
        __builtin_amdgcn_s_sleep(1);
        if ((++sp & 255u) == 0u) { if (xb_ld(&bar[XB_TMO])) break; if (sp > XB_SPIN_CAP) { atomicAdd(&bar[XB_TMO], 1u); break; } }
    }
    nloc = mine > 0u ? mine : 1u; nx = cnt > 0u ? cnt : 1u;
}
__device__ __forceinline__ void xcd_barrier(const XcdBarrier& b) {
    asm volatile("s_waitcnt vmcnt(0)" ::: "memory");
    __syncthreads();
    if (threadIdx.x == 0) {
        unsigned* bar = b.bar; unsigned bx_ = b.x; asm volatile("" : "+s"(bar), "+s"(bx_));
        __builtin_amdgcn_s_waitcnt(0);
        unsigned nloc = b.st[0], nx = b.st[1];
        if (nloc == 0u) { xcd_barrier_complete(bar, bx_, nloc, nx); b.st[0] = nloc; b.st[1] = nx; }
        const unsigned old = xb_add(&bar[XB_XSUB(bx_)], 1u);
        const unsigned gen = old / nloc;
        if (old + 1u == (gen + 1u) * nloc) {
            __builtin_amdgcn_fence(__ATOMIC_RELEASE, "agent");
            asm volatile("s_waitcnt vmcnt(0)" ::: "memory");
            const unsigned og = xb_add(&bar[XB_TOP], 1u);
            const unsigned tg = og / nx;
            if (og + 1u == (tg + 1u) * nx) xb_add(&bar[XB_TOPGEN], 1u);
            else XB_SPIN(xb_ld(&bar[XB_TOPGEN]) == tg, bar);
            __builtin_amdgcn_fence(__ATOMIC_ACQUIRE, "agent");
            xb_add(&bar[XB_XGEN(bx_)], 1u);
            asm volatile("s_waitcnt vmcnt(0)" ::: "memory");
        } else {
            XB_SPIN(xb_ld(&bar[XB_XGEN(bx_)]) == gen, bar);
            __builtin_amdgcn_fence(__ATOMIC_ACQUIRE, "agent");
            asm volatile("s_waitcnt vmcnt(0)" ::: "memory");
        }
    }
    __syncthreads();
}

namespace att {
constexpr int NW = 8, QBLK = 32, KVBLK = 64;
constexpr float THR2 = 8.f * LOG2E;
enum { K_MEM = 0, K_FOX = 1, K_MLA = 2, K_DIL = 3, K_DSA = 4 };
constexpr int L_V = 0, L_K = 49152, L_XB = 100352, L_TBL = 106496, L_END = 141312, VB = 16384;

struct AP {
    const bf16_t* Q; const bf16_t* K; const bf16_t* V; bf16_t* O;
    long qs, ks, vs, os;
    int kt0, nt;
    int q0;
    float C;
    const float* cum; long cums;
    const u64* msk;
    float* ost; long osts;
    float* mst; long msts;
    int carry_in, carry_out;
    int o8;
    const float* t5; int head, dil;
};

#define ATT_SBAR() __builtin_amdgcn_sched_barrier(0)
__device__ __forceinline__ int crow(int r, int hi) { return (r & 3) + 8 * (r >> 2) + 4 * hi; }
__device__ __forceinline__ int t5_bucket(int dist) {
    const int n = dist < 0 ? 0 : dist; if (n < 16) return n;
    const float v = __log2f((float)n * 0.0625f) * (16.0f / 7.0f); int b = 16 + (int)v; return b > 31 ? 31 : b;
}
__device__ __forceinline__ void rowmax_decide(const f32x16& p0, const f32x16& p1, float& m_reg, float& alpha) {
    float pmax = p0[0];
#pragma unroll
    for (int r = 1; r < 16; ++r) pmax = fmaxf(pmax, p0[r]);
#pragma unroll
    for (int r = 0; r < 16; ++r) pmax = fmaxf(pmax, p1[r]);
    { auto rr = __builtin_amdgcn_permlane32_swap(__float_as_uint(pmax), __float_as_uint(pmax), false, false); pmax = fmaxf(__uint_as_float(rr[0]), __uint_as_float(rr[1])); }
    if (__builtin_expect(__all(pmax - m_reg <= THR2), 1)) { alpha = 1.f; }
    else { const float mn = fmaxf(m_reg, pmax); alpha = __builtin_amdgcn_exp2f(m_reg - mn); m_reg = mn; }
}
__device__ __forceinline__ float half_sum(float ps) {
    auto rr = __builtin_amdgcn_permlane32_swap(__float_as_uint(ps), __float_as_uint(ps), false, false); return __uint_as_float(rr[0]) + __uint_as_float(rr[1]);
}
__device__ __forceinline__ void pack_p(const f32x16& p0, const f32x16& p1, bf16x8& pa0, bf16x8& pa1, bf16x8& pa2, bf16x8& pa3) {
#define ATT_PK4(P, BASE, OUT) do { unsigned a0 = cvt_pk_bf16(P[BASE + 0], P[BASE + 1]), a1 = cvt_pk_bf16(P[BASE + 2], P[BASE + 3]);   \
    unsigned b0 = cvt_pk_bf16(P[BASE + 4], P[BASE + 5]), b1 = cvt_pk_bf16(P[BASE + 6], P[BASE + 7]);                              \
    auto r0 = __builtin_amdgcn_permlane32_swap(a0, b0, false, false); auto r1 = __builtin_amdgcn_permlane32_swap(a1, b1, false, false); \
    u32x4 w = {r0[0], r1[0], r0[1], r1[1]}; OUT = __builtin_bit_cast(bf16x8, w); } while (0)
    ATT_PK4(p0, 0, pa0); ATT_PK4(p0, 8, pa1); ATT_PK4(p1, 0, pa2); ATT_PK4(p1, 8, pa3);
#undef ATT_PK4
}
template <int DK, int NQL>
__device__ __forceinline__ void qkt(f32x16& p0, f32x16& p1, const LAS unsigned char* Ks, const int (&kad)[4], const bf16x8* qr, const LAS unsigned char* qsp) {
    p0 = f32x16{}; p1 = f32x16{};
    constexpr int ND = DK / 16, NQR = ND - NQL;
#define ATT_LDK(d, hf) (*(const LAS bf16x8*)(Ks + ((DK == 128) ? (kad[(d) & 3] ^ (((d) >> 2) ? 128 : 0)) : (kad[(d) & 3] + 128 * ((d) >> 2))) + (hf) * 32 * DK * 2))
#define ATT_LDQ(d) (((d) < NQR) ? qr[(d) < NQR ? (d) : 0] : *(const LAS bf16x8*)(qsp + ((d) - NQR) * 1024))
    bf16x8 b0 = ATT_LDK(0, 0), b1 = ATT_LDK(0, 1), qf = ATT_LDQ(0);
#pragma unroll
    for (int d0 = 0; d0 < ND; ++d0) {
        bf16x8 c0 = b0, c1 = b1, qn = qf;
        if (d0 + 1 < ND) { c0 = ATT_LDK(d0 + 1, 0); c1 = ATT_LDK(d0 + 1, 1); qn = ATT_LDQ(d0 + 1); }
        ATT_SBAR();
        p0 = __builtin_amdgcn_mfma_f32_32x32x16_bf16(b0, qf, p0, 0, 0, 0);
        p1 = __builtin_amdgcn_mfma_f32_32x32x16_bf16(b1, qf, p1, 0, 0, 0);
        ATT_SBAR();
        b0 = c0; b1 = c1; qf = qn; }
#undef ATT_LDK
#undef ATT_LDQ
}
__device__ __forceinline__ int v_st(int k, int c) { const int kk = (k & ~0xC) | ((k & 4) << 1) | ((k & 8) >> 1); return ((kk >> 3) * 4 + (c >> 5)) * 512 + ((kk & 7) * 32 + (c & 31)) * 2; }
__device__ __forceinline__ int v_rd_base(int lane) { return ((lane & 3) << 3) | (((lane >> 2) & 3) << 6) | (((lane >> 4) & 1) << 5) | (((lane >> 5) & 1) << 8); }
constexpr int v_rd_off(int d0, int ks, int half) { return d0 * 512 + ks * 4096 + half * 2048; }
template <int OFF> __device__ __forceinline__ s16x4 tr_read(int vb) { s16x4 r; asm volatile("ds_read_b64_tr_b16 %0, %1 offset:%2" : "=&v"(r) : "v"(vb), "i"(OFF) : "memory"); return r; }
struct VF { s16x4 l0, h0, l1, h1, l2, h2, l3, h3; };
template <int D0> __device__ __forceinline__ void pv_read(VF& f, int vb) {
    f.l0 = tr_read<v_rd_off(D0, 0, 0)>(vb); f.h0 = tr_read<v_rd_off(D0, 0, 1)>(vb); f.l1 = tr_read<v_rd_off(D0, 1, 0)>(vb); f.h1 = tr_read<v_rd_off(D0, 1, 1)>(vb);
    f.l2 = tr_read<v_rd_off(D0, 2, 0)>(vb); f.h2 = tr_read<v_rd_off(D0, 2, 1)>(vb); f.l3 = tr_read<v_rd_off(D0, 3, 0)>(vb); f.h3 = tr_read<v_rd_off(D0, 3, 1)>(vb);
}
#define ATT_VWAIT(n, f) asm volatile("s_waitcnt lgkmcnt(" #n ")" : "+v"(f.l0), "+v"(f.h0), "+v"(f.l1), "+v"(f.h1), "+v"(f.l2), "+v"(f.h2), "+v"(f.l3), "+v"(f.h3) :: "memory")
#define ATT_PK(L, H) (bf16x8){L[0], L[1], L[2], L[3], H[0], H[1], H[2], H[3]}
__device__ __forceinline__ void pv_only(f32x16* o, int vb, bf16x8 pa0, bf16x8 pa1, bf16x8 pa2, bf16x8 pa3) {
    VF fa, fb;
#define ATT_MMA4(od, f) do { od = __builtin_amdgcn_mfma_f32_32x32x16_bf16(pa0, ATT_PK(f.l0, f.h0), od, 0, 0, 0); od = __builtin_amdgcn_mfma_f32_32x32x16_bf16(pa1, ATT_PK(f.l1, f.h1), od, 0, 0, 0); \
        od = __builtin_amdgcn_mfma_f32_32x32x16_bf16(pa2, ATT_PK(f.l2, f.h2), od, 0, 0, 0); od = __builtin_amdgcn_mfma_f32_32x32x16_bf16(pa3, ATT_PK(f.l3, f.h3), od, 0, 0, 0); } while (0)
    pv_read<0>(fa, vb); pv_read<1>(fb, vb);
    ATT_VWAIT(8, fa); ATT_SBAR(); ATT_MMA4(o[0], fa); ATT_SBAR(); pv_read<2>(fa, vb);
    ATT_VWAIT(8, fb); ATT_SBAR(); ATT_MMA4(o[1], fb); ATT_SBAR(); pv_read<3>(fb, vb);
    ATT_VWAIT(8, fa); ATT_SBAR(); ATT_MMA4(o[2], fa); ATT_SBAR();
    ATT_VWAIT(0, fb); ATT_SBAR(); ATT_MMA4(o[3], fb);
#undef ATT_MMA4
}
__device__ __forceinline__ float sm_only(f32x16& p0, f32x16& p1, float m) {
    float s = 0.f;
#pragma unroll
    for (int r = 0; r < 16; ++r) { p0[r] = __builtin_amdgcn_exp2f(p0[r] - m); s += p0[r]; }
#pragma unroll
    for (int r = 0; r < 16; ++r) { p1[r] = __builtin_amdgcn_exp2f(p1[r] - m); s += p1[r]; }
    return s;
}
__device__ __forceinline__ float pv_sm(f32x16* o, int vb, bf16x8 pa0, bf16x8 pa1, bf16x8 pa2, bf16x8 pa3, f32x16& p0, f32x16& p1, float m) {
    VF fa, fb; float s = 0.f;
#define ATT_GAP(od, pa, L, H, X, B) do { od = __builtin_amdgcn_mfma_f32_32x32x16_bf16(pa, ATT_PK(L, H), od, 0, 0, 0); \
        { float t0_ = X[B] - m, t1_ = X[B + 1] - m, e0_, e1_; asm volatile("v_exp_f32 %0, %1" : "=v"(e0_) : "v"(t0_)); asm volatile("v_exp_f32 %0, %1" : "=v"(e1_) : "v"(t1_));     \
          X[B] = e0_; X[B + 1] = e1_; s += e0_; s += e1_; } ATT_SBAR(); } while (0)
    pv_read<0>(fa, vb); pv_read<1>(fb, vb);
    ATT_VWAIT(8, fa); ATT_SBAR();
    ATT_GAP(o[0], pa0, fa.l0, fa.h0, p0, 0); ATT_GAP(o[0], pa1, fa.l1, fa.h1, p0, 2); ATT_GAP(o[0], pa2, fa.l2, fa.h2, p0, 4); ATT_GAP(o[0], pa3, fa.l3, fa.h3, p0, 6);
    pv_read<2>(fa, vb); ATT_VWAIT(8, fb); ATT_SBAR();
    ATT_GAP(o[1], pa0, fb.l0, fb.h0, p0, 8); ATT_GAP(o[1], pa1, fb.l1, fb.h1, p0, 10); ATT_GAP(o[1], pa2, fb.l2, fb.h2, p0, 12); ATT_GAP(o[1], pa3, fb.l3, fb.h3, p0, 14);
    pv_read<3>(fb, vb); ATT_VWAIT(8, fa); ATT_SBAR();
    ATT_GAP(o[2], pa0, fa.l0, fa.h0, p1, 0); ATT_GAP(o[2], pa1, fa.l1, fa.h1, p1, 2); ATT_GAP(o[2], pa2, fa.l2, fa.h2, p1, 4); ATT_GAP(o[2], pa3, fa.l3, fa.h3, p1, 6);
    ATT_VWAIT(0, fb); ATT_SBAR();
    ATT_GAP(o[3], pa0, fb.l0, fb.h0, p1, 8); ATT_GAP(o[3], pa1, fb.l1, fb.h1, p1, 10); ATT_GAP(o[3], pa2, fb.l2, fb.h2, p1, 12); ATT_GAP(o[3], pa3, fb.l3, fb.h3, p1, 14);
#undef ATT_GAP
    return s;
}

template <int KIND>
__device__ __forceinline__ void score(f32x16& p0, f32x16& p1, const AP& a, int t, int buf, LAS unsigned char* lds, int wid, int r32, int hi, float cq) {
    const float C = a.C; const int k0 = t * 64; const int q = a.q0 + wid * 32 + r32; const float NEG = -INFINITY;
    if constexpr (KIND == K_FOX) {
        const LAS f32x4* cb = (const LAS f32x4*)(lds + L_XB + buf * 2048) + hi;
#pragma unroll
        for (int g = 0; g < 4; ++g) { const f32x4 c4 = cb[2 * g], c4b = cb[2 * g + 8];
#pragma unroll
            for (int j = 0; j < 4; ++j) { p0[4 * g + j] = fmaf(p0[4 * g + j], C, -c4[j]); p1[4 * g + j] = fmaf(p1[4 * g + j], C, -c4b[j]); } }
    } else if constexpr (KIND == K_DSA || KIND == K_DIL) {
        const LAS float* tb = (const LAS float*)(lds + L_TBL) + (q - k0 - 4 * hi + 256 - 59);
#pragma unroll
        for (int r = 0; r < 16; ++r) { const int cc = (r & 3) + 8 * (r >> 2); p0[r] = fmaf(p0[r], C, tb[59 - cc]); p1[r] = fmaf(p1[r], C, tb[59 - cc - 32]); }
        if constexpr (KIND == K_DSA) {
            const LAS unsigned* mb = (const LAS unsigned*)(lds + L_XB + buf * 2048) + wid * 64;
            const unsigned wl = mb[r32] >> (4 * hi), wh = mb[32 + r32] >> (4 * hi);
#pragma unroll
            for (int r = 0; r < 16; ++r) { const int cc = (r & 3) + 8 * (r >> 2); p0[r] = ((wl >> cc) & 1u) ? p0[r] : NEG; p1[r] = ((wh >> cc) & 1u) ? p1[r] : NEG; }
        }
    } else {
#pragma unroll
        for (int r = 0; r < 16; ++r) { p0[r] *= C; p1[r] *= C; }
    }
    if constexpr (KIND == K_FOX || KIND == K_MLA) {
        if (k0 + 63 > a.q0) {
            const int kb = k0 + 4 * hi;
#pragma unroll
            for (int r = 0; r < 16; ++r) { const int kv = kb + (r & 3) + 8 * (r >> 2); if (kv > q) p0[r] = NEG; if (kv + 32 > q) p1[r] = NEG; }
        }
    }
}

template <int KIND, int DK>
__device__ __forceinline__ void attn_unit(LAS unsigned char* lds, const AP& a, const int wave_id) {
    const int tid = tid_opaque(wave_id);
    const int lane = tid & 63, r32 = lane & 31, hi = lane >> 5; const int wid = __builtin_amdgcn_readfirstlane(tid >> 6);
    constexpr bool HAS_TBL = (KIND == K_DSA || KIND == K_DIL), HAS_X = (KIND == K_FOX || KIND == K_DSA);
    constexpr int KB = KVBLK * DK * 2, NKC = DK / 8, NKL = (64 * NKC) / 512, ND0 = DK / 16;
    constexpr int NQL = (DK == 192) ? 2 : (HAS_TBL ? 2 : 4), NQR = ND0 - NQL, NLD = NKL + 2 + (HAS_X ? 1 : 0);
    constexpr int LWS = (DK == 192) ? 122880 : 98304, LQSP = (DK == 192) ? 124928 : (HAS_TBL ? 123904 : 106496);
    LAS unsigned char* V_lds = lds + L_V; LAS unsigned char* K_lds = lds + L_K;
    LAS float* wsf = (LAS float*)(lds + LWS) + wid * 64; LAS float* li_l = wsf; LAS float* al_l = wsf + 32;
    LAS unsigned char* qsp = lds + LQSP + wid * (NQL * 1024) + lane * 16;
    float m_reg = -1e30f, l_reg = 0.f; f32x16 o[4] = {}; bf16x8 qr[NQR];
    const int qi = wid * 32 + r32;
    const bf16_t* Qw = a.Q + (long)qi * a.qs + hi * 8;
#pragma unroll
    for (int d0 = 0; d0 < ND0; ++d0) { const bf16x8 qv = *(const bf16x8*)(Qw + d0 * 16); if (d0 < NQR) qr[d0 < NQR ? d0 : 0] = qv; else *(LAS bf16x8*)(qsp + (d0 - NQR) * 1024) = qv; }
    float cq = 0.f;

    if constexpr (KIND == K_DIL) {
        if (a.carry_in) {
            m_reg = a.mst[(long)qi * a.msts]; l_reg = a.mst[(long)qi * a.msts + 1];
#pragma unroll
            for (int r = 0; r < 16; ++r) { const unsigned* orow = (const unsigned*)a.ost + (long)(wid * 32 + crow(r, hi)) * a.osts + r32;
                const unsigned w0 = __builtin_nontemporal_load(orow), w1 = __builtin_nontemporal_load(orow + 32);
                o[0][r] = bf_lo(w0); o[1][r] = bf_hi(w0); o[2][r] = bf_lo(w1); o[3][r] = bf_hi(w1); }
        }
    }
    if constexpr (KIND == K_DSA) {
        LAS float* tbl = (LAS float*)(lds + L_TBL);
        for (int i = tid; i < 4352; i += 512) { const int dist = i - 256; tbl[i] = dist < 0 ? -INFINITY : a.t5[t5_bucket(dist) * 16 + a.head] * LOG2E; }
    }
    if constexpr (KIND == K_DIL) {
        LAS float* tbl = (LAS float*)(lds + L_TBL);
        for (int i = tid; i < 640; i += 512) { const int rel = i - 256; tbl[i] = (rel < 0 || rel > 128) ? -INFINITY : a.t5[t5_bucket(rel * a.dil) * 16 + a.head] * LOG2E; }
    }
    int ksrc[NKL], vsrc[2];
#pragma unroll
    for (int c = 0; c < NKL; ++c) { const int Lb = (wid * NKL + c) * 1024 + lane * 16, row = Lb / (DK * 2), chp = (Lb % (DK * 2)) / 16; ksrc[c] = row * (int)a.ks + ((DK == 128) ? (chp ^ (row & 15)) : ((chp & ~7) | ((chp & 7) ^ (row & 7)))) * 8; }
#pragma unroll
    for (int c = 0; c < 2; ++c) { const int sl = (2 * wid + c) * 64 + lane, st = sl >> 5, wi = sl & 31, kk = ((st >> 2) << 3) | (wi >> 2), k = (kk & ~0xC) | ((kk & 4) << 1) | ((kk & 8) >> 1); vsrc[c] = k * (int)a.vs + (st & 3) * 32 + (wi & 3) * 8; }
    const int vb0 = (int)(unsigned)(uintptr_t)V_lds + v_rd_base(lane);
    int kad[4];
#pragma unroll
    for (int j = 0; j < 4; ++j) kad[j] = r32 * (DK * 2) + (((hi | (j << 1)) ^ (r32 & 7)) << 4) + ((DK == 128) ? 128 * ((r32 >> 3) & 1) : 0);
#define ATT_DMA(t, sl) do { const long kb_ = (long)(t) * 64; \
        _Pragma("unroll") for (int c_ = 0; c_ < NKL; ++c_) __builtin_amdgcn_global_load_lds((const unsigned*)(a.K + kb_ * a.ks + ksrc[c_]), (LAS unsigned*)(K_lds + (sl) * KB + (wid * NKL + c_) * 1024), 16, 0, 0); \
        _Pragma("unroll") for (int c_ = 0; c_ < 2; ++c_) __builtin_amdgcn_global_load_lds((const unsigned*)(a.V + kb_ * a.vs + vsrc[c_]), (LAS unsigned*)(V_lds + (sl) * VB + (2 * wid + c_) * 1024), 16, 0, 0); \
        if constexpr (KIND == K_FOX) __builtin_amdgcn_global_load_lds((const unsigned*)(a.cum + (kb_ + lane) * a.cums), (LAS unsigned*)(lds + L_XB + (sl) * 2048), 4, 0, 0);     \
        if constexpr (KIND == K_DSA) __builtin_amdgcn_global_load_lds((const unsigned*)(a.msk + (long)(wid * 32 + r32) * 64 + (t)) + hi, (LAS unsigned*)(lds + L_XB + (sl) * 2048 + wid * 256), 4, 0, 0); } while (0)
#define ATT_RESC(al) do { if (__any((al) < 1.f)) { if (hi == 0) al_l[r32] = (al); asm volatile("s_waitcnt lgkmcnt(0)" ::: "memory"); \
        _Pragma("unroll") for (int d = 0; d < 4; ++d) _Pragma("unroll") for (int r = 0; r < 16; ++r) o[d][r] *= al_l[crow(r, hi)]; } } while (0)
#define ATT_BAR() do { asm volatile("s_waitcnt lgkmcnt(0)" ::: "memory"); __builtin_amdgcn_s_barrier(); asm volatile("" ::: "memory"); } while (0)
    f32x16 p0, p1; float al = 1.f; bf16x8 pa0, pa1, pa2, pa3; const int NT = a.nt, T0 = a.kt0;
    asm volatile("s_waitcnt vmcnt(0) lgkmcnt(0)" ::: "memory");
    ATT_DMA(T0, 0);
    if (NT > 1) { ATT_DMA(T0 + 1, 1); asm volatile("s_waitcnt vmcnt(%0)" :: "n"(NLD) : "memory"); } else { asm volatile("s_waitcnt vmcnt(0)" ::: "memory"); }
    ATT_BAR();
    int sl = 0, sl2 = 2;
    for (int jj = 0; jj < NT; ++jj) {
        const int t = T0 + jj;
        if (jj + 2 < NT) ATT_DMA(t + 2, sl2);
        bool lv = true; { const int k0_ = t * 64, qw_ = a.q0 + wid * 32;
            if constexpr (KIND == K_FOX || KIND == K_MLA || KIND == K_DSA) lv = k0_ <= qw_ + 31;
            if constexpr (KIND == K_DIL) lv = (k0_ <= qw_ + 31) && (k0_ + 63 >= qw_ - 128); }
        if (lv) {
            ATT_SBAR(); qkt<DK, NQL>(p0, p1, K_lds + sl * KB, kad, qr, qsp);
            score<KIND>(p0, p1, a, t, sl, lds, wid, r32, hi, cq);
            rowmax_decide(p0, p1, m_reg, al);
            const float ps = sm_only(p0, p1, m_reg);
            l_reg = l_reg * al + half_sum(ps);
            ATT_RESC(al);
            pack_p(p0, p1, pa0, pa1, pa2, pa3); ATT_SBAR();
            pv_only(o, vb0 + sl * VB, pa0, pa1, pa2, pa3);
        }
        if (jj + 2 < NT) asm volatile("s_waitcnt vmcnt(%0)" :: "n"(NLD) : "memory"); else asm volatile("s_waitcnt vmcnt(0)" ::: "memory");
        ATT_BAR();
        sl = (sl == 2) ? 0 : sl + 1; sl2 = (sl2 == 2) ? 0 : sl2 + 1;
    }
    bool stateout = false;
    if constexpr (KIND == K_DIL) stateout = a.carry_out != 0;
    if (stateout) {
        int qi2 = qi; asm volatile("" : "+v"(qi2));
        if (hi == 0) { a.mst[(long)qi2 * a.msts] = m_reg; a.mst[(long)qi2 * a.msts + 1] = l_reg; }
        asm volatile("s_nop 7\n\ts_nop 7\n\ts_nop 7" : "+v"(o[0]), "+v"(o[1]), "+v"(o[2]), "+v"(o[3]));
#pragma unroll
        for (int r = 0; r < 16; ++r) { unsigned* orow = (unsigned*)a.ost + (long)(wid * 32 + crow(r, hi)) * a.osts + r32;
            __builtin_nontemporal_store(cvt_pk_bf16(o[0][r], o[1][r]), orow); __builtin_nontemporal_store(cvt_pk_bf16(o[2][r], o[3][r]), orow + 32); }
        __syncthreads();
    } else {
        if (hi == 0) li_l[r32] = l_reg;
        asm volatile("s_waitcnt lgkmcnt(0)" ::: "memory");
        float rli[16];
#pragma unroll
        for (int r = 0; r < 16; ++r) rli[r] = __builtin_amdgcn_rcpf(li_l[crow(r, hi)]);
        __syncthreads();
        LAS unsigned short* ost = (LAS unsigned short*)(lds + wid * 8192);
#pragma unroll
        for (int r = 0; r < 16; ++r) { const int orow = crow(r, hi);
#pragma unroll
            for (int d0 = 0; d0 < 4; ++d0) { const unsigned w = cvt_pk_bf16(o[d0][r] * rli[r], 0.f); ost[orow * 128 + d0 * 32 + r32] = (unsigned short)w; } }
        asm volatile("s_waitcnt lgkmcnt(0)" ::: "memory");
#pragma unroll
        for (int i = 0; i < 8; ++i) { const int ch = lane + 64 * i, row = ch >> 4, c16 = ch & 15;
            const u32x4 v = *(const LAS u32x4*)(lds + wid * 8192 + row * 256 + c16 * 16);
            if (a.o8) {
              int q0 = __builtin_amdgcn_cvt_pk_fp8_f32(bf_lo(v.x) * 16.f, bf_hi(v.x) * 16.f, 0, false); q0 = __builtin_amdgcn_cvt_pk_fp8_f32(bf_lo(v.y) * 16.f, bf_hi(v.y) * 16.f, q0, true);
              int q1 = __builtin_amdgcn_cvt_pk_fp8_f32(bf_lo(v.z) * 16.f, bf_hi(v.z) * 16.f, 0, false); q1 = __builtin_amdgcn_cvt_pk_fp8_f32(bf_lo(v.w) * 16.f, bf_hi(v.w) * 16.f, q1, true);
              *(u32x2*)((unsigned char*)a.O + (long)(wid * 32 + row) * a.os + c16 * 8) = (u32x2){(unsigned)q0, (unsigned)q1}; }
            else *(u32x4*)(a.O + (long)(wid * 32 + row) * a.os + c16 * 8) = v; }
        __syncthreads();
    }
#undef ATT_DMA
#undef ATT_RESC
#undef ATT_BAR
}
#undef ATT_VWAIT
#undef ATT_PK
}

struct Fr { LAS unsigned char* lds; int tid, lane, wave, vcu, G, gw, ngw; };

__device__ __forceinline__ float wave_sum(float v) {
#pragma unroll
    for (int o = 1; o < 64; o <<= 1) v += __shfl_xor(v, o);
    return v;
}
__device__ __forceinline__ void unpack8(const u32x4 w, float (&v)[8]) {
    v[0] = bf_lo(w.x); v[1] = bf_hi(w.x); v[2] = bf_lo(w.y); v[3] = bf_hi(w.y); v[4] = bf_lo(w.z); v[5] = bf_hi(w.z); v[6] = bf_lo(w.w); v[7] = bf_hi(w.w);
}
__device__ __forceinline__ u32x4 pack8(const float (&v)[8]) {
    u32x4 w; w.x = cvt_pk_bf16(v[0], v[1]); w.y = cvt_pk_bf16(v[2], v[3]); w.z = cvt_pk_bf16(v[4], v[5]); w.w = cvt_pk_bf16(v[6], v[7]); return w;
}
__device__ __forceinline__ float sumsq8(const float (&v)[8]) { return ((v[0] * v[0] + v[1] * v[1]) + (v[2] * v[2] + v[3] * v[3])) + ((v[4] * v[4] + v[5] * v[5]) + (v[6] * v[6] + v[7] * v[7])); }

__device__ __forceinline__ int map_col(int kind, int n) {
    switch (kind) {
        case 1: return 256 * (n >> 7) + (n & 127);
        case 2: return 256 * (n >> 7) + 128 + (n & 127);
        case 3: return n < 6144 ? n : (n < 6160 ? 6656 + (n - 6144) : 6144 + (n - 6160));
        case 4: return n < 1088 ? n : 1280 + (n - 1088);
        case 5: return n < 6144 ? n : (n < 18432 ? n + 512 : 6144 + (n - 18432));
        case 6: return n < 4176 ? n : 4352 + (n - 4176);
        default: return n;
    }
}
struct TrDesc { const float* W; const float* gain; bf16_t* WT; int K, N, ldt, kind, r, f8, tiled; };
__device__ __forceinline__ void tr_load(const TrDesc& d, int lane, f32x4 (&v)[16]) {
    const int nblk = (d.N + 63) / 64, kb = d.r / nblk, nb = d.r % nblk, k0 = 64 * kb, n = 64 * nb + 4 * (lane & 15); const bool ok = n < d.N;
    const float* src = d.W + (size_t)(k0 + (lane >> 4)) * d.N + (ok ? n : 0); const size_t rs = (size_t)4 * d.N;
#pragma unroll
    for (int j = 0; j < 16; ++j) v[j] = __builtin_nontemporal_load((const f32x4*)(src + (size_t)j * rs));
}
__device__ __forceinline__ void tr_store(const TrDesc& d, int lane, const f32x4 (&v)[16], LAS float* scr) {
    const int nblk = (d.N + 63) / 64, kb = d.r / nblk, nb = d.r % nblk, k0 = 64 * kb, n0 = 64 * nb;
    { LAS float* w = scr + (lane >> 4) * 65 + 4 * (lane & 15);
#pragma unroll
      for (int j = 0; j < 16; ++j) { w[j * 260 + 0] = v[j][0]; w[j * 260 + 1] = v[j][1]; w[j * 260 + 2] = v[j][2]; w[j * 260 + 3] = v[j][3]; } }
    const int c = lane & 7, nn = lane >> 3; float g[8];
#pragma unroll
    for (int jj = 0; jj < 8; ++jj) g[jj] = d.gain ? d.gain[k0 + 8 * c + jj] : 1.f;
    asm volatile("s_waitcnt lgkmcnt(0)" ::: "memory");
#pragma unroll
    for (int it = 0; it < 8; ++it) { const int nl = nn + 8 * it; const LAS float* rp = scr + (8 * c) * 65 + nl;
        u32x4 o; o.x = cvt_pk_bf16(rp[0 * 65] * g[0], rp[1 * 65] * g[1]); o.y = cvt_pk_bf16(rp[2 * 65] * g[2], rp[3 * 65] * g[3]); o.z = cvt_pk_bf16(rp[4 * 65] * g[4], rp[5 * 65] * g[5]); o.w = cvt_pk_bf16(rp[6 * 65] * g[6], rp[7 * 65] * g[7]);
        if (n0 + nl < d.N) {
            if (d.f8) { int q0 = __builtin_amdgcn_cvt_pk_fp8_f32(rp[0 * 65] * g[0] * 64.f, rp[1 * 65] * g[1] * 64.f, 0, false); q0 = __builtin_amdgcn_cvt_pk_fp8_f32(rp[2 * 65] * g[2] * 64.f, rp[3 * 65] * g[3] * 64.f, q0, true);
                        int q1 = __builtin_amdgcn_cvt_pk_fp8_f32(rp[4 * 65] * g[4] * 64.f, rp[5 * 65] * g[5] * 64.f, 0, false); q1 = __builtin_amdgcn_cvt_pk_fp8_f32(rp[6 * 65] * g[6] * 64.f, rp[7 * 65] * g[7] * 64.f, q1, true);
                        *(u32x2*)((unsigned char*)d.WT + (size_t)map_col(d.kind, n0 + nl) * d.ldt + k0 + 8 * c) = (u32x2){(unsigned)q0, (unsigned)q1}; }
            else if (d.tiled) { const int n = n0 + nl;
                *(u32x4*)(d.WT + ((((size_t)(n >> 8) * (d.K >> 6) + (k0 >> 6)) * 2 + ((n >> 7) & 1)) * 128 + (n & 127)) * 64 + 8 * c) = o; }
            else *(u32x4*)(d.WT + (size_t)map_col(d.kind, n0 + nl) * d.ldt + k0 + 8 * c) = o; } }
    asm volatile("s_waitcnt lgkmcnt(0)" ::: "memory");
}

__device__ __forceinline__ void rows2048(const Fr& F, const float* x, int nrows, bf16_t* xb, void* out, int mode) {
    for (int m = F.gw; m < nrows; m += F.ngw) {
        const f32x4* xr = (const f32x4*)(x + (size_t)m * DM) + F.lane; f32x4 v[8]; float s = 0.f;
#pragma unroll
        for (int j = 0; j < 8; ++j) { v[j] = xr[64 * j]; s += (v[j].x * v[j].x + v[j].y * v[j].y) + (v[j].z * v[j].z + v[j].w * v[j].w); }
        s = wave_sum(s);
        if (F.lane == 0) { if (mode) ((float*)out)[m] = __builtin_amdgcn_rsqf(s * (1.0f / DM) + RMS_EPS); else ((u64*)out)[m] = (u64)(s * pg8::SSQ_SCALE); }
        if (xb) { u32x2* o8 = (u32x2*)(xb + (size_t)m * DM) + F.lane;
#pragma unroll
            for (int j = 0; j < 8; ++j) { u32x2 w; w.x = cvt_pk_bf16(v[j].x, v[j].y); w.y = cvt_pk_bf16(v[j].z, v[j].w); o8[64 * j] = w; } }
    }
}

__device__ __forceinline__ void hn_step(bf16_t* p, const float (&g)[8]) {
    float v[8]; unpack8(*(const u32x4*)p, v); float ss = sumsq8(v);
    ss += __shfl_xor(ss, 1); ss += __shfl_xor(ss, 2); ss += __shfl_xor(ss, 4); ss += __shfl_xor(ss, 8);
    const float rs = __builtin_amdgcn_rsqf(ss * (1.0f / 128.0f) + RMS_EPS);
#pragma unroll
    for (int j = 0; j < 8; ++j) v[j] = v[j] * rs * g[j];
    *(u32x4*)p = pack8(v);
}
__device__ __forceinline__ void load_gain8(const float* g, int lane, float (&o)[8]) {
#pragma unroll
    for (int j = 0; j < 8; ++j) o[j] = g ? g[(lane & 15) * 8 + j] : 1.f;
}
__device__ __forceinline__ void prep_rows(const Fr& F, bf16_t* P, long ld, int nrows, int c0, int n0, const float* g0, int c1, int n1, const float* g1, int c2, int n2, const float* g2) {
    float ga[8], gb[8], gc[8]; load_gain8(g0, F.lane, ga); load_gain8(g1, F.lane, gb); load_gain8(g2, F.lane, gc);
    for (int m = F.gw; m < nrows; m += F.ngw) {
        bf16_t* row = P + (size_t)m * ld + F.lane * 8;
        for (int s = 0; s < n0; ++s) hn_step(row + c0 + s * 512, ga);
        for (int s = 0; s < n1; ++s) hn_step(row + c1 + s * 512, gb);
        for (int s = 0; s < n2; ++s) hn_step(row + c2 + s * 512, gc);
    }
}

__device__ __forceinline__ void fox_cumsum(const Fr& F, const float* FG, const float* b_f, float* CUM) {
    for (int task = ((F.gw & 15) == 0) ? (F.gw >> 4) : NB * NH; task < NB * NH; task += (F.ngw >> 4)) {
        const int b = task >> 4, h = task & 15; const float bias = b_f[h];
        const float* src = FG + ((size_t)b * SEQ + (size_t)F.lane * 64) * 16 + h; float v[64]; float run = 0.f;
#pragma unroll
        for (int i = 0; i < 64; ++i) { const float xg = src[(size_t)i * 16] + bias;
            const float e = __expf(-fabsf(xg)); const float ls = fminf(xg, 0.f) - __logf(1.0f + e);
            run += ls; v[i] = run; }
        float incl = run;
#pragma unroll
        for (int o = 1; o < 64; o <<= 1) { const float t = __shfl_up(incl, o); if (F.lane >= o) incl += t; }
        const float excl = incl - run;
        float* dst = CUM + ((size_t)b * SEQ + (size_t)F.lane * 64) * 16 + h;
#pragma unroll
        for (int i = 0; i < 64; ++i) dst[(size_t)i * 16] = (v[i] + excl) * LOG2E;
    }
}

__device__ const double ROPE_INV[32] = {
    1.0, 0.7498942093324559, 0.5623413251903491, 0.4216965034285822, 0.31622776601683794, 0.23713737056616552, 0.1778279410038923, 0.1333521432163324,
    0.1, 0.07498942093324558, 0.05623413251903491, 0.04216965034285822, 0.03162277660168379, 0.023713737056616554, 0.01778279410038923, 0.01333521432163324,
    0.01, 0.007498942093324558, 0.005623413251903491, 0.004216965034285823, 0.0031622776601683794, 0.0023713737056616554, 0.001778279410038923, 0.001333521432163324,
    0.001, 0.0007498942093324559, 0.0005623413251903491, 0.0004216965034285823, 0.00031622776601683794, 0.00023713737056616554, 0.0001778279410038923, 0.0001333521432163324};
__device__ __forceinline__ void rope_table(const Fr& F, const int* pos, float* COS, float* SIN) {
    const int gt = F.vcu * 512 + F.tid, ngt = F.G * 512;
    for (int i = gt; i < MTOK * 32; i += ngt) { const int m = i >> 5, f = i & 31;
        const double a = (double)pos[m] * (double)(float)ROPE_INV[f]; const double rev = a * 0.15915494309189535; const float fr = (float)(rev - floor(rev));
        COS[i] = __builtin_amdgcn_cosf(fr); SIN[i] = __builtin_amdgcn_sinf(fr); }
}

__device__ __forceinline__ void mla_prep_a(const Fr& F, bf16_t* P, float* RSQ, float* RSKV, bf16_t* KR, const float* rope_g1, const float* gmem, const float* COS, const float* SIN) {
    const int lane = F.lane; float gr[8];
#pragma unroll
    for (int j = 0; j < 8; ++j) gr[j] = rope_g1[(lane & 7) * 8 + j];
    for (int m = F.gw; m < MTOK; m += F.ngw) {
        bf16_t* pr = P + (size_t)m * 1792; float v[8];
        const u32x4 wq = *(const u32x4*)(pr + lane * 8), wk = *(const u32x4*)(pr + 512 + lane * 8);
        u32x4 w = (u32x4){0u, 0u, 0u, 0u}; if (lane < 8) w = *(const u32x4*)(pr + 1024 + lane * 8);
        const float* cp = COS + (size_t)m * 32 + (lane & 3) * 8; const float* sp = SIN + (size_t)m * 32 + (lane & 3) * 8; float cs[8], sn[8];
#pragma unroll
        for (int j = 0; j < 8; ++j) { cs[j] = cp[j]; sn[j] = sp[j]; }
        asm volatile("" ::: "memory");
        unpack8(wq, v); float ss = wave_sum(sumsq8(v)); if (lane == 0) RSQ[m] = __builtin_amdgcn_rsqf(ss * (1.0f / 512.0f) + RMS_EPS);
        unpack8(wk, v); ss = wave_sum(sumsq8(v)); if (lane == 0) RSKV[m] = __builtin_amdgcn_rsqf(ss * (1.0f / 512.0f) + RMS_EPS);
        unpack8(w, v); ss = sumsq8(v); ss += __shfl_xor(ss, 1); ss += __shfl_xor(ss, 2); ss += __shfl_xor(ss, 4);
        const float rs = __builtin_amdgcn_rsqf(ss * (1.0f / 64.0f) + RMS_EPS); float o[8];
#pragma unroll
        for (int j = 0; j < 8; ++j) { const float x = v[j] * rs * gr[j]; const float y = __shfl_xor(x, 4); o[j] = (lane & 4) ? (y * sn[j] + x * cs[j]) : (x * cs[j] - y * sn[j]); }
        if (lane < 8) *(u32x4*)(KR + (size_t)m * 64 + lane * 8) = pack8(o);
    }
}
__device__ __forceinline__ void mla_prep_b(const Fr& F, bf16_t* Q, const bf16_t* KV, bf16_t* KF, const bf16_t* KR, const float* nope_g, const float* rope_g, const float* COS, const float* SIN) {
    const int lane = F.lane, half = lane >> 5, l5 = lane & 31; float gqn[8], gqr[8], gkn[8];
#pragma unroll
    for (int j = 0; j < 8; ++j) { gqn[j] = nope_g[(l5 & 15) * 8 + j]; gkn[j] = nope_g[128 + (l5 & 15) * 8 + j]; gqr[j] = rope_g[(l5 & 7) * 8 + j]; }
    for (int m = F.gw; m < MTOK; m += F.ngw) {
        const float* cp = COS + (size_t)m * 32 + (l5 & 3) * 8; const float* sp = SIN + (size_t)m * 32 + (l5 & 3) * 8; float cs[8], sn[8];
#pragma unroll
        for (int j = 0; j < 8; ++j) { cs[j] = cp[j]; sn[j] = sp[j]; }
        u32x4 krw = (u32x4){0u, 0u, 0u, 0u}; if (l5 >= 16 && l5 < 24) krw = *(const u32x4*)(KR + (size_t)m * 64 + (l5 - 16) * 8);
        u32x4 qw[8], kw[8];
#pragma unroll
        for (int it = 0; it < 8; ++it) { const int h = 2 * it + half;
            qw[it] = (u32x4){0u, 0u, 0u, 0u}; if (l5 < 24) qw[it] = *(const u32x4*)(Q + (size_t)m * 3072 + h * 192 + l5 * 8);
            kw[it] = (u32x4){0u, 0u, 0u, 0u}; if (l5 < 16) kw[it] = *(const u32x4*)(KV + (size_t)m * 4096 + h * 256 + l5 * 8); }
        asm volatile("" ::: "memory");
#pragma unroll
        for (int it = 0; it < 8; ++it) { const int h = 2 * it + half;
            bf16_t* qrow = Q + (size_t)m * 3072 + h * 192 + l5 * 8; float v[8];
            unpack8(qw[it], v); float s8 = sumsq8(v); s8 += __shfl_xor(s8, 1); s8 += __shfl_xor(s8, 2); s8 += __shfl_xor(s8, 4); const float s16 = s8 + __shfl_xor(s8, 8);
            const float rs = (l5 < 16) ? __builtin_amdgcn_rsqf(s16 * (1.0f / 128.0f) + RMS_EPS) : __builtin_amdgcn_rsqf(s8 * (1.0f / 64.0f) + RMS_EPS);
            float o[8];
#pragma unroll
            for (int j = 0; j < 8; ++j) { const float x = v[j] * rs * ((l5 < 16) ? gqn[j] : gqr[j]); const float y = __shfl_xor(x, 4);
                const float rot = (l5 & 4) ? (y * sn[j] + x * cs[j]) : (x * cs[j] - y * sn[j]); o[j] = (l5 < 16) ? x : rot; }
            if (l5 < 24) *(u32x4*)qrow = pack8(o);
            bf16_t* kfrow = KF + (size_t)m * 3072 + h * 192;
            unpack8(kw[it], v); float k16 = sumsq8(v); k16 += __shfl_xor(k16, 1); k16 += __shfl_xor(k16, 2); k16 += __shfl_xor(k16, 4); k16 += __shfl_xor(k16, 8);
            const float krs = __builtin_amdgcn_rsqf(k16 * (1.0f / 128.0f) + RMS_EPS);
#pragma unroll
            for (int j = 0; j < 8; ++j) o[j] = v[j] * krs * gkn[j];
            if (l5 < 16) *(u32x4*)(kfrow + l5 * 8) = pack8(o);
            else if (l5 < 24) *(u32x4*)(kfrow + 128 + (l5 - 16) * 8) = krw;
        }
    }
}

__device__ __forceinline__ void dsa_indexer(const Fr& F, const bf16_t* P, float* SC) {
    constexpr int LDP = 4864, CQI = 3072, CKI = 4096, CWI = 4160;
    constexpr int RING = 81920;
    const int lane = F.lane, r32 = lane & 31, hg = lane >> 5;
    LAS float* ibuf = (LAS float*)(F.lds + F.wave * 9216);
    const int drow = 8 * F.wave + (lane >> 3), dchunk = (lane & 7) ^ ((lane >> 3) & 7);
#define IDX_DMA(t_) __builtin_amdgcn_global_load_lds((const unsigned*)(kbase + (size_t)(t_) * 64 * LDP), (LAS unsigned*)(F.lds + RING + ((t_) & 3) * 8192 + F.wave * 1024), 16, 0, 0)
    for (int ui = blockIdx.x; ui < 512; ui += F.G) {
        const int c = ui & 255, second = ui >> 8, b = c >> 5, qb0 = c & 31, qb = second ? 63 - qb0 : qb0;
        const size_t tok0 = (size_t)b * SEQ + qb * 64 + F.wave * 8;
        bf16x8 aq[4][4]; f32x2 wv[4][8];
#pragma unroll
        for (int g = 0; g < 4; ++g) { const size_t tok = tok0 + 2 * g + (r32 >> 4); const bf16_t* qp = P + tok * LDP + CQI + (r32 & 15) * 64 + 8 * hg;
#pragma unroll
            for (int ks = 0; ks < 4; ++ks) aq[g][ks] = *(const bf16x8*)(qp + 16 * ks);
#pragma unroll
            for (int r = 0; r < 16; ++r) { const int head = (r & 3) + 8 * ((r >> 2) & 1) + 4 * hg; const size_t tq = tok0 + 2 * g + (r >> 3);
                wv[g][r >> 1][r & 1] = bf_lo((unsigned)P[tq * LDP + CWI + head]) * (0.25f * 0.125f); } }
        const int nt = qb + 1;
        const bf16_t* kbase = P + ((size_t)b * SEQ + drow) * LDP + CKI + 8 * dchunk;
        asm volatile("s_waitcnt vmcnt(0) lgkmcnt(0)" ::: "memory"); __builtin_amdgcn_s_barrier(); asm volatile("" ::: "memory");
        IDX_DMA(0); if (nt > 1) IDX_DMA(1);
        for (int t = 0; t < nt; ++t) {
            if (t + 1 < nt) asm volatile("s_waitcnt vmcnt(1)" ::: "memory"); else asm volatile("s_waitcnt vmcnt(0)" ::: "memory");
            asm volatile("s_waitcnt lgkmcnt(0)" ::: "memory"); __builtin_amdgcn_s_barrier(); asm volatile("" ::: "memory");
            if (t + 2 < nt) IDX_DMA(t + 2);
            const LAS unsigned char* slot = F.lds + RING + (t & 3) * 8192;
            bf16x8 bk[2][4];
#pragma unroll
            for (int kg = 0; kg < 2; ++kg) { const int key = kg * 32 + r32;
#pragma unroll
                for (int ks = 0; ks < 4; ++ks) bk[kg][ks] = *(const LAS bf16x8*)(slot + key * 128 + (((2 * ks + hg) ^ (key & 7)) << 4)); }
            f32x16 dcur = f32x16{};
#pragma unroll
            for (int ks = 0; ks < 4; ++ks) dcur = __builtin_amdgcn_mfma_f32_32x32x16_bf16(aq[0][ks], bk[0][ks], dcur, 0, 0, 0);
#pragma unroll
            for (int j = 0; j < 8; ++j) { const int kg = j >> 2, g = j & 3;
                f32x16 dnext = f32x16{};
                if (j < 7) {
#pragma unroll
                    for (int ks = 0; ks < 4; ++ks) dnext = __builtin_amdgcn_mfma_f32_32x32x16_bf16(aq[(j + 1) & 3][ks], bk[(j + 1) >> 2][ks], dnext, 0, 0, 0); }
                f32x2 accA = {0.f, 0.f}, accB = {0.f, 0.f};
#pragma unroll
                for (int i = 0; i < 4; ++i) { f32x2 xa, xb;
#define IDX_RELU(x_) __int_as_float(max(__float_as_int(x_), 0))
                    xa[0] = IDX_RELU(dcur[2 * i]); xa[1] = IDX_RELU(dcur[2 * i + 1]); xb[0] = IDX_RELU(dcur[8 + 2 * i]); xb[1] = IDX_RELU(dcur[9 + 2 * i]);
#undef IDX_RELU
                    accA = __builtin_elementwise_fma(wv[g][i], xa, accA); accB = __builtin_elementwise_fma(wv[g][4 + i], xb, accB); }
                const float s0 = accA[0] + accA[1], s1 = accB[0] + accB[1];
                auto rr = __builtin_amdgcn_permlane32_swap(__float_as_uint(s0), __float_as_uint(s1), false, false);
                const float tot = __uint_as_float(rr[0]) + __uint_as_float(rr[1]);
                ibuf[(2 * g + hg) * 288 + (t & 3) * 64 + kg * 32 + r32] = tot;
                if (j < 7) {
#pragma unroll
                    for (int i = 0; i < 4; ++i) { __builtin_amdgcn_sched_group_barrier(0x008, 1, 0); __builtin_amdgcn_sched_group_barrier(0x002, 6, 0); } }
                dcur = dnext;
            }
            if ((t & 3) == 3 || t == nt - 1) { const int t0 = t & ~3, cnt = (t - t0 + 1) * 64;
                if (4 * lane < cnt) {
#pragma unroll
                    for (int q = 0; q < 8; ++q) { const f32x4 v = *(const LAS f32x4*)(ibuf + q * 288 + 4 * lane);
                        __builtin_nontemporal_store(v, (f32x4*)(SC + (tok0 + q) * (size_t)SEQ + t0 * 64 + 4 * lane)); } } }
        }
    }
#undef IDX_DMA
}

__device__ __forceinline__ int dsa_qmap(const Fr& F, int k) { return k * F.ngw + ((k & 1) ? F.ngw - 1 - F.gw : F.gw); }
__device__ __forceinline__ void dsa_issue(const float* SC, int q, int lane, unsigned (&raw)[64]) {
    const int s = q & (SEQ - 1); const float* row = SC + (size_t)q * SEQ;
    if (s < 256) return;
#pragma unroll
    for (int c4 = 0; c4 < 4; ++c4) {
        if (1024 * c4 <= s) {
#pragma unroll
            for (int i = 16 * c4; i < 16 * c4 + 16; ++i) raw[i] = __float_as_uint(__builtin_nontemporal_load(row + 64 * i + lane)); }
        else {
#pragma unroll
            for (int i = 16 * c4; i < 16 * c4 + 16; ++i) raw[i] = 0u; } }
}
__device__ __forceinline__ void dsa_select(const Fr& F, const float* SC, u64* MSK) {
    const int lane = F.lane;
    int k = 0, q = dsa_qmap(F, 0); bool have = q < MTOK;
    unsigned raw[64];
#pragma unroll
    for (int i = 0; i < 64; ++i) raw[i] = 0u;
    if (have) dsa_issue(SC, q, lane, raw);
    while (have) {
        const int s = q & (SEQ - 1); u64* mrow = MSK + (size_t)q * 64;
        const int qn = dsa_qmap(F, k + 1); const bool hn = qn < MTOK;
        if (s < 256) { const int lo = 64 * lane; u64 w = 0ull; if (s >= lo + 63) w = ~0ull; else if (s >= lo) w = (2ull << (s - lo)) - 1ull; mrow[lane] = w;
            if (hn) dsa_issue(SC, qn, lane, raw); q = qn; have = hn; ++k; continue; }
        unsigned u[64];
#pragma unroll
        for (int i = 0; i < 64; ++i) { const int key = 64 * i + lane; const unsigned bits = raw[i]; const unsigned ord = (bits & 0x80000000u) ? ~bits : (bits | 0x80000000u); u[i] = (key <= s) ? ord : 0u; }
        if (hn) dsa_issue(SC, qn, lane, raw);
        unsigned T = 0u; const int ng = (s >> 9) + 1;
        for (int bit = 31; bit >= 0; --bit) { const unsigned cand = T | (1u << bit); int cl = 0;
#pragma unroll
            for (int g8 = 0; g8 < 8; ++g8) { if (g8 >= ng) break;
                u64 m[8];
#pragma unroll
                for (int j = 0; j < 8; ++j) asm("v_cmp_le_u32_e64 %0, %1, %2" : "=s"(m[j]) : "s"(cand), "v"(u[8 * g8 + j]));
#pragma unroll
                for (int j = 0; j < 8; ++j) cl += __popcll(m[j]); }
            cl = __builtin_amdgcn_readfirstlane(cl);
            if (cl >= 256) { T = cand; if (cl == 256) break; } }
        int cgt = 0;
#pragma unroll
        for (int g8 = 0; g8 < 8; ++g8) { if (g8 >= ng) break;
            u64 m[8];
#pragma unroll
            for (int j = 0; j < 8; ++j) asm("v_cmp_lt_u32_e64 %0, %1, %2" : "=s"(m[j]) : "s"(T), "v"(u[8 * g8 + j]));
#pragma unroll
            for (int j = 0; j < 8; ++j) cgt += __popcll(m[j]); }
        int need = 256 - __builtin_amdgcn_readfirstlane(cgt); unsigned mlo = 0u, mhi = 0u;
#pragma unroll
        for (int i = 0; i < 64; ++i) { if ((i & 7) == 0 && (i >> 3) >= ng) break;
            const u64 gt = __ballot(u[i] > T), eq = __ballot(u[i] == T); u64 take = 0ull;
            if (need > 0 && eq != 0ull) { const int c = __popcll(eq);
                if (c <= need) { take = eq; need -= c; }
                else { u64 e = eq; for (int n = 0; n < need; ++n) { const u64 low = e & (0ull - e); take |= low; e ^= low; } need = 0; } }
            const u64 w = gt | take; const bool me = lane == i;
            mlo = me ? (unsigned)w : mlo; mhi = me ? (unsigned)(w >> 32) : mhi; }
        mrow[lane] = ((u64)mhi << 32) | (u64)mlo;
        q = qn; have = hn; ++k;
    }
}

constexpr size_t MiB = 1u << 20;
constexpr size_t WS_CTL = 0, CTL_ZERO_BYTES = 8 * MiB;
constexpr int CW_BAR = 4096;
constexpr size_t WS_SSQ = 1 * MiB;
constexpr size_t WS_WB = 8 * MiB;
constexpr size_t WS_XB = 236 * MiB;
constexpr size_t WS_MEMB = 364 * MiB;
constexpr size_t WS_MEMKV = 372 * MiB;
constexpr size_t WS_COS = 388 * MiB, WS_SIN = 392 * MiB, WS_RSMEM = 396 * MiB, WS_RSQ = 397 * MiB, WS_RSKV = 398 * MiB;
constexpr size_t WS_XB8 = 560 * MiB;
constexpr size_t WS_MIX = 400 * MiB;
constexpr size_t WS_SCR = 624 * MiB;
constexpr size_t WS_END = (624 + 832) * MiB;
constexpr size_t WB_GU0 = 0, WB_GU1 = 23068672, WB_D0 = 46137344, WB_D1 = 57671680, WB_IN = 69206016, WB_OUT = 108003328, WB_MKV = 113246208, WB_UQ = 115343360, WB_UKV = 116916224;
constexpr int RING_BYTES = 146944, MISC_OFF = RING_BYTES + 64, LDS_BYTES = 147456;
static_assert(att::L_END <= RING_BYTES && pg8::STAGE_BYTES <= RING_BYTES, "LDS map");
constexpr int NPHASES = 44;
#ifndef F8MASK
#define F8MASK 4
#endif
#define F8LAYER(L) (((F8MASK) >> (L)) & 1)
#ifndef RG
#define RG 1
#endif
#ifndef RD
#define RD 1
#endif
#ifndef RI
#define RI 1
#endif
#ifndef RA
#define RA 1
#endif
#ifndef F8OUT
#define F8OUT 0
#endif
#define F8OUTL(L_) (((F8OUT) >> (L_)) & 1)
#ifndef F8MODE
#define F8MODE 2
#endif
#ifndef RCV
#define RCV 1
#endif
#ifndef RIX
#define RIX 1
#endif
#ifndef RSL
#define RSL 1
#endif
#ifndef RC
#define RC 1
#endif
#define REP(n) for (int rep_ = 0; rep_ < (n); ++rep_)

struct Args { const void* in[27]; float* out; unsigned char* ws; int ph_lo, ph_hi; };

typedef const __attribute__((address_space(4))) struct Args* ArgsPc;
__device__ __forceinline__ TrDesc tr_desc(ArgsPc A, int L, bf16_t* WB, int it) {
    const float* w_gate = (const float*)A->in[5]; const float* w_up = (const float*)A->in[6]; const float* w_down = (const float*)A->in[7];
    const float* ffn_norm = (const float*)A->in[4]; const float* attn_norm = (const float*)A->in[8];
    const float* w_out = (const float*)A->in[12];
    const float* w_in = (const float*)(L == 0 ? A->in[13] : L == 1 ? A->in[16] : L == 2 ? A->in[23] : A->in[25]);
    const int nin = (L == 0 ? 6672 : L == 1 ? 1600 : L == 2 ? 18944 : 4688);
    const int I_GU = 32 * 88, I_D = 88 * 32, I_IN = 32 * ((nin + 63) / 64), I_OUT = 40 * 32, I_UQ = (L == 1) ? 8 * 48 : 0;
    TrDesc d; d.f8 = 0; d.tiled = 0; int r = it;
    if (r < 4 * I_GU) { const int s = r / I_GU; r -= s * I_GU; const int f = s >> 1, up = s & 1;
        d.W = (up ? w_up : w_gate) + (size_t)(L * 2 + f) * DM * DFF; d.K = DM; d.N = DFF; d.gain = ffn_norm + (size_t)(L * 2 + f) * DM; d.WT = WB + (f ? WB_GU1 : WB_GU0); d.ldt = DM; d.kind = up ? 2 : 1; }
    else { r -= 4 * I_GU;
        if (r < 2 * I_D) { const int f = r / I_D; r -= f * I_D; d.W = w_down + (size_t)(L * 2 + f) * DFF * DM; d.K = DFF; d.N = DM; d.gain = nullptr; d.WT = WB + (f ? WB_D1 : WB_D0); d.ldt = DFF; d.kind = 0; d.tiled = 1; }
        else { r -= 2 * I_D;
            if (r < I_IN) { d.W = w_in; d.K = DM; d.N = nin; d.gain = attn_norm + (size_t)L * DM; d.WT = WB + WB_IN; d.ldt = DM; d.kind = 3 + L; d.f8 = F8LAYER(L) ? 1 : 0; }
            else { r -= I_IN;
                if (r < I_OUT) { d.W = w_out + (size_t)L * OUTIN * DM; d.K = OUTIN; d.N = DM; d.gain = nullptr; d.WT = WB + WB_OUT; d.ldt = OUTIN; d.kind = 0;
                    d.f8 = F8OUTL(L);
                }
                else { r -= I_OUT;
                    if (r < I_UQ) { d.W = (const float*)A->in[18]; d.K = 512; d.N = 3072; d.gain = (const float*)A->in[17]; d.WT = WB + WB_UQ; d.ldt = 512; d.kind = 0; }
                    else { r -= I_UQ; d.W = (const float*)A->in[20]; d.K = 512; d.N = 4096; d.gain = (const float*)A->in[19]; d.WT = WB + WB_UKV; d.ldt = 512; d.kind = 0; } } } } }
    d.r = r; return d;
}
__device__ __forceinline__ void convert_layer(const Fr& F, ArgsPc A, int L, bf16_t* WB) {
    const int nin = (L == 0 ? 6672 : L == 1 ? 1600 : L == 2 ? 18944 : 4688);
    const int total = 4 * 32 * 88 + 2 * 88 * 32 + 32 * ((nin + 63) / 64) + 40 * 32 + ((L == 1) ? 8 * 48 + 8 * 64 : 0);
    LAS float* scr = (LAS float*)(F.lds + F.wave * 16640);
    f32x4 va[16], vb[16]; int it = F.gw;
    if (it >= total) return;
    TrDesc da = tr_desc(A, L, WB, it), db = da; tr_load(da, F.lane, va);
    for (;;) {
        const bool nb_ = it + F.ngw < total; if (nb_) { db = tr_desc(A, L, WB, it + F.ngw); tr_load(db, F.lane, vb); }
        tr_store(da, F.lane, va, scr); it += F.ngw; if (!nb_) break;
        const bool na_ = it + F.ngw < total; if (na_) { da = tr_desc(A, L, WB, it + F.ngw); tr_load(da, F.lane, va); }
        tr_store(db, F.lane, vb, scr); it += F.ngw; if (!na_) break;
    }
}

#define MIXP(off_) (o8_ ? (bf16_t*)((unsigned char*)MIX + (off_)) : MIX + (off_))
__device__ __forceinline__ void mem_attn_units(const Fr& F, const bf16_t* P, long ldp, int memq_col, const bf16_t* MEMKV, bf16_t* MIX, int o8_) {
    for (int i = blockIdx.x; i < 512; i += F.G) {
        const int b = i >> 6, mh = (i >> 4) & 3, qb = i & 15; const size_t tok = (size_t)b * SEQ + qb * 256;
        att::AP a{}; a.Q = P + tok * ldp + memq_col + mh * 128; a.qs = ldp; a.K = MEMKV + (size_t)b * NMEM * 4096 + mh * 128; a.ks = 4096; a.V = a.K + 512; a.vs = 4096;
        a.O = MIXP(tok * OUTIN + 2048 + mh * 128); a.o8 = o8_; a.os = OUTIN; a.kt0 = 0; a.nt = 4; a.q0 = 0; a.C = 0.08838834764831845f * LOG2E;
        att::attn_unit<att::K_MEM, 128>(F.lds, a, F.wave);
    }
}
__device__ __forceinline__ void causal_unit_ids(int i, int& b, int& h, int& qb) {
    const int slot = i >> 8, c = i & 255, bh = (c >> 4) * 8 + (c & 7), half = (c >> 3) & 1;
    qb = half ? ((slot & 1) ? slot : 14 - slot) : ((slot & 1) ? slot - 1 : 15 - slot); b = bh >> 4; h = bh & 15;
}

__device__ __forceinline__ Fr mk_frame(unsigned char* lds_raw, int wave_id) {
    Fr F; F.lds = (LAS unsigned char*)lds_raw; F.tid = tid_opaque(wave_id); F.lane = F.tid & 63; F.wave = __builtin_amdgcn_readfirstlane(F.tid >> 6);
    F.G = gridDim.x; { const int bx = blockIdx.x; F.vcu = (F.G % 8 == 0) ? (bx % 8) * (F.G / 8) + bx / 8 : bx; }
    F.gw = F.vcu * 8 + F.wave; F.ngw = F.G * 8; return F;
}
typedef const __attribute__((address_space(4))) Args* ArgsP;
__device__ __forceinline__ ArgsP args_ptr() { auto p = __builtin_amdgcn_kernarg_segment_ptr(); asm volatile("" : "+s"(p)); return (ArgsP)p; }
#define WSP(T, off) ((T*)(AP_->ws + (off)))
#define SCRP(T, mib) ((T*)(AP_->ws + WS_SCR + (size_t)(mib) * MiB))

__global__ void __launch_bounds__(512, 2) fwd(Args A) {
    extern __shared__ __attribute__((aligned(16))) unsigned char lds_raw[];
    { LAS unsigned* z = (LAS unsigned*)((LAS unsigned char*)lds_raw + RING_BYTES); for (int u = threadIdx.x; u < (LDS_BYTES - RING_BYTES) / 4; u += 512) z[u] = 0u; }
    __syncthreads();
    const int lo = A.ph_lo, hi = A.ph_hi; const int wave_id = __builtin_amdgcn_readfirstlane((int)threadIdx.x >> 6);
    XcdBarrier bar; bar.bar = (unsigned*)(A.ws + WS_CTL) + CW_BAR; bar.x = 0; bar.st = nullptr;
    if (hi - lo > 1) bar = xcd_barrier_post((unsigned*)(A.ws + WS_CTL) + CW_BAR, (volatile LAS unsigned*)((LAS unsigned char*)lds_raw + MISC_OFF) + 8);
    int ph = 0;
#ifdef TMASK
    unsigned long long tacc_ = 0ull, tb_ = 0ull;
#define PH_BEGIN if (ph >= lo && ph < hi) { if ((TMASK >> ph) & 1ull) tb_ = __builtin_amdgcn_s_memrealtime(); const Fr F = mk_frame(lds_raw, wave_id); const ArgsP AP_ = args_ptr();
#define PH_END   if (ph + 1 < hi) xcd_barrier(bar); if ((TMASK >> ph) & 1ull) tacc_ += __builtin_amdgcn_s_memrealtime() - tb_; } ++ph;
#else
#define PH_BEGIN if (ph >= lo && ph < hi) { const Fr F = mk_frame(lds_raw, wave_id); const ArgsP AP_ = args_ptr();
#define PH_END   if (ph + 1 < hi) xcd_barrier(bar); } ++ph;
#endif
    const float SC128 = 0.08838834764831845f * LOG2E, SC192 = 0.07216878364870323f * LOG2E;

    PH_BEGIN
        rows2048(F, (const float*)AP_->in[1], NB * NMEM, WSP(bf16_t, WS_MEMB), WSP(float, WS_RSMEM), 1);
        rope_table(F, (const int*)AP_->in[2], WSP(float, WS_COS), WSP(float, WS_SIN));
        rows2048(F, (const float*)AP_->in[0], MTOK, WSP(bf16_t, WS_XB), WSP(u64, WS_SSQ), 0);
#ifdef RZ
        { u32x4* z = WSP(u32x4, WS_END); for (size_t i = (size_t)F.vcu * 512 + F.tid; i < (size_t)2 * DFF * DM * 2 / 16; i += (size_t)F.G * 512) z[i] = (u32x4){0u, 0u, 0u, 0u}; }
#endif
        { LAS float* scr = (LAS float*)(F.lds + F.wave * 16640);
          for (int it = F.gw; it < 4 * 512; it += F.ngw) { const int Lm = it >> 9; TrDesc d; d.W = (const float*)AP_->in[10] + (size_t)Lm * DM * 1024; d.K = DM; d.N = 1024; d.gain = (const float*)AP_->in[9] + (size_t)Lm * DM;
              d.WT = SCRP(bf16_t, 0) + (size_t)Lm * 1024 * DM; d.ldt = DM; d.kind = 0; d.f8 = 0; d.tiled = 0; d.r = it & 511; f32x4 v[16]; tr_load(d, F.lane, v); tr_store(d, F.lane, v, scr); } }
    PH_END
    PH_BEGIN { pg8::Gemm g{WSP(bf16_t, WS_MEMB), SCRP(bf16_t, 0), NB * NMEM, 4096, DM, DM, DM, 0}; pg8::StaticOrder S; S.init(g.M, g.N, F.G, (int)blockIdx.x);
        pg8::EpiProj E{WSP(bf16_t, WS_MEMKV), 4096, WSP(float, WS_RSMEM), 0, nullptr, -1, (const float*)AP_->in[11] + 128, 0, 0, nullptr, 0, 0, nullptr, 0, 0, 1.0f, 4, 2, 256}; pg8::gemm_phase(F.lds, g, S, E, F.tid); } PH_END

    int ver = 0;
#pragma clang loop unroll(full)
    for (int hl = 0; hl < 8; ++hl) {
        const int L = hl >> 1, f = hl & 1;
        if (f == 0) {
            PH_BEGIN REP(RCV) convert_layer(F, AP_, L, WSP(bf16_t, WS_WB)); PH_END

        }
        PH_BEGIN
#ifdef RZ
            { pg8::Gemm g{WSP(bf16_t, WS_XB), WSP(bf16_t, WS_END), MTOK, 2 * DFF, DM, DM, DM, 0}; pg8::StaticOrder S; S.init(g.M, g.N, F.G, (int)blockIdx.x);
              pg8::EpiSwiGLU E{SCRP(bf16_t, 0), DFF, WSP(u64, WS_SSQ) + (size_t)ver * MTOK}; pg8::gemm_phase(F.lds, g, S, E, F.tid); }
#endif
            REP(RG) { pg8::Gemm g{WSP(bf16_t, WS_XB), WSP(bf16_t, WS_WB) + (f ? WB_GU1 : WB_GU0), MTOK, 2 * DFF, DM, DM, DM, 0}; pg8::StaticOrder S; S.init(g.M, g.N, F.G, (int)blockIdx.x);
            pg8::EpiSwiGLU E{SCRP(bf16_t, 0), DFF, WSP(u64, WS_SSQ) + (size_t)ver * MTOK}; pg8::gemm_phase(F.lds, g, S, E, F.tid); } PH_END
        PH_BEGIN { pg8::Gemm g{SCRP(bf16_t, 0), WSP(bf16_t, WS_WB) + (f ? WB_D1 : WB_D0), MTOK, DM, DFF, DFF, DFF, 1, 1}; pg8::StaticOrder S; S.init(g.M, g.N, F.G, (int)blockIdx.x);
            if (RD > 1) { pg8::EpiResid E0{ver == 0 ? (const float*)AP_->in[0] : AP_->out, SCRP(float, 400), SCRP(bf16_t, 660), nullptr, nullptr, 0.5f};
#ifdef PROBE_PM
                pg8::Gemm g0 = g; g0.pm_and = PROBE_PM; pg8::gemm_phase(F.lds, g0, S, E0, F.tid);
#else
                pg8::gemm_phase(F.lds, g, S, E0, F.tid);
#endif
            }
            pg8::EpiResid E{ver == 0 ? (const float*)AP_->in[0] : AP_->out, AP_->out, WSP(bf16_t, WS_XB), WSP(u64, WS_SSQ) + (size_t)(ver + 1) * MTOK, (f == 0 && F8LAYER(L)) ? WSP(unsigned char, WS_XB8) : nullptr, 0.5f}; pg8::gemm_phase(F.lds, g, S, E, F.tid); } PH_END
        ++ver;
        if (f != 0) continue;
        const int ngrp = (L == 2) ? 3 : 1;
#pragma clang loop unroll(full)
        for (int g = 0; g < ngrp; ++g) {
            PH_BEGIN REP(RI) { const int ldp = (L == 0) ? 6912 : (L == 1) ? 1792 : (L == 2) ? 6656 : 4864;
                const int nproj = (L == 2) ? (g == 0 ? 6656 : 6144) : ldp; const size_t roff = (L == 2) ? (g == 0 ? 0 : (g == 1 ? 6656 : 12800)) : 0;
                pg8::Gemm gm = F8LAYER(L) ? pg8::Gemm{WSP(bf16_t, WS_XB8), (const bf16_t*)((const unsigned char*)(WSP(bf16_t, WS_WB) + WB_IN) + roff * DM), MTOK, nproj, DM / 2, DM / 2, DM / 2, 0}
                                       : pg8::Gemm{WSP(bf16_t, WS_XB), WSP(bf16_t, WS_WB) + WB_IN + roff * DM, MTOK, nproj, DM, DM, DM, 0};
                pg8::StaticOrder S; S.init(gm.M, gm.N, F.G, (int)blockIdx.x);
                const float* gmq = (const float*)AP_->in[11] + (size_t)L * 256;
                const float* qg = (L == 0) ? (const float*)AP_->in[15] : (L == 2) ? (const float*)AP_->in[24] + (size_t)g * 256 : (L == 3) ? (const float*)AP_->in[26] : nullptr;
                const int kt_hi = (L == 3) ? 10 : 16, mq_lo = (L == 0 || L == 2) ? 24 : (L == 1) ? 5 : 17, mq_hi = (L == 2 && g > 0) ? mq_lo : mq_lo + 2;
                pg8::EpiProj E{SCRP(bf16_t, 0), ldp, WSP(u64, WS_SSQ) + (size_t)ver * MTOK, 1, (L == 0) ? SCRP(float, 432) : nullptr, 26,
                               qg, 0, (L == 1) ? 0 : 8, qg ? qg + 128 : nullptr, 8, (L == 1) ? 8 : kt_hi, gmq, mq_lo, mq_hi, F8LAYER(L) ? (1.0f / 64.0f) : 1.0f, 0, 0, 0}; if (F8LAYER(L)) pg8::gemm_phase<F8MODE>(F.lds, gm, S, E, F.tid); else pg8::gemm_phase<0>(F.lds, gm, S, E, F.tid); } PH_END
            if (L == 0) { PH_BEGIN fox_cumsum(F, SCRP(const float, 432), (const float*)AP_->in[14], SCRP(float, 434)); PH_END }
            if (L == 1) { PH_BEGIN mla_prep_a(F, SCRP(bf16_t, 0), WSP(float, WS_RSQ), WSP(float, WS_RSKV), SCRP(bf16_t, 752), (const float*)AP_->in[22] + 64, nullptr, WSP(float, WS_COS), WSP(float, WS_SIN)); PH_END }
            if (L == 1) {
                PH_BEGIN
                    REP(RI) for (int i = 0; i < 2; ++i) { pg8::Gemm gm{SCRP(bf16_t, 0) + (i ? 512 : 0), WSP(bf16_t, WS_WB) + (i ? WB_UKV : WB_UQ), MTOK, i ? 4096 : 3072, 512, 1792, 512, 0}; pg8::StaticOrder S; S.init(gm.M, gm.N, F.G, (int)blockIdx.x);
                        pg8::EpiProj E{i ? SCRP(bf16_t, 304) : SCRP(bf16_t, 112), i ? 4096 : 3072, i ? WSP(float, WS_RSKV) : WSP(float, WS_RSQ), 0, nullptr, -1, nullptr, 0, 0, nullptr, 0, 0, nullptr, 0, 0, 1.0f, 0, 0, 0}; pg8::gemm_phase(F.lds, gm, S, E, F.tid); }
                PH_END
                PH_BEGIN mla_prep_b(F, SCRP(bf16_t, 112), SCRP(const bf16_t, 304), SCRP(bf16_t, 560), SCRP(const bf16_t, 752), (const float*)AP_->in[21], (const float*)AP_->in[22], WSP(float, WS_COS), WSP(float, WS_SIN)); PH_END
            }
            if (L == 3) {
                PH_BEGIN REP(RIX) dsa_indexer(F, SCRP(const bf16_t, 0), SCRP(float, 304)); PH_END
                PH_BEGIN REP(RSL) dsa_select(F, SCRP(const float, 304), SCRP(u64, 816)); PH_END
            }
            PH_BEGIN
                bf16_t* P = SCRP(bf16_t, 0); bf16_t* MIX = WSP(bf16_t, WS_MIX); const int o8_ = F8OUTL(L);
                const long ldp = (L == 0) ? 6912 : (L == 1) ? 1792 : (L == 2) ? 6656 : 4864;
                REP(L == 2 ? 1 : RA) {
                if (L == 0) {
                    const float* CUM = SCRP(const float, 434);
                    for (int i = blockIdx.x; i < 2048; i += F.G) { int b, h, qb; causal_unit_ids(i, b, h, qb); const size_t t0 = (size_t)b * SEQ;
                        att::AP a{}; a.Q = P + (t0 + qb * 256) * ldp + h * 128; a.qs = ldp; a.K = P + t0 * ldp + 2048 + h * 128; a.ks = ldp; a.V = a.K + 2048; a.vs = ldp;
                        a.O = MIXP((t0 + qb * 256) * OUTIN + h * 128); a.o8 = o8_; a.os = OUTIN; a.kt0 = 0; a.nt = 4 * (qb + 1); a.q0 = qb * 256; a.C = SC128; a.cum = CUM + t0 * 16 + h; a.cums = 16;
                        att::attn_unit<att::K_FOX, 128>(F.lds, a, F.wave); }
                }
                if (L == 1) {
                    const bf16_t* Qb = SCRP(const bf16_t, 112); const bf16_t* KVb = SCRP(const bf16_t, 304); const bf16_t* KF = SCRP(const bf16_t, 560);
                    for (int i = blockIdx.x; i < 2048; i += F.G) { int b, h, qb; causal_unit_ids(i, b, h, qb); const size_t t0 = (size_t)b * SEQ;
                        att::AP a{}; a.Q = Qb + (t0 + qb * 256) * 3072 + h * 192; a.qs = 3072; a.K = KF + t0 * 3072 + h * 192; a.ks = 3072; a.V = KVb + t0 * 4096 + h * 256 + 128; a.vs = 4096;
                        a.O = MIXP((t0 + qb * 256) * OUTIN + h * 128); a.o8 = o8_; a.os = OUTIN; a.kt0 = 0; a.nt = 4 * (qb + 1); a.q0 = qb * 256; a.C = SC192;
                        att::attn_unit<att::K_MLA, 192>(F.lds, a, F.wave); }
                }
                if (L == 2) {
                    const int dil = (g == 0) ? 1 : (g == 1 ? 4 : 16), nblk = 16 / dil; float* OST = SCRP(float, 416); float* ML = SCRP(float, 672);
                    for (int i = blockIdx.x; i < 2048; i += F.G) { const int h = i & 15, rest = i >> 4, b = rest >> 4, rj = rest & 15, r = rj / nblk, jb = rj % nblk;
                        const size_t tokz = (size_t)b * SEQ + r, tokq = tokz + (size_t)jb * 256 * dil;
                        att::AP a{}; a.Q = P + tokq * ldp + h * 128; a.qs = (long)dil * ldp; a.K = P + tokz * ldp + 2048 + h * 128; a.ks = (long)dil * ldp; a.V = a.K + 2048; a.vs = a.ks;
                        a.O = MIXP(tokq * OUTIN + h * 128); a.o8 = o8_; a.os = (long)dil * OUTIN; a.q0 = jb * 256; a.kt0 = jb == 0 ? 0 : 4 * jb - 2; a.nt = jb == 0 ? 4 : 6; a.C = SC128;
                        a.ost = OST + tokq * 1024 + h * 64; a.osts = (long)dil * 1024; a.mst = ML + (tokq * 16 + h) * 2; a.msts = (long)dil * 32; a.carry_in = g > 0; a.carry_out = g < 2;
                        a.t5 = (const float*)AP_->in[3]; a.head = h; a.dil = dil;
                        att::attn_unit<att::K_DIL, 128>(F.lds, a, F.wave); }
                }
                if (L == 3) {
                    const u64* MSK = SCRP(const u64, 816);
                    for (int i = blockIdx.x; i < 2048; i += F.G) { int b, h, qb; causal_unit_ids(i, b, h, qb); const size_t t0 = (size_t)b * SEQ;
                        att::AP a{}; a.Q = P + (t0 + qb * 256) * ldp + h * 128; a.qs = ldp; a.K = P + t0 * ldp + 2048 + (h >> 2) * 128; a.ks = ldp; a.V = a.K + 512; a.vs = ldp;
                        a.O = MIXP((t0 + qb * 256) * OUTIN + h * 128); a.o8 = o8_; a.os = OUTIN; a.kt0 = 0; a.nt = 4 * (qb + 1); a.q0 = qb * 256; a.C = SC128; a.msk = MSK + (t0 + qb * 256) * 64; a.t5 = (const float*)AP_->in[3]; a.head = h;
                        att::attn_unit<att::K_DSA, 128>(F.lds, a, F.wave); }
                }
                if (g == 0) { const int memq_col = (L == 0) ? 6144 : (L == 1) ? 1280 : (L == 2) ? 6144 : 4352; mem_attn_units(F, P, ldp, memq_col, WSP(const bf16_t, WS_MEMKV) + L * 1024, MIX, o8_); }
                }
            PH_END
        }
        if (F8OUTL(L)) { PH_BEGIN { pg8::Gemm gm{WSP(bf16_t, WS_MIX), WSP(bf16_t, WS_WB) + WB_OUT, MTOK, DM, OUTIN / 2, OUTIN / 2, OUTIN / 2, 0};   pg8::StaticOrder S; S.init(gm.M, gm.N, F.G, (int)blockIdx.x);
            pg8::EpiResid E{AP_->out, AP_->out, WSP(bf16_t, WS_XB), WSP(u64, WS_SSQ) + (size_t)(ver + 1) * MTOK, nullptr, 1.0f / 1024.0f}; pg8::gemm_phase<F8MODE>(F.lds, gm, S, E, F.tid); } PH_END }
        else { PH_BEGIN { pg8::Gemm gm{WSP(bf16_t, WS_MIX), WSP(bf16_t, WS_WB) + WB_OUT, MTOK, DM, OUTIN, OUTIN, OUTIN, 0}; pg8::StaticOrder S; S.init(gm.M, gm.N, F.G, (int)blockIdx.x);
            if (RD > 1) { pg8::EpiResid E0{AP_->out, SCRP(float, 400), SCRP(bf16_t, 660), nullptr, nullptr, 1.0f}; pg8::gemm_phase(F.lds, gm, S, E0, F.tid); }
            pg8::EpiResid E{AP_->out, AP_->out, WSP(bf16_t, WS_XB), WSP(u64, WS_SSQ) + (size_t)(ver + 1) * MTOK, nullptr, 1.0f}; pg8::gemm_phase(F.lds, gm, S, E, F.tid); } PH_END }
        ++ver;
    }
#ifdef TMASK
    if (blockIdx.x == 0) { const unsigned long long t0_ = __builtin_amdgcn_s_memrealtime(); while (__builtin_amdgcn_s_memrealtime() - t0_ < tacc_ * (unsigned long long)TMUL) __builtin_amdgcn_s_sleep(8); }
#endif
#undef PH_BEGIN
#undef PH_END
}

#ifndef MK_ONE_LAUNCH
#define MK_ONE_LAUNCH 0
#endif
extern "C" void kernel_launch(void* const* d_in, const int* in_sizes, int n_in, void* d_out, int out_size, void* d_ws, size_t ws_size, hipStream_t stream) {
    static int grid = 0;
    if (grid == 0) {
        if (n_in != 27 || in_sizes[0] != MTOK * DM || out_size != MTOK * DM || ws_size < WS_END) {
            fprintf(stderr, "kernel_launch: unexpected shapes: n_in %d in0 %d out %d ws %zu (need >= %zu); nothing launched\n", n_in, n_in > 0 ? in_sizes[0] : -1, out_size, ws_size, (size_t)WS_END); grid = -1; return; }
        int dev = 0, cus = 0, per_cu = 0;
        if (hipGetDevice(&dev) != hipSuccess || hipDeviceGetAttribute(&cus, hipDeviceAttributeMultiprocessorCount, dev) != hipSuccess) { fprintf(stderr, "kernel_launch: device query failed\n"); grid = -1; return; }
        if (hipFuncSetAttribute((const void*)fwd, hipFuncAttributeMaxDynamicSharedMemorySize, LDS_BYTES) != hipSuccess) { fprintf(stderr, "kernel_launch: hipFuncSetAttribute failed\n"); grid = -1; return; }
        if (hipOccupancyMaxActiveBlocksPerMultiprocessor(&per_cu, (const void*)fwd, 512, LDS_BYTES) != hipSuccess || per_cu < 1)
            fprintf(stderr, "kernel_launch: note: occupancy query reports %d workgroups per CU\n", per_cu);
        (void)hipGetLastError();
        grid = cus;
    }
    if (grid < 0) return;
    if (hipMemsetAsync((char*)d_ws + WS_CTL, 0, CTL_ZERO_BYTES, stream) != hipSuccess) { fprintf(stderr, "kernel_launch: memset failed\n"); return; }
    Args a{};
    for (int i = 0; i < 27; ++i) a.in[i] = d_in[i];
    a.out = (float*)d_out; a.ws = (unsigned char*)d_ws;
#if MK_ONE_LAUNCH
    a.ph_lo = 0; a.ph_hi = NPHASES;
    hipLaunchKernelGGL(fwd, dim3(grid), dim3(512), LDS_BYTES, stream, a);
#else
#ifndef NPH_LIMIT
#define NPH_LIMIT NPHASES
#endif
    for (int p = 0; p < NPH_LIMIT; ++p) { a.ph_lo = p; a.ph_hi = p + 1; hipLaunchKernelGGL(fwd, dim3(grid), dim3(512), LDS_BYTES, stream, a); }
#endif
    const hipError_t le = hipPeekAtLastError();
    if (le != hipSuccess) fprintf(stderr, "kernel_launch: launch failed: %s\n", hipGetErrorName(le));
}
```

```cpp
#define MK_ONE_LAUNCH 1
#define F8OUT 8
#define F8FFN 128
#include <hip/hip_runtime.h>
#include <cstdio>
#include <cstdint>

#define LAS __attribute__((address_space(3)))
#define GAS __attribute__((address_space(1)))
typedef unsigned short bf16_t;
typedef short bf16x8 __attribute__((ext_vector_type(8)));
typedef short s16x4 __attribute__((ext_vector_type(4)));
typedef float f32x2 __attribute__((ext_vector_type(2)));
typedef float f32x4 __attribute__((ext_vector_type(4)));
typedef float f32x16 __attribute__((ext_vector_type(16)));
typedef unsigned u32x2 __attribute__((ext_vector_type(2)));
typedef unsigned u32x4 __attribute__((ext_vector_type(4)));
typedef unsigned long long u64;

constexpr int DM = 2048, NB = 8, SEQ = 4096, MTOK = NB * SEQ, DFF = 5632, NH = 16, HD = 128, NMEM = 256, MEMW = 512, OUTIN = 2560;
constexpr float RMS_EPS = 1e-6f;
constexpr float LOG2E = 1.4426950408889634f;

__device__ __forceinline__ unsigned cvt_pk_bf16(float lo, float hi) { unsigned r; asm volatile("v_cvt_pk_bf16_f32 %0, %1, %2" : "=v"(r) : "v"(lo), "v"(hi)); return r; }
__device__ __forceinline__ float bf_lo(unsigned w) { return __uint_as_float(w << 16); }
__device__ __forceinline__ float bf_hi(unsigned w) { return __uint_as_float(w & 0xffff0000u); }

__device__ __forceinline__ int tid_opaque(int wave_id) {
    int l; asm volatile("v_mbcnt_lo_u32_b32 %0, -1, 0\n\tv_mbcnt_hi_u32_b32 %0, -1, %0" : "=v"(l)); return wave_id * 64 + l; }

namespace pg8 {
constexpr int BM = 256, BK = 64, HALF = 128, HTB = HALF * BK * 2, STAGE_BYTES = 8 * HTB, NXCD = 8, WGM = 8;
__host__ __device__ __forceinline__ int lds_byte(int r, int c) { const int st = (r >> 4) * 2 + (c >> 5), rr = r & 15, cc = c & 31, ob = rr * 64 + cc * 2; return st * 1024 + (ob ^ (((ob >> 9) & 1) << 5)); }
__host__ __device__ __forceinline__ void stage_rc(int b, int& R, int& C) { const int st = b / 1024, sb = b % 1024, swz = sb ^ (((sb >> 9) & 1) << 5); R = (st >> 1) * 16 + swz / 64; C = (st & 1) * 32 + (swz % 64) / 2; }
__host__ __device__ __forceinline__ int perm32(int rho) { const int n = rho >> 4, i = rho & 15; return 8 * (i >> 2) + 4 * n + (i & 3); }

struct Unit { int pm, pn; };
struct Gemm { const bf16_t* A; const bf16_t* Bt; int M, N, K, lda, ldb; int a_tiled; int b_tiled; int pm_and; };

struct StaticOrder {
    int nM, nN, nwg, G, c, wgm;
    __host__ __device__ void init(int M, int N, int G_, int c_) { nM = M / BM; nN = N / BM; nwg = nM * nN; G = G_; c = c_; wgm = (nN == 8) ? 4 : WGM; }
    __host__ __device__ bool next(int i, Unit& u) const {
        const long L = (long)i * G + c; if (L >= nwg) return false;
        int wgid = (int)L; { const int q = nwg / NXCD, r = nwg % NXCD, xcd = wgid % NXCD, off = wgid / NXCD; wgid = (xcd < r ? xcd * (q + 1) : r * (q + 1) + (xcd - r) * q) + off; }
        const int nig = wgm * nN, gid = wgid / nig, fm = gid * wgm, gsz = (nM - fm) < wgm ? (nM - fm) : wgm;
        u.pm = fm + ((wgid % nig) % gsz); u.pn = (wgid % nig) / gsz; return true;
    }
};

constexpr float SSQ_SCALE = 16777216.0f;
__device__ __forceinline__ float rs_from_ssq(const u64 v) { return __builtin_amdgcn_rsqf((float)v * (1.0f / (SSQ_SCALE * DM)) + RMS_EPS); }
__device__ __forceinline__ float rs_of(const void* rsv, int row, int mode) { return mode ? rs_from_ssq(((const u64*)rsv)[row]) : ((const float*)rsv)[row]; }

struct EpiProj {
    bf16_t* O; int ldc; const void* rsv; int rs_mode;
    float* fgout; int fg_tile;
    const float* g0; int t0a, t0b; const float* g1; int t1a, t1b; const float* g2; int t2a, t2b;
    float oscale;
    int gper, gcnt, gstride;
    __device__ __forceinline__ void operator()(f32x4 (&acc)[2][2][4][2], const Unit& u, int wr, int wc, int fr, int fq, LAS unsigned char* xlds) const {
        const int row0 = u.pm * BM + wr * 64 + fr; const int col0 = u.pn * BM + wc * 32 + 8 * fq;
        const float* gain = (u.pn >= t0a && u.pn < t0b) ? g0 : (u.pn >= t1a && u.pn < t1b) ? g1 : (u.pn >= t2a && u.pn < t2b) ? g2 : nullptr;
        if (gper) gain = (u.pn % gper < gcnt) ? g0 + (size_t)(u.pn / gper) * gstride : nullptr;
        float rsa[2][4];
#pragma unroll
        for (int ai = 0; ai < 2; ++ai)
#pragma unroll
            for (int m = 0; m < 4; ++m) rsa[ai][m] = rs_of(rsv, row0 + ai * HALF + m * 16, rs_mode) * oscale;
#pragma unroll
        for (int ai = 0; ai < 2; ++ai)
#pragma unroll
            for (int m = 0; m < 4; ++m) { const float rs = rsa[ai][m];
#pragma unroll
                for (int bj = 0; bj < 2; ++bj) { acc[ai][bj][m][0] *= rs; acc[ai][bj][m][1] *= rs; } }
        if (gain) {
            LAS float* part = (LAS float*)xlds;
#pragma unroll
            for (int ai = 0; ai < 2; ++ai)
#pragma unroll
                for (int m = 0; m < 4; ++m)
#pragma unroll
                    for (int bj = 0; bj < 2; ++bj) { const f32x4 a = acc[ai][bj][m][0], b = acc[ai][bj][m][1];
                        float ss = ((a[0] * a[0] + a[1] * a[1]) + (a[2] * a[2] + a[3] * a[3])) + ((b[0] * b[0] + b[1] * b[1]) + (b[2] * b[2] + b[3] * b[3]));
                        ss += __shfl_xor(ss, 16); ss += __shfl_xor(ss, 32);
                        if (fq == 0) part[((ai * HALF + wr * 64 + m * 16 + fr) * 2 + bj) * 4 + wc] = ss; }
            asm volatile("s_waitcnt lgkmcnt(0)" ::: "memory"); __builtin_amdgcn_s_barrier(); asm volatile("" ::: "memory");
            const f32x4 gv0 = *(const f32x4*)(gain + wc * 32 + 8 * fq), gv1 = *(const f32x4*)(gain + wc * 32 + 8 * fq + 4);
#pragma unroll
            for (int ai = 0; ai < 2; ++ai)
#pragma unroll
                for (int m = 0; m < 4; ++m)
#pragma unroll
                    for (int bj = 0; bj < 2; ++bj) { const f32x4 p4 = *(const LAS f32x4*)(part + ((ai * HALF + wr * 64 + m * 16 + fr) * 2 + bj) * 4);
                        const float r2 = __builtin_amdgcn_rsqf(((p4[0] + p4[1]) + (p4[2] + p4[3])) * (1.0f / 128.0f) + RMS_EPS);
                        acc[ai][bj][m][0] *= gv0 * r2; acc[ai][bj][m][1] *= gv1 * r2; }
        }
#pragma unroll
        for (int ai = 0; ai < 2; ++ai)
#pragma unroll
            for (int m = 0; m < 4; ++m) { const int row = row0 + ai * HALF + m * 16;
                bf16_t* rowp = O + (size_t)row * ldc + col0;
#pragma unroll
                for (int bj = 0; bj < 2; ++bj) { const f32x4 v0 = acc[ai][bj][m][0], v1 = acc[ai][bj][m][1];
                    u32x4 w; w.x = cvt_pk_bf16(v0[0], v0[1]); w.y = cvt_pk_bf16(v0[2], v0[3]); w.z = cvt_pk_bf16(v1[0], v1[1]); w.w = cvt_pk_bf16(v1[2], v1[3]);
                    *(u32x4*)(rowp + bj * HALF) = w;
                    if (fgout && bj == 0 && u.pn == fg_tile && wc == 0 && fq < 2) { float* fp = fgout + (size_t)row * 16 + 8 * fq; *(f32x4*)fp = v0; *(f32x4*)(fp + 4) = v1; } } }
    }
};
struct EpiSwiGLU {
    bf16_t* O; int ldc; const u64* ssq; float oscale;
    __device__ __forceinline__ void operator()(f32x4 (&acc)[2][2][4][2], const Unit& u, int wr, int wc, int fr, int fq, LAS unsigned char*) const {
        const int row0 = u.pm * BM + wr * 64 + fr; const int col0 = u.pn * HALF + wc * 32 + 8 * fq;
        float rsv[2][4];
#pragma unroll
        for (int ai = 0; ai < 2; ++ai)
#pragma unroll
            for (int m = 0; m < 4; ++m) rsv[ai][m] = rs_from_ssq(ssq[row0 + ai * HALF + m * 16]) * oscale;
#pragma unroll
        for (int ai = 0; ai < 2; ++ai)
#pragma unroll
            for (int m = 0; m < 4; ++m) { const int row = row0 + ai * HALF + m * 16; const float rs = rsv[ai][m];
                float h[8];
#pragma unroll
                for (int n = 0; n < 2; ++n)
#pragma unroll
                    for (int j = 0; j < 4; ++j) { const float g = acc[ai][0][m][n][j] * rs, uu = acc[ai][1][m][n][j] * rs;
                        const float e = __builtin_amdgcn_exp2f(-g * LOG2E); h[n * 4 + j] = g * __builtin_amdgcn_rcpf(1.0f + e) * uu; }
                u32x4 w; w.x = cvt_pk_bf16(h[0], h[1]); w.y = cvt_pk_bf16(h[2], h[3]); w.z = cvt_pk_bf16(h[4], h[5]); w.w = cvt_pk_bf16(h[6], h[7]);
                const int kt = col0 >> 6, hh = (row >> 7) & 1;
                __builtin_nontemporal_store(w, (u32x4*)(O + ((size_t)((size_t)u.pm * (ldc >> 6) + kt) * 2 + hh) * (HALF * BK) + (size_t)(row & 127) * BK + (col0 & 63))); }
    }
};
struct EpiResid {
    const float* xin; float* xout; bf16_t* xb; u64* ssq_out; unsigned char* xb8; float alpha;
    __device__ __forceinline__ void operator()(f32x4 (&acc)[2][2][4][2], const Unit& u, int wr, int wc, int fr, int fq, LAS unsigned char*) const {
        const int row0 = u.pm * BM + wr * 64 + fr; const int col0 = u.pn * BM + wc * 32 + 8 * fq;
#pragma unroll
        for (int ai = 0; ai < 2; ++ai) {
            f32x4 xi[4][2][2];
#pragma unroll
            for (int m = 0; m < 4; ++m) { const size_t off = (size_t)(row0 + ai * HALF + m * 16) * DM + col0;
#pragma unroll
                for (int bj = 0; bj < 2; ++bj) { xi[m][bj][0] = __builtin_nontemporal_load((const f32x4*)(xin + off + bj * HALF)); xi[m][bj][1] = __builtin_nontemporal_load((const f32x4*)(xin + off + bj * HALF + 4)); } }
            asm volatile("" ::: "memory");
#pragma unroll
            for (int m = 0; m < 4; ++m) { const int row = row0 + ai * HALF + m * 16; const size_t off = (size_t)row * DM + col0; float ss = 0.f;
#pragma unroll
                for (int bj = 0; bj < 2; ++bj) {
                    const f32x4 v0 = xi[m][bj][0] + acc[ai][bj][m][0] * alpha, v1 = xi[m][bj][1] + acc[ai][bj][m][1] * alpha;
                    __builtin_nontemporal_store(v0, (f32x4*)(xout + off + bj * HALF)); __builtin_nontemporal_store(v1, (f32x4*)(xout + off + bj * HALF + 4));
                    u32x4 w; w.x = cvt_pk_bf16(v0[0], v0[1]); w.y = cvt_pk_bf16(v0[2], v0[3]); w.z = cvt_pk_bf16(v1[0], v1[1]); w.w = cvt_pk_bf16(v1[2], v1[3]);
                    *(u32x4*)(xb + off + bj * HALF) = w;
                    if (xb8) { int q0 = __builtin_amdgcn_cvt_pk_fp8_f32(v0[0], v0[1], 0, false); q0 = __builtin_amdgcn_cvt_pk_fp8_f32(v0[2], v0[3], q0, true);
                               int q1 = __builtin_amdgcn_cvt_pk_fp8_f32(v1[0], v1[1], 0, false); q1 = __builtin_amdgcn_cvt_pk_fp8_f32(v1[2], v1[3], q1, true);
                               *(u32x2*)(xb8 + off + bj * HALF) = (u32x2){(unsigned)q0, (unsigned)q1}; }
                    ss += (v0[0] * v0[0] + v0[1] * v0[1]) + (v0[2] * v0[2] + v0[3] * v0[3]) + (v1[0] * v1[0] + v1[1] * v1[1]) + (v1[2] * v1[2] + v1[3] * v1[3]); }
                if (ssq_out) { ss += __shfl_xor(ss, 16); ss += __shfl_xor(ss, 32); if (fq == 0) atomicAdd(ssq_out + row, (u64)(ss * SSQ_SCALE)); } }
            asm volatile("" ::: "memory");
        }
    }
};

template <int FP8 = 0, class Epi, class Sched>
__device__ __forceinline__ void gemm_phase(LAS unsigned char* lds, const Gemm g, const Sched& S, const Epi& E, const int tid) {
    const int wid = __builtin_amdgcn_readfirstlane(tid >> 6), lane = tid & 63, wr = wid >> 2, wc = wid & 3, fr = lane & 15, fq = lane >> 4;
    const int K = g.K, nt = K / BK;
    unsigned voffA[2], voffB[2];
#pragma unroll
    for (int i = 0; i < 2; ++i) { int R, C; stage_rc(tid * 16 + i * 8192, R, C); const int Rb = (R & ~31) + perm32(R & 31);
        voffA[i] = (unsigned)(R * (g.a_tiled ? BK : g.lda) + C) * 2u; voffB[i] = (unsigned)(Rb * (g.b_tiled ? BK : g.ldb) + C) * 2u; }
    const size_t kstep = (size_t)(BK * 2), kstepA = g.a_tiled ? (size_t)(2 * HTB) : kstep, kstepB = g.b_tiled ? (size_t)(2 * HTB) : kstep;
    const size_t hstepA = g.a_tiled ? (size_t)HTB : (size_t)HALF * g.lda * 2, hstepB = g.b_tiled ? (size_t)HTB : (size_t)HALF * g.ldb * 2;
    const size_t tstepA = g.a_tiled ? (size_t)nt * 2 * HTB : 2 * hstepA, tstepB = g.b_tiled ? (size_t)nt * 2 * HTB : 2 * hstepB;
    const unsigned ldsw = (unsigned)wid * 1024u;
    const int aoff = lds_byte(wr * 64 + fr, fq * 8), boff = lds_byte(wc * 32 + fr, fq * 8);
#define PG8_SA(b, h) (((b) * 2 + (h)) * HTB)
#define PG8_SB(b, h) ((4 + (b) * 2 + (h)) * HTB)
#define PG8_STAGE(bufoff, gbase, voff) do { _Pragma("unroll") for (int _i = 0; _i < 2; ++_i) \
        __builtin_amdgcn_global_load_lds((const unsigned*)((const char*)(gbase) + (voff)[_i]), (LAS unsigned*)(lds + (bufoff) + ldsw + _i * 8192), 16, 0, 0); } while (0)
#define PG8_LD8(p_) __builtin_shufflevector(*(const LAS i32x4_t*)(p_), *(const LAS i32x4_t*)((p_) + 1024), 0, 1, 2, 3, 4, 5, 6, 7)
#define PG8_LDA(dst, b, h) do { if constexpr (FP8 == 2) { _Pragma("unroll") for (int m = 0; m < 4; ++m) dst##8[m] = PG8_LD8(lds + PG8_SA(b, h) + aoff + m * 2048); } \
        else { _Pragma("unroll") for (int m = 0; m < 4; ++m) _Pragma("unroll") for (int k = 0; k < 2; ++k) dst[m][k] = *(const LAS bf16x8*)(lds + PG8_SA(b, h) + aoff + m * 2048 + k * 1024); } } while (0)
#define PG8_LDB(dst, b, h) do { if constexpr (FP8 == 2) { _Pragma("unroll") for (int n = 0; n < 2; ++n) dst##8[n] = PG8_LD8(lds + PG8_SB(b, h) + boff + n * 2048); } \
        else { _Pragma("unroll") for (int n = 0; n < 2; ++n) _Pragma("unroll") for (int k = 0; k < 2; ++k) dst[n][k] = *(const LAS bf16x8*)(lds + PG8_SB(b, h) + boff + n * 2048 + k * 1024); } } while (0)
typedef long i64x2_t __attribute__((ext_vector_type(2)));
typedef int i32x4_t __attribute__((ext_vector_type(4)));
typedef int i32x8_t __attribute__((ext_vector_type(8)));
#define PG8_MMA(ai, bj, At, Bt) do { __builtin_amdgcn_s_setprio(1); \
        if constexpr (FP8 == 2) { _Pragma("unroll") for (int m = 0; m < 4; ++m) _Pragma("unroll") for (int n = 0; n < 2; ++n) \
            asm volatile("v_mfma_scale_f32_16x16x128_f8f6f4 %0, %1, %2, %0, %3, %3 op_sel_hi:[0,0,0]" : "+v"(acc[ai][bj][m][n]) : "v"(Bt##8[n]), "v"(At##8[m]), "v"(f8sc)); } \
        else if constexpr (FP8 == 1) { _Pragma("unroll") for (int m = 0; m < 4; ++m) _Pragma("unroll") for (int n = 0; n < 2; ++n) _Pragma("unroll") for (int k = 0; k < 2; ++k) { \
            const i64x2_t b_ = __builtin_bit_cast(i64x2_t, Bt[n][k]), a_ = __builtin_bit_cast(i64x2_t, At[m][k]); \
            acc[ai][bj][m][n] = __builtin_amdgcn_mfma_f32_16x16x32_fp8_fp8(b_[0], a_[0], acc[ai][bj][m][n], 0, 0, 0); \
            acc[ai][bj][m][n] = __builtin_amdgcn_mfma_f32_16x16x32_fp8_fp8(b_[1], a_[1], acc[ai][bj][m][n], 0, 0, 0); } } \
        else { _Pragma("unroll") for (int m = 0; m < 4; ++m) _Pragma("unroll") for (int n = 0; n < 2; ++n) _Pragma("unroll") for (int k = 0; k < 2; ++k) \
            acc[ai][bj][m][n] = __builtin_amdgcn_mfma_f32_16x16x32_bf16(Bt[n][k], At[m][k], acc[ai][bj][m][n], 0, 0, 0); } \
        __builtin_amdgcn_s_setprio(0); } while (0)
#define PG8_WAIT_V(n) asm volatile("s_waitcnt vmcnt(" #n ")" ::: "memory")
#define PG8_WAIT_L(n) asm volatile("s_waitcnt lgkmcnt(" #n ")" ::: "memory")
#define PG8_BAR __builtin_amdgcn_s_barrier()
#define PG8_SCHED __builtin_amdgcn_sched_barrier(0)
    Unit cur, nxt; int ui = 0;
    if (!S.next(0, cur)) return;
    f32x4 acc[2][2][4][2];
#pragma unroll
    for (int a = 0; a < 2; ++a)
#pragma unroll
        for (int b = 0; b < 2; ++b)
#pragma unroll
            for (int m = 0; m < 4; ++m)
#pragma unroll
                for (int n = 0; n < 2; ++n) acc[a][b][m][n] = (f32x4){0.f, 0.f, 0.f, 0.f};
    const int f8sc = 0x7f7f7f7f;
    bf16x8 At[4][2], B0[2][2], B1[2][2]; i32x8_t At8[4], B08[2], B18[2];
#ifdef PROBE_PM
#define PG8_PM(u_) ((g.pm_and & 1) ? ((u_).pm & 1) : (u_).pm)
#define PG8_PN(u_) ((g.pm_and & 2) ? ((u_).pn & 1) : (u_).pn)
#else
#define PG8_PM(u_) (u_).pm
#define PG8_PN(u_) (u_).pn
#endif
    const char* cA = (const char*)g.A + (size_t)PG8_PM(cur) * tstepA; const char* cB = (const char*)g.Bt + (size_t)PG8_PN(cur) * tstepB;
    PG8_STAGE(PG8_SB(0, 0), cB, voffB); PG8_STAGE(PG8_SB(0, 1), cB + hstepB, voffB); PG8_STAGE(PG8_SA(0, 0), cA, voffA); PG8_STAGE(PG8_SA(0, 1), cA + hstepA, voffA);
    if (wr == 1) PG8_BAR;
    PG8_WAIT_V(2); PG8_BAR;
    PG8_STAGE(PG8_SB(1, 0), cB + kstepB, voffB); PG8_STAGE(PG8_SA(1, 0), cA + kstepA, voffA); PG8_STAGE(PG8_SB(1, 1), cB + hstepB + kstepB, voffB);
    PG8_WAIT_V(6); PG8_BAR;
    for (;;) {
        const bool has_next = S.next(ui + 1, nxt);
        const char* nA = has_next ? (const char*)g.A + (size_t)PG8_PM(nxt) * tstepA : cA; const char* nB = has_next ? (const char*)g.Bt + (size_t)PG8_PN(nxt) * tstepB : cB;
        for (int t = 0; t < nt; t += 2) {
            const bool last = (t == nt - 2);
            const char* a1 = cA + (size_t)(t + 1) * kstepA;
            const char* a2 = last ? nA : cA + (size_t)(t + 2) * kstepA; const char* b2 = last ? nB : cB + (size_t)(t + 2) * kstepB;
            const char* a3 = a2 + kstepA; const char* b3 = b2 + kstepB;
            PG8_LDB(B0, 0, 0); PG8_LDB(B1, 0, 1); PG8_SCHED; PG8_LDA(At, 0, 0); PG8_STAGE(PG8_SA(1, 1), a1 + hstepA, voffA);
            PG8_WAIT_V(8); PG8_WAIT_L(0); PG8_BAR; PG8_MMA(0, 0, At, B0); PG8_MMA(0, 1, At, B1); PG8_BAR; PG8_SCHED;
            PG8_LDA(At, 0, 1); PG8_STAGE(PG8_SB(0, 0), b2, voffB); PG8_STAGE(PG8_SB(0, 1), b2 + hstepB, voffB); PG8_STAGE(PG8_SA(0, 0), a2, voffA);
            PG8_WAIT_V(8); PG8_WAIT_L(0); PG8_BAR; PG8_MMA(1, 0, At, B0); PG8_MMA(1, 1, At, B1); PG8_BAR; PG8_SCHED;
            PG8_LDB(B0, 1, 0); PG8_LDB(B1, 1, 1); PG8_SCHED; PG8_LDA(At, 1, 0); PG8_STAGE(PG8_SA(0, 1), a2 + hstepA, voffA);
            PG8_WAIT_V(8); PG8_WAIT_L(0); PG8_BAR; PG8_MMA(0, 0, At, B0); PG8_MMA(0, 1, At, B1); PG8_BAR; PG8_SCHED;
            PG8_LDA(At, 1, 1); PG8_STAGE(PG8_SB(1, 0), b3, voffB); PG8_STAGE(PG8_SB(1, 1), b3 + hstepB, voffB); PG8_STAGE(PG8_SA(1, 0), a3, voffA);
            PG8_WAIT_V(8); PG8_WAIT_L(0); PG8_BAR; PG8_MMA(1, 0, At, B0); PG8_MMA(1, 1, At, B1); PG8_BAR; PG8_SCHED;
        }
        if (wr == 0) PG8_BAR;
        if constexpr (FP8 == 2) { asm volatile("s_nop 7\n\ts_nop 7\n\ts_nop 7\n\ts_nop 7" ::: "memory"); PG8_SCHED; }
        E(acc, cur, wr, wc, fr, fq, lds + STAGE_BYTES);
        if (!has_next) break;
#pragma unroll
        for (int a = 0; a < 2; ++a)
#pragma unroll
            for (int b = 0; b < 2; ++b)
#pragma unroll
                for (int m = 0; m < 4; ++m)
#pragma unroll
                    for (int n = 0; n < 2; ++n) acc[a][b][m][n] = (f32x4){0.f, 0.f, 0.f, 0.f};
        cur = nxt; cA = nA; cB = nB; ++ui;
        if (wr == 1) PG8_BAR;
    }
    PG8_WAIT_V(0);
    PG8_BAR;
#undef PG8_SA
#undef PG8_SB
#undef PG8_STAGE
#undef PG8_LDA
#undef PG8_LD8
#undef PG8_LDB
#undef PG8_MMA
#undef PG8_WAIT_V
#undef PG8_WAIT_L
#undef PG8_BAR
#undef PG8_SCHED
}
}

#define XB_TMO      128
#define XB_XCNT(j)  (256  + 64 * (j))
#define XB_XSUB(j)  (1280 + 64 * (j))
#define XB_XGEN(j)  (2304 + 64 * (j))
#define XB_TOP      3328
#define XB_TOPGEN   3392
#define XCD_BAR_WORDS 3456
#define XB_SPIN_CAP (1u << 22)

__device__ __forceinline__ unsigned xb_ld(unsigned* p)              { return __hip_atomic_load(p, __ATOMIC_RELAXED, __HIP_MEMORY_SCOPE_AGENT); }
__device__ __forceinline__ unsigned xb_add(unsigned* p, unsigned v) { return __hip_atomic_fetch_add(p, v, __ATOMIC_RELAXED, __HIP_MEMORY_SCOPE_AGENT); }
__device__ __forceinline__ unsigned xb_xcc_id() { return (unsigned)__builtin_amdgcn_s_getreg((3 << 11) | 20) & 0xFu; }
#define XB_SPIN(cond, bar) do { unsigned _sp = 0; while (cond) { __builtin_amdgcn_s_sleep(1); \
    if ((++_sp & 255u) == 0u) { if (xb_ld(&(bar)[XB_TMO])) break; if (_sp > XB_SPIN_CAP) { atomicAdd(&(bar)[XB_TMO], 1u); break; } } } } while (0)

struct XcdBarrier { unsigned* bar; unsigned x; volatile LAS unsigned* st; };

__device__ __forceinline__ XcdBarrier xcd_barrier_post(unsigned* bar, volatile LAS unsigned* st) {
    XcdBarrier b; b.bar = bar; b.x = xb_xcc_id(); b.st = st;
    if (threadIdx.x == 0) (void)xb_add(&bar[XB_XCNT(b.x)], 1u);
    return b;
}
__device__ __forceinline__ void xcd_barrier_complete(unsigned* bar, unsigned x, unsigned& nloc, unsigned& nx) {
    const unsigned G = gridDim.x * gridDim.y * gridDim.z;
    unsigned sum, cnt, mine, sp = 0u;
    for (;;) {
        sum = 0u; cnt = 0u; mine = 0u;
#pragma unroll
        for (unsigned j = 0; j < 16; ++j) { const unsigned c = xb_ld(&bar[XB_XCNT(j)]); sum += c; cnt += (c > 0u) ? 1u : 0u; mine = (j == x) ? c : mine; }
        if (sum == G) break;
        __builtin_amdgcn_s_sleep(1);
        if ((++sp & 255u) == 0u) { if (xb_ld(&bar[XB_TMO])) break; if (sp > XB_SPIN_CAP) { atomicAdd(&bar[XB_TMO], 1u); break; } }
    }
    nloc = mine > 0u ? mine : 1u; nx = cnt > 0u ? cnt : 1u;
}
__device__ __forceinline__ void xcd_barrier(const XcdBarrier& b) {
    asm volatile("s_waitcnt vmcnt(0)" ::: "memory");
    __syncthreads();
    if (threadIdx.x == 0) {
        unsigned* bar = b.bar; unsigned bx_ = b.x; asm volatile("" : "+s"(bar), "+s"(bx_));
        __builtin_amdgcn_s_waitcnt(0);
        unsigned nloc = b.st[0], nx = b.st[1];
        if (nloc == 0u) { xcd_barrier_complete(bar, bx_, nloc, nx); b.st[0] = nloc; b.st[1] = nx; }
        const unsigned old = xb_add(&bar[XB_XSUB(bx_)], 1u);
        const unsigned gen = old / nloc;
        if (old + 1u == (gen + 1u) * nloc) {
            __builtin_amdgcn_fence(__ATOMIC_RELEASE, "agent");
            asm volatile("s_waitcnt vmcnt(0)" ::: "memory");
            const unsigned og = xb_add(&bar[XB_TOP], 1u);
            const unsigned tg = og / nx;
            if (og + 1u == (tg + 1u) * nx) xb_add(&bar[XB_TOPGEN], 1u);
            else XB_SPIN(xb_ld(&bar[XB_TOPGEN]) == tg, bar);
            __builtin_amdgcn_fence(__ATOMIC_ACQUIRE, "agent");
            xb_add(&bar[XB_XGEN(bx_)], 1u);
            asm volatile("s_waitcnt vmcnt(0)" ::: "memory");
        } else {
            XB_SPIN(xb_ld(&bar[XB_XGEN(bx_)]) == gen, bar);
            __builtin_amdgcn_fence(__ATOMIC_ACQUIRE, "agent");
            asm volatile("s_waitcnt vmcnt(0)" ::: "memory");
        }
    }
    __syncthreads();
}

namespace att {
constexpr int NW = 8, QBLK = 32, KVBLK = 64;
constexpr float THR2 = 8.f * LOG2E;
enum { K_MEM = 0, K_FOX = 1, K_MLA = 2, K_DIL = 3, K_DSA = 4 };
constexpr int L_V = 0, L_K = 49152, L_XB = 100352, L_TBL = 106496, L_END = 141312, VB = 16384;

struct AP {
    const bf16_t* Q; const bf16_t* K; const bf16_t* V; bf16_t* O;
    long qs, ks, vs, os;
    int kt0, nt;
    int q0;
    float C;
    const float* cum; long cums;
    const u64* msk;
    float* ost; long osts;
    float* mst; long msts;
    int carry_in, carry_out;
    int o8;
    const float* t5; int head, dil;
};

#define ATT_SBAR() __builtin_amdgcn_sched_barrier(0)
__device__ __forceinline__ int crow(int r, int hi) { return (r & 3) + 8 * (r >> 2) + 4 * hi; }
__device__ __forceinline__ int t5_bucket(int dist) {
    const int n = dist < 0 ? 0 : dist; if (n < 16) return n;
    const float v = __log2f((float)n * 0.0625f) * (16.0f / 7.0f); int b = 16 + (int)v; return b > 31 ? 31 : b;
}
__device__ __forceinline__ void rowmax_decide(const f32x16& p0, const f32x16& p1, float& m_reg, float& alpha) {
    float pmax = p0[0];
#pragma unroll
    for (int r = 1; r < 16; ++r) pmax = fmaxf(pmax, p0[r]);
#pragma unroll
    for (int r = 0; r < 16; ++r) pmax = fmaxf(pmax, p1[r]);
    { auto rr = __builtin_amdgcn_permlane32_swap(__float_as_uint(pmax), __float_as_uint(pmax), false, false); pmax = fmaxf(__uint_as_float(rr[0]), __uint_as_float(rr[1])); }
    if (__builtin_expect(__all(pmax - m_reg <= THR2), 1)) { alpha = 1.f; }
    else { const float mn = fmaxf(m_reg, pmax); alpha = __builtin_amdgcn_exp2f(m_reg - mn); m_reg = mn; }
}
__device__ __forceinline__ float half_sum(float ps) {
    auto rr = __builtin_amdgcn_permlane32_swap(__float_as_uint(ps), __float_as_uint(ps), false, false); return __uint_as_float(rr[0]) + __uint_as_float(rr[1]);
}
__device__ __forceinline__ void pack_p(const f32x16& p0, const f32x16& p1, bf16x8& pa0, bf16x8& pa1, bf16x8& pa2, bf16x8& pa3) {
#define ATT_PK4(P, BASE, OUT) do { unsigned a0 = cvt_pk_bf16(P[BASE + 0], P[BASE + 1]), a1 = cvt_pk_bf16(P[BASE + 2], P[BASE + 3]);   \
    unsigned b0 = cvt_pk_bf16(P[BASE + 4], P[BASE + 5]), b1 = cvt_pk_bf16(P[BASE + 6], P[BASE + 7]);                              \
    auto r0 = __builtin_amdgcn_permlane32_swap(a0, b0, false, false); auto r1 = __builtin_amdgcn_permlane32_swap(a1, b1, false, false); \
    u32x4 w = {r0[0], r1[0], r0[1], r1[1]}; OUT = __builtin_bit_cast(bf16x8, w); } while (0)
    ATT_PK4(p0, 0, pa0); ATT_PK4(p0, 8, pa1); ATT_PK4(p1, 0, pa2); ATT_PK4(p1, 8, pa3);
#undef ATT_PK4
}
template <int DK, int NQL>
__device__ __forceinline__ void qkt(f32x16& p0, f32x16& p1, const LAS unsigned char* Ks, const int (&kad)[4], const bf16x8* qr, const LAS unsigned char* qsp) {
    p0 = f32x16{}; p1 = f32x16{};
    constexpr int ND = DK / 16, NQR = ND - NQL;
#define ATT_LDK(d, hf) (*(const LAS bf16x8*)(Ks + ((DK == 128) ? (kad[(d) & 3] ^ (((d) >> 2) ? 128 : 0)) : (kad[(d) & 3] + 128 * ((d) >> 2))) + (hf) * 32 * DK * 2))
#define ATT_LDQ(d) (((d) < NQR) ? qr[(d) < NQR ? (d) : 0] : *(const LAS bf16x8*)(qsp + ((d) - NQR) * 1024))
    bf16x8 b0 = ATT_LDK(0, 0), b1 = ATT_LDK(0, 1), qf = ATT_LDQ(0);
#pragma unroll
    for (int d0 = 0; d0 < ND; ++d0) {
        bf16x8 c0 = b0, c1 = b1, qn = qf;
        if (d0 + 1 < ND) { c0 = ATT_LDK(d0 + 1, 0); c1 = ATT_LDK(d0 + 1, 1); qn = ATT_LDQ(d0 + 1); }
        ATT_SBAR();
        p0 = __builtin_amdgcn_mfma_f32_32x32x16_bf16(b0, qf, p0, 0, 0, 0);
        p1 = __builtin_amdgcn_mfma_f32_32x32x16_bf16(b1, qf, p1, 0, 0, 0);
        ATT_SBAR();
        b0 = c0; b1 = c1; qf = qn; }
#undef ATT_LDK
#undef ATT_LDQ
}
__device__ __forceinline__ int v_st(int k, int c) { const int kk = (k & ~0xC) | ((k & 4) << 1) | ((k & 8) >> 1); return ((kk >> 3) * 4 + (c >> 5)) * 512 + ((kk & 7) * 32 + (c & 31)) * 2; }
__device__ __forceinline__ int v_rd_base(int lane) { return ((lane & 3) << 3) | (((lane >> 2) & 3) << 6) | (((lane >> 4) & 1) << 5) | (((lane >> 5) & 1) << 8); }
constexpr int v_rd_off(int d0, int ks, int half) { return d0 * 512 + ks * 4096 + half * 2048; }
template <int OFF> __device__ __forceinline__ s16x4 tr_read(int vb) { s16x4 r; asm volatile("ds_read_b64_tr_b16 %0, %1 offset:%2" : "=&v"(r) : "v"(vb), "i"(OFF) : "memory"); return r; }
struct VF { s16x4 l0, h0, l1, h1, l2, h2, l3, h3; };
template <int D0> __device__ __forceinline__ void pv_read(VF& f, int vb) {
    f.l0 = tr_read<v_rd_off(D0, 0, 0)>(vb); f.h0 = tr_read<v_rd_off(D0, 0, 1)>(vb); f.l1 = tr_read<v_rd_off(D0, 1, 0)>(vb); f.h1 = tr_read<v_rd_off(D0, 1, 1)>(vb);
    f.l2 = tr_read<v_rd_off(D0, 2, 0)>(vb); f.h2 = tr_read<v_rd_off(D0, 2, 1)>(vb); f.l3 = tr_read<v_rd_off(D0, 3, 0)>(vb); f.h3 = tr_read<v_rd_off(D0, 3, 1)>(vb);
}
#define ATT_VWAIT(n, f) asm volatile("s_waitcnt lgkmcnt(" #n ")" : "+v"(f.l0), "+v"(f.h0), "+v"(f.l1), "+v"(f.h1), "+v"(f.l2), "+v"(f.h2), "+v"(f.l3), "+v"(f.h3) :: "memory")
#define ATT_PK(L, H) (bf16x8){L[0], L[1], L[2], L[3], H[0], H[1], H[2], H[3]}
__device__ __forceinline__ void pv_only(f32x16* o, int vb, bf16x8 pa0, bf16x8 pa1, bf16x8 pa2, bf16x8 pa3) {
    VF fa, fb;
#define ATT_MMA4(od, f) do { od = __builtin_amdgcn_mfma_f32_32x32x16_bf16(pa0, ATT_PK(f.l0, f.h0), od, 0, 0, 0); od = __builtin_amdgcn_mfma_f32_32x32x16_bf16(pa1, ATT_PK(f.l1, f.h1), od, 0, 0, 0); \
        od = __builtin_amdgcn_mfma_f32_32x32x16_bf16(pa2, ATT_PK(f.l2, f.h2), od, 0, 0, 0); od = __builtin_amdgcn_mfma_f32_32x32x16_bf16(pa3, ATT_PK(f.l3, f.h3), od, 0, 0, 0); } while (0)
    pv_read<0>(fa, vb); pv_read<1>(fb, vb);
    ATT_VWAIT(8, fa); ATT_SBAR(); ATT_MMA4(o[0], fa); ATT_SBAR(); pv_read<2>(fa, vb);
    ATT_VWAIT(8, fb); ATT_SBAR(); ATT_MMA4(o[1], fb); ATT_SBAR(); pv_read<3>(fb, vb);
    ATT_VWAIT(8, fa); ATT_SBAR(); ATT_MMA4(o[2], fa); ATT_SBAR();
    ATT_VWAIT(0, fb); ATT_SBAR(); ATT_MMA4(o[3], fb);
#undef ATT_MMA4
}
__device__ __forceinline__ float sm_only(f32x16& p0, f32x16& p1, float m) {
    float s = 0.f;
#pragma unroll
    for (int r = 0; r < 16; ++r) { p0[r] = __builtin_amdgcn_exp2f(p0[r] - m); s += p0[r]; }
#pragma unroll
    for (int r = 0; r < 16; ++r) { p1[r] = __builtin_amdgcn_exp2f(p1[r] - m); s += p1[r]; }
    return s;
}
__device__ __forceinline__ float pv_sm(f32x16* o, int vb, bf16x8 pa0, bf16x8 pa1, bf16x8 pa2, bf16x8 pa3, f32x16& p0, f32x16& p1, float m) {
    VF fa, fb; float s = 0.f;
#define ATT_GAP(od, pa, L, H, X, B) do { od = __builtin_amdgcn_mfma_f32_32x32x16_bf16(pa, ATT_PK(L, H), od, 0, 0, 0); \
        { float t0_ = X[B] - m, t1_ = X[B + 1] - m, e0_, e1_; asm volatile("v_exp_f32 %0, %1" : "=v"(e0_) : "v"(t0_)); asm volatile("v_exp_f32 %0, %1" : "=v"(e1_) : "v"(t1_));     \
          X[B] = e0_; X[B + 1] = e1_; s += e0_; s += e1_; } ATT_SBAR(); } while (0)
    pv_read<0>(fa, vb); pv_read<1>(fb, vb);
    ATT_VWAIT(8, fa); ATT_SBAR();
    ATT_GAP(o[0], pa0, fa.l0, fa.h0, p0, 0); ATT_GAP(o[0], pa1, fa.l1, fa.h1, p0, 2); ATT_GAP(o[0], pa2, fa.l2, fa.h2, p0, 4); ATT_GAP(o[0], pa3, fa.l3, fa.h3, p0, 6);
    pv_read<2>(fa, vb); ATT_VWAIT(8, fb); ATT_SBAR();
    ATT_GAP(o[1], pa0, fb.l0, fb.h0, p0, 8); ATT_GAP(o[1], pa1, fb.l1, fb.h1, p0, 10); ATT_GAP(o[1], pa2, fb.l2, fb.h2, p0, 12); ATT_GAP(o[1], pa3, fb.l3, fb.h3, p0, 14);
    pv_read<3>(fb, vb); ATT_VWAIT(8, fa); ATT_SBAR();
    ATT_GAP(o[2], pa0, fa.l0, fa.h0, p1, 0); ATT_GAP(o[2], pa1, fa.l1, fa.h1, p1, 2); ATT_GAP(o[2], pa2, fa.l2, fa.h2, p1, 4); ATT_GAP(o[2], pa3, fa.l3, fa.h3, p1, 6);
    ATT_VWAIT(0, fb); ATT_SBAR();
    ATT_GAP(o[3], pa0, fb.l0, fb.h0, p1, 8); ATT_GAP(o[3], pa1, fb.l1, fb.h1, p1, 10); ATT_GAP(o[3], pa2, fb.l2, fb.h2, p1, 12); ATT_GAP(o[3], pa3, fb.l3, fb.h3, p1, 14);
#undef ATT_GAP
    return s;
}

template <int KIND>
__device__ __forceinline__ void score(f32x16& p0, f32x16& p1, const AP& a, int t, int buf, LAS unsigned char* lds, int wid, int r32, int hi, float cq) {
    const float C = a.C; const int k0 = t * 64; const int q = a.q0 + wid * 32 + r32; const float NEG = -INFINITY;
    if constexpr (KIND == K_FOX) {
        const LAS f32x4* cb = (const LAS f32x4*)(lds + L_XB + buf * 2048) + hi;
#pragma unroll
        for (int g = 0; g < 4; ++g) { const f32x4 c4 = cb[2 * g], c4b = cb[2 * g + 8];
#pragma unroll
            for (int j = 0; j < 4; ++j) { p0[4 * g + j] = fmaf(p0[4 * g + j], C, -c4[j]); p1[4 * g + j] = fmaf(p1[4 * g + j], C, -c4b[j]); } }
    } else if constexpr (KIND == K_DSA || KIND == K_DIL) {
        const LAS float* tb = (const LAS float*)(lds + L_TBL) + (q - k0 - 4 * hi + 256 - 59);
#pragma unroll
        for (int r = 0; r < 16; ++r) { const int cc = (r & 3) + 8 * (r >> 2); p0[r] = fmaf(p0[r], C, tb[59 - cc]); p1[r] = fmaf(p1[r], C, tb[59 - cc - 32]); }
        if constexpr (KIND == K_DSA) {
            const LAS unsigned* mb = (const LAS unsigned*)(lds + L_XB + buf * 2048) + wid * 64;
            const unsigned wl = mb[r32] >> (4 * hi), wh = mb[32 + r32] >> (4 * hi);
#pragma unroll
            for (int r = 0; r < 16; ++r) { const int cc = (r & 3) + 8 * (r >> 2); p0[r] = ((wl >> cc) & 1u) ? p0[r] : NEG; p1[r] = ((wh >> cc) & 1u) ? p1[r] : NEG; }
        }
    } else {
#pragma unroll
        for (int r = 0; r < 16; ++r) { p0[r] *= C; p1[r] *= C; }
    }
    if constexpr (KIND == K_FOX || KIND == K_MLA) {
        if (k0 + 63 > a.q0) {
            const int kb = k0 + 4 * hi;
#pragma unroll
            for (int r = 0; r < 16; ++r) { const int kv = kb + (r & 3) + 8 * (r >> 2); if (kv > q) p0[r] = NEG; if (kv + 32 > q) p1[r] = NEG; }
        }
    }
}

template <int KIND, int DK>
__device__ __forceinline__ void attn_unit(LAS unsigned char* lds, const AP& a, const int wave_id) {
    const int tid = tid_opaque(wave_id);
    const int lane = tid & 63, r32 = lane & 31, hi = lane >> 5; const int wid = __builtin_amdgcn_readfirstlane(tid >> 6);
    constexpr bool HAS_TBL = (KIND == K_DSA || KIND == K_DIL), HAS_X = (KIND == K_FOX || KIND == K_DSA);
    constexpr int KB = KVBLK * DK * 2, NKC = DK / 8, NKL = (64 * NKC) / 512, ND0 = DK / 16;
    constexpr int NQL = (DK == 192) ? 2 : (HAS_TBL ? 2 : 4), NQR = ND0 - NQL, NLD = NKL + 2 + (HAS_X ? 1 : 0);
    constexpr int LWS = (DK == 192) ? 122880 : 98304, LQSP = (DK == 192) ? 124928 : (HAS_TBL ? 123904 : 106496);
    LAS unsigned char* V_lds = lds + L_V; LAS unsigned char* K_lds = lds + L_K;
    LAS float* wsf = (LAS float*)(lds + LWS) + wid * 64; LAS float* li_l = wsf; LAS float* al_l = wsf + 32;
    LAS unsigned char* qsp = lds + LQSP + wid * (NQL * 1024) + lane * 16;
    float m_reg = -1e30f, l_reg = 0.f; f32x16 o[4] = {}; bf16x8 qr[NQR];
    const int qi = wid * 32 + r32;
    const bf16_t* Qw = a.Q + (long)qi * a.qs + hi * 8;
#pragma unroll
    for (int d0 = 0; d0 < ND0; ++d0) { const bf16x8 qv = *(const bf16x8*)(Qw + d0 * 16); if (d0 < NQR) qr[d0 < NQR ? d0 : 0] = qv; else *(LAS bf16x8*)(qsp + (d0 - NQR) * 1024) = qv; }
    float cq = 0.f;

    if constexpr (KIND == K_DIL) {
        if (a.carry_in) {
            m_reg = a.mst[(long)qi * a.msts]; l_reg = a.mst[(long)qi * a.msts + 1];
#pragma unroll
            for (int r = 0; r < 16; ++r) { const unsigned* orow = (const unsigned*)a.ost + (long)(wid * 32 + crow(r, hi)) * a.osts + r32;
                const unsigned w0 = __builtin_nontemporal_load(orow), w1 = __builtin_nontemporal_load(orow + 32);
                o[0][r] = bf_lo(w0); o[1][r] = bf_hi(w0); o[2][r] = bf_lo(w1); o[3][r] = bf_hi(w1); }
        }
    }
    if constexpr (KIND == K_DSA) {
        LAS float* tbl = (LAS float*)(lds + L_TBL);
        for (int i = tid; i < 4352; i += 512) { const int dist = i - 256; tbl[i] = dist < 0 ? -INFINITY : a.t5[t5_bucket(dist) * 16 + a.head] * LOG2E; }
    }
    if constexpr (KIND == K_DIL) {
        LAS float* tbl = (LAS float*)(lds + L_TBL);
        for (int i = tid; i < 640; i += 512) { const int rel = i - 256; tbl[i] = (rel < 0 || rel > 128) ? -INFINITY : a.t5[t5_bucket(rel * a.dil) * 16 + a.head] * LOG2E; }
    }
    int ksrc[NKL], vsrc[2];
#pragma unroll
    for (int c = 0; c < NKL; ++c) { const int Lb = (wid * NKL + c) * 1024 + lane * 16, row = Lb / (DK * 2), chp = (Lb % (DK * 2)) / 16; ksrc[c] = row * (int)a.ks + ((DK == 128) ? (chp ^ (row & 15)) : ((chp & ~7) | ((chp & 7) ^ (row & 7)))) * 8; }
#pragma unroll
    for (int c = 0; c < 2; ++c) { const int sl = (2 * wid + c) * 64 + lane, st = sl >> 5, wi = sl & 31, kk = ((st >> 2) << 3) | (wi >> 2), k = (kk & ~0xC) | ((kk & 4) << 1) | ((kk & 8) >> 1); vsrc[c] = k * (int)a.vs + (st & 3) * 32 + (wi & 3) * 8; }
    const int vb0 = (int)(unsigned)(uintptr_t)V_lds + v_rd_base(lane);
    int kad[4];
#pragma unroll
    for (int j = 0; j < 4; ++j) kad[j] = r32 * (DK * 2) + (((hi | (j << 1)) ^ (r32 & 7)) << 4) + ((DK == 128) ? 128 * ((r32 >> 3) & 1) : 0);
#define ATT_DMA(t, sl) do { const long kb_ = (long)(t) * 64; \
        _Pragma("unroll") for (int c_ = 0; c_ < NKL; ++c_) __builtin_amdgcn_global_load_lds((const unsigned*)(a.K + kb_ * a.ks + ksrc[c_]), (LAS unsigned*)(K_lds + (sl) * KB + (wid * NKL + c_) * 1024), 16, 0, 0); \
        _Pragma("unroll") for (int c_ = 0; c_ < 2; ++c_) __builtin_amdgcn_global_load_lds((const unsigned*)(a.V + kb_ * a.vs + vsrc[c_]), (LAS unsigned*)(V_lds + (sl) * VB + (2 * wid + c_) * 1024), 16, 0, 0); \
        if constexpr (KIND == K_FOX) __builtin_amdgcn_global_load_lds((const unsigned*)(a.cum + (kb_ + lane) * a.cums), (LAS unsigned*)(lds + L_XB + (sl) * 2048), 4, 0, 0);     \
        if constexpr (KIND == K_DSA) __builtin_amdgcn_global_load_lds((const unsigned*)(a.msk + (long)(wid * 32 + r32) * 64 + (t)) + hi, (LAS unsigned*)(lds + L_XB + (sl) * 2048 + wid * 256), 4, 0, 0); } while (0)
#define ATT_RESC(al) do { if (__any((al) < 1.f)) { if (hi == 0) al_l[r32] = (al); asm volatile("s_waitcnt lgkmcnt(0)" ::: "memory"); \
        _Pragma("unroll") for (int d = 0; d < 4; ++d) _Pragma("unroll") for (int r = 0; r < 16; ++r) o[d][r] *= al_l[crow(r, hi)]; } } while (0)
#define ATT_BAR() do { asm volatile("s_waitcnt lgkmcnt(0)" ::: "memory"); __builtin_amdgcn_s_barrier(); asm volatile("" ::: "memory"); } while (0)
    f32x16 p0, p1; float al = 1.f; bf16x8 pa0, pa1, pa2, pa3; const int NT = a.nt, T0 = a.kt0;
    asm volatile("s_waitcnt vmcnt(0) lgkmcnt(0)" ::: "memory");
    ATT_DMA(T0, 0);
    if (NT > 1) { ATT_DMA(T0 + 1, 1); asm volatile("s_waitcnt vmcnt(%0)" :: "n"(NLD) : "memory"); } else { asm volatile("s_waitcnt vmcnt(0)" ::: "memory"); }
    ATT_BAR();
    int sl = 0, sl2 = 2;
    for (int jj = 0; jj < NT; ++jj) {
        const int t = T0 + jj;
        if (jj + 2 < NT) ATT_DMA(t + 2, sl2);
        bool lv = true; { const int k0_ = t * 64, qw_ = a.q0 + wid * 32;
            if constexpr (KIND == K_FOX || KIND == K_MLA || KIND == K_DSA) lv = k0_ <= qw_ + 31;
            if constexpr (KIND == K_DIL) lv = (k0_ <= qw_ + 31) && (k0_ + 63 >= qw_ - 128); }
        if (lv) {
            ATT_SBAR(); qkt<DK, NQL>(p0, p1, K_lds + sl * KB, kad, qr, qsp);
            score<KIND>(p0, p1, a, t, sl, lds, wid, r32, hi, cq);
            rowmax_decide(p0, p1, m_reg, al);
            const float ps = sm_only(p0, p1, m_reg);
            l_reg = l_reg * al + half_sum(ps);
            ATT_RESC(al);
            pack_p(p0, p1, pa0, pa1, pa2, pa3); ATT_SBAR();
            pv_only(o, vb0 + sl * VB, pa0, pa1, pa2, pa3);
        }
        if (jj + 2 < NT) asm volatile("s_waitcnt vmcnt(%0)" :: "n"(NLD) : "memory"); else asm volatile("s_waitcnt vmcnt(0)" ::: "memory");
        ATT_BAR();
        sl = (sl == 2) ? 0 : sl + 1; sl2 = (sl2 == 2) ? 0 : sl2 + 1;
    }
    bool stateout = false;
    if constexpr (KIND == K_DIL) stateout = a.carry_out != 0;
    if (stateout) {
        int qi2 = qi; asm volatile("" : "+v"(qi2));
        if (hi == 0) { a.mst[(long)qi2 * a.msts] = m_reg; a.mst[(long)qi2 * a.msts + 1] = l_reg; }
        asm volatile("s_nop 7\n\ts_nop 7\n\ts_nop 7" : "+v"(o[0]), "+v"(o[1]), "+v"(o[2]), "+v"(o[3]));
#pragma unroll
        for (int r = 0; r < 16; ++r) { unsigned* orow = (unsigned*)a.ost + (long)(wid * 32 + crow(r, hi)) * a.osts + r32;
            __builtin_nontemporal_store(cvt_pk_bf16(o[0][r], o[1][r]), orow); __builtin_nontemporal_store(cvt_pk_bf16(o[2][r], o[3][r]), orow + 32); }
        __syncthreads();
    } else {
        if (hi == 0) li_l[r32] = l_reg;
        asm volatile("s_waitcnt lgkmcnt(0)" ::: "memory");
        float rli[16];
#pragma unroll
        for (int r = 0; r < 16; ++r) rli[r] = __builtin_amdgcn_rcpf(li_l[crow(r, hi)]);
        __syncthreads();
        LAS unsigned short* ost = (LAS unsigned short*)(lds + wid * 8192);
#pragma unroll
        for (int r = 0; r < 16; ++r) { const int orow = crow(r, hi);
#pragma unroll
            for (int d0 = 0; d0 < 4; ++d0) { const unsigned w = cvt_pk_bf16(o[d0][r] * rli[r], 0.f); ost[orow * 128 + d0 * 32 + r32] = (unsigned short)w; } }
        asm volatile("s_waitcnt lgkmcnt(0)" ::: "memory");
#pragma unroll
        for (int i = 0; i < 8; ++i) { const int ch = lane + 64 * i, row = ch >> 4, c16 = ch & 15;
            const u32x4 v = *(const LAS u32x4*)(lds + wid * 8192 + row * 256 + c16 * 16);
            if (a.o8) {
              int q0 = __builtin_amdgcn_cvt_pk_fp8_f32(bf_lo(v.x) * 16.f, bf_hi(v.x) * 16.f, 0, false); q0 = __builtin_amdgcn_cvt_pk_fp8_f32(bf_lo(v.y) * 16.f, bf_hi(v.y) * 16.f, q0, true);
              int q1 = __builtin_amdgcn_cvt_pk_fp8_f32(bf_lo(v.z) * 16.f, bf_hi(v.z) * 16.f, 0, false); q1 = __builtin_amdgcn_cvt_pk_fp8_f32(bf_lo(v.w) * 16.f, bf_hi(v.w) * 16.f, q1, true);
              *(u32x2*)((unsigned char*)a.O + (long)(wid * 32 + row) * a.os + c16 * 8) = (u32x2){(unsigned)q0, (unsigned)q1}; }
            else *(u32x4*)(a.O + (long)(wid * 32 + row) * a.os + c16 * 8) = v; }
        __syncthreads();
    }
#undef ATT_DMA
#undef ATT_RESC
#undef ATT_BAR
}
#undef ATT_VWAIT
#undef ATT_PK
}

struct Fr { LAS unsigned char* lds; int tid, lane, wave, vcu, G, gw, ngw; };

__device__ __forceinline__ float wave_sum(float v) {
#pragma unroll
    for (int o = 1; o < 64; o <<= 1) v += __shfl_xor(v, o);
    return v;
}
__device__ __forceinline__ void unpack8(const u32x4 w, float (&v)[8]) {
    v[0] = bf_lo(w.x); v[1] = bf_hi(w.x); v[2] = bf_lo(w.y); v[3] = bf_hi(w.y); v[4] = bf_lo(w.z); v[5] = bf_hi(w.z); v[6] = bf_lo(w.w); v[7] = bf_hi(w.w);
}
__device__ __forceinline__ u32x4 pack8(const float (&v)[8]) {
    u32x4 w; w.x = cvt_pk_bf16(v[0], v[1]); w.y = cvt_pk_bf16(v[2], v[3]); w.z = cvt_pk_bf16(v[4], v[5]); w.w = cvt_pk_bf16(v[6], v[7]); return w;
}
__device__ __forceinline__ float sumsq8(const float (&v)[8]) { return ((v[0] * v[0] + v[1] * v[1]) + (v[2] * v[2] + v[3] * v[3])) + ((v[4] * v[4] + v[5] * v[5]) + (v[6] * v[6] + v[7] * v[7])); }

__device__ __forceinline__ int map_col(int kind, int n) {
    switch (kind) {
        case 1: return 256 * (n >> 7) + (n & 127);
        case 2: return 256 * (n >> 7) + 128 + (n & 127);
        case 3: return n < 6144 ? n : (n < 6160 ? 6656 + (n - 6144) : 6144 + (n - 6160));
        case 4: return n < 1088 ? n : 1280 + (n - 1088);
        case 5: return n < 6144 ? n : (n < 18432 ? n + 512 : 6144 + (n - 18432));
        case 6: return n < 4176 ? n : 4352 + (n - 4176);
        default: return n;
    }
}
struct TrDesc { const float* W; const float* gain; bf16_t* WT; int K, N, ldt, kind, r, f8, tiled; };
__device__ __forceinline__ void tr_load(const TrDesc& d, int lane, f32x4 (&v)[16]) {
    const int nblk = (d.N + 63) / 64, kb = d.r / nblk, nb = d.r % nblk, k0 = 64 * kb, n = 64 * nb + 4 * (lane & 15); const bool ok = n < d.N;
    const float* src = d.W + (size_t)(k0 + (lane >> 4)) * d.N + (ok ? n : 0); const size_t rs = (size_t)4 * d.N;
#pragma unroll
    for (int j = 0; j < 16; ++j) v[j] = __builtin_nontemporal_load((const f32x4*)(src + (size_t)j * rs));
}
__device__ __forceinline__ void tr_store(const TrDesc& d, int lane, const f32x4 (&v)[16], LAS float* scr) {
    const int nblk = (d.N + 63) / 64, kb = d.r / nblk, nb = d.r % nblk, k0 = 64 * kb, n0 = 64 * nb;
    { LAS float* w = scr + (lane >> 4) * 65 + 4 * (lane & 15);
#pragma unroll
      for (int j = 0; j < 16; ++j) { w[j * 260 + 0] = v[j][0]; w[j * 260 + 1] = v[j][1]; w[j * 260 + 2] = v[j][2]; w[j * 260 + 3] = v[j][3]; } }
    const int c = lane & 7, nn = lane >> 3; float g[8];
#pragma unroll
    for (int jj = 0; jj < 8; ++jj) g[jj] = d.gain ? d.gain[k0 + 8 * c + jj] : 1.f;
    asm volatile("s_waitcnt lgkmcnt(0)" ::: "memory");
#pragma unroll
    for (int it = 0; it < 8; ++it) { const int nl = nn + 8 * it; const LAS float* rp = scr + (8 * c) * 65 + nl;
        u32x4 o; o.x = cvt_pk_bf16(rp[0 * 65] * g[0], rp[1 * 65] * g[1]); o.y = cvt_pk_bf16(rp[2 * 65] * g[2], rp[3 * 65] * g[3]); o.z = cvt_pk_bf16(rp[4 * 65] * g[4], rp[5 * 65] * g[5]); o.w = cvt_pk_bf16(rp[6 * 65] * g[6], rp[7 * 65] * g[7]);
        if (n0 + nl < d.N) {
            if (d.f8) { int q0 = __builtin_amdgcn_cvt_pk_fp8_f32(rp[0 * 65] * g[0] * 64.f, rp[1 * 65] * g[1] * 64.f, 0, false); q0 = __builtin_amdgcn_cvt_pk_fp8_f32(rp[2 * 65] * g[2] * 64.f, rp[3 * 65] * g[3] * 64.f, q0, true);
                        int q1 = __builtin_amdgcn_cvt_pk_fp8_f32(rp[4 * 65] * g[4] * 64.f, rp[5 * 65] * g[5] * 64.f, 0, false); q1 = __builtin_amdgcn_cvt_pk_fp8_f32(rp[6 * 65] * g[6] * 64.f, rp[7 * 65] * g[7] * 64.f, q1, true);
                        *(u32x2*)((unsigned char*)d.WT + (size_t)map_col(d.kind, n0 + nl) * d.ldt + k0 + 8 * c) = (u32x2){(unsigned)q0, (unsigned)q1}; }
            else if (d.tiled) { const int n = n0 + nl;
                *(u32x4*)(d.WT + ((((size_t)(n >> 8) * (d.K >> 6) + (k0 >> 6)) * 2 + ((n >> 7) & 1)) * 128 + (n & 127)) * 64 + 8 * c) = o; }
            else *(u32x4*)(d.WT + (size_t)map_col(d.kind, n0 + nl) * d.ldt + k0 + 8 * c) = o; } }
    asm volatile("s_waitcnt lgkmcnt(0)" ::: "memory");
}

__device__ __forceinline__ void rows2048(const Fr& F, const float* x, int nrows, bf16_t* xb, void* out, int mode) {
    for (int m = F.gw; m < nrows; m += F.ngw) {
        const f32x4* xr = (const f32x4*)(x + (size_t)m * DM) + F.lane; f32x4 v[8]; float s = 0.f;
#pragma unroll
        for (int j = 0; j < 8; ++j) { v[j] = xr[64 * j]; s += (v[j].x * v[j].x + v[j].y * v[j].y) + (v[j].z * v[j].z + v[j].w * v[j].w); }
        s = wave_sum(s);
        if (F.lane == 0) { if (mode) ((float*)out)[m] = __builtin_amdgcn_rsqf(s * (1.0f / DM) + RMS_EPS); else ((u64*)out)[m] = (u64)(s * pg8::SSQ_SCALE); }
        if (xb) { u32x2* o8 = (u32x2*)(xb + (size_t)m * DM) + F.lane;
#pragma unroll
            for (int j = 0; j < 8; ++j) { u32x2 w; w.x = cvt_pk_bf16(v[j].x, v[j].y); w.y = cvt_pk_bf16(v[j].z, v[j].w); o8[64 * j] = w; } }
    }
}

__device__ __forceinline__ void hn_step(bf16_t* p, const float (&g)[8]) {
    float v[8]; unpack8(*(const u32x4*)p, v); float ss = sumsq8(v);
    ss += __shfl_xor(ss, 1); ss += __shfl_xor(ss, 2); ss += __shfl_xor(ss, 4); ss += __shfl_xor(ss, 8);
    const float rs = __builtin_amdgcn_rsqf(ss * (1.0f / 128.0f) + RMS_EPS);
#pragma unroll
    for (int j = 0; j < 8; ++j) v[j] = v[j] * rs * g[j];
    *(u32x4*)p = pack8(v);
}
__device__ __forceinline__ void load_gain8(const float* g, int lane, float (&o)[8]) {
#pragma unroll
    for (int j = 0; j < 8; ++j) o[j] = g ? g[(lane & 15) * 8 + j] : 1.f;
}
__device__ __forceinline__ void prep_rows(const Fr& F, bf16_t* P, long ld, int nrows, int c0, int n0, const float* g0, int c1, int n1, const float* g1, int c2, int n2, const float* g2) {
    float ga[8], gb[8], gc[8]; load_gain8(g0, F.lane, ga); load_gain8(g1, F.lane, gb); load_gain8(g2, F.lane, gc);
    for (int m = F.gw; m < nrows; m += F.ngw) {
        bf16_t* row = P + (size_t)m * ld + F.lane * 8;
        for (int s = 0; s < n0; ++s) hn_step(row + c0 + s * 512, ga);
        for (int s = 0; s < n1; ++s) hn_step(row + c1 + s * 512, gb);
        for (int s = 0; s < n2; ++s) hn_step(row + c2 + s * 512, gc);
    }
}

__device__ __forceinline__ void fox_cumsum(const Fr& F, const float* FG, const float* b_f, float* CUM) {
    for (int task = ((F.gw & 15) == 0) ? (F.gw >> 4) : NB * NH; task < NB * NH; task += (F.ngw >> 4)) {
        const int b = task >> 4, h = task & 15; const float bias = b_f[h];
        const float* src = FG + ((size_t)b * SEQ + (size_t)F.lane * 64) * 16 + h; float v[64]; float run = 0.f;
#pragma unroll
        for (int i = 0; i < 64; ++i) { const float xg = src[(size_t)i * 16] + bias;
            const float e = __expf(-fabsf(xg)); const float ls = fminf(xg, 0.f) - __logf(1.0f + e);
            run += ls; v[i] = run; }
        float incl = run;
#pragma unroll
        for (int o = 1; o < 64; o <<= 1) { const float t = __shfl_up(incl, o); if (F.lane >= o) incl += t; }
        const float excl = incl - run;
        float* dst = CUM + ((size_t)b * SEQ + (size_t)F.lane * 64) * 16 + h;
#pragma unroll
        for (int i = 0; i < 64; ++i) dst[(size_t)i * 16] = (v[i] + excl) * LOG2E;
    }
}

__device__ const double ROPE_INV[32] = {
    1.0, 0.7498942093324559, 0.5623413251903491, 0.4216965034285822, 0.31622776601683794, 0.23713737056616552, 0.1778279410038923, 0.1333521432163324,
    0.1, 0.07498942093324558, 0.05623413251903491, 0.04216965034285822, 0.03162277660168379, 0.023713737056616554, 0.01778279410038923, 0.01333521432163324,
    0.01, 0.007498942093324558, 0.005623413251903491, 0.004216965034285823, 0.0031622776601683794, 0.0023713737056616554, 0.001778279410038923, 0.001333521432163324,
    0.001, 0.0007498942093324559, 0.0005623413251903491, 0.0004216965034285823, 0.00031622776601683794, 0.00023713737056616554, 0.0001778279410038923, 0.0001333521432163324};
__device__ __forceinline__ void rope_table(const Fr& F, const int* pos, float* COS, float* SIN) {
    const int gt = F.vcu * 512 + F.tid, ngt = F.G * 512;
    for (int i = gt; i < MTOK * 32; i += ngt) { const int m = i >> 5, f = i & 31;
        const double a = (double)pos[m] * (double)(float)ROPE_INV[f]; const double rev = a * 0.15915494309189535; const float fr = (float)(rev - floor(rev));
        COS[i] = __builtin_amdgcn_cosf(fr); SIN[i] = __builtin_amdgcn_sinf(fr); }
}

__device__ __forceinline__ void mla_prep_a(const Fr& F, bf16_t* P, float* RSQ, float* RSKV, bf16_t* KR, const float* rope_g1, const float* gmem, const float* COS, const float* SIN) {
    const int lane = F.lane; float gr[8];
#pragma unroll
    for (int j = 0; j < 8; ++j) gr[j] = rope_g1[(lane & 7) * 8 + j];
    for (int m = F.gw; m < MTOK; m += F.ngw) {
        bf16_t* pr = P + (size_t)m * 1792; float v[8];
        const u32x4 wq = *(const u32x4*)(pr + lane * 8), wk = *(const u32x4*)(pr + 512 + lane * 8);
        u32x4 w = (u32x4){0u, 0u, 0u, 0u}; if (lane < 8) w = *(const u32x4*)(pr + 1024 + lane * 8);
        const float* cp = COS + (size_t)m * 32 + (lane & 3) * 8; const float* sp = SIN + (size_t)m * 32 + (lane & 3) * 8; float cs[8], sn[8];
#pragma unroll
        for (int j = 0; j < 8; ++j) { cs[j] = cp[j]; sn[j] = sp[j]; }
        asm volatile("" ::: "memory");
        unpack8(wq, v); float ss = wave_sum(sumsq8(v)); if (lane == 0) RSQ[m] = __builtin_amdgcn_rsqf(ss * (1.0f / 512.0f) + RMS_EPS);
        unpack8(wk, v); ss = wave_sum(sumsq8(v)); if (lane == 0) RSKV[m] = __builtin_amdgcn_rsqf(ss * (1.0f / 512.0f) + RMS_EPS);
        unpack8(w, v); ss = sumsq8(v); ss += __shfl_xor(ss, 1); ss += __shfl_xor(ss, 2); ss += __shfl_xor(ss, 4);
        const float rs = __builtin_amdgcn_rsqf(ss * (1.0f / 64.0f) + RMS_EPS); float o[8];
#pragma unroll
        for (int j = 0; j < 8; ++j) { const float x = v[j] * rs * gr[j]; const float y = __shfl_xor(x, 4); o[j] = (lane & 4) ? (y * sn[j] + x * cs[j]) : (x * cs[j] - y * sn[j]); }
        if (lane < 8) *(u32x4*)(KR + (size_t)m * 64 + lane * 8) = pack8(o);
    }
}
__device__ __forceinline__ void mla_prep_b(const Fr& F, bf16_t* Q, const bf16_t* KV, bf16_t* KF, const bf16_t* KR, const float* nope_g, const float* rope_g, const float* COS, const float* SIN) {
    const int lane = F.lane, half = lane >> 5, l5 = lane & 31; float gqn[8], gqr[8], gkn[8];
#pragma unroll
    for (int j = 0; j < 8; ++j) { gqn[j] = nope_g[(l5 & 15) * 8 + j]; gkn[j] = nope_g[128 + (l5 & 15) * 8 + j]; gqr[j] = rope_g[(l5 & 7) * 8 + j]; }
    for (int m = F.gw; m < MTOK; m += F.ngw) {
        const float* cp = COS + (size_t)m * 32 + (l5 & 3) * 8; const float* sp = SIN + (size_t)m * 32 + (l5 & 3) * 8; float cs[8], sn[8];
#pragma unroll
        for (int j = 0; j < 8; ++j) { cs[j] = cp[j]; sn[j] = sp[j]; }
        u32x4 krw = (u32x4){0u, 0u, 0u, 0u}; if (l5 >= 16 && l5 < 24) krw = *(const u32x4*)(KR + (size_t)m * 64 + (l5 - 16) * 8);
        u32x4 qw[8], kw[8];
#pragma unroll
        for (int it = 0; it < 8; ++it) { const int h = 2 * it + half;
            qw[it] = (u32x4){0u, 0u, 0u, 0u}; if (l5 < 24) qw[it] = *(const u32x4*)(Q + (size_t)m * 3072 + h * 192 + l5 * 8);
            kw[it] = (u32x4){0u, 0u, 0u, 0u}; if (l5 < 16) kw[it] = *(const u32x4*)(KV + (size_t)m * 4096 + h * 256 + l5 * 8); }
        asm volatile("" ::: "memory");
#pragma unroll
        for (int it = 0; it < 8; ++it) { const int h = 2 * it + half;
            bf16_t* qrow = Q + (size_t)m * 3072 + h * 192 + l5 * 8; float v[8];
            unpack8(qw[it], v); float s8 = sumsq8(v); s8 += __shfl_xor(s8, 1); s8 += __shfl_xor(s8, 2); s8 += __shfl_xor(s8, 4); const float s16 = s8 + __shfl_xor(s8, 8);
            const float rs = (l5 < 16) ? __builtin_amdgcn_rsqf(s16 * (1.0f / 128.0f) + RMS_EPS) : __builtin_amdgcn_rsqf(s8 * (1.0f / 64.0f) + RMS_EPS);
            float o[8];
#pragma unroll
            for (int j = 0; j < 8; ++j) { const float x = v[j] * rs * ((l5 < 16) ? gqn[j] : gqr[j]); const float y = __shfl_xor(x, 4);
                const float rot = (l5 & 4) ? (y * sn[j] + x * cs[j]) : (x * cs[j] - y * sn[j]); o[j] = (l5 < 16) ? x : rot; }
            if (l5 < 24) *(u32x4*)qrow = pack8(o);
            bf16_t* kfrow = KF + (size_t)m * 3072 + h * 192;
            unpack8(kw[it], v); float k16 = sumsq8(v); k16 += __shfl_xor(k16, 1); k16 += __shfl_xor(k16, 2); k16 += __shfl_xor(k16, 4); k16 += __shfl_xor(k16, 8);
            const float krs = __builtin_amdgcn_rsqf(k16 * (1.0f / 128.0f) + RMS_EPS);
#pragma unroll
            for (int j = 0; j < 8; ++j) o[j] = v[j] * krs * gkn[j];
            if (l5 < 16) *(u32x4*)(kfrow + l5 * 8) = pack8(o);
            else if (l5 < 24) *(u32x4*)(kfrow + 128 + (l5 - 16) * 8) = krw;
        }
    }
}

__device__ __forceinline__ void dsa_indexer(const Fr& F, const bf16_t* P, float* SC) {
    constexpr int LDP = 4864, CQI = 3072, CKI = 4096, CWI = 4160;
    constexpr int RING = 81920;
    const int lane = F.lane, r32 = lane & 31, hg = lane >> 5;
    LAS float* ibuf = (LAS float*)(F.lds + F.wave * 9216);
    const int drow = 8 * F.wave + (lane >> 3), dchunk = (lane & 7) ^ ((lane >> 3) & 7);
#define IDX_DMA(t_) __builtin_amdgcn_global_load_lds((const unsigned*)(kbase + (size_t)(t_) * 64 * LDP), (LAS unsigned*)(F.lds + RING + ((t_) & 3) * 8192 + F.wave * 1024), 16, 0, 0)
    for (int ui = blockIdx.x; ui < 512; ui += F.G) {
        const int c = ui & 255, second = ui >> 8, b = c >> 5, qb0 = c & 31, qb = second ? 63 - qb0 : qb0;
        const size_t tok0 = (size_t)b * SEQ + qb * 64 + F.wave * 8;
        bf16x8 aq[4][4]; f32x2 wv[4][8];
#pragma unroll
        for (int g = 0; g < 4; ++g) { const size_t tok = tok0 + 2 * g + (r32 >> 4); const bf16_t* qp = P + tok * LDP + CQI + (r32 & 15) * 64 + 8 * hg;
#pragma unroll
            for (int ks = 0; ks < 4; ++ks) aq[g][ks] = *(const bf16x8*)(qp + 16 * ks);
#pragma unroll
            for (int r = 0; r < 16; ++r) { const int head = (r & 3) + 8 * ((r >> 2) & 1) + 4 * hg; const size_t tq = tok0 + 2 * g + (r >> 3);
                wv[g][r >> 1][r & 1] = bf_lo((unsigned)P[tq * LDP + CWI + head]) * (0.25f * 0.125f); } }
        const int nt = qb + 1;
        const bf16_t* kbase = P + ((size_t)b * SEQ + drow) * LDP + CKI + 8 * dchunk;
        asm volatile("s_waitcnt vmcnt(0) lgkmcnt(0)" ::: "memory"); __builtin_amdgcn_s_barrier(); asm volatile("" ::: "memory");
        IDX_DMA(0); if (nt > 1) IDX_DMA(1);
        for (int t = 0; t < nt; ++t) {
            if (t + 1 < nt) asm volatile("s_waitcnt vmcnt(1)" ::: "memory"); else asm volatile("s_waitcnt vmcnt(0)" ::: "memory");
            asm volatile("s_waitcnt lgkmcnt(0)" ::: "memory"); __builtin_amdgcn_s_barrier(); asm volatile("" ::: "memory");
            if (t + 2 < nt) IDX_DMA(t + 2);
            const LAS unsigned char* slot = F.lds + RING + (t & 3) * 8192;
            bf16x8 bk[2][4];
#pragma unroll
            for (int kg = 0; kg < 2; ++kg) { const int key = kg * 32 + r32;
#pragma unroll
                for (int ks = 0; ks < 4; ++ks) bk[kg][ks] = *(const LAS bf16x8*)(slot + key * 128 + (((2 * ks + hg) ^ (key & 7)) << 4)); }
            f32x16 dcur = f32x16{};
#pragma unroll
            for (int ks = 0; ks < 4; ++ks) dcur = __builtin_amdgcn_mfma_f32_32x32x16_bf16(aq[0][ks], bk[0][ks], dcur, 0, 0, 0);
#pragma unroll
            for (int j = 0; j < 8; ++j) { const int kg = j >> 2, g = j & 3;
                f32x16 dnext = f32x16{};
                if (j < 7) {
#pragma unroll
                    for (int ks = 0; ks < 4; ++ks) dnext = __builtin_amdgcn_mfma_f32_32x32x16_bf16(aq[(j + 1) & 3][ks], bk[(j + 1) >> 2][ks], dnext, 0, 0, 0); }
                f32x2 accA = {0.f, 0.f}, accB = {0.f, 0.f};
#pragma unroll
                for (int i = 0; i < 4; ++i) { f32x2 xa, xb;
#define IDX_RELU(x_) __int_as_float(max(__float_as_int(x_), 0))
                    xa[0] = IDX_RELU(dcur[2 * i]); xa[1] = IDX_RELU(dcur[2 * i + 1]); xb[0] = IDX_RELU(dcur[8 + 2 * i]); xb[1] = IDX_RELU(dcur[9 + 2 * i]);
#undef IDX_RELU
                    accA = __builtin_elementwise_fma(wv[g][i], xa, accA); accB = __builtin_elementwise_fma(wv[g][4 + i], xb, accB); }
                const float s0 = accA[0] + accA[1], s1 = accB[0] + accB[1];
                auto rr = __builtin_amdgcn_permlane32_swap(__float_as_uint(s0), __float_as_uint(s1), false, false);
                const float tot = __uint_as_float(rr[0]) + __uint_as_float(rr[1]);
                ibuf[(2 * g + hg) * 288 + (t & 3) * 64 + kg * 32 + r32] = tot;
                if (j < 7) {
#pragma unroll
                    for (int i = 0; i < 4; ++i) { __builtin_amdgcn_sched_group_barrier(0x008, 1, 0); __builtin_amdgcn_sched_group_barrier(0x002, 6, 0); } }
                dcur = dnext;
            }
            if ((t & 3) == 3 || t == nt - 1) { const int t0 = t & ~3, cnt = (t - t0 + 1) * 64;
                if (4 * lane < cnt) {
#pragma unroll
                    for (int q = 0; q < 8; ++q) { const f32x4 v = *(const LAS f32x4*)(ibuf + q * 288 + 4 * lane);
                        __builtin_nontemporal_store(v, (f32x4*)(SC + (tok0 + q) * (size_t)SEQ + t0 * 64 + 4 * lane)); } } }
        }
    }
#undef IDX_DMA
}

__device__ __forceinline__ int dsa_qmap(const Fr& F, int k) { return k * F.ngw + ((k & 1) ? F.ngw - 1 - F.gw : F.gw); }
__device__ __forceinline__ void dsa_issue(const float* SC, int q, int lane, unsigned (&raw)[64]) {
    const int s = q & (SEQ - 1); const float* row = SC + (size_t)q * SEQ;
    if (s < 256) return;
#pragma unroll
    for (int c4 = 0; c4 < 4; ++c4) {
        if (1024 * c4 <= s) {
#pragma unroll
            for (int i = 16 * c4; i < 16 * c4 + 16; ++i) raw[i] = __float_as_uint(__builtin_nontemporal_load(row + 64 * i + lane)); }
        else {
#pragma unroll
            for (int i = 16 * c4; i < 16 * c4 + 16; ++i) raw[i] = 0u; } }
}
__device__ __forceinline__ void dsa_select(const Fr& F, const float* SC, u64* MSK) {
    const int lane = F.lane;
    int k = 0, q = dsa_qmap(F, 0); bool have = q < MTOK;
    unsigned raw[64];
#pragma unroll
    for (int i = 0; i < 64; ++i) raw[i] = 0u;
    if (have) dsa_issue(SC, q, lane, raw);
    while (have) {
        const int s = q & (SEQ - 1); u64* mrow = MSK + (size_t)q * 64;
        const int qn = dsa_qmap(F, k + 1); const bool hn = qn < MTOK;
        if (s < 256) { const int lo = 64 * lane; u64 w = 0ull; if (s >= lo + 63) w = ~0ull; else if (s >= lo) w = (2ull << (s - lo)) - 1ull; mrow[lane] = w;
            if (hn) dsa_issue(SC, qn, lane, raw); q = qn; have = hn; ++k; continue; }
        unsigned u[64];
#pragma unroll
        for (int i = 0; i < 64; ++i) { const int key = 64 * i + lane; const unsigned bits = raw[i]; const unsigned ord = (bits & 0x80000000u) ? ~bits : (bits | 0x80000000u); u[i] = (key <= s) ? ord : 0u; }
        if (hn) dsa_issue(SC, qn, lane, raw);
        unsigned T = 0u; const int ng = (s >> 9) + 1;
        for (int bit = 31; bit >= 0; --bit) { const unsigned cand = T | (1u << bit); int cl = 0;
#pragma unroll
            for (int g8 = 0; g8 < 8; ++g8) { if (g8 >= ng) break;
                u64 m[8];
#pragma unroll
                for (int j = 0; j < 8; ++j) asm("v_cmp_le_u32_e64 %0, %1, %2" : "=s"(m[j]) : "s"(cand), "v"(u[8 * g8 + j]));
#pragma unroll
                for (int j = 0; j < 8; ++j) cl += __popcll(m[j]); }
            cl = __builtin_amdgcn_readfirstlane(cl);
            if (cl >= 256) { T = cand; if (cl == 256) break; } }
        int cgt = 0;
#pragma unroll
        for (int g8 = 0; g8 < 8; ++g8) { if (g8 >= ng) break;
            u64 m[8];
#pragma unroll
            for (int j = 0; j < 8; ++j) asm("v_cmp_lt_u32_e64 %0, %1, %2" : "=s"(m[j]) : "s"(T), "v"(u[8 * g8 + j]));
#pragma unroll
            for (int j = 0; j < 8; ++j) cgt += __popcll(m[j]); }
        int need = 256 - __builtin_amdgcn_readfirstlane(cgt); unsigned mlo = 0u, mhi = 0u;
#pragma unroll
        for (int i = 0; i < 64; ++i) { if ((i & 7) == 0 && (i >> 3) >= ng) break;
            const u64 gt = __ballot(u[i] > T), eq = __ballot(u[i] == T); u64 take = 0ull;
            if (need > 0 && eq != 0ull) { const int c = __popcll(eq);
                if (c <= need) { take = eq; need -= c; }
                else { u64 e = eq; for (int n = 0; n < need; ++n) { const u64 low = e & (0ull - e); take |= low; e ^= low; } need = 0; } }
            const u64 w = gt | take; const bool me = lane == i;
            mlo = me ? (unsigned)w : mlo; mhi = me ? (unsigned)(w >> 32) : mhi; }
        mrow[lane] = ((u64)mhi << 32) | (u64)mlo;
        q = qn; have = hn; ++k;
    }
}

constexpr size_t MiB = 1u << 20;
constexpr size_t WS_CTL = 0, CTL_ZERO_BYTES = 8 * MiB;
constexpr int CW_BAR = 4096;
constexpr size_t WS_SSQ = 1 * MiB;
constexpr size_t WS_WB = 8 * MiB;
constexpr size_t WS_XB = 236 * MiB;
constexpr size_t WS_MEMB = 364 * MiB;
constexpr size_t WS_MEMKV = 372 * MiB;
constexpr size_t WS_COS = 388 * MiB, WS_SIN = 392 * MiB, WS_RSMEM = 396 * MiB, WS_RSQ = 397 * MiB, WS_RSKV = 398 * MiB;
constexpr size_t WS_XB8 = 560 * MiB;
constexpr size_t WS_MIX = 400 * MiB;
constexpr size_t WS_SCR = 624 * MiB;
constexpr size_t WS_END = (624 + 832) * MiB;
constexpr size_t WB_GU0 = 0, WB_GU1 = 23068672, WB_D0 = 46137344, WB_D1 = 57671680, WB_IN = 69206016, WB_OUT = 108003328, WB_MKV = 113246208, WB_UQ = 115343360, WB_UKV = 116916224;
constexpr int RING_BYTES = 146944, MISC_OFF = RING_BYTES + 64, LDS_BYTES = 147456;
static_assert(att::L_END <= RING_BYTES && pg8::STAGE_BYTES <= RING_BYTES, "LDS map");
constexpr int NPHASES = 44;
#ifndef F8MASK
#define F8MASK 4
#endif
#define F8LAYER(L) (((F8MASK) >> (L)) & 1)
#ifndef RG
#define RG 1
#endif
#ifndef RD
#define RD 1
#endif
#ifndef RI
#define RI 1
#endif
#ifndef RA
#define RA 1
#endif
#ifndef F8OUT
#define F8OUT 0
#endif
#define F8OUTL(L_) (((F8OUT) >> (L_)) & 1)
#ifndef F8FFN
#define F8FFN 0
#endif
#define F8FFNL(L_, f_) (((F8FFN) >> (2 * (L_) + (f_))) & 1)
#ifndef F8MODE
#define F8MODE 2
#endif
#ifndef RCV
#define RCV 1
#endif
#ifndef RIX
#define RIX 1
#endif
#ifndef RSL
#define RSL 1
#endif
#ifndef RC
#define RC 1
#endif
#define REP(n) for (int rep_ = 0; rep_ < (n); ++rep_)

struct Args { const void* in[27]; float* out; unsigned char* ws; int ph_lo, ph_hi; };

typedef const __attribute__((address_space(4))) struct Args* ArgsPc;
__device__ __forceinline__ TrDesc tr_desc(ArgsPc A, int L, bf16_t* WB, int it) {
    const float* w_gate = (const float*)A->in[5]; const float* w_up = (const float*)A->in[6]; const float* w_down = (const float*)A->in[7];
    const float* ffn_norm = (const float*)A->in[4]; const float* attn_norm = (const float*)A->in[8];
    const float* w_out = (const float*)A->in[12];
    const float* w_in = (const float*)(L == 0 ? A->in[13] : L == 1 ? A->in[16] : L == 2 ? A->in[23] : A->in[25]);
    const int nin = (L == 0 ? 6672 : L == 1 ? 1600 : L == 2 ? 18944 : 4688);
    const int I_GU = 32 * 88, I_D = 88 * 32, I_IN = 32 * ((nin + 63) / 64), I_OUT = 40 * 32, I_UQ = (L == 1) ? 8 * 48 : 0;
    TrDesc d; d.f8 = 0; d.tiled = 0; int r = it;
    if (r < 4 * I_GU) { const int s = r / I_GU; r -= s * I_GU; const int f = s >> 1, up = s & 1;
        d.W = (up ? w_up : w_gate) + (size_t)(L * 2 + f) * DM * DFF; d.K = DM; d.N = DFF; d.gain = ffn_norm + (size_t)(L * 2 + f) * DM; d.WT = WB + (f ? WB_GU1 : WB_GU0); d.ldt = DM; d.kind = up ? 2 : 1; d.f8 = F8FFNL(L, f); }
    else { r -= 4 * I_GU;
        if (r < 2 * I_D) { const int f = r / I_D; r -= f * I_D; d.W = w_down + (size_t)(L * 2 + f) * DFF * DM; d.K = DFF; d.N = DM; d.gain = nullptr; d.WT = WB + (f ? WB_D1 : WB_D0); d.ldt = DFF; d.kind = 0; d.tiled = 1; }
        else { r -= 2 * I_D;
            if (r < I_IN) { d.W = w_in; d.K = DM; d.N = nin; d.gain = attn_norm + (size_t)L * DM; d.WT = WB + WB_IN; d.ldt = DM; d.kind = 3 + L; d.f8 = F8LAYER(L) ? 1 : 0; }
            else { r -= I_IN;
                if (r < I_OUT) { d.W = w_out + (size_t)L * OUTIN * DM; d.K = OUTIN; d.N = DM; d.gain = nullptr; d.WT = WB + WB_OUT; d.ldt = OUTIN; d.kind = 0;
                    d.f8 = F8OUTL(L);
                }
                else { r -= I_OUT;
                    if (r < I_UQ) { d.W = (const float*)A->in[18]; d.K = 512; d.N = 3072; d.gain = (const float*)A->in[17]; d.WT = WB + WB_UQ; d.ldt = 512; d.kind = 0; }
                    else { r -= I_UQ; d.W = (const float*)A->in[20]; d.K = 512; d.N = 4096; d.gain = (const float*)A->in[19]; d.WT = WB + WB_UKV; d.ldt = 512; d.kind = 0; } } } } }
    d.r = r; return d;
}
__device__ __forceinline__ void convert_layer(const Fr& F, ArgsPc A, int L, bf16_t* WB) {
    const int nin = (L == 0 ? 6672 : L == 1 ? 1600 : L == 2 ? 18944 : 4688);
    const int total = 4 * 32 * 88 + 2 * 88 * 32 + 32 * ((nin + 63) / 64) + 40 * 32 + ((L == 1) ? 8 * 48 + 8 * 64 : 0);
    LAS float* scr = (LAS float*)(F.lds + F.wave * 16640);
    f32x4 va[16], vb[16]; int it = F.gw;
    if (it >= total) return;
    TrDesc da = tr_desc(A, L, WB, it), db = da; tr_load(da, F.lane, va);
    for (;;) {
        const bool nb_ = it + F.ngw < total; if (nb_) { db = tr_desc(A, L, WB, it + F.ngw); tr_load(db, F.lane, vb); }
        tr_store(da, F.lane, va, scr); it += F.ngw; if (!nb_) break;
        const bool na_ = it + F.ngw < total; if (na_) { da = tr_desc(A, L, WB, it + F.ngw); tr_load(da, F.lane, va); }
        tr_store(db, F.lane, vb, scr); it += F.ngw; if (!na_) break;
    }
}

#define MIXP(off_) (o8_ ? (bf16_t*)((unsigned char*)MIX + (off_)) : MIX + (off_))
__device__ __forceinline__ void mem_attn_units(const Fr& F, const bf16_t* P, long ldp, int memq_col, const bf16_t* MEMKV, bf16_t* MIX, int o8_) {
    for (int i = blockIdx.x; i < 512; i += F.G) {
        const int b = i >> 6, mh = (i >> 4) & 3, qb = i & 15; const size_t tok = (size_t)b * SEQ + qb * 256;
        att::AP a{}; a.Q = P + tok * ldp + memq_col + mh * 128; a.qs = ldp; a.K = MEMKV + (size_t)b * NMEM * 4096 + mh * 128; a.ks = 4096; a.V = a.K + 512; a.vs = 4096;
        a.O = MIXP(tok * OUTIN + 2048 + mh * 128); a.o8 = o8_; a.os = OUTIN; a.kt0 = 0; a.nt = 4; a.q0 = 0; a.C = 0.08838834764831845f * LOG2E;
        att::attn_unit<att::K_MEM, 128>(F.lds, a, F.wave);
    }
}
__device__ __forceinline__ void causal_unit_ids(int i, int& b, int& h, int& qb) {
    const int slot = i >> 8, c = i & 255, bh = (c >> 4) * 8 + (c & 7), half = (c >> 3) & 1;
    qb = half ? ((slot & 1) ? slot : 14 - slot) : ((slot & 1) ? slot - 1 : 15 - slot); b = bh >> 4; h = bh & 15;
}

__device__ __forceinline__ Fr mk_frame(unsigned char* lds_raw, int wave_id) {
    Fr F; F.lds = (LAS unsigned char*)lds_raw; F.tid = tid_opaque(wave_id); F.lane = F.tid & 63; F.wave = __builtin_amdgcn_readfirstlane(F.tid >> 6);
    F.G = gridDim.x; { const int bx = blockIdx.x; F.vcu = (F.G % 8 == 0) ? (bx % 8) * (F.G / 8) + bx / 8 : bx; }
    F.gw = F.vcu * 8 + F.wave; F.ngw = F.G * 8; return F;
}
typedef const __attribute__((address_space(4))) Args* ArgsP;
__device__ __forceinline__ ArgsP args_ptr() { auto p = __builtin_amdgcn_kernarg_segment_ptr(); asm volatile("" : "+s"(p)); return (ArgsP)p; }
#define WSP(T, off) ((T*)(AP_->ws + (off)))
#define SCRP(T, mib) ((T*)(AP_->ws + WS_SCR + (size_t)(mib) * MiB))

__global__ void __launch_bounds__(512, 2) fwd(Args A) {
    extern __shared__ __attribute__((aligned(16))) unsigned char lds_raw[];
    { LAS unsigned* z = (LAS unsigned*)((LAS unsigned char*)lds_raw + RING_BYTES); for (int u = threadIdx.x; u < (LDS_BYTES - RING_BYTES) / 4; u += 512) z[u] = 0u; }
    __syncthreads();
    const int lo = A.ph_lo, hi = A.ph_hi; const int wave_id = __builtin_amdgcn_readfirstlane((int)threadIdx.x >> 6);
    XcdBarrier bar; bar.bar = (unsigned*)(A.ws + WS_CTL) + CW_BAR; bar.x = 0; bar.st = nullptr;
    if (hi - lo > 1) bar = xcd_barrier_post((unsigned*)(A.ws + WS_CTL) + CW_BAR, (volatile LAS unsigned*)((LAS unsigned char*)lds_raw + MISC_OFF) + 8);
    int ph = 0;
#ifdef TMASK
    unsigned long long tacc_ = 0ull, tb_ = 0ull;
#define PH_BEGIN if (ph >= lo && ph < hi) { if ((TMASK >> ph) & 1ull) tb_ = __builtin_amdgcn_s_memrealtime(); const Fr F = mk_frame(lds_raw, wave_id); const ArgsP AP_ = args_ptr();
#define PH_END   if (ph + 1 < hi) xcd_barrier(bar); if ((TMASK >> ph) & 1ull) tacc_ += __builtin_amdgcn_s_memrealtime() - tb_; } ++ph;
#else
#define PH_BEGIN if (ph >= lo && ph < hi) { const Fr F = mk_frame(lds_raw, wave_id); const ArgsP AP_ = args_ptr();
#define PH_END   if (ph + 1 < hi) xcd_barrier(bar); } ++ph;
#endif
    const float SC128 = 0.08838834764831845f * LOG2E, SC192 = 0.07216878364870323f * LOG2E;

    PH_BEGIN
        rows2048(F, (const float*)AP_->in[1], NB * NMEM, WSP(bf16_t, WS_MEMB), WSP(float, WS_RSMEM), 1);
        rope_table(F, (const int*)AP_->in[2], WSP(float, WS_COS), WSP(float, WS_SIN));
        rows2048(F, (const float*)AP_->in[0], MTOK, WSP(bf16_t, WS_XB), WSP(u64, WS_SSQ), 0);
#ifdef RZ
        { u32x4* z = WSP(u32x4, WS_END); for (size_t i = (size_t)F.vcu * 512 + F.tid; i < (size_t)2 * DFF * DM * 2 / 16; i += (size_t)F.G * 512) z[i] = (u32x4){0u, 0u, 0u, 0u}; }
#endif
        { LAS float* scr = (LAS float*)(F.lds + F.wave * 16640);
          for (int it = F.gw; it < 4 * 512; it += F.ngw) { const int Lm = it >> 9; TrDesc d; d.W = (const float*)AP_->in[10] + (size_t)Lm * DM * 1024; d.K = DM; d.N = 1024; d.gain = (const float*)AP_->in[9] + (size_t)Lm * DM;
              d.WT = SCRP(bf16_t, 0) + (size_t)Lm * 1024 * DM; d.ldt = DM; d.kind = 0; d.f8 = 0; d.tiled = 0; d.r = it & 511; f32x4 v[16]; tr_load(d, F.lane, v); tr_store(d, F.lane, v, scr); } }
    PH_END
    PH_BEGIN { pg8::Gemm g{WSP(bf16_t, WS_MEMB), SCRP(bf16_t, 0), NB * NMEM, 4096, DM, DM, DM, 0}; pg8::StaticOrder S; S.init(g.M, g.N, F.G, (int)blockIdx.x);
        pg8::EpiProj E{WSP(bf16_t, WS_MEMKV), 4096, WSP(float, WS_RSMEM), 0, nullptr, -1, (const float*)AP_->in[11] + 128, 0, 0, nullptr, 0, 0, nullptr, 0, 0, 1.0f, 4, 2, 256}; pg8::gemm_phase(F.lds, g, S, E, F.tid); } PH_END

    int ver = 0;
#pragma clang loop unroll(full)
    for (int hl = 0; hl < 8; ++hl) {
        const int L = hl >> 1, f = hl & 1;
        if (f == 0) {
            PH_BEGIN REP(RCV) convert_layer(F, AP_, L, WSP(bf16_t, WS_WB)); PH_END

        }
        PH_BEGIN
#ifdef RZ
            { pg8::Gemm g{WSP(bf16_t, WS_XB), WSP(bf16_t, WS_END), MTOK, 2 * DFF, DM, DM, DM, 0}; pg8::StaticOrder S; S.init(g.M, g.N, F.G, (int)blockIdx.x);
              pg8::EpiSwiGLU E{SCRP(bf16_t, 0), DFF, WSP(u64, WS_SSQ) + (size_t)ver * MTOK, 1.0f}; pg8::gemm_phase(F.lds, g, S, E, F.tid); }
#endif
            REP(RG) { const bool f8_ = F8FFNL(L, f);
            pg8::Gemm g = f8_ ? pg8::Gemm{WSP(bf16_t, WS_XB8), WSP(bf16_t, WS_WB) + (f ? WB_GU1 : WB_GU0), MTOK, 2 * DFF, DM / 2, DM / 2, DM / 2, 0}
                              : pg8::Gemm{WSP(bf16_t, WS_XB), WSP(bf16_t, WS_WB) + (f ? WB_GU1 : WB_GU0), MTOK, 2 * DFF, DM, DM, DM, 0}; pg8::StaticOrder S; S.init(g.M, g.N, F.G, (int)blockIdx.x);
            pg8::EpiSwiGLU E{SCRP(bf16_t, 0), DFF, WSP(u64, WS_SSQ) + (size_t)ver * MTOK, f8_ ? (1.0f / 64.0f) : 1.0f};
            if (f8_) pg8::gemm_phase<F8MODE>(F.lds, g, S, E, F.tid); else pg8::gemm_phase<0>(F.lds, g, S, E, F.tid); } PH_END
        PH_BEGIN { pg8::Gemm g{SCRP(bf16_t, 0), WSP(bf16_t, WS_WB) + (f ? WB_D1 : WB_D0), MTOK, DM, DFF, DFF, DFF, 1, 1}; pg8::StaticOrder S; S.init(g.M, g.N, F.G, (int)blockIdx.x);
            if (RD > 1) { pg8::EpiResid E0{ver == 0 ? (const float*)AP_->in[0] : AP_->out, SCRP(float, 400), SCRP(bf16_t, 660), nullptr, nullptr, 0.5f};
#ifdef PROBE_PM
                pg8::Gemm g0 = g; g0.pm_and = PROBE_PM; pg8::gemm_phase(F.lds, g0, S, E0, F.tid);
#else
                pg8::gemm_phase(F.lds, g, S, E0, F.tid);
#endif
            }
            pg8::EpiResid E{ver == 0 ? (const float*)AP_->in[0] : AP_->out, AP_->out, WSP(bf16_t, WS_XB), WSP(u64, WS_SSQ) + (size_t)(ver + 1) * MTOK, (f == 0 && F8LAYER(L)) ? WSP(unsigned char, WS_XB8) : nullptr, 0.5f}; pg8::gemm_phase(F.lds, g, S, E, F.tid); } PH_END
        ++ver;
        if (f != 0) continue;
        const int ngrp = (L == 2) ? 3 : 1;
#pragma clang loop unroll(full)
        for (int g = 0; g < ngrp; ++g) {
            PH_BEGIN REP(RI) { const int ldp = (L == 0) ? 6912 : (L == 1) ? 1792 : (L == 2) ? 6656 : 4864;
                const int nproj = (L == 2) ? (g == 0 ? 6656 : 6144) : ldp; const size_t roff = (L == 2) ? (g == 0 ? 0 : (g == 1 ? 6656 : 12800)) : 0;
                pg8::Gemm gm = F8LAYER(L) ? pg8::Gemm{WSP(bf16_t, WS_XB8), (const bf16_t*)((const unsigned char*)(WSP(bf16_t, WS_WB) + WB_IN) + roff * DM), MTOK, nproj, DM / 2, DM / 2, DM / 2, 0}
                                       : pg8::Gemm{WSP(bf16_t, WS_XB), WSP(bf16_t, WS_WB) + WB_IN + roff * DM, MTOK, nproj, DM, DM, DM, 0};
                pg8::StaticOrder S; S.init(gm.M, gm.N, F.G, (int)blockIdx.x);
                const float* gmq = (const float*)AP_->in[11] + (size_t)L * 256;
                const float* qg = (L == 0) ? (const float*)AP_->in[15] : (L == 2) ? (const float*)AP_->in[24] + (size_t)g * 256 : (L == 3) ? (const float*)AP_->in[26] : nullptr;
                const int kt_hi = (L == 3) ? 10 : 16, mq_lo = (L == 0 || L == 2) ? 24 : (L == 1) ? 5 : 17, mq_hi = (L == 2 && g > 0) ? mq_lo : mq_lo + 2;
                pg8::EpiProj E{SCRP(bf16_t, 0), ldp, WSP(u64, WS_SSQ) + (size_t)ver * MTOK, 1, (L == 0) ? SCRP(float, 432) : nullptr, 26,
                               qg, 0, (L == 1) ? 0 : 8, qg ? qg + 128 : nullptr, 8, (L == 1) ? 8 : kt_hi, gmq, mq_lo, mq_hi, F8LAYER(L) ? (1.0f / 64.0f) : 1.0f, 0, 0, 0}; if (F8LAYER(L)) pg8::gemm_phase<F8MODE>(F.lds, gm, S, E, F.tid); else pg8::gemm_phase<0>(F.lds, gm, S, E, F.tid); } PH_END
            if (L == 0) { PH_BEGIN fox_cumsum(F, SCRP(const float, 432), (const float*)AP_->in[14], SCRP(float, 434)); PH_END }
            if (L == 1) { PH_BEGIN mla_prep_a(F, SCRP(bf16_t, 0), WSP(float, WS_RSQ), WSP(float, WS_RSKV), SCRP(bf16_t, 752), (const float*)AP_->in[22] + 64, nullptr, WSP(float, WS_COS), WSP(float, WS_SIN)); PH_END }
            if (L == 1) {
                PH_BEGIN
                    REP(RI) for (int i = 0; i < 2; ++i) { pg8::Gemm gm{SCRP(bf16_t, 0) + (i ? 512 : 0), WSP(bf16_t, WS_WB) + (i ? WB_UKV : WB_UQ), MTOK, i ? 4096 : 3072, 512, 1792, 512, 0}; pg8::StaticOrder S; S.init(gm.M, gm.N, F.G, (int)blockIdx.x);
                        pg8::EpiProj E{i ? SCRP(bf16_t, 304) : SCRP(bf16_t, 112), i ? 4096 : 3072, i ? WSP(float, WS_RSKV) : WSP(float, WS_RSQ), 0, nullptr, -1, nullptr, 0, 0, nullptr, 0, 0, nullptr, 0, 0, 1.0f, 0, 0, 0}; pg8::gemm_phase(F.lds, gm, S, E, F.tid); }
                PH_END
                PH_BEGIN mla_prep_b(F, SCRP(bf16_t, 112), SCRP(const bf16_t, 304), SCRP(bf16_t, 560), SCRP(const bf16_t, 752), (const float*)AP_->in[21], (const float*)AP_->in[22], WSP(float, WS_COS), WSP(float, WS_SIN)); PH_END
            }
            if (L == 3) {
                PH_BEGIN REP(RIX) dsa_indexer(F, SCRP(const bf16_t, 0), SCRP(float, 304)); PH_END
                PH_BEGIN REP(RSL) dsa_select(F, SCRP(const float, 304), SCRP(u64, 816)); PH_END
            }
            PH_BEGIN
                bf16_t* P = SCRP(bf16_t, 0); bf16_t* MIX = WSP(bf16_t, WS_MIX); const int o8_ = F8OUTL(L);
                const long ldp = (L == 0) ? 6912 : (L == 1) ? 1792 : (L == 2) ? 6656 : 4864;
                REP(L == 2 ? 1 : RA) {
                if (L == 0) {
                    const float* CUM = SCRP(const float, 434);
                    for (int i = blockIdx.x; i < 2048; i += F.G) { int b, h, qb; causal_unit_ids(i, b, h, qb); const size_t t0 = (size_t)b * SEQ;
                        att::AP a{}; a.Q = P + (t0 + qb * 256) * ldp + h * 128; a.qs = ldp; a.K = P + t0 * ldp + 2048 + h * 128; a.ks = ldp; a.V = a.K + 2048; a.vs = ldp;
                        a.O = MIXP((t0 + qb * 256) * OUTIN + h * 128); a.o8 = o8_; a.os = OUTIN; a.kt0 = 0; a.nt = 4 * (qb + 1); a.q0 = qb * 256; a.C = SC128; a.cum = CUM + t0 * 16 + h; a.cums = 16;
                        att::attn_unit<att::K_FOX, 128>(F.lds, a, F.wave); }
                }
                if (L == 1) {
                    const bf16_t* Qb = SCRP(const bf16_t, 112); const bf16_t* KVb = SCRP(const bf16_t, 304); const bf16_t* KF = SCRP(const bf16_t, 560);
                    for (int i = blockIdx.x; i < 2048; i += F.G) { int b, h, qb; causal_unit_ids(i, b, h, qb); const size_t t0 = (size_t)b * SEQ;
                        att::AP a{}; a.Q = Qb + (t0 + qb * 256) * 3072 + h * 192; a.qs = 3072; a.K = KF + t0 * 3072 + h * 192; a.ks = 3072; a.V = KVb + t0 * 4096 + h * 256 + 128; a.vs = 4096;
                        a.O = MIXP((t0 + qb * 256) * OUTIN + h * 128); a.o8 = o8_; a.os = OUTIN; a.kt0 = 0; a.nt = 4 * (qb + 1); a.q0 = qb * 256; a.C = SC192;
                        att::attn_unit<att::K_MLA, 192>(F.lds, a, F.wave); }
                }
                if (L == 2) {
                    const int dil = (g == 0) ? 1 : (g == 1 ? 4 : 16), nblk = 16 / dil; float* OST = SCRP(float, 416); float* ML = SCRP(float, 672);
                    for (int i = blockIdx.x; i < 2048; i += F.G) { const int h = i & 15, rest = i >> 4, b = rest >> 4, rj = rest & 15, r = rj / nblk, jb = rj % nblk;
                        const size_t tokz = (size_t)b * SEQ + r, tokq = tokz + (size_t)jb * 256 * dil;
                        att::AP a{}; a.Q = P + tokq * ldp + h * 128; a.qs = (long)dil * ldp; a.K = P + tokz * ldp + 2048 + h * 128; a.ks = (long)dil * ldp; a.V = a.K + 2048; a.vs = a.ks;
                        a.O = MIXP(tokq * OUTIN + h * 128); a.o8 = o8_; a.os = (long)dil * OUTIN; a.q0 = jb * 256; a.kt0 = jb == 0 ? 0 : 4 * jb - 2; a.nt = jb == 0 ? 4 : 6; a.C = SC128;
                        a.ost = OST + tokq * 1024 + h * 64; a.osts = (long)dil * 1024; a.mst = ML + (tokq * 16 + h) * 2; a.msts = (long)dil * 32; a.carry_in = g > 0; a.carry_out = g < 2;
                        a.t5 = (const float*)AP_->in[3]; a.head = h; a.dil = dil;
                        att::attn_unit<att::K_DIL, 128>(F.lds, a, F.wave); }
                }
                if (L == 3) {
                    const u64* MSK = SCRP(const u64, 816);
                    for (int i = blockIdx.x; i < 2048; i += F.G) { int b, h, qb; causal_unit_ids(i, b, h, qb); const size_t t0 = (size_t)b * SEQ;
                        att::AP a{}; a.Q = P + (t0 + qb * 256) * ldp + h * 128; a.qs = ldp; a.K = P + t0 * ldp + 2048 + (h >> 2) * 128; a.ks = ldp; a.V = a.K + 512; a.vs = ldp;
                        a.O = MIXP((t0 + qb * 256) * OUTIN + h * 128); a.o8 = o8_; a.os = OUTIN; a.kt0 = 0; a.nt = 4 * (qb + 1); a.q0 = qb * 256; a.C = SC128; a.msk = MSK + (t0 + qb * 256) * 64; a.t5 = (const float*)AP_->in[3]; a.head = h;
                        att::attn_unit<att::K_DSA, 128>(F.lds, a, F.wave); }
                }
                if (g == 0) { const int memq_col = (L == 0) ? 6144 : (L == 1) ? 1280 : (L == 2) ? 6144 : 4352; mem_attn_units(F, P, ldp, memq_col, WSP(const bf16_t, WS_MEMKV) + L * 1024, MIX, o8_); }
                }
            PH_END
        }
        if (F8OUTL(L)) { PH_BEGIN { pg8::Gemm gm{WSP(bf16_t, WS_MIX), WSP(bf16_t, WS_WB) + WB_OUT, MTOK, DM, OUTIN / 2, OUTIN / 2, OUTIN / 2, 0};   pg8::StaticOrder S; S.init(gm.M, gm.N, F.G, (int)blockIdx.x);
            pg8::EpiResid E{AP_->out, AP_->out, WSP(bf16_t, WS_XB), WSP(u64, WS_SSQ) + (size_t)(ver + 1) * MTOK, F8FFNL(L, 1) ? WSP(unsigned char, WS_XB8) : nullptr, 1.0f / 1024.0f}; pg8::gemm_phase<F8MODE>(F.lds, gm, S, E, F.tid); } PH_END }
        else { PH_BEGIN { pg8::Gemm gm{WSP(bf16_t, WS_MIX), WSP(bf16_t, WS_WB) + WB_OUT, MTOK, DM, OUTIN, OUTIN, OUTIN, 0}; pg8::StaticOrder S; S.init(gm.M, gm.N, F.G, (int)blockIdx.x);
            if (RD > 1) { pg8::EpiResid E0{AP_->out, SCRP(float, 400), SCRP(bf16_t, 660), nullptr, nullptr, 1.0f}; pg8::gemm_phase(F.lds, gm, S, E0, F.tid); }
            pg8::EpiResid E{AP_->out, AP_->out, WSP(bf16_t, WS_XB), WSP(u64, WS_SSQ) + (size_t)(ver + 1) * MTOK, F8FFNL(L, 1) ? WSP(unsigned char, WS_XB8) : nullptr, 1.0f}; pg8::gemm_phase(F.lds, gm, S, E, F.tid); } PH_END }
        ++ver;
    }
#ifdef TMASK
    if (blockIdx.x == 0) { const unsigned long long t0_ = __builtin_amdgcn_s_memrealtime(); while (__builtin_amdgcn_s_memrealtime() - t0_ < tacc_ * (unsigned long long)TMUL) __builtin_amdgcn_s_sleep(8); }
#endif
#undef PH_BEGIN
#undef PH_END
}

#ifndef MK_ONE_LAUNCH
#define MK_ONE_LAUNCH 0
#endif
extern "C" void kernel_launch(void* const* d_in, const int* in_sizes, int n_in, void* d_out, int out_size, void* d_ws, size_t ws_size, hipStream_t stream) {
    static int grid = 0;
    if (grid == 0) {
        if (n_in != 27 || in_sizes[0] != MTOK * DM || out_size != MTOK * DM || ws_size < WS_END) {
            fprintf(stderr, "kernel_launch: unexpected shapes: n_in %d in0 %d out %d ws %zu (need >= %zu); nothing launched\n", n_in, n_in > 0 ? in_sizes[0] : -1, out_size, ws_size, (size_t)WS_END); grid = -1; return; }
        int dev = 0, cus = 0, per_cu = 0;
        if (hipGetDevice(&dev) != hipSuccess || hipDeviceGetAttribute(&cus, hipDeviceAttributeMultiprocessorCount, dev) != hipSuccess) { fprintf(stderr, "kernel_launch: device query failed\n"); grid = -1; return; }
        if (hipFuncSetAttribute((const void*)fwd, hipFuncAttributeMaxDynamicSharedMemorySize, LDS_BYTES) != hipSuccess) { fprintf(stderr, "kernel_launch: hipFuncSetAttribute failed\n"); grid = -1; return; }
        if (hipOccupancyMaxActiveBlocksPerMultiprocessor(&per_cu, (const void*)fwd, 512, LDS_BYTES) != hipSuccess || per_cu < 1)
            fprintf(stderr, "kernel_launch: note: occupancy query reports %d workgroups per CU\n", per_cu);
        (void)hipGetLastError();
        grid = cus;
    }
    if (grid < 0) return;
    if (hipMemsetAsync((char*)d_ws + WS_CTL, 0, CTL_ZERO_BYTES, stream) != hipSuccess) { fprintf(stderr, "kernel_launch: memset failed\n"); return; }
    Args a{};
    for (int i = 0; i < 27; ++i) a.in[i] = d_in[i];
    a.out = (float*)d_out; a.ws = (unsigned char*)d_ws;
#if MK_ONE_LAUNCH
    a.ph_lo = 0; a.ph_hi = NPHASES;
    hipLaunchKernelGGL(fwd, dim3(grid), dim3(512), LDS_BYTES, stream, a);
#else
#ifndef NPH_LIMIT
#define NPH_LIMIT NPHASES
#endif
    for (int p = 0; p < NPH_LIMIT; ++p) { a.ph_lo = p; a.ph_hi = p + 1; hipLaunchKernelGGL(fwd, dim3(grid), dim3(512), LDS_BYTES, stream, a); }
#endif
    const hipError_t le = hipPeekAtLastError();
    if (le != hipSuccess) fprintf(stderr, "kernel_launch: launch failed: %s\n", hipGetErrorName(le));
}
```

```cpp
#define MK_ONE_LAUNCH 1
#define F8OUT 8
#define F8FFN 128
#define F8FFND 128
#include <hip/hip_runtime.h>
#include <cstdio>
#include <cstdint>

#define LAS __attribute__((address_space(3)))
#define GAS __attribute__((address_space(1)))
typedef unsigned short bf16_t;
typedef short bf16x8 __attribute__((ext_vector_type(8)));
typedef short s16x4 __attribute__((ext_vector_type(4)));
typedef float f32x2 __attribute__((ext_vector_type(2)));
typedef float f32x4 __attribute__((ext_vector_type(4)));
typedef float f32x16 __attribute__((ext_vector_type(16)));
typedef unsigned u32x2 __attribute__((ext_vector_type(2)));
typedef unsigned u32x4 __attribute__((ext_vector_type(4)));
typedef unsigned long long u64;

constexpr int DM = 2048, NB = 8, SEQ = 4096, MTOK = NB * SEQ, DFF = 5632, NH = 16, HD = 128, NMEM = 256, MEMW = 512, OUTIN = 2560;
constexpr float RMS_EPS = 1e-6f;
constexpr float LOG2E = 1.4426950408889634f;

__device__ __forceinline__ unsigned cvt_pk_bf16(float lo, float hi) { unsigned r; asm volatile("v_cvt_pk_bf16_f32 %0, %1, %2" : "=v"(r) : "v"(lo), "v"(hi)); return r; }
__device__ __forceinline__ float bf_lo(unsigned w) { return __uint_as_float(w << 16); }
__device__ __forceinline__ float bf_hi(unsigned w) { return __uint_as_float(w & 0xffff0000u); }

__device__ __forceinline__ int tid_opaque(int wave_id) {
    int l; asm volatile("v_mbcnt_lo_u32_b32 %0, -1, 0\n\tv_mbcnt_hi_u32_b32 %0, -1, %0" : "=v"(l)); return wave_id * 64 + l; }

namespace pg8 {
constexpr int BM = 256, BK = 64, HALF = 128, HTB = HALF * BK * 2, STAGE_BYTES = 8 * HTB, NXCD = 8, WGM = 8;
__host__ __device__ __forceinline__ int lds_byte(int r, int c) { const int st = (r >> 4) * 2 + (c >> 5), rr = r & 15, cc = c & 31, ob = rr * 64 + cc * 2; return st * 1024 + (ob ^ (((ob >> 9) & 1) << 5)); }
__host__ __device__ __forceinline__ void stage_rc(int b, int& R, int& C) { const int st = b / 1024, sb = b % 1024, swz = sb ^ (((sb >> 9) & 1) << 5); R = (st >> 1) * 16 + swz / 64; C = (st & 1) * 32 + (swz % 64) / 2; }
__host__ __device__ __forceinline__ int perm32(int rho) { const int n = rho >> 4, i = rho & 15; return 8 * (i >> 2) + 4 * n + (i & 3); }

struct Unit { int pm, pn; };
struct Gemm { const bf16_t* A; const bf16_t* Bt; int M, N, K, lda, ldb; int a_tiled; int b_tiled; int pm_and; };

struct StaticOrder {
    int nM, nN, nwg, G, c, wgm;
    __host__ __device__ void init(int M, int N, int G_, int c_) { nM = M / BM; nN = N / BM; nwg = nM * nN; G = G_; c = c_; wgm = (nN == 8) ? 4 : WGM; }
    __host__ __device__ bool next(int i, Unit& u) const {
        const long L = (long)i * G + c; if (L >= nwg) return false;
        int wgid = (int)L; { const int q = nwg / NXCD, r = nwg % NXCD, xcd = wgid % NXCD, off = wgid / NXCD; wgid = (xcd < r ? xcd * (q + 1) : r * (q + 1) + (xcd - r) * q) + off; }
        const int nig = wgm * nN, gid = wgid / nig, fm = gid * wgm, gsz = (nM - fm) < wgm ? (nM - fm) : wgm;
        u.pm = fm + ((wgid % nig) % gsz); u.pn = (wgid % nig) / gsz; return true;
    }
};

constexpr float SSQ_SCALE = 16777216.0f;
__device__ __forceinline__ float rs_from_ssq(const u64 v) { return __builtin_amdgcn_rsqf((float)v * (1.0f / (SSQ_SCALE * DM)) + RMS_EPS); }
__device__ __forceinline__ float rs_of(const void* rsv, int row, int mode) { return mode ? rs_from_ssq(((const u64*)rsv)[row]) : ((const float*)rsv)[row]; }

struct EpiProj {
    bf16_t* O; int ldc; const void* rsv; int rs_mode;
    float* fgout; int fg_tile;
    const float* g0; int t0a, t0b; const float* g1; int t1a, t1b; const float* g2; int t2a, t2b;
    float oscale;
    int gper, gcnt, gstride;
    __device__ __forceinline__ void operator()(f32x4 (&acc)[2][2][4][2], const Unit& u, int wr, int wc, int fr, int fq, LAS unsigned char* xlds) const {
        const int row0 = u.pm * BM + wr * 64 + fr; const int col0 = u.pn * BM + wc * 32 + 8 * fq;
        const float* gain = (u.pn >= t0a && u.pn < t0b) ? g0 : (u.pn >= t1a && u.pn < t1b) ? g1 : (u.pn >= t2a && u.pn < t2b) ? g2 : nullptr;
        if (gper) gain = (u.pn % gper < gcnt) ? g0 + (size_t)(u.pn / gper) * gstride : nullptr;
        float rsa[2][4];
#pragma unroll
        for (int ai = 0; ai < 2; ++ai)
#pragma unroll
            for (int m = 0; m < 4; ++m) rsa[ai][m] = rs_of(rsv, row0 + ai * HALF + m * 16, rs_mode) * oscale;
#pragma unroll
        for (int ai = 0; ai < 2; ++ai)
#pragma unroll
            for (int m = 0; m < 4; ++m) { const float rs = rsa[ai][m];
#pragma unroll
                for (int bj = 0; bj < 2; ++bj) { acc[ai][bj][m][0] *= rs; acc[ai][bj][m][1] *= rs; } }
        if (gain) {
            LAS float* part = (LAS float*)xlds;
#pragma unroll
            for (int ai = 0; ai < 2; ++ai)
#pragma unroll
                for (int m = 0; m < 4; ++m)
#pragma unroll
                    for (int bj = 0; bj < 2; ++bj) { const f32x4 a = acc[ai][bj][m][0], b = acc[ai][bj][m][1];
                        float ss = ((a[0] * a[0] + a[1] * a[1]) + (a[2] * a[2] + a[3] * a[3])) + ((b[0] * b[0] + b[1] * b[1]) + (b[2] * b[2] + b[3] * b[3]));
                        ss += __shfl_xor(ss, 16); ss += __shfl_xor(ss, 32);
                        if (fq == 0) part[((ai * HALF + wr * 64 + m * 16 + fr) * 2 + bj) * 4 + wc] = ss; }
            asm volatile("s_waitcnt lgkmcnt(0)" ::: "memory"); __builtin_amdgcn_s_barrier(); asm volatile("" ::: "memory");
            const f32x4 gv0 = *(const f32x4*)(gain + wc * 32 + 8 * fq), gv1 = *(const f32x4*)(gain + wc * 32 + 8 * fq + 4);
#pragma unroll
            for (int ai = 0; ai < 2; ++ai)
#pragma unroll
                for (int m = 0; m < 4; ++m)
#pragma unroll
                    for (int bj = 0; bj < 2; ++bj) { const f32x4 p4 = *(const LAS f32x4*)(part + ((ai * HALF + wr * 64 + m * 16 + fr) * 2 + bj) * 4);
                        const float r2 = __builtin_amdgcn_rsqf(((p4[0] + p4[1]) + (p4[2] + p4[3])) * (1.0f / 128.0f) + RMS_EPS);
                        acc[ai][bj][m][0] *= gv0 * r2; acc[ai][bj][m][1] *= gv1 * r2; }
        }
#pragma unroll
        for (int ai = 0; ai < 2; ++ai)
#pragma unroll
            for (int m = 0; m < 4; ++m) { const int row = row0 + ai * HALF + m * 16;
                bf16_t* rowp = O + (size_t)row * ldc + col0;
#pragma unroll
                for (int bj = 0; bj < 2; ++bj) { const f32x4 v0 = acc[ai][bj][m][0], v1 = acc[ai][bj][m][1];
                    u32x4 w; w.x = cvt_pk_bf16(v0[0], v0[1]); w.y = cvt_pk_bf16(v0[2], v0[3]); w.z = cvt_pk_bf16(v1[0], v1[1]); w.w = cvt_pk_bf16(v1[2], v1[3]);
                    *(u32x4*)(rowp + bj * HALF) = w;
                    if (fgout && bj == 0 && u.pn == fg_tile && wc == 0 && fq < 2) { float* fp = fgout + (size_t)row * 16 + 8 * fq; *(f32x4*)fp = v0; *(f32x4*)(fp + 4) = v1; } } }
    }
};
struct EpiSwiGLU {
    bf16_t* O; int ldc; const u64* ssq; float oscale; int h8;
    __device__ __forceinline__ void operator()(f32x4 (&acc)[2][2][4][2], const Unit& u, int wr, int wc, int fr, int fq, LAS unsigned char*) const {
        const int row0 = u.pm * BM + wr * 64 + fr; const int col0 = u.pn * HALF + wc * 32 + 8 * fq;
        float rsv[2][4];
#pragma unroll
        for (int ai = 0; ai < 2; ++ai)
#pragma unroll
            for (int m = 0; m < 4; ++m) rsv[ai][m] = rs_from_ssq(ssq[row0 + ai * HALF + m * 16]) * oscale;
#pragma unroll
        for (int ai = 0; ai < 2; ++ai)
#pragma unroll
            for (int m = 0; m < 4; ++m) { const int row = row0 + ai * HALF + m * 16; const float rs = rsv[ai][m];
                float h[8];
#pragma unroll
                for (int n = 0; n < 2; ++n)
#pragma unroll
                    for (int j = 0; j < 4; ++j) { const float g = acc[ai][0][m][n][j] * rs, uu = acc[ai][1][m][n][j] * rs;
                        const float e = __builtin_amdgcn_exp2f(-g * LOG2E); h[n * 4 + j] = g * __builtin_amdgcn_rcpf(1.0f + e) * uu; }
                if (h8) {
                    int q0 = __builtin_amdgcn_cvt_pk_fp8_f32(h[0] * 8.f, h[1] * 8.f, 0, false); q0 = __builtin_amdgcn_cvt_pk_fp8_f32(h[2] * 8.f, h[3] * 8.f, q0, true);
                    int q1 = __builtin_amdgcn_cvt_pk_fp8_f32(h[4] * 8.f, h[5] * 8.f, 0, false); q1 = __builtin_amdgcn_cvt_pk_fp8_f32(h[6] * 8.f, h[7] * 8.f, q1, true);
                    const int kt8 = col0 >> 7, hh8 = (row >> 7) & 1;
                    __builtin_nontemporal_store((u32x2){(unsigned)q0, (unsigned)q1}, (u32x2*)((unsigned char*)O + ((size_t)((size_t)u.pm * (ldc >> 7) + kt8) * 2 + hh8) * (size_t)HTB + (size_t)(row & 127) * 128 + (col0 & 127)));
                    continue; }
                u32x4 w; w.x = cvt_pk_bf16(h[0], h[1]); w.y = cvt_pk_bf16(h[2], h[3]); w.z = cvt_pk_bf16(h[4], h[5]); w.w = cvt_pk_bf16(h[6], h[7]);
                const int kt = col0 >> 6, hh = (row >> 7) & 1;
                __builtin_nontemporal_store(w, (u32x4*)(O + ((size_t)((size_t)u.pm * (ldc >> 6) + kt) * 2 + hh) * (HALF * BK) + (size_t)(row & 127) * BK + (col0 & 63))); }
    }
};
struct EpiResid {
    const float* xin; float* xout; bf16_t* xb; u64* ssq_out; unsigned char* xb8; float alpha;
    __device__ __forceinline__ void operator()(f32x4 (&acc)[2][2][4][2], const Unit& u, int wr, int wc, int fr, int fq, LAS unsigned char*) const {
        const int row0 = u.pm * BM + wr * 64 + fr; const int col0 = u.pn * BM + wc * 32 + 8 * fq;
#pragma unroll
        for (int ai = 0; ai < 2; ++ai) {
            f32x4 xi[4][2][2];
#pragma unroll
            for (int m = 0; m < 4; ++m) { const size_t off = (size_t)(row0 + ai * HALF + m * 16) * DM + col0;
#pragma unroll
                for (int bj = 0; bj < 2; ++bj) { xi[m][bj][0] = __builtin_nontemporal_load((const f32x4*)(xin + off + bj * HALF)); xi[m][bj][1] = __builtin_nontemporal_load((const f32x4*)(xin + off + bj * HALF + 4)); } }
            asm volatile("" ::: "memory");
#pragma unroll
            for (int m = 0; m < 4; ++m) { const int row = row0 + ai * HALF + m * 16; const size_t off = (size_t)row * DM + col0; float ss = 0.f;
#pragma unroll
                for (int bj = 0; bj < 2; ++bj) {
                    const f32x4 v0 = xi[m][bj][0] + acc[ai][bj][m][0] * alpha, v1 = xi[m][bj][1] + acc[ai][bj][m][1] * alpha;
                    __builtin_nontemporal_store(v0, (f32x4*)(xout + off + bj * HALF)); __builtin_nontemporal_store(v1, (f32x4*)(xout + off + bj * HALF + 4));
                    u32x4 w; w.x = cvt_pk_bf16(v0[0], v0[1]); w.y = cvt_pk_bf16(v0[2], v0[3]); w.z = cvt_pk_bf16(v1[0], v1[1]); w.w = cvt_pk_bf16(v1[2], v1[3]);
                    *(u32x4*)(xb + off + bj * HALF) = w;
                    if (xb8) { int q0 = __builtin_amdgcn_cvt_pk_fp8_f32(v0[0], v0[1], 0, false); q0 = __builtin_amdgcn_cvt_pk_fp8_f32(v0[2], v0[3], q0, true);
                               int q1 = __builtin_amdgcn_cvt_pk_fp8_f32(v1[0], v1[1], 0, false); q1 = __builtin_amdgcn_cvt_pk_fp8_f32(v1[2], v1[3], q1, true);
                               *(u32x2*)(xb8 + off + bj * HALF) = (u32x2){(unsigned)q0, (unsigned)q1}; }
                    ss += (v0[0] * v0[0] + v0[1] * v0[1]) + (v0[2] * v0[2] + v0[3] * v0[3]) + (v1[0] * v1[0] + v1[1] * v1[1]) + (v1[2] * v1[2] + v1[3] * v1[3]); }
                if (ssq_out) { ss += __shfl_xor(ss, 16); ss += __shfl_xor(ss, 32); if (fq == 0) atomicAdd(ssq_out + row, (u64)(ss * SSQ_SCALE)); } }
            asm volatile("" ::: "memory");
        }
    }
};

template <int FP8 = 0, class Epi, class Sched>
__device__ __forceinline__ void gemm_phase(LAS unsigned char* lds, const Gemm g, const Sched& S, const Epi& E, const int tid) {
    const int wid = __builtin_amdgcn_readfirstlane(tid >> 6), lane = tid & 63, wr = wid >> 2, wc = wid & 3, fr = lane & 15, fq = lane >> 4;
    const int K = g.K, nt = K / BK;
    unsigned voffA[2], voffB[2];
#pragma unroll
    for (int i = 0; i < 2; ++i) { int R, C; stage_rc(tid * 16 + i * 8192, R, C); const int Rb = (R & ~31) + perm32(R & 31);
        voffA[i] = (unsigned)(R * (g.a_tiled ? BK : g.lda) + C) * 2u; voffB[i] = (unsigned)(Rb * (g.b_tiled ? BK : g.ldb) + C) * 2u; }
    const size_t kstep = (size_t)(BK * 2), kstepA = g.a_tiled ? (size_t)(2 * HTB) : kstep, kstepB = g.b_tiled ? (size_t)(2 * HTB) : kstep;
    const size_t hstepA = g.a_tiled ? (size_t)HTB : (size_t)HALF * g.lda * 2, hstepB = g.b_tiled ? (size_t)HTB : (size_t)HALF * g.ldb * 2;
    const size_t tstepA = g.a_tiled ? (size_t)nt * 2 * HTB : 2 * hstepA, tstepB = g.b_tiled ? (size_t)nt * 2 * HTB : 2 * hstepB;
    const unsigned ldsw = (unsigned)wid * 1024u;
    const int aoff = lds_byte(wr * 64 + fr, fq * 8), boff = lds_byte(wc * 32 + fr, fq * 8);
#define PG8_SA(b, h) (((b) * 2 + (h)) * HTB)
#define PG8_SB(b, h) ((4 + (b) * 2 + (h)) * HTB)
#define PG8_STAGE(bufoff, gbase, voff) do { _Pragma("unroll") for (int _i = 0; _i < 2; ++_i) \
        __builtin_amdgcn_global_load_lds((const unsigned*)((const char*)(gbase) + (voff)[_i]), (LAS unsigned*)(lds + (bufoff) + ldsw + _i * 8192), 16, 0, 0); } while (0)
#define PG8_LD8(p_) __builtin_shufflevector(*(const LAS i32x4_t*)(p_), *(const LAS i32x4_t*)((p_) + 1024), 0, 1, 2, 3, 4, 5, 6, 7)
#define PG8_LDA(dst, b, h) do { if constexpr (FP8 == 2) { _Pragma("unroll") for (int m = 0; m < 4; ++m) dst##8[m] = PG8_LD8(lds + PG8_SA(b, h) + aoff + m * 2048); } \
        else { _Pragma("unroll") for (int m = 0; m < 4; ++m) _Pragma("unroll") for (int k = 0; k < 2; ++k) dst[m][k] = *(const LAS bf16x8*)(lds + PG8_SA(b, h) + aoff + m * 2048 + k * 1024); } } while (0)
#define PG8_LDB(dst, b, h) do { if constexpr (FP8 == 2) { _Pragma("unroll") for (int n = 0; n < 2; ++n) dst##8[n] = PG8_LD8(lds + PG8_SB(b, h) + boff + n * 2048); } \
        else { _Pragma("unroll") for (int n = 0; n < 2; ++n) _Pragma("unroll") for (int k = 0; k < 2; ++k) dst[n][k] = *(const LAS bf16x8*)(lds + PG8_SB(b, h) + boff + n * 2048 + k * 1024); } } while (0)
typedef long i64x2_t __attribute__((ext_vector_type(2)));
typedef int i32x4_t __attribute__((ext_vector_type(4)));
typedef int i32x8_t __attribute__((ext_vector_type(8)));
#define PG8_MMA(ai, bj, At, Bt) do { __builtin_amdgcn_s_setprio(1); \
        if constexpr (FP8 == 2) { _Pragma("unroll") for (int m = 0; m < 4; ++m) _Pragma("unroll") for (int n = 0; n < 2; ++n) \
            asm volatile("v_mfma_scale_f32_16x16x128_f8f6f4 %0, %1, %2, %0, %3, %3 op_sel_hi:[0,0,0]" : "+v"(acc[ai][bj][m][n]) : "v"(Bt##8[n]), "v"(At##8[m]), "v"(f8sc)); } \
        else if constexpr (FP8 == 1) { _Pragma("unroll") for (int m = 0; m < 4; ++m) _Pragma("unroll") for (int n = 0; n < 2; ++n) _Pragma("unroll") for (int k = 0; k < 2; ++k) { \
            const i64x2_t b_ = __builtin_bit_cast(i64x2_t, Bt[n][k]), a_ = __builtin_bit_cast(i64x2_t, At[m][k]); \
            acc[ai][bj][m][n] = __builtin_amdgcn_mfma_f32_16x16x32_fp8_fp8(b_[0], a_[0], acc[ai][bj][m][n], 0, 0, 0); \
            acc[ai][bj][m][n] = __builtin_amdgcn_mfma_f32_16x16x32_fp8_fp8(b_[1], a_[1], acc[ai][bj][m][n], 0, 0, 0); } } \
        else { _Pragma("unroll") for (int m = 0; m < 4; ++m) _Pragma("unroll") for (int n = 0; n < 2; ++n) _Pragma("unroll") for (int k = 0; k < 2; ++k) \
            acc[ai][bj][m][n] = __builtin_amdgcn_mfma_f32_16x16x32_bf16(Bt[n][k], At[m][k], acc[ai][bj][m][n], 0, 0, 0); } \
        __builtin_amdgcn_s_setprio(0); } while (0)
#define PG8_WAIT_V(n) asm volatile("s_waitcnt vmcnt(" #n ")" ::: "memory")
#define PG8_WAIT_L(n) asm volatile("s_waitcnt lgkmcnt(" #n ")" ::: "memory")
#define PG8_BAR __builtin_amdgcn_s_barrier()
#define PG8_SCHED __builtin_amdgcn_sched_barrier(0)
    Unit cur, nxt; int ui = 0;
    if (!S.next(0, cur)) return;
    f32x4 acc[2][2][4][2];
#pragma unroll
    for (int a = 0; a < 2; ++a)
#pragma unroll
        for (int b = 0; b < 2; ++b)
#pragma unroll
            for (int m = 0; m < 4; ++m)
#pragma unroll
                for (int n = 0; n < 2; ++n) acc[a][b][m][n] = (f32x4){0.f, 0.f, 0.f, 0.f};
    const int f8sc = 0x7f7f7f7f;
    bf16x8 At[4][2], B0[2][2], B1[2][2]; i32x8_t At8[4], B08[2], B18[2];
#ifdef PROBE_PM
#define PG8_PM(u_) ((g.pm_and & 1) ? ((u_).pm & 1) : (u_).pm)
#define PG8_PN(u_) ((g.pm_and & 2) ? ((u_).pn & 1) : (u_).pn)
#else
#define PG8_PM(u_) (u_).pm
#define PG8_PN(u_) (u_).pn
#endif
    const char* cA = (const char*)g.A + (size_t)PG8_PM(cur) * tstepA; const char* cB = (const char*)g.Bt + (size_t)PG8_PN(cur) * tstepB;
    PG8_STAGE(PG8_SB(0, 0), cB, voffB); PG8_STAGE(PG8_SB(0, 1), cB + hstepB, voffB); PG8_STAGE(PG8_SA(0, 0), cA, voffA); PG8_STAGE(PG8_SA(0, 1), cA + hstepA, voffA);
    if (wr == 1) PG8_BAR;
    PG8_WAIT_V(2); PG8_BAR;
    PG8_STAGE(PG8_SB(1, 0), cB + kstepB, voffB); PG8_STAGE(PG8_SA(1, 0), cA + kstepA, voffA); PG8_STAGE(PG8_SB(1, 1), cB + hstepB + kstepB, voffB);
    PG8_WAIT_V(6); PG8_BAR;
    for (;;) {
        const bool has_next = S.next(ui + 1, nxt);
        const char* nA = has_next ? (const char*)g.A + (size_t)PG8_PM(nxt) * tstepA : cA; const char* nB = has_next ? (const char*)g.Bt + (size_t)PG8_PN(nxt) * tstepB : cB;
        for (int t = 0; t < nt; t += 2) {
            const bool last = (t == nt - 2);
            const char* a1 = cA + (size_t)(t + 1) * kstepA;
            const char* a2 = last ? nA : cA + (size_t)(t + 2) * kstepA; const char* b2 = last ? nB : cB + (size_t)(t + 2) * kstepB;
            const char* a3 = a2 + kstepA; const char* b3 = b2 + kstepB;
            PG8_LDB(B0, 0, 0); PG8_LDB(B1, 0, 1); PG8_SCHED; PG8_LDA(At, 0, 0); PG8_STAGE(PG8_SA(1, 1), a1 + hstepA, voffA);
            PG8_WAIT_V(8); PG8_WAIT_L(0); PG8_BAR; PG8_MMA(0, 0, At, B0); PG8_MMA(0, 1, At, B1); PG8_BAR; PG8_SCHED;
            PG8_LDA(At, 0, 1); PG8_STAGE(PG8_SB(0, 0), b2, voffB); PG8_STAGE(PG8_SB(0, 1), b2 + hstepB, voffB); PG8_STAGE(PG8_SA(0, 0), a2, voffA);
            PG8_WAIT_V(8); PG8_WAIT_L(0); PG8_BAR; PG8_MMA(1, 0, At, B0); PG8_MMA(1, 1, At, B1); PG8_BAR; PG8_SCHED;
            PG8_LDB(B0, 1, 0); PG8_LDB(B1, 1, 1); PG8_SCHED; PG8_LDA(At, 1, 0); PG8_STAGE(PG8_SA(0, 1), a2 + hstepA, voffA);
            PG8_WAIT_V(8); PG8_WAIT_L(0); PG8_BAR; PG8_MMA(0, 0, At, B0); PG8_MMA(0, 1, At, B1); PG8_BAR; PG8_SCHED;
            PG8_LDA(At, 1, 1); PG8_STAGE(PG8_SB(1, 0), b3, voffB); PG8_STAGE(PG8_SB(1, 1), b3 + hstepB, voffB); PG8_STAGE(PG8_SA(1, 0), a3, voffA);
            PG8_WAIT_V(8); PG8_WAIT_L(0); PG8_BAR; PG8_MMA(1, 0, At, B0); PG8_MMA(1, 1, At, B1); PG8_BAR; PG8_SCHED;
        }
        if (wr == 0) PG8_BAR;
        if constexpr (FP8 == 2) { asm volatile("s_nop 7\n\ts_nop 7\n\ts_nop 7\n\ts_nop 7" ::: "memory"); PG8_SCHED; }
        E(acc, cur, wr, wc, fr, fq, lds + STAGE_BYTES);
        if (!has_next) break;
#pragma unroll
        for (int a = 0; a < 2; ++a)
#pragma unroll
            for (int b = 0; b < 2; ++b)
#pragma unroll
                for (int m = 0; m < 4; ++m)
#pragma unroll
                    for (int n = 0; n < 2; ++n) acc[a][b][m][n] = (f32x4){0.f, 0.f, 0.f, 0.f};
        cur = nxt; cA = nA; cB = nB; ++ui;
        if (wr == 1) PG8_BAR;
    }
    PG8_WAIT_V(0);
    PG8_BAR;
#undef PG8_SA
#undef PG8_SB
#undef PG8_STAGE
#undef PG8_LDA
#undef PG8_LD8
#undef PG8_LDB
#undef PG8_MMA
#undef PG8_WAIT_V
#undef PG8_WAIT_L
#undef PG8_BAR
#undef PG8_SCHED
}
}

#define XB_TMO      128
#define XB_XCNT(j)  (256  + 64 * (j))
#define XB_XSUB(j)  (1280 + 64 * (j))
#define XB_XGEN(j)  (2304 + 64 * (j))
#define XB_TOP      3328
#define XB_TOPGEN   3392
#define XCD_BAR_WORDS 3456
#define XB_SPIN_CAP (1u << 22)

__device__ __forceinline__ unsigned xb_ld(unsigned* p)              { return __hip_atomic_load(p, __ATOMIC_RELAXED, __HIP_MEMORY_SCOPE_AGENT); }
__device__ __forceinline__ unsigned xb_add(unsigned* p, unsigned v) { return __hip_atomic_fetch_add(p, v, __ATOMIC_RELAXED, __HIP_MEMORY_SCOPE_AGENT); }
__device__ __forceinline__ unsigned xb_xcc_id() { return (unsigned)__builtin_amdgcn_s_getreg((3 << 11) | 20) & 0xFu; }
#define XB_SPIN(cond, bar) do { unsigned _sp = 0; while (cond) { __builtin_amdgcn_s_sleep(1); \
    if ((++_sp & 255u) == 0u) { if (xb_ld(&(bar)[XB_TMO])) break; if (_sp > XB_SPIN_CAP) { atomicAdd(&(bar)[XB_TMO], 1u); break; } } } } while (0)

struct XcdBarrier { unsigned* bar; unsigned x; volatile LAS unsigned* st; };

__device__ __forceinline__ XcdBarrier xcd_barrier_post(unsigned* bar, volatile LAS unsigned* st) {
    XcdBarrier b; b.bar = bar; b.x = xb_xcc_id(); b.st = st;
    if (threadIdx.x == 0) (void)xb_add(&bar[XB_XCNT(b.x)], 1u);
    return b;
}
__device__ __forceinline__ void xcd_barrier_complete(unsigned* bar, unsigned x, unsigned& nloc, unsigned& nx) {
    const unsigned G = gridDim.x * gridDim.y * gridDim.z;
    unsigned sum, cnt, mine, sp = 0u;
    for (;;) {
        sum = 0u; cnt = 0u; mine = 0u;
#pragma unroll
        for (unsigned j = 0; j < 16; ++j) { const unsigned c = xb_ld(&bar[XB_XCNT(j)]); sum += c; cnt += (c > 0u) ? 1u : 0u; mine = (j == x) ? c : mine; }
        if (sum == G) break;
        __builtin_amdgcn_s_sleep(1);
        if ((++sp & 255u) == 0u) { if (xb_ld(&bar[XB_TMO])) break; if (sp > XB_SPIN_CAP) { atomicAdd(&bar[XB_TMO], 1u); break; } }
    }
    nloc = mine > 0u ? mine : 1u; nx = cnt > 0u ? cnt : 1u;
}
__device__ __forceinline__ void xcd_barrier(const XcdBarrier& b) {
    asm volatile("s_waitcnt vmcnt(0)" ::: "memory");
    __syncthreads();
    if (threadIdx.x == 0) {
        unsigned* bar = b.bar; unsigned bx_ = b.x; asm volatile("" : "+s"(bar), "+s"(bx_));
        __builtin_amdgcn_s_waitcnt(0);
        unsigned nloc = b.st[0], nx = b.st[1];
        if (nloc == 0u) { xcd_barrier_complete(bar, bx_, nloc, nx); b.st[0] = nloc; b.st[1] = nx; }
        const unsigned old = xb_add(&bar[XB_XSUB(bx_)], 1u);
        const unsigned gen = old / nloc;
        if (old + 1u == (gen + 1u) * nloc) {
            __builtin_amdgcn_fence(__ATOMIC_RELEASE, "agent");
            asm volatile("s_waitcnt vmcnt(0)" ::: "memory");
            const unsigned og = xb_add(&bar[XB_TOP], 1u);
            const unsigned tg = og / nx;
            if (og + 1u == (tg + 1u) * nx) xb_add(&bar[XB_TOPGEN], 1u);
            else XB_SPIN(xb_ld(&bar[XB_TOPGEN]) == tg, bar);
            __builtin_amdgcn_fence(__ATOMIC_ACQUIRE, "agent");
            xb_add(&bar[XB_XGEN(bx_)], 1u);
            asm volatile("s_waitcnt vmcnt(0)" ::: "memory");
        } else {
            XB_SPIN(xb_ld(&bar[XB_XGEN(bx_)]) == gen, bar);
            __builtin_amdgcn_fence(__ATOMIC_ACQUIRE, "agent");
            asm volatile("s_waitcnt vmcnt(0)" ::: "memory");
        }
    }
    __syncthreads();
}

namespace att {
constexpr int NW = 8, QBLK = 32, KVBLK = 64;
constexpr float THR2 = 8.f * LOG2E;
enum { K_MEM = 0, K_FOX = 1, K_MLA = 2, K_DIL = 3, K_DSA = 4 };
constexpr int L_V = 0, L_K = 49152, L_XB = 100352, L_TBL = 106496, L_END = 141312, VB = 16384;

struct AP {
    const bf16_t* Q; const bf16_t* K; const bf16_t* V; bf16_t* O;
    long qs, ks, vs, os;
    int kt0, nt;
    int q0;
    float C;
    const float* cum; long cums;
    const u64* msk;
    float* ost; long osts;
    float* mst; long msts;
    int carry_in, carry_out;
    int o8;
    const float* t5; int head, dil;
};

#define ATT_SBAR() __builtin_amdgcn_sched_barrier(0)
__device__ __forceinline__ int crow(int r, int hi) { return (r & 3) + 8 * (r >> 2) + 4 * hi; }
__device__ __forceinline__ int t5_bucket(int dist) {
    const int n = dist < 0 ? 0 : dist; if (n < 16) return n;
    const float v = __log2f((float)n * 0.0625f) * (16.0f / 7.0f); int b = 16 + (int)v; return b > 31 ? 31 : b;
}
__device__ __forceinline__ void rowmax_decide(const f32x16& p0, const f32x16& p1, float& m_reg, float& alpha) {
    float pmax = p0[0];
#pragma unroll
    for (int r = 1; r < 16; ++r) pmax = fmaxf(pmax, p0[r]);
#pragma unroll
    for (int r = 0; r < 16; ++r) pmax = fmaxf(pmax, p1[r]);
    { auto rr = __builtin_amdgcn_permlane32_swap(__float_as_uint(pmax), __float_as_uint(pmax), false, false); pmax = fmaxf(__uint_as_float(rr[0]), __uint_as_float(rr[1])); }
    if (__builtin_expect(__all(pmax - m_reg <= THR2), 1)) { alpha = 1.f; }
    else { const float mn = fmaxf(m_reg, pmax); alpha = __builtin_amdgcn_exp2f(m_reg - mn); m_reg = mn; }
}
__device__ __forceinline__ float half_sum(float ps) {
    auto rr = __builtin_amdgcn_permlane32_swap(__float_as_uint(ps), __float_as_uint(ps), false, false); return __uint_as_float(rr[0]) + __uint_as_float(rr[1]);
}
__device__ __forceinline__ void pack_p(const f32x16& p0, const f32x16& p1, bf16x8& pa0, bf16x8& pa1, bf16x8& pa2, bf16x8& pa3) {
#define ATT_PK4(P, BASE, OUT) do { unsigned a0 = cvt_pk_bf16(P[BASE + 0], P[BASE + 1]), a1 = cvt_pk_bf16(P[BASE + 2], P[BASE + 3]);   \
    unsigned b0 = cvt_pk_bf16(P[BASE + 4], P[BASE + 5]), b1 = cvt_pk_bf16(P[BASE + 6], P[BASE + 7]);                              \
    auto r0 = __builtin_amdgcn_permlane32_swap(a0, b0, false, false); auto r1 = __builtin_amdgcn_permlane32_swap(a1, b1, false, false); \
    u32x4 w = {r0[0], r1[0], r0[1], r1[1]}; OUT = __builtin_bit_cast(bf16x8, w); } while (0)
    ATT_PK4(p0, 0, pa0); ATT_PK4(p0, 8, pa1); ATT_PK4(p1, 0, pa2); ATT_PK4(p1, 8, pa3);
#undef ATT_PK4
}
template <int DK, int NQL>
__device__ __forceinline__ void qkt(f32x16& p0, f32x16& p1, const LAS unsigned char* Ks, const int (&kad)[4], const bf16x8* qr, const LAS unsigned char* qsp) {
    p0 = f32x16{}; p1 = f32x16{};
    constexpr int ND = DK / 16, NQR = ND - NQL;
#define ATT_LDK(d, hf) (*(const LAS bf16x8*)(Ks + ((DK == 128) ? (kad[(d) & 3] ^ (((d) >> 2) ? 128 : 0)) : (kad[(d) & 3] + 128 * ((d) >> 2))) + (hf) * 32 * DK * 2))
#define ATT_LDQ(d) (((d) < NQR) ? qr[(d) < NQR ? (d) : 0] : *(const LAS bf16x8*)(qsp + ((d) - NQR) * 1024))
    bf16x8 b0 = ATT_LDK(0, 0), b1 = ATT_LDK(0, 1), qf = ATT_LDQ(0);
#pragma unroll
    for (int d0 = 0; d0 < ND; ++d0) {
        bf16x8 c0 = b0, c1 = b1, qn = qf;
        if (d0 + 1 < ND) { c0 = ATT_LDK(d0 + 1, 0); c1 = ATT_LDK(d0 + 1, 1); qn = ATT_LDQ(d0 + 1); }
        ATT_SBAR();
        p0 = __builtin_amdgcn_mfma_f32_32x32x16_bf16(b0, qf, p0, 0, 0, 0);
        p1 = __builtin_amdgcn_mfma_f32_32x32x16_bf16(b1, qf, p1, 0, 0, 0);
        ATT_SBAR();
        b0 = c0; b1 = c1; qf = qn; }
#undef ATT_LDK
#undef ATT_LDQ
}
__device__ __forceinline__ int v_st(int k, int c) { const int kk = (k & ~0xC) | ((k & 4) << 1) | ((k & 8) >> 1); return ((kk >> 3) * 4 + (c >> 5)) * 512 + ((kk & 7) * 32 + (c & 31)) * 2; }
__device__ __forceinline__ int v_rd_base(int lane) { return ((lane & 3) << 3) | (((lane >> 2) & 3) << 6) | (((lane >> 4) & 1) << 5) | (((lane >> 5) & 1) << 8); }
constexpr int v_rd_off(int d0, int ks, int half) { return d0 * 512 + ks * 4096 + half * 2048; }
template <int OFF> __device__ __forceinline__ s16x4 tr_read(int vb) { s16x4 r; asm volatile("ds_read_b64_tr_b16 %0, %1 offset:%2" : "=&v"(r) : "v"(vb), "i"(OFF) : "memory"); return r; }
struct VF { s16x4 l0, h0, l1, h1, l2, h2, l3, h3; };
template <int D0> __device__ __forceinline__ void pv_read(VF& f, int vb) {
    f.l0 = tr_read<v_rd_off(D0, 0, 0)>(vb); f.h0 = tr_read<v_rd_off(D0, 0, 1)>(vb); f.l1 = tr_read<v_rd_off(D0, 1, 0)>(vb); f.h1 = tr_read<v_rd_off(D0, 1, 1)>(vb);
    f.l2 = tr_read<v_rd_off(D0, 2, 0)>(vb); f.h2 = tr_read<v_rd_off(D0, 2, 1)>(vb); f.l3 = tr_read<v_rd_off(D0, 3, 0)>(vb); f.h3 = tr_read<v_rd_off(D0, 3, 1)>(vb);
}
#define ATT_VWAIT(n, f) asm volatile("s_waitcnt lgkmcnt(" #n ")" : "+v"(f.l0), "+v"(f.h0), "+v"(f.l1), "+v"(f.h1), "+v"(f.l2), "+v"(f.h2), "+v"(f.l3), "+v"(f.h3) :: "memory")
#define ATT_PK(L, H) (bf16x8){L[0], L[1], L[2], L[3], H[0], H[1], H[2], H[3]}
__device__ __forceinline__ void pv_only(f32x16* o, int vb, bf16x8 pa0, bf16x8 pa1, bf16x8 pa2, bf16x8 pa3) {
    VF fa, fb;
#define ATT_MMA4(od, f) do { od = __builtin_amdgcn_mfma_f32_32x32x16_bf16(pa0, ATT_PK(f.l0, f.h0), od, 0, 0, 0); od = __builtin_amdgcn_mfma_f32_32x32x16_bf16(pa1, ATT_PK(f.l1, f.h1), od, 0, 0, 0); \
        od = __builtin_amdgcn_mfma_f32_32x32x16_bf16(pa2, ATT_PK(f.l2, f.h2), od, 0, 0, 0); od = __builtin_amdgcn_mfma_f32_32x32x16_bf16(pa3, ATT_PK(f.l3, f.h3), od, 0, 0, 0); } while (0)
    pv_read<0>(fa, vb); pv_read<1>(fb, vb);
    ATT_VWAIT(8, fa); ATT_SBAR(); ATT_MMA4(o[0], fa); ATT_SBAR(); pv_read<2>(fa, vb);
    ATT_VWAIT(8, fb); ATT_SBAR(); ATT_MMA4(o[1], fb); ATT_SBAR(); pv_read<3>(fb, vb);
    ATT_VWAIT(8, fa); ATT_SBAR(); ATT_MMA4(o[2], fa); ATT_SBAR();
    ATT_VWAIT(0, fb); ATT_SBAR(); ATT_MMA4(o[3], fb);
#undef ATT_MMA4
}
__device__ __forceinline__ float sm_only(f32x16& p0, f32x16& p1, float m) {
    float s = 0.f;
#pragma unroll
    for (int r = 0; r < 16; ++r) { p0[r] = __builtin_amdgcn_exp2f(p0[r] - m); s += p0[r]; }
#pragma unroll
    for (int r = 0; r < 16; ++r) { p1[r] = __builtin_amdgcn_exp2f(p1[r] - m); s += p1[r]; }
    return s;
}
__device__ __forceinline__ float pv_sm(f32x16* o, int vb, bf16x8 pa0, bf16x8 pa1, bf16x8 pa2, bf16x8 pa3, f32x16& p0, f32x16& p1, float m) {
    VF fa, fb; float s = 0.f;
#define ATT_GAP(od, pa, L, H, X, B) do { od = __builtin_amdgcn_mfma_f32_32x32x16_bf16(pa, ATT_PK(L, H), od, 0, 0, 0); \
        { float t0_ = X[B] - m, t1_ = X[B + 1] - m, e0_, e1_; asm volatile("v_exp_f32 %0, %1" : "=v"(e0_) : "v"(t0_)); asm volatile("v_exp_f32 %0, %1" : "=v"(e1_) : "v"(t1_));     \
          X[B] = e0_; X[B + 1] = e1_; s += e0_; s += e1_; } ATT_SBAR(); } while (0)
    pv_read<0>(fa, vb); pv_read<1>(fb, vb);
    ATT_VWAIT(8, fa); ATT_SBAR();
    ATT_GAP(o[0], pa0, fa.l0, fa.h0, p0, 0); ATT_GAP(o[0], pa1, fa.l1, fa.h1, p0, 2); ATT_GAP(o[0], pa2, fa.l2, fa.h2, p0, 4); ATT_GAP(o[0], pa3, fa.l3, fa.h3, p0, 6);
    pv_read<2>(fa, vb); ATT_VWAIT(8, fb); ATT_SBAR();
    ATT_GAP(o[1], pa0, fb.l0, fb.h0, p0, 8); ATT_GAP(o[1], pa1, fb.l1, fb.h1, p0, 10); ATT_GAP(o[1], pa2, fb.l2, fb.h2, p0, 12); ATT_GAP(o[1], pa3, fb.l3, fb.h3, p0, 14);
    pv_read<3>(fb, vb); ATT_VWAIT(8, fa); ATT_SBAR();
    ATT_GAP(o[2], pa0, fa.l0, fa.h0, p1, 0); ATT_GAP(o[2], pa1, fa.l1, fa.h1, p1, 2); ATT_GAP(o[2], pa2, fa.l2, fa.h2, p1, 4); ATT_GAP(o[2], pa3, fa.l3, fa.h3, p1, 6);
    ATT_VWAIT(0, fb); ATT_SBAR();
    ATT_GAP(o[3], pa0, fb.l0, fb.h0, p1, 8); ATT_GAP(o[3], pa1, fb.l1, fb.h1, p1, 10); ATT_GAP(o[3], pa2, fb.l2, fb.h2, p1, 12); ATT_GAP(o[3], pa3, fb.l3, fb.h3, p1, 14);
#undef ATT_GAP
    return s;
}

template <int KIND>
__device__ __forceinline__ void score(f32x16& p0, f32x16& p1, const AP& a, int t, int buf, LAS unsigned char* lds, int wid, int r32, int hi, float cq) {
    const float C = a.C; const int k0 = t * 64; const int q = a.q0 + wid * 32 + r32; const float NEG = -INFINITY;
    if constexpr (KIND == K_FOX) {
        const LAS f32x4* cb = (const LAS f32x4*)(lds + L_XB + buf * 2048) + hi;
#pragma unroll
        for (int g = 0; g < 4; ++g) { const f32x4 c4 = cb[2 * g], c4b = cb[2 * g + 8];
#pragma unroll
            for (int j = 0; j < 4; ++j) { p0[4 * g + j] = fmaf(p0[4 * g + j], C, -c4[j]); p1[4 * g + j] = fmaf(p1[4 * g + j], C, -c4b[j]); } }
    } else if constexpr (KIND == K_DSA || KIND == K_DIL) {
        const LAS float* tb = (const LAS float*)(lds + L_TBL) + (q - k0 - 4 * hi + 256 - 59);
#pragma unroll
        for (int r = 0; r < 16; ++r) { const int cc = (r & 3) + 8 * (r >> 2); p0[r] = fmaf(p0[r], C, tb[59 - cc]); p1[r] = fmaf(p1[r], C, tb[59 - cc - 32]); }
        if constexpr (KIND == K_DSA) {
            const LAS unsigned* mb = (const LAS unsigned*)(lds + L_XB + buf * 2048) + wid * 64;
            const unsigned wl = mb[r32] >> (4 * hi), wh = mb[32 + r32] >> (4 * hi);
#pragma unroll
            for (int r = 0; r < 16; ++r) { const int cc = (r & 3) + 8 * (r >> 2); p0[r] = ((wl >> cc) & 1u) ? p0[r] : NEG; p1[r] = ((wh >> cc) & 1u) ? p1[r] : NEG; }
        }
    } else {
#pragma unroll
        for (int r = 0; r < 16; ++r) { p0[r] *= C; p1[r] *= C; }
    }
    if constexpr (KIND == K_FOX || KIND == K_MLA) {
        if (k0 + 63 > a.q0) {
            const int kb = k0 + 4 * hi;
#pragma unroll
            for (int r = 0; r < 16; ++r) { const int kv = kb + (r & 3) + 8 * (r >> 2); if (kv > q) p0[r] = NEG; if (kv + 32 > q) p1[r] = NEG; }
        }
    }
}

template <int KIND, int DK>
__device__ __forceinline__ void attn_unit(LAS unsigned char* lds, const AP& a, const int wave_id) {
    const int tid = tid_opaque(wave_id);
    const int lane = tid & 63, r32 = lane & 31, hi = lane >> 5; const int wid = __builtin_amdgcn_readfirstlane(tid >> 6);
    constexpr bool HAS_TBL = (KIND == K_DSA || KIND == K_DIL), HAS_X = (KIND == K_FOX || KIND == K_DSA);
    constexpr int KB = KVBLK * DK * 2, NKC = DK / 8, NKL = (64 * NKC) / 512, ND0 = DK / 16;
    constexpr int NQL = (DK == 192) ? 2 : (HAS_TBL ? 2 : 4), NQR = ND0 - NQL, NLD = NKL + 2 + (HAS_X ? 1 : 0);
    constexpr int LWS = (DK == 192) ? 122880 : 98304, LQSP = (DK == 192) ? 124928 : (HAS_TBL ? 123904 : 106496);
    LAS unsigned char* V_lds = lds + L_V; LAS unsigned char* K_lds = lds + L_K;
    LAS float* wsf = (LAS float*)(lds + LWS) + wid * 64; LAS float* li_l = wsf; LAS float* al_l = wsf + 32;
    LAS unsigned char* qsp = lds + LQSP + wid * (NQL * 1024) + lane * 16;
    float m_reg = -1e30f, l_reg = 0.f; f32x16 o[4] = {}; bf16x8 qr[NQR];
    const int qi = wid * 32 + r32;
    const bf16_t* Qw = a.Q + (long)qi * a.qs + hi * 8;
#pragma unroll
    for (int d0 = 0; d0 < ND0; ++d0) { const bf16x8 qv = *(const bf16x8*)(Qw + d0 * 16); if (d0 < NQR) qr[d0 < NQR ? d0 : 0] = qv; else *(LAS bf16x8*)(qsp + (d0 - NQR) * 1024) = qv; }
    float cq = 0.f;

    if constexpr (KIND == K_DIL) {
        if (a.carry_in) {
            m_reg = a.mst[(long)qi * a.msts]; l_reg = a.mst[(long)qi * a.msts + 1];
#pragma unroll
            for (int r = 0; r < 16; ++r) { const unsigned* orow = (const unsigned*)a.ost + (long)(wid * 32 + crow(r, hi)) * a.osts + r32;
                const unsigned w0 = __builtin_nontemporal_load(orow), w1 = __builtin_nontemporal_load(orow + 32);
                o[0][r] = bf_lo(w0); o[1][r] = bf_hi(w0); o[2][r] = bf_lo(w1); o[3][r] = bf_hi(w1); }
        }
    }
    if constexpr (KIND == K_DSA) {
        LAS float* tbl = (LAS float*)(lds + L_TBL);
        for (int i = tid; i < 4352; i += 512) { const int dist = i - 256; tbl[i] = dist < 0 ? -INFINITY : a.t5[t5_bucket(dist) * 16 + a.head] * LOG2E; }
    }
    if constexpr (KIND == K_DIL) {
        LAS float* tbl = (LAS float*)(lds + L_TBL);
        for (int i = tid; i < 640; i += 512) { const int rel = i - 256; tbl[i] = (rel < 0 || rel > 128) ? -INFINITY : a.t5[t5_bucket(rel * a.dil) * 16 + a.head] * LOG2E; }
    }
    int ksrc[NKL], vsrc[2];
#pragma unroll
    for (int c = 0; c < NKL; ++c) { const int Lb = (wid * NKL + c) * 1024 + lane * 16, row = Lb / (DK * 2), chp = (Lb % (DK * 2)) / 16; ksrc[c] = row * (int)a.ks + ((DK == 128) ? (chp ^ (row & 15)) : ((chp & ~7) | ((chp & 7) ^ (row & 7)))) * 8; }
#pragma unroll
    for (int c = 0; c < 2; ++c) { const int sl = (2 * wid + c) * 64 + lane, st = sl >> 5, wi = sl & 31, kk = ((st >> 2) << 3) | (wi >> 2), k = (kk & ~0xC) | ((kk & 4) << 1) | ((kk & 8) >> 1); vsrc[c] = k * (int)a.vs + (st & 3) * 32 + (wi & 3) * 8; }
    const int vb0 = (int)(unsigned)(uintptr_t)V_lds + v_rd_base(lane);
    int kad[4];
#pragma unroll
    for (int j = 0; j < 4; ++j) kad[j] = r32 * (DK * 2) + (((hi | (j << 1)) ^ (r32 & 7)) << 4) + ((DK == 128) ? 128 * ((r32 >> 3) & 1) : 0);
#define ATT_DMA(t, sl) do { const long kb_ = (long)(t) * 64; \
        _Pragma("unroll") for (int c_ = 0; c_ < NKL; ++c_) __builtin_amdgcn_global_load_lds((const unsigned*)(a.K + kb_ * a.ks + ksrc[c_]), (LAS unsigned*)(K_lds + (sl) * KB + (wid * NKL + c_) * 1024), 16, 0, 0); \
        _Pragma("unroll") for (int c_ = 0; c_ < 2; ++c_) __builtin_amdgcn_global_load_lds((const unsigned*)(a.V + kb_ * a.vs + vsrc[c_]), (LAS unsigned*)(V_lds + (sl) * VB + (2 * wid + c_) * 1024), 16, 0, 0); \
        if constexpr (KIND == K_FOX) __builtin_amdgcn_global_load_lds((const unsigned*)(a.cum + (kb_ + lane) * a.cums), (LAS unsigned*)(lds + L_XB + (sl) * 2048), 4, 0, 0);     \
        if constexpr (KIND == K_DSA) __builtin_amdgcn_global_load_lds((const unsigned*)(a.msk + (long)(wid * 32 + r32) * 64 + (t)) + hi, (LAS unsigned*)(lds + L_XB + (sl) * 2048 + wid * 256), 4, 0, 0); } while (0)
#define ATT_RESC(al) do { if (__any((al) < 1.f)) { if (hi == 0) al_l[r32] = (al); asm volatile("s_waitcnt lgkmcnt(0)" ::: "memory"); \
        _Pragma("unroll") for (int d = 0; d < 4; ++d) _Pragma("unroll") for (int r = 0; r < 16; ++r) o[d][r] *= al_l[crow(r, hi)]; } } while (0)
#define ATT_BAR() do { asm volatile("s_waitcnt lgkmcnt(0)" ::: "memory"); __builtin_amdgcn_s_barrier(); asm volatile("" ::: "memory"); } while (0)
    f32x16 p0, p1; float al = 1.f; bf16x8 pa0, pa1, pa2, pa3; const int NT = a.nt, T0 = a.kt0;
    asm volatile("s_waitcnt vmcnt(0) lgkmcnt(0)" ::: "memory");
    ATT_DMA(T0, 0);
    if (NT > 1) { ATT_DMA(T0 + 1, 1); asm volatile("s_waitcnt vmcnt(%0)" :: "n"(NLD) : "memory"); } else { asm volatile("s_waitcnt vmcnt(0)" ::: "memory"); }
    ATT_BAR();
    int sl = 0, sl2 = 2;
    for (int jj = 0; jj < NT; ++jj) {
        const int t = T0 + jj;
        if (jj + 2 < NT) ATT_DMA(t + 2, sl2);
        bool lv = true; { const int k0_ = t * 64, qw_ = a.q0 + wid * 32;
            if constexpr (KIND == K_FOX || KIND == K_MLA || KIND == K_DSA) lv = k0_ <= qw_ + 31;
            if constexpr (KIND == K_DIL) lv = (k0_ <= qw_ + 31) && (k0_ + 63 >= qw_ - 128); }
        if (lv) {
            ATT_SBAR(); qkt<DK, NQL>(p0, p1, K_lds + sl * KB, kad, qr, qsp);
            score<KIND>(p0, p1, a, t, sl, lds, wid, r32, hi, cq);
            rowmax_decide(p0, p1, m_reg, al);
            const float ps = sm_only(p0, p1, m_reg);
            l_reg = l_reg * al + half_sum(ps);
            ATT_RESC(al);
            pack_p(p0, p1, pa0, pa1, pa2, pa3); ATT_SBAR();
            pv_only(o, vb0 + sl * VB, pa0, pa1, pa2, pa3);
        }
        if (jj + 2 < NT) asm volatile("s_waitcnt vmcnt(%0)" :: "n"(NLD) : "memory"); else asm volatile("s_waitcnt vmcnt(0)" ::: "memory");
        ATT_BAR();
        sl = (sl == 2) ? 0 : sl + 1; sl2 = (sl2 == 2) ? 0 : sl2 + 1;
    }
    bool stateout = false;
    if constexpr (KIND == K_DIL) stateout = a.carry_out != 0;
    if (stateout) {
        int qi2 = qi; asm volatile("" : "+v"(qi2));
        if (hi == 0) { a.mst[(long)qi2 * a.msts] = m_reg; a.mst[(long)qi2 * a.msts + 1] = l_reg; }
        asm volatile("s_nop 7\n\ts_nop 7\n\ts_nop 7" : "+v"(o[0]), "+v"(o[1]), "+v"(o[2]), "+v"(o[3]));
#pragma unroll
        for (int r = 0; r < 16; ++r) { unsigned* orow = (unsigned*)a.ost + (long)(wid * 32 + crow(r, hi)) * a.osts + r32;
            __builtin_nontemporal_store(cvt_pk_bf16(o[0][r], o[1][r]), orow); __builtin_nontemporal_store(cvt_pk_bf16(o[2][r], o[3][r]), orow + 32); }
        __syncthreads();
    } else {
        if (hi == 0) li_l[r32] = l_reg;
        asm volatile("s_waitcnt lgkmcnt(0)" ::: "memory");
        float rli[16];
#pragma unroll
        for (int r = 0; r < 16; ++r) rli[r] = __builtin_amdgcn_rcpf(li_l[crow(r, hi)]);
        __syncthreads();
        LAS unsigned short* ost = (LAS unsigned short*)(lds + wid * 8192);
#pragma unroll
        for (int r = 0; r < 16; ++r) { const int orow = crow(r, hi);
#pragma unroll
            for (int d0 = 0; d0 < 4; ++d0) { const unsigned w = cvt_pk_bf16(o[d0][r] * rli[r], 0.f); ost[orow * 128 + d0 * 32 + r32] = (unsigned short)w; } }
        asm volatile("s_waitcnt lgkmcnt(0)" ::: "memory");
#pragma unroll
        for (int i = 0; i < 8; ++i) { const int ch = lane + 64 * i, row = ch >> 4, c16 = ch & 15;
            const u32x4 v = *(const LAS u32x4*)(lds + wid * 8192 + row * 256 + c16 * 16);
            if (a.o8) {
              int q0 = __builtin_amdgcn_cvt_pk_fp8_f32(bf_lo(v.x) * 16.f, bf_hi(v.x) * 16.f, 0, false); q0 = __builtin_amdgcn_cvt_pk_fp8_f32(bf_lo(v.y) * 16.f, bf_hi(v.y) * 16.f, q0, true);
              int q1 = __builtin_amdgcn_cvt_pk_fp8_f32(bf_lo(v.z) * 16.f, bf_hi(v.z) * 16.f, 0, false); q1 = __builtin_amdgcn_cvt_pk_fp8_f32(bf_lo(v.w) * 16.f, bf_hi(v.w) * 16.f, q1, true);
              *(u32x2*)((unsigned char*)a.O + (long)(wid * 32 + row) * a.os + c16 * 8) = (u32x2){(unsigned)q0, (unsigned)q1}; }
            else *(u32x4*)(a.O + (long)(wid * 32 + row) * a.os + c16 * 8) = v; }
        __syncthreads();
    }
#undef ATT_DMA
#undef ATT_RESC
#undef ATT_BAR
}
#undef ATT_VWAIT
#undef ATT_PK
}

struct Fr { LAS unsigned char* lds; int tid, lane, wave, vcu, G, gw, ngw; };

__device__ __forceinline__ float wave_sum(float v) {
#pragma unroll
    for (int o = 1; o < 64; o <<= 1) v += __shfl_xor(v, o);
    return v;
}
__device__ __forceinline__ void unpack8(const u32x4 w, float (&v)[8]) {
    v[0] = bf_lo(w.x); v[1] = bf_hi(w.x); v[2] = bf_lo(w.y); v[3] = bf_hi(w.y); v[4] = bf_lo(w.z); v[5] = bf_hi(w.z); v[6] = bf_lo(w.w); v[7] = bf_hi(w.w);
}
__device__ __forceinline__ u32x4 pack8(const float (&v)[8]) {
    u32x4 w; w.x = cvt_pk_bf16(v[0], v[1]); w.y = cvt_pk_bf16(v[2], v[3]); w.z = cvt_pk_bf16(v[4], v[5]); w.w = cvt_pk_bf16(v[6], v[7]); return w;
}
__device__ __forceinline__ float sumsq8(const float (&v)[8]) { return ((v[0] * v[0] + v[1] * v[1]) + (v[2] * v[2] + v[3] * v[3])) + ((v[4] * v[4] + v[5] * v[5]) + (v[6] * v[6] + v[7] * v[7])); }

__device__ __forceinline__ int map_col(int kind, int n) {
    switch (kind) {
        case 1: return 256 * (n >> 7) + (n & 127);
        case 2: return 256 * (n >> 7) + 128 + (n & 127);
        case 3: return n < 6144 ? n : (n < 6160 ? 6656 + (n - 6144) : 6144 + (n - 6160));
        case 4: return n < 1088 ? n : 1280 + (n - 1088);
        case 5: return n < 6144 ? n : (n < 18432 ? n + 512 : 6144 + (n - 18432));
        case 6: return n < 4176 ? n : 4352 + (n - 4176);
        default: return n;
    }
}
struct TrDesc { const float* W; const float* gain; bf16_t* WT; int K, N, ldt, kind, r, f8, tiled; };
__device__ __forceinline__ void tr_load(const TrDesc& d, int lane, f32x4 (&v)[16]) {
    const int nblk = (d.N + 63) / 64, kb = d.r / nblk, nb = d.r % nblk, k0 = 64 * kb, n = 64 * nb + 4 * (lane & 15); const bool ok = n < d.N;
    const float* src = d.W + (size_t)(k0 + (lane >> 4)) * d.N + (ok ? n : 0); const size_t rs = (size_t)4 * d.N;
#pragma unroll
    for (int j = 0; j < 16; ++j) v[j] = __builtin_nontemporal_load((const f32x4*)(src + (size_t)j * rs));
}
__device__ __forceinline__ void tr_store(const TrDesc& d, int lane, const f32x4 (&v)[16], LAS float* scr) {
    const int nblk = (d.N + 63) / 64, kb = d.r / nblk, nb = d.r % nblk, k0 = 64 * kb, n0 = 64 * nb;
    { LAS float* w = scr + (lane >> 4) * 65 + 4 * (lane & 15);
#pragma unroll
      for (int j = 0; j < 16; ++j) { w[j * 260 + 0] = v[j][0]; w[j * 260 + 1] = v[j][1]; w[j * 260 + 2] = v[j][2]; w[j * 260 + 3] = v[j][3]; } }
    const int c = lane & 7, nn = lane >> 3; float g[8];
#pragma unroll
    for (int jj = 0; jj < 8; ++jj) g[jj] = d.gain ? d.gain[k0 + 8 * c + jj] : 1.f;
    asm volatile("s_waitcnt lgkmcnt(0)" ::: "memory");
#pragma unroll
    for (int it = 0; it < 8; ++it) { const int nl = nn + 8 * it; const LAS float* rp = scr + (8 * c) * 65 + nl;
        u32x4 o; o.x = cvt_pk_bf16(rp[0 * 65] * g[0], rp[1 * 65] * g[1]); o.y = cvt_pk_bf16(rp[2 * 65] * g[2], rp[3 * 65] * g[3]); o.z = cvt_pk_bf16(rp[4 * 65] * g[4], rp[5 * 65] * g[5]); o.w = cvt_pk_bf16(rp[6 * 65] * g[6], rp[7 * 65] * g[7]);
        if (n0 + nl < d.N) {
            if (d.f8) { int q0 = __builtin_amdgcn_cvt_pk_fp8_f32(rp[0 * 65] * g[0] * 64.f, rp[1 * 65] * g[1] * 64.f, 0, false); q0 = __builtin_amdgcn_cvt_pk_fp8_f32(rp[2 * 65] * g[2] * 64.f, rp[3 * 65] * g[3] * 64.f, q0, true);
                        int q1 = __builtin_amdgcn_cvt_pk_fp8_f32(rp[4 * 65] * g[4] * 64.f, rp[5 * 65] * g[5] * 64.f, 0, false); q1 = __builtin_amdgcn_cvt_pk_fp8_f32(rp[6 * 65] * g[6] * 64.f, rp[7 * 65] * g[7] * 64.f, q1, true);
                        if (d.tiled) { const int n = n0 + nl;
                            *(u32x2*)((unsigned char*)d.WT + ((((size_t)(n >> 8) * (d.K >> 7) + (k0 >> 7)) * 2 + ((n >> 7) & 1)) * 128 + (n & 127)) * 128 + (k0 & 127) + 8 * c) = (u32x2){(unsigned)q0, (unsigned)q1}; }
                        else *(u32x2*)((unsigned char*)d.WT + (size_t)map_col(d.kind, n0 + nl) * d.ldt + k0 + 8 * c) = (u32x2){(unsigned)q0, (unsigned)q1}; }
            else if (d.tiled) { const int n = n0 + nl;
                *(u32x4*)(d.WT + ((((size_t)(n >> 8) * (d.K >> 6) + (k0 >> 6)) * 2 + ((n >> 7) & 1)) * 128 + (n & 127)) * 64 + 8 * c) = o; }
            else *(u32x4*)(d.WT + (size_t)map_col(d.kind, n0 + nl) * d.ldt + k0 + 8 * c) = o; } }
    asm volatile("s_waitcnt lgkmcnt(0)" ::: "memory");
}

__device__ __forceinline__ void rows2048(const Fr& F, const float* x, int nrows, bf16_t* xb, void* out, int mode) {
    for (int m = F.gw; m < nrows; m += F.ngw) {
        const f32x4* xr = (const f32x4*)(x + (size_t)m * DM) + F.lane; f32x4 v[8]; float s = 0.f;
#pragma unroll
        for (int j = 0; j < 8; ++j) { v[j] = xr[64 * j]; s += (v[j].x * v[j].x + v[j].y * v[j].y) + (v[j].z * v[j].z + v[j].w * v[j].w); }
        s = wave_sum(s);
        if (F.lane == 0) { if (mode) ((float*)out)[m] = __builtin_amdgcn_rsqf(s * (1.0f / DM) + RMS_EPS); else ((u64*)out)[m] = (u64)(s * pg8::SSQ_SCALE); }
        if (xb) { u32x2* o8 = (u32x2*)(xb + (size_t)m * DM) + F.lane;
#pragma unroll
            for (int j = 0; j < 8; ++j) { u32x2 w; w.x = cvt_pk_bf16(v[j].x, v[j].y); w.y = cvt_pk_bf16(v[j].z, v[j].w); o8[64 * j] = w; } }
    }
}

__device__ __forceinline__ void hn_step(bf16_t* p, const float (&g)[8]) {
    float v[8]; unpack8(*(const u32x4*)p, v); float ss = sumsq8(v);
    ss += __shfl_xor(ss, 1); ss += __shfl_xor(ss, 2); ss += __shfl_xor(ss, 4); ss += __shfl_xor(ss, 8);
    const float rs = __builtin_amdgcn_rsqf(ss * (1.0f / 128.0f) + RMS_EPS);
#pragma unroll
    for (int j = 0; j < 8; ++j) v[j] = v[j] * rs * g[j];
    *(u32x4*)p = pack8(v);
}
__device__ __forceinline__ void load_gain8(const float* g, int lane, float (&o)[8]) {
#pragma unroll
    for (int j = 0; j < 8; ++j) o[j] = g ? g[(lane & 15) * 8 + j] : 1.f;
}
__device__ __forceinline__ void prep_rows(const Fr& F, bf16_t* P, long ld, int nrows, int c0, int n0, const float* g0, int c1, int n1, const float* g1, int c2, int n2, const float* g2) {
    float ga[8], gb[8], gc[8]; load_gain8(g0, F.lane, ga); load_gain8(g1, F.lane, gb); load_gain8(g2, F.lane, gc);
    for (int m = F.gw; m < nrows; m += F.ngw) {
        bf16_t* row = P + (size_t)m * ld + F.lane * 8;
        for (int s = 0; s < n0; ++s) hn_step(row + c0 + s * 512, ga);
        for (int s = 0; s < n1; ++s) hn_step(row + c1 + s * 512, gb);
        for (int s = 0; s < n2; ++s) hn_step(row + c2 + s * 512, gc);
    }
}

__device__ __forceinline__ void fox_cumsum(const Fr& F, const float* FG, const float* b_f, float* CUM) {
    for (int task = ((F.gw & 15) == 0) ? (F.gw >> 4) : NB * NH; task < NB * NH; task += (F.ngw >> 4)) {
        const int b = task >> 4, h = task & 15; const float bias = b_f[h];
        const float* src = FG + ((size_t)b * SEQ + (size_t)F.lane * 64) * 16 + h; float v[64]; float run = 0.f;
#pragma unroll
        for (int i = 0; i < 64; ++i) { const float xg = src[(size_t)i * 16] + bias;
            const float e = __expf(-fabsf(xg)); const float ls = fminf(xg, 0.f) - __logf(1.0f + e);
            run += ls; v[i] = run; }
        float incl = run;
#pragma unroll
        for (int o = 1; o < 64; o <<= 1) { const float t = __shfl_up(incl, o); if (F.lane >= o) incl += t; }
        const float excl = incl - run;
        float* dst = CUM + ((size_t)b * SEQ + (size_t)F.lane * 64) * 16 + h;
#pragma unroll
        for (int i = 0; i < 64; ++i) dst[(size_t)i * 16] = (v[i] + excl) * LOG2E;
    }
}

__device__ const double ROPE_INV[32] = {
    1.0, 0.7498942093324559, 0.5623413251903491, 0.4216965034285822, 0.31622776601683794, 0.23713737056616552, 0.1778279410038923, 0.1333521432163324,
    0.1, 0.07498942093324558, 0.05623413251903491, 0.04216965034285822, 0.03162277660168379, 0.023713737056616554, 0.01778279410038923, 0.01333521432163324,
    0.01, 0.007498942093324558, 0.005623413251903491, 0.004216965034285823, 0.0031622776601683794, 0.0023713737056616554, 0.001778279410038923, 0.001333521432163324,
    0.001, 0.0007498942093324559, 0.0005623413251903491, 0.0004216965034285823, 0.00031622776601683794, 0.00023713737056616554, 0.0001778279410038923, 0.0001333521432163324};
__device__ __forceinline__ void rope_table(const Fr& F, const int* pos, float* COS, float* SIN) {
    const int gt = F.vcu * 512 + F.tid, ngt = F.G * 512;
    for (int i = gt; i < MTOK * 32; i += ngt) { const int m = i >> 5, f = i & 31;
        const double a = (double)pos[m] * (double)(float)ROPE_INV[f]; const double rev = a * 0.15915494309189535; const float fr = (float)(rev - floor(rev));
        COS[i] = __builtin_amdgcn_cosf(fr); SIN[i] = __builtin_amdgcn_sinf(fr); }
}

__device__ __forceinline__ void mla_prep_a(const Fr& F, bf16_t* P, float* RSQ, float* RSKV, bf16_t* KR, const float* rope_g1, const float* gmem, const float* COS, const float* SIN) {
    const int lane = F.lane; float gr[8];
#pragma unroll
    for (int j = 0; j < 8; ++j) gr[j] = rope_g1[(lane & 7) * 8 + j];
    for (int m = F.gw; m < MTOK; m += F.ngw) {
        bf16_t* pr = P + (size_t)m * 1792; float v[8];
        const u32x4 wq = *(const u32x4*)(pr + lane * 8), wk = *(const u32x4*)(pr + 512 + lane * 8);
        u32x4 w = (u32x4){0u, 0u, 0u, 0u}; if (lane < 8) w = *(const u32x4*)(pr + 1024 + lane * 8);
        const float* cp = COS + (size_t)m * 32 + (lane & 3) * 8; const float* sp = SIN + (size_t)m * 32 + (lane & 3) * 8; float cs[8], sn[8];
#pragma unroll
        for (int j = 0; j < 8; ++j) { cs[j] = cp[j]; sn[j] = sp[j]; }
        asm volatile("" ::: "memory");
        unpack8(wq, v); float ss = wave_sum(sumsq8(v)); if (lane == 0) RSQ[m] = __builtin_amdgcn_rsqf(ss * (1.0f / 512.0f) + RMS_EPS);
        unpack8(wk, v); ss = wave_sum(sumsq8(v)); if (lane == 0) RSKV[m] = __builtin_amdgcn_rsqf(ss * (1.0f / 512.0f) + RMS_EPS);
        unpack8(w, v); ss = sumsq8(v); ss += __shfl_xor(ss, 1); ss += __shfl_xor(ss, 2); ss += __shfl_xor(ss, 4);
        const float rs = __builtin_amdgcn_rsqf(ss * (1.0f / 64.0f) + RMS_EPS); float o[8];
#pragma unroll
        for (int j = 0; j < 8; ++j) { const float x = v[j] * rs * gr[j]; const float y = __shfl_xor(x, 4); o[j] = (lane & 4) ? (y * sn[j] + x * cs[j]) : (x * cs[j] - y * sn[j]); }
        if (lane < 8) *(u32x4*)(KR + (size_t)m * 64 + lane * 8) = pack8(o);
    }
}
__device__ __forceinline__ void mla_prep_b(const Fr& F, bf16_t* Q, const bf16_t* KV, bf16_t* KF, const bf16_t* KR, const float* nope_g, const float* rope_g, const float* COS, const float* SIN) {
    const int lane = F.lane, half = lane >> 5, l5 = lane & 31; float gqn[8], gqr[8], gkn[8];
#pragma unroll
    for (int j = 0; j < 8; ++j) { gqn[j] = nope_g[(l5 & 15) * 8 + j]; gkn[j] = nope_g[128 + (l5 & 15) * 8 + j]; gqr[j] = rope_g[(l5 & 7) * 8 + j]; }
    for (int m = F.gw; m < MTOK; m += F.ngw) {
        const float* cp = COS + (size_t)m * 32 + (l5 & 3) * 8; const float* sp = SIN + (size_t)m * 32 + (l5 & 3) * 8; float cs[8], sn[8];
#pragma unroll
        for (int j = 0; j < 8; ++j) { cs[j] = cp[j]; sn[j] = sp[j]; }
        u32x4 krw = (u32x4){0u, 0u, 0u, 0u}; if (l5 >= 16 && l5 < 24) krw = *(const u32x4*)(KR + (size_t)m * 64 + (l5 - 16) * 8);
        u32x4 qw[8], kw[8];
#pragma unroll
        for (int it = 0; it < 8; ++it) { const int h = 2 * it + half;
            qw[it] = (u32x4){0u, 0u, 0u, 0u}; if (l5 < 24) qw[it] = *(const u32x4*)(Q + (size_t)m * 3072 + h * 192 + l5 * 8);
            kw[it] = (u32x4){0u, 0u, 0u, 0u}; if (l5 < 16) kw[it] = *(const u32x4*)(KV + (size_t)m * 4096 + h * 256 + l5 * 8); }
        asm volatile("" ::: "memory");
#pragma unroll
        for (int it = 0; it < 8; ++it) { const int h = 2 * it + half;
            bf16_t* qrow = Q + (size_t)m * 3072 + h * 192 + l5 * 8; float v[8];
            unpack8(qw[it], v); float s8 = sumsq8(v); s8 += __shfl_xor(s8, 1); s8 += __shfl_xor(s8, 2); s8 += __shfl_xor(s8, 4); const float s16 = s8 + __shfl_xor(s8, 8);
            const float rs = (l5 < 16) ? __builtin_amdgcn_rsqf(s16 * (1.0f / 128.0f) + RMS_EPS) : __builtin_amdgcn_rsqf(s8 * (1.0f / 64.0f) + RMS_EPS);
            float o[8];
#pragma unroll
            for (int j = 0; j < 8; ++j) { const float x = v[j] * rs * ((l5 < 16) ? gqn[j] : gqr[j]); const float y = __shfl_xor(x, 4);
                const float rot = (l5 & 4) ? (y * sn[j] + x * cs[j]) : (x * cs[j] - y * sn[j]); o[j] = (l5 < 16) ? x : rot; }
            if (l5 < 24) *(u32x4*)qrow = pack8(o);
            bf16_t* kfrow = KF + (size_t)m * 3072 + h * 192;
            unpack8(kw[it], v); float k16 = sumsq8(v); k16 += __shfl_xor(k16, 1); k16 += __shfl_xor(k16, 2); k16 += __shfl_xor(k16, 4); k16 += __shfl_xor(k16, 8);
            const float krs = __builtin_amdgcn_rsqf(k16 * (1.0f / 128.0f) + RMS_EPS);
#pragma unroll
            for (int j = 0; j < 8; ++j) o[j] = v[j] * krs * gkn[j];
            if (l5 < 16) *(u32x4*)(kfrow + l5 * 8) = pack8(o);
            else if (l5 < 24) *(u32x4*)(kfrow + 128 + (l5 - 16) * 8) = krw;
        }
    }
}

__device__ __forceinline__ void dsa_indexer(const Fr& F, const bf16_t* P, float* SC) {
    constexpr int LDP = 4864, CQI = 3072, CKI = 4096, CWI = 4160;
    constexpr int RING = 81920;
    const int lane = F.lane, r32 = lane & 31, hg = lane >> 5;
    LAS float* ibuf = (LAS float*)(F.lds + F.wave * 9216);
    const int drow = 8 * F.wave + (lane >> 3), dchunk = (lane & 7) ^ ((lane >> 3) & 7);
#define IDX_DMA(t_) __builtin_amdgcn_global_load_lds((const unsigned*)(kbase + (size_t)(t_) * 64 * LDP), (LAS unsigned*)(F.lds + RING + ((t_) & 3) * 8192 + F.wave * 1024), 16, 0, 0)
    for (int ui = blockIdx.x; ui < 512; ui += F.G) {
        const int c = ui & 255, second = ui >> 8, b = c >> 5, qb0 = c & 31, qb = second ? 63 - qb0 : qb0;
        const size_t tok0 = (size_t)b * SEQ + qb * 64 + F.wave * 8;
        bf16x8 aq[4][4]; f32x2 wv[4][8];
#pragma unroll
        for (int g = 0; g < 4; ++g) { const size_t tok = tok0 + 2 * g + (r32 >> 4); const bf16_t* qp = P + tok * LDP + CQI + (r32 & 15) * 64 + 8 * hg;
#pragma unroll
            for (int ks = 0; ks < 4; ++ks) aq[g][ks] = *(const bf16x8*)(qp + 16 * ks);
#pragma unroll
            for (int r = 0; r < 16; ++r) { const int head = (r & 3) + 8 * ((r >> 2) & 1) + 4 * hg; const size_t tq = tok0 + 2 * g + (r >> 3);
                wv[g][r >> 1][r & 1] = bf_lo((unsigned)P[tq * LDP + CWI + head]) * (0.25f * 0.125f); } }
        const int nt = qb + 1;
        const bf16_t* kbase = P + ((size_t)b * SEQ + drow) * LDP + CKI + 8 * dchunk;
        asm volatile("s_waitcnt vmcnt(0) lgkmcnt(0)" ::: "memory"); __builtin_amdgcn_s_barrier(); asm volatile("" ::: "memory");
        IDX_DMA(0); if (nt > 1) IDX_DMA(1);
        for (int t = 0; t < nt; ++t) {
            if (t + 1 < nt) asm volatile("s_waitcnt vmcnt(1)" ::: "memory"); else asm volatile("s_waitcnt vmcnt(0)" ::: "memory");
            asm volatile("s_waitcnt lgkmcnt(0)" ::: "memory"); __builtin_amdgcn_s_barrier(); asm volatile("" ::: "memory");
            if (t + 2 < nt) IDX_DMA(t + 2);
            const LAS unsigned char* slot = F.lds + RING + (t & 3) * 8192;
            bf16x8 bk[2][4];
#pragma unroll
            for (int kg = 0; kg < 2; ++kg) { const int key = kg * 32 + r32;
#pragma unroll
                for (int ks = 0; ks < 4; ++ks) bk[kg][ks] = *(const LAS bf16x8*)(slot + key * 128 + (((2 * ks + hg) ^ (key & 7)) << 4)); }
            f32x16 dcur = f32x16{};
#pragma unroll
            for (int ks = 0; ks < 4; ++ks) dcur = __builtin_amdgcn_mfma_f32_32x32x16_bf16(aq[0][ks], bk[0][ks], dcur, 0, 0, 0);
#pragma unroll
            for (int j = 0; j < 8; ++j) { const int kg = j >> 2, g = j & 3;
                f32x16 dnext = f32x16{};
                if (j < 7) {
#pragma unroll
                    for (int ks = 0; ks < 4; ++ks) dnext = __builtin_amdgcn_mfma_f32_32x32x16_bf16(aq[(j + 1) & 3][ks], bk[(j + 1) >> 2][ks], dnext, 0, 0, 0); }
                f32x2 accA = {0.f, 0.f}, accB = {0.f, 0.f};
#pragma unroll
                for (int i = 0; i < 4; ++i) { f32x2 xa, xb;
#define IDX_RELU(x_) __int_as_float(max(__float_as_int(x_), 0))
                    xa[0] = IDX_RELU(dcur[2 * i]); xa[1] = IDX_RELU(dcur[2 * i + 1]); xb[0] = IDX_RELU(dcur[8 + 2 * i]); xb[1] = IDX_RELU(dcur[9 + 2 * i]);
#undef IDX_RELU
                    accA = __builtin_elementwise_fma(wv[g][i], xa, accA); accB = __builtin_elementwise_fma(wv[g][4 + i], xb, accB); }
                const float s0 = accA[0] + accA[1], s1 = accB[0] + accB[1];
                auto rr = __builtin_amdgcn_permlane32_swap(__float_as_uint(s0), __float_as_uint(s1), false, false);
                const float tot = __uint_as_float(rr[0]) + __uint_as_float(rr[1]);
                ibuf[(2 * g + hg) * 288 + (t & 3) * 64 + kg * 32 + r32] = tot;
                if (j < 7) {
#pragma unroll
                    for (int i = 0; i < 4; ++i) { __builtin_amdgcn_sched_group_barrier(0x008, 1, 0); __builtin_amdgcn_sched_group_barrier(0x002, 6, 0); } }
                dcur = dnext;
            }
            if ((t & 3) == 3 || t == nt - 1) { const int t0 = t & ~3, cnt = (t - t0 + 1) * 64;
                if (4 * lane < cnt) {
#pragma unroll
                    for (int q = 0; q < 8; ++q) { const f32x4 v = *(const LAS f32x4*)(ibuf + q * 288 + 4 * lane);
                        __builtin_nontemporal_store(v, (f32x4*)(SC + (tok0 + q) * (size_t)SEQ + t0 * 64 + 4 * lane)); } } }
        }
    }
#undef IDX_DMA
}

__device__ __forceinline__ int dsa_qmap(const Fr& F, int k) { return k * F.ngw + ((k & 1) ? F.ngw - 1 - F.gw : F.gw); }
__device__ __forceinline__ void dsa_issue(const float* SC, int q, int lane, unsigned (&raw)[64]) {
    const int s = q & (SEQ - 1); const float* row = SC + (size_t)q * SEQ;
    if (s < 256) return;
#pragma unroll
    for (int c4 = 0; c4 < 4; ++c4) {
        if (1024 * c4 <= s) {
#pragma unroll
            for (int i = 16 * c4; i < 16 * c4 + 16; ++i) raw[i] = __float_as_uint(__builtin_nontemporal_load(row + 64 * i + lane)); }
        else {
#pragma unroll
            for (int i = 16 * c4; i < 16 * c4 + 16; ++i) raw[i] = 0u; } }
}
__device__ __forceinline__ void dsa_select(const Fr& F, const float* SC, u64* MSK) {
    const int lane = F.lane;
    int k = 0, q = dsa_qmap(F, 0); bool have = q < MTOK;
    unsigned raw[64];
#pragma unroll
    for (int i = 0; i < 64; ++i) raw[i] = 0u;
    if (have) dsa_issue(SC, q, lane, raw);
    while (have) {
        const int s = q & (SEQ - 1); u64* mrow = MSK + (size_t)q * 64;
        const int qn = dsa_qmap(F, k + 1); const bool hn = qn < MTOK;
        if (s < 256) { const int lo = 64 * lane; u64 w = 0ull; if (s >= lo + 63) w = ~0ull; else if (s >= lo) w = (2ull << (s - lo)) - 1ull; mrow[lane] = w;
            if (hn) dsa_issue(SC, qn, lane, raw); q = qn; have = hn; ++k; continue; }
        unsigned u[64];
#pragma unroll
        for (int i = 0; i < 64; ++i) { const int key = 64 * i + lane; const unsigned bits = raw[i]; const unsigned ord = (bits & 0x80000000u) ? ~bits : (bits | 0x80000000u); u[i] = (key <= s) ? ord : 0u; }
        if (hn) dsa_issue(SC, qn, lane, raw);
        unsigned T = 0u; const int ng = (s >> 9) + 1;
        for (int bit = 31; bit >= 0; --bit) { const unsigned cand = T | (1u << bit); int cl = 0;
#pragma unroll
            for (int g8 = 0; g8 < 8; ++g8) { if (g8 >= ng) break;
                u64 m[8];
#pragma unroll
                for (int j = 0; j < 8; ++j) asm("v_cmp_le_u32_e64 %0, %1, %2" : "=s"(m[j]) : "s"(cand), "v"(u[8 * g8 + j]));
#pragma unroll
                for (int j = 0; j < 8; ++j) cl += __popcll(m[j]); }
            cl = __builtin_amdgcn_readfirstlane(cl);
            if (cl >= 256) { T = cand; if (cl == 256) break; } }
        int cgt = 0;
#pragma unroll
        for (int g8 = 0; g8 < 8; ++g8) { if (g8 >= ng) break;
            u64 m[8];
#pragma unroll
            for (int j = 0; j < 8; ++j) asm("v_cmp_lt_u32_e64 %0, %1, %2" : "=s"(m[j]) : "s"(T), "v"(u[8 * g8 + j]));
#pragma unroll
            for (int j = 0; j < 8; ++j) cgt += __popcll(m[j]); }
        int need = 256 - __builtin_amdgcn_readfirstlane(cgt); unsigned mlo = 0u, mhi = 0u;
#pragma unroll
        for (int i = 0; i < 64; ++i) { if ((i & 7) == 0 && (i >> 3) >= ng) break;
            const u64 gt = __ballot(u[i] > T), eq = __ballot(u[i] == T); u64 take = 0ull;
            if (need > 0 && eq != 0ull) { const int c = __popcll(eq);
                if (c <= need) { take = eq; need -= c; }
                else { u64 e = eq; for (int n = 0; n < need; ++n) { const u64 low = e & (0ull - e); take |= low; e ^= low; } need = 0; } }
            const u64 w = gt | take; const bool me = lane == i;
            mlo = me ? (unsigned)w : mlo; mhi = me ? (unsigned)(w >> 32) : mhi; }
        mrow[lane] = ((u64)mhi << 32) | (u64)mlo;
        q = qn; have = hn; ++k;
    }
}

constexpr size_t MiB = 1u << 20;
constexpr size_t WS_CTL = 0, CTL_ZERO_BYTES = 8 * MiB;
constexpr int CW_BAR = 4096;
constexpr size_t WS_SSQ = 1 * MiB;
constexpr size_t WS_WB = 8 * MiB;
constexpr size_t WS_XB = 236 * MiB;
constexpr size_t WS_MEMB = 364 * MiB;
constexpr size_t WS_MEMKV = 372 * MiB;
constexpr size_t WS_COS = 388 * MiB, WS_SIN = 392 * MiB, WS_RSMEM = 396 * MiB, WS_RSQ = 397 * MiB, WS_RSKV = 398 * MiB;
constexpr size_t WS_XB8 = 560 * MiB;
constexpr size_t WS_MIX = 400 * MiB;
constexpr size_t WS_SCR = 624 * MiB;
constexpr size_t WS_END = (624 + 832) * MiB;
constexpr size_t WB_GU0 = 0, WB_GU1 = 23068672, WB_D0 = 46137344, WB_D1 = 57671680, WB_IN = 69206016, WB_OUT = 108003328, WB_MKV = 113246208, WB_UQ = 115343360, WB_UKV = 116916224;
constexpr int RING_BYTES = 146944, MISC_OFF = RING_BYTES + 64, LDS_BYTES = 147456;
static_assert(att::L_END <= RING_BYTES && pg8::STAGE_BYTES <= RING_BYTES, "LDS map");
constexpr int NPHASES = 44;
#ifndef F8MASK
#define F8MASK 4
#endif
#define F8LAYER(L) (((F8MASK) >> (L)) & 1)
#ifndef RG
#define RG 1
#endif
#ifndef RD
#define RD 1
#endif
#ifndef RI
#define RI 1
#endif
#ifndef RA
#define RA 1
#endif
#ifndef F8OUT
#define F8OUT 0
#endif
#define F8OUTL(L_) (((F8OUT) >> (L_)) & 1)
#ifndef F8FFN
#define F8FFN 0
#endif
#define F8FFNL(L_, f_) (((F8FFN) >> (2 * (L_) + (f_))) & 1)
#ifndef F8FFND
#define F8FFND 0
#endif
#define F8FFNDL(L_, f_) (((F8FFND) >> (2 * (L_) + (f_))) & 1)
#ifndef F8MODE
#define F8MODE 2
#endif
#ifndef RCV
#define RCV 1
#endif
#ifndef RIX
#define RIX 1
#endif
#ifndef RSL
#define RSL 1
#endif
#ifndef RC
#define RC 1
#endif
#define REP(n) for (int rep_ = 0; rep_ < (n); ++rep_)

struct Args { const void* in[27]; float* out; unsigned char* ws; int ph_lo, ph_hi; };

typedef const __attribute__((address_space(4))) struct Args* ArgsPc;
__device__ __forceinline__ TrDesc tr_desc(ArgsPc A, int L, bf16_t* WB, int it) {
    const float* w_gate = (const float*)A->in[5]; const float* w_up = (const float*)A->in[6]; const float* w_down = (const float*)A->in[7];
    const float* ffn_norm = (const float*)A->in[4]; const float* attn_norm = (const float*)A->in[8];
    const float* w_out = (const float*)A->in[12];
    const float* w_in = (const float*)(L == 0 ? A->in[13] : L == 1 ? A->in[16] : L == 2 ? A->in[23] : A->in[25]);
    const int nin = (L == 0 ? 6672 : L == 1 ? 1600 : L == 2 ? 18944 : 4688);
    const int I_GU = 32 * 88, I_D = 88 * 32, I_IN = 32 * ((nin + 63) / 64), I_OUT = 40 * 32, I_UQ = (L == 1) ? 8 * 48 : 0;
    TrDesc d; d.f8 = 0; d.tiled = 0; int r = it;
    if (r < 4 * I_GU) { const int s = r / I_GU; r -= s * I_GU; const int f = s >> 1, up = s & 1;
        d.W = (up ? w_up : w_gate) + (size_t)(L * 2 + f) * DM * DFF; d.K = DM; d.N = DFF; d.gain = ffn_norm + (size_t)(L * 2 + f) * DM; d.WT = WB + (f ? WB_GU1 : WB_GU0); d.ldt = DM; d.kind = up ? 2 : 1; d.f8 = F8FFNL(L, f); }
    else { r -= 4 * I_GU;
        if (r < 2 * I_D) { const int f = r / I_D; r -= f * I_D; d.W = w_down + (size_t)(L * 2 + f) * DFF * DM; d.K = DFF; d.N = DM; d.gain = nullptr; d.WT = WB + (f ? WB_D1 : WB_D0); d.ldt = DFF; d.kind = 0; d.tiled = 1; d.f8 = F8FFNDL(L, f); }
        else { r -= 2 * I_D;
            if (r < I_IN) { d.W = w_in; d.K = DM; d.N = nin; d.gain = attn_norm + (size_t)L * DM; d.WT = WB + WB_IN; d.ldt = DM; d.kind = 3 + L; d.f8 = F8LAYER(L) ? 1 : 0; }
            else { r -= I_IN;
                if (r < I_OUT) { d.W = w_out + (size_t)L * OUTIN * DM; d.K = OUTIN; d.N = DM; d.gain = nullptr; d.WT = WB + WB_OUT; d.ldt = OUTIN; d.kind = 0;
                    d.f8 = F8OUTL(L);
                }
                else { r -= I_OUT;
                    if (r < I_UQ) { d.W = (const float*)A->in[18]; d.K = 512; d.N = 3072; d.gain = (const float*)A->in[17]; d.WT = WB + WB_UQ; d.ldt = 512; d.kind = 0; }
                    else { r -= I_UQ; d.W = (const float*)A->in[20]; d.K = 512; d.N = 4096; d.gain = (const float*)A->in[19]; d.WT = WB + WB_UKV; d.ldt = 512; d.kind = 0; } } } } }
    d.r = r; return d;
}
__device__ __forceinline__ void convert_layer(const Fr& F, ArgsPc A, int L, bf16_t* WB) {
    const int nin = (L == 0 ? 6672 : L == 1 ? 1600 : L == 2 ? 18944 : 4688);
    const int total = 4 * 32 * 88 + 2 * 88 * 32 + 32 * ((nin + 63) / 64) + 40 * 32 + ((L == 1) ? 8 * 48 + 8 * 64 : 0);
    LAS float* scr = (LAS float*)(F.lds + F.wave * 16640);
    f32x4 va[16], vb[16]; int it = F.gw;
    if (it >= total) return;
    TrDesc da = tr_desc(A, L, WB, it), db = da; tr_load(da, F.lane, va);
    for (;;) {
        const bool nb_ = it + F.ngw < total; if (nb_) { db = tr_desc(A, L, WB, it + F.ngw); tr_load(db, F.lane, vb); }
        tr_store(da, F.lane, va, scr); it += F.ngw; if (!nb_) break;
        const bool na_ = it + F.ngw < total; if (na_) { da = tr_desc(A, L, WB, it + F.ngw); tr_load(da, F.lane, va); }
        tr_store(db, F.lane, vb, scr); it += F.ngw; if (!na_) break;
    }
}

#define MIXP(off_) (o8_ ? (bf16_t*)((unsigned char*)MIX + (off_)) : MIX + (off_))
__device__ __forceinline__ void mem_attn_units(const Fr& F, const bf16_t* P, long ldp, int memq_col, const bf16_t* MEMKV, bf16_t* MIX, int o8_) {
    for (int i = blockIdx.x; i < 512; i += F.G) {
        const int b = i >> 6, mh = (i >> 4) & 3, qb = i & 15; const size_t tok = (size_t)b * SEQ + qb * 256;
        att::AP a{}; a.Q = P + tok * ldp + memq_col + mh * 128; a.qs = ldp; a.K = MEMKV + (size_t)b * NMEM * 4096 + mh * 128; a.ks = 4096; a.V = a.K + 512; a.vs = 4096;
        a.O = MIXP(tok * OUTIN + 2048 + mh * 128); a.o8 = o8_; a.os = OUTIN; a.kt0 = 0; a.nt = 4; a.q0 = 0; a.C = 0.08838834764831845f * LOG2E;
        att::attn_unit<att::K_MEM, 128>(F.lds, a, F.wave);
    }
}
__device__ __forceinline__ void causal_unit_ids(int i, int& b, int& h, int& qb) {
    const int slot = i >> 8, c = i & 255, bh = (c >> 4) * 8 + (c & 7), half = (c >> 3) & 1;
    qb = half ? ((slot & 1) ? slot : 14 - slot) : ((slot & 1) ? slot - 1 : 15 - slot); b = bh >> 4; h = bh & 15;
}

__device__ __forceinline__ Fr mk_frame(unsigned char* lds_raw, int wave_id) {
    Fr F; F.lds = (LAS unsigned char*)lds_raw; F.tid = tid_opaque(wave_id); F.lane = F.tid & 63; F.wave = __builtin_amdgcn_readfirstlane(F.tid >> 6);
    F.G = gridDim.x; { const int bx = blockIdx.x; F.vcu = (F.G % 8 == 0) ? (bx % 8) * (F.G / 8) + bx / 8 : bx; }
    F.gw = F.vcu * 8 + F.wave; F.ngw = F.G * 8; return F;
}
typedef const __attribute__((address_space(4))) Args* ArgsP;
__device__ __forceinline__ ArgsP args_ptr() { auto p = __builtin_amdgcn_kernarg_segment_ptr(); asm volatile("" : "+s"(p)); return (ArgsP)p; }
#define WSP(T, off) ((T*)(AP_->ws + (off)))
#define SCRP(T, mib) ((T*)(AP_->ws + WS_SCR + (size_t)(mib) * MiB))

__global__ void __launch_bounds__(512, 2) fwd(Args A) {
    extern __shared__ __attribute__((aligned(16))) unsigned char lds_raw[];
    { LAS unsigned* z = (LAS unsigned*)((LAS unsigned char*)lds_raw + RING_BYTES); for (int u = threadIdx.x; u < (LDS_BYTES - RING_BYTES) / 4; u += 512) z[u] = 0u; }
    __syncthreads();
    const int lo = A.ph_lo, hi = A.ph_hi; const int wave_id = __builtin_amdgcn_readfirstlane((int)threadIdx.x >> 6);
    XcdBarrier bar; bar.bar = (unsigned*)(A.ws + WS_CTL) + CW_BAR; bar.x = 0; bar.st = nullptr;
    if (hi - lo > 1) bar = xcd_barrier_post((unsigned*)(A.ws + WS_CTL) + CW_BAR, (volatile LAS unsigned*)((LAS unsigned char*)lds_raw + MISC_OFF) + 8);
    int ph = 0;
#ifdef TMASK
    unsigned long long tacc_ = 0ull, tb_ = 0ull;
#define PH_BEGIN if (ph >= lo && ph < hi) { if ((TMASK >> ph) & 1ull) tb_ = __builtin_amdgcn_s_memrealtime(); const Fr F = mk_frame(lds_raw, wave_id); const ArgsP AP_ = args_ptr();
#define PH_END   if (ph + 1 < hi) xcd_barrier(bar); if ((TMASK >> ph) & 1ull) tacc_ += __builtin_amdgcn_s_memrealtime() - tb_; } ++ph;
#else
#define PH_BEGIN if (ph >= lo && ph < hi) { const Fr F = mk_frame(lds_raw, wave_id); const ArgsP AP_ = args_ptr();
#define PH_END   if (ph + 1 < hi) xcd_barrier(bar); } ++ph;
#endif
    const float SC128 = 0.08838834764831845f * LOG2E, SC192 = 0.07216878364870323f * LOG2E;

    PH_BEGIN
        rows2048(F, (const float*)AP_->in[1], NB * NMEM, WSP(bf16_t, WS_MEMB), WSP(float, WS_RSMEM), 1);
        rope_table(F, (const int*)AP_->in[2], WSP(float, WS_COS), WSP(float, WS_SIN));
        rows2048(F, (const float*)AP_->in[0], MTOK, WSP(bf16_t, WS_XB), WSP(u64, WS_SSQ), 0);
#ifdef RZ
        { u32x4* z = WSP(u32x4, WS_END); for (size_t i = (size_t)F.vcu * 512 + F.tid; i < (size_t)2 * DFF * DM * 2 / 16; i += (size_t)F.G * 512) z[i] = (u32x4){0u, 0u, 0u, 0u}; }
#endif
        { LAS float* scr = (LAS float*)(F.lds + F.wave * 16640);
          for (int it = F.gw; it < 4 * 512; it += F.ngw) { const int Lm = it >> 9; TrDesc d; d.W = (const float*)AP_->in[10] + (size_t)Lm * DM * 1024; d.K = DM; d.N = 1024; d.gain = (const float*)AP_->in[9] + (size_t)Lm * DM;
              d.WT = SCRP(bf16_t, 0) + (size_t)Lm * 1024 * DM; d.ldt = DM; d.kind = 0; d.f8 = 0; d.tiled = 0; d.r = it & 511; f32x4 v[16]; tr_load(d, F.lane, v); tr_store(d, F.lane, v, scr); } }
    PH_END
    PH_BEGIN { pg8::Gemm g{WSP(bf16_t, WS_MEMB), SCRP(bf16_t, 0), NB * NMEM, 4096, DM, DM, DM, 0}; pg8::StaticOrder S; S.init(g.M, g.N, F.G, (int)blockIdx.x);
        pg8::EpiProj E{WSP(bf16_t, WS_MEMKV), 4096, WSP(float, WS_RSMEM), 0, nullptr, -1, (const float*)AP_->in[11] + 128, 0, 0, nullptr, 0, 0, nullptr, 0, 0, 1.0f, 4, 2, 256}; pg8::gemm_phase(F.lds, g, S, E, F.tid); } PH_END

    int ver = 0;
#pragma clang loop unroll(full)
    for (int hl = 0; hl < 8; ++hl) {
        const int L = hl >> 1, f = hl & 1;
        if (f == 0) {
            PH_BEGIN REP(RCV) convert_layer(F, AP_, L, WSP(bf16_t, WS_WB)); PH_END

        }
        PH_BEGIN
#ifdef RZ
            { pg8::Gemm g{WSP(bf16_t, WS_XB), WSP(bf16_t, WS_END), MTOK, 2 * DFF, DM, DM, DM, 0}; pg8::StaticOrder S; S.init(g.M, g.N, F.G, (int)blockIdx.x);
              pg8::EpiSwiGLU E{SCRP(bf16_t, 0), DFF, WSP(u64, WS_SSQ) + (size_t)ver * MTOK, 1.0f, 0}; pg8::gemm_phase(F.lds, g, S, E, F.tid); }
#endif
            REP(RG) { const bool f8_ = F8FFNL(L, f);
            pg8::Gemm g = f8_ ? pg8::Gemm{WSP(bf16_t, WS_XB8), WSP(bf16_t, WS_WB) + (f ? WB_GU1 : WB_GU0), MTOK, 2 * DFF, DM / 2, DM / 2, DM / 2, 0}
                              : pg8::Gemm{WSP(bf16_t, WS_XB), WSP(bf16_t, WS_WB) + (f ? WB_GU1 : WB_GU0), MTOK, 2 * DFF, DM, DM, DM, 0}; pg8::StaticOrder S; S.init(g.M, g.N, F.G, (int)blockIdx.x);
            pg8::EpiSwiGLU E{SCRP(bf16_t, 0), DFF, WSP(u64, WS_SSQ) + (size_t)ver * MTOK, f8_ ? (1.0f / 64.0f) : 1.0f, F8FFNDL(L, f)};
            if (f8_) pg8::gemm_phase<F8MODE>(F.lds, g, S, E, F.tid); else pg8::gemm_phase<0>(F.lds, g, S, E, F.tid); } PH_END
        if (F8FFNDL(L, f)) { PH_BEGIN { pg8::Gemm g{SCRP(bf16_t, 0), WSP(bf16_t, WS_WB) + (f ? WB_D1 : WB_D0), MTOK, DM, DFF / 2, DFF / 2, DFF / 2, 1, 1};   pg8::StaticOrder S; S.init(g.M, g.N, F.G, (int)blockIdx.x);
            pg8::EpiResid E{ver == 0 ? (const float*)AP_->in[0] : AP_->out, AP_->out, WSP(bf16_t, WS_XB), WSP(u64, WS_SSQ) + (size_t)(ver + 1) * MTOK, nullptr, 0.5f / 512.0f}; pg8::gemm_phase<F8MODE>(F.lds, g, S, E, F.tid); } PH_END }
        else { PH_BEGIN { pg8::Gemm g{SCRP(bf16_t, 0), WSP(bf16_t, WS_WB) + (f ? WB_D1 : WB_D0), MTOK, DM, DFF, DFF, DFF, 1, 1}; pg8::StaticOrder S; S.init(g.M, g.N, F.G, (int)blockIdx.x);
            if (RD > 1) { pg8::EpiResid E0{ver == 0 ? (const float*)AP_->in[0] : AP_->out, SCRP(float, 400), SCRP(bf16_t, 660), nullptr, nullptr, 0.5f};
#ifdef PROBE_PM
                pg8::Gemm g0 = g; g0.pm_and = PROBE_PM; pg8::gemm_phase(F.lds, g0, S, E0, F.tid);
#else
                pg8::gemm_phase(F.lds, g, S, E0, F.tid);
#endif
            }
            pg8::EpiResid E{ver == 0 ? (const float*)AP_->in[0] : AP_->out, AP_->out, WSP(bf16_t, WS_XB), WSP(u64, WS_SSQ) + (size_t)(ver + 1) * MTOK, (f == 0 && F8LAYER(L)) ? WSP(unsigned char, WS_XB8) : nullptr, 0.5f}; pg8::gemm_phase(F.lds, g, S, E, F.tid); } PH_END }
        ++ver;
        if (f != 0) continue;
        const int ngrp = (L == 2) ? 3 : 1;
#pragma clang loop unroll(full)
        for (int g = 0; g < ngrp; ++g) {
            PH_BEGIN REP(RI) { const int ldp = (L == 0) ? 6912 : (L == 1) ? 1792 : (L == 2) ? 6656 : 4864;
                const int nproj = (L == 2) ? (g == 0 ? 6656 : 6144) : ldp; const size_t roff = (L == 2) ? (g == 0 ? 0 : (g == 1 ? 6656 : 12800)) : 0;
                pg8::Gemm gm = F8LAYER(L) ? pg8::Gemm{WSP(bf16_t, WS_XB8), (const bf16_t*)((const unsigned char*)(WSP(bf16_t, WS_WB) + WB_IN) + roff * DM), MTOK, nproj, DM / 2, DM / 2, DM / 2, 0}
                                       : pg8::Gemm{WSP(bf16_t, WS_XB), WSP(bf16_t, WS_WB) + WB_IN + roff * DM, MTOK, nproj, DM, DM, DM, 0};
                pg8::StaticOrder S; S.init(gm.M, gm.N, F.G, (int)blockIdx.x);
                const float* gmq = (const float*)AP_->in[11] + (size_t)L * 256;
                const float* qg = (L == 0) ? (const float*)AP_->in[15] : (L == 2) ? (const float*)AP_->in[24] + (size_t)g * 256 : (L == 3) ? (const float*)AP_->in[26] : nullptr;
                const int kt_hi = (L == 3) ? 10 : 16, mq_lo = (L == 0 || L == 2) ? 24 : (L == 1) ? 5 : 17, mq_hi = (L == 2 && g > 0) ? mq_lo : mq_lo + 2;
                pg8::EpiProj E{SCRP(bf16_t, 0), ldp, WSP(u64, WS_SSQ) + (size_t)ver * MTOK, 1, (L == 0) ? SCRP(float, 432) : nullptr, 26,
                               qg, 0, (L == 1) ? 0 : 8, qg ? qg + 128 : nullptr, 8, (L == 1) ? 8 : kt_hi, gmq, mq_lo, mq_hi, F8LAYER(L) ? (1.0f / 64.0f) : 1.0f, 0, 0, 0}; if (F8LAYER(L)) pg8::gemm_phase<F8MODE>(F.lds, gm, S, E, F.tid); else pg8::gemm_phase<0>(F.lds, gm, S, E, F.tid); } PH_END
            if (L == 0) { PH_BEGIN fox_cumsum(F, SCRP(const float, 432), (const float*)AP_->in[14], SCRP(float, 434)); PH_END }
            if (L == 1) { PH_BEGIN mla_prep_a(F, SCRP(bf16_t, 0), WSP(float, WS_RSQ), WSP(float, WS_RSKV), SCRP(bf16_t, 752), (const float*)AP_->in[22] + 64, nullptr, WSP(float, WS_COS), WSP(float, WS_SIN)); PH_END }
            if (L == 1) {
                PH_BEGIN
                    REP(RI) for (int i = 0; i < 2; ++i) { pg8::Gemm gm{SCRP(bf16_t, 0) + (i ? 512 : 0), WSP(bf16_t, WS_WB) + (i ? WB_UKV : WB_UQ), MTOK, i ? 4096 : 3072, 512, 1792, 512, 0}; pg8::StaticOrder S; S.init(gm.M, gm.N, F.G, (int)blockIdx.x);
                        pg8::EpiProj E{i ? SCRP(bf16_t, 304) : SCRP(bf16_t, 112), i ? 4096 : 3072, i ? WSP(float, WS_RSKV) : WSP(float, WS_RSQ), 0, nullptr, -1, nullptr, 0, 0, nullptr, 0, 0, nullptr, 0, 0, 1.0f, 0, 0, 0}; pg8::gemm_phase(F.lds, gm, S, E, F.tid); }
                PH_END
                PH_BEGIN mla_prep_b(F, SCRP(bf16_t, 112), SCRP(const bf16_t, 304), SCRP(bf16_t, 560), SCRP(const bf16_t, 752), (const float*)AP_->in[21], (const float*)AP_->in[22], WSP(float, WS_COS), WSP(float, WS_SIN)); PH_END
            }
            if (L == 3) {
                PH_BEGIN REP(RIX) dsa_indexer(F, SCRP(const bf16_t, 0), SCRP(float, 304)); PH_END
                PH_BEGIN REP(RSL) dsa_select(F, SCRP(const float, 304), SCRP(u64, 816)); PH_END
            }
            PH_BEGIN
                bf16_t* P = SCRP(bf16_t, 0); bf16_t* MIX = WSP(bf16_t, WS_MIX); const int o8_ = F8OUTL(L);
                const long ldp = (L == 0) ? 6912 : (L == 1) ? 1792 : (L == 2) ? 6656 : 4864;
                REP(L == 2 ? 1 : RA) {
                if (L == 0) {
                    const float* CUM = SCRP(const float, 434);
                    for (int i = blockIdx.x; i < 2048; i += F.G) { int b, h, qb; causal_unit_ids(i, b, h, qb); const size_t t0 = (size_t)b * SEQ;
                        att::AP a{}; a.Q = P + (t0 + qb * 256) * ldp + h * 128; a.qs = ldp; a.K = P + t0 * ldp + 2048 + h * 128; a.ks = ldp; a.V = a.K + 2048; a.vs = ldp;
                        a.O = MIXP((t0 + qb * 256) * OUTIN + h * 128); a.o8 = o8_; a.os = OUTIN; a.kt0 = 0; a.nt = 4 * (qb + 1); a.q0 = qb * 256; a.C = SC128; a.cum = CUM + t0 * 16 + h; a.cums = 16;
                        att::attn_unit<att::K_FOX, 128>(F.lds, a, F.wave); }
                }
                if (L == 1) {
                    const bf16_t* Qb = SCRP(const bf16_t, 112); const bf16_t* KVb = SCRP(const bf16_t, 304); const bf16_t* KF = SCRP(const bf16_t, 560);
                    for (int i = blockIdx.x; i < 2048; i += F.G) { int b, h, qb; causal_unit_ids(i, b, h, qb); const size_t t0 = (size_t)b * SEQ;
                        att::AP a{}; a.Q = Qb + (t0 + qb * 256) * 3072 + h * 192; a.qs = 3072; a.K = KF + t0 * 3072 + h * 192; a.ks = 3072; a.V = KVb + t0 * 4096 + h * 256 + 128; a.vs = 4096;
                        a.O = MIXP((t0 + qb * 256) * OUTIN + h * 128); a.o8 = o8_; a.os = OUTIN; a.kt0 = 0; a.nt = 4 * (qb + 1); a.q0 = qb * 256; a.C = SC192;
                        att::attn_unit<att::K_MLA, 192>(F.lds, a, F.wave); }
                }
                if (L == 2) {
                    const int dil = (g == 0) ? 1 : (g == 1 ? 4 : 16), nblk = 16 / dil; float* OST = SCRP(float, 416); float* ML = SCRP(float, 672);
                    for (int i = blockIdx.x; i < 2048; i += F.G) { const int h = i & 15, rest = i >> 4, b = rest >> 4, rj = rest & 15, r = rj / nblk, jb = rj % nblk;
                        const size_t tokz = (size_t)b * SEQ + r, tokq = tokz + (size_t)jb * 256 * dil;
                        att::AP a{}; a.Q = P + tokq * ldp + h * 128; a.qs = (long)dil * ldp; a.K = P + tokz * ldp + 2048 + h * 128; a.ks = (long)dil * ldp; a.V = a.K + 2048; a.vs = a.ks;
                        a.O = MIXP(tokq * OUTIN + h * 128); a.o8 = o8_; a.os = (long)dil * OUTIN; a.q0 = jb * 256; a.kt0 = jb == 0 ? 0 : 4 * jb - 2; a.nt = jb == 0 ? 4 : 6; a.C = SC128;
                        a.ost = OST + tokq * 1024 + h * 64; a.osts = (long)dil * 1024; a.mst = ML + (tokq * 16 + h) * 2; a.msts = (long)dil * 32; a.carry_in = g > 0; a.carry_out = g < 2;
                        a.t5 = (const float*)AP_->in[3]; a.head = h; a.dil = dil;
                        att::attn_unit<att::K_DIL, 128>(F.lds, a, F.wave); }
                }
                if (L == 3) {
                    const u64* MSK = SCRP(const u64, 816);
                    for (int i = blockIdx.x; i < 2048; i += F.G) { int b, h, qb; causal_unit_ids(i, b, h, qb); const size_t t0 = (size_t)b * SEQ;
                        att::AP a{}; a.Q = P + (t0 + qb * 256) * ldp + h * 128; a.qs = ldp; a.K = P + t0 * ldp + 2048 + (h >> 2) * 128; a.ks = ldp; a.V = a.K + 512; a.vs = ldp;
                        a.O = MIXP((t0 + qb * 256) * OUTIN + h * 128); a.o8 = o8_; a.os = OUTIN; a.kt0 = 0; a.nt = 4 * (qb + 1); a.q0 = qb * 256; a.C = SC128; a.msk = MSK + (t0 + qb * 256) * 64; a.t5 = (const float*)AP_->in[3]; a.head = h;
                        att::attn_unit<att::K_DSA, 128>(F.lds, a, F.wave); }
                }
                if (g == 0) { const int memq_col = (L == 0) ? 6144 : (L == 1) ? 1280 : (L == 2) ? 6144 : 4352; mem_attn_units(F, P, ldp, memq_col, WSP(const bf16_t, WS_MEMKV) + L * 1024, MIX, o8_); }
                }
            PH_END
        }
        if (F8OUTL(L)) { PH_BEGIN { pg8::Gemm gm{WSP(bf16_t, WS_MIX), WSP(bf16_t, WS_WB) + WB_OUT, MTOK, DM, OUTIN / 2, OUTIN / 2, OUTIN / 2, 0};   pg8::StaticOrder S; S.init(gm.M, gm.N, F.G, (int)blockIdx.x);
            pg8::EpiResid E{AP_->out, AP_->out, WSP(bf16_t, WS_XB), WSP(u64, WS_SSQ) + (size_t)(ver + 1) * MTOK, F8FFNL(L, 1) ? WSP(unsigned char, WS_XB8) : nullptr, 1.0f / 1024.0f}; pg8::gemm_phase<F8MODE>(F.lds, gm, S, E, F.tid); } PH_END }
        else { PH_BEGIN { pg8::Gemm gm{WSP(bf16_t, WS_MIX), WSP(bf16_t, WS_WB) + WB_OUT, MTOK, DM, OUTIN, OUTIN, OUTIN, 0}; pg8::StaticOrder S; S.init(gm.M, gm.N, F.G, (int)blockIdx.x);
            if (RD > 1) { pg8::EpiResid E0{AP_->out, SCRP(float, 400), SCRP(bf16_t, 660), nullptr, nullptr, 1.0f}; pg8::gemm_phase(F.lds, gm, S, E0, F.tid); }
            pg8::EpiResid E{AP_->out, AP_->out, WSP(bf16_t, WS_XB), WSP(u64, WS_SSQ) + (size_t)(ver + 1) * MTOK, F8FFNL(L, 1) ? WSP(unsigned char, WS_XB8) : nullptr, 1.0f}; pg8::gemm_phase(F.lds, gm, S, E, F.tid); } PH_END }
        ++ver;
    }
#ifdef TMASK
    if (blockIdx.x == 0) { const unsigned long long t0_ = __builtin_amdgcn_s_memrealtime(); while (__builtin_amdgcn_s_memrealtime() - t0_ < tacc_ * (unsigned long long)TMUL) __builtin_amdgcn_s_sleep(8); }
#endif
#undef PH_BEGIN
#undef PH_END
}

#ifndef MK_ONE_LAUNCH
#define MK_ONE_LAUNCH 0
#endif
extern "C" void kernel_launch(void* const* d_in, const int* in_sizes, int n_in, void* d_out, int out_size, void* d_ws, size_t ws_size, hipStream_t stream) {
    static int grid = 0;
    if (grid == 0) {
        if (n_in != 27 || in_sizes[0] != MTOK * DM || out_size != MTOK * DM || ws_size < WS_END) {
            fprintf(stderr, "kernel_launch: unexpected shapes: n_in %d in0 %d out %d ws %zu (need >= %zu); nothing launched\n", n_in, n_in > 0 ? in_sizes[0] : -1, out_size, ws_size, (size_t)WS_END); grid = -1; return; }
        int dev = 0, cus = 0, per_cu = 0;
        if (hipGetDevice(&dev) != hipSuccess || hipDeviceGetAttribute(&cus, hipDeviceAttributeMultiprocessorCount, dev) != hipSuccess) { fprintf(stderr, "kernel_launch: device query failed\n"); grid = -1; return; }
        if (hipFuncSetAttribute((const void*)fwd, hipFuncAttributeMaxDynamicSharedMemorySize, LDS_BYTES) != hipSuccess) { fprintf(stderr, "kernel_launch: hipFuncSetAttribute failed\n"); grid = -1; return; }
        if (hipOccupancyMaxActiveBlocksPerMultiprocessor(&per_cu, (const void*)fwd, 512, LDS_BYTES) != hipSuccess || per_cu < 1)
            fprintf(stderr, "kernel_launch: note: occupancy query reports %d workgroups per CU\n", per_cu);
        (void)hipGetLastError();
        grid = cus;
    }
    if (grid < 0) return;
    if (hipMemsetAsync((char*)d_ws + WS_CTL, 0, CTL_ZERO_BYTES, stream) != hipSuccess) { fprintf(stderr, "kernel_launch: memset failed\n"); return; }
    Args a{};
    for (int i = 0; i < 27; ++i) a.in[i] = d_in[i];
    a.out = (float*)d_out; a.ws = (unsigned char*)d_ws;
#if MK_ONE_LAUNCH
    a.ph_lo = 0; a.ph_hi = NPHASES;
    hipLaunchKernelGGL(fwd, dim3(grid), dim3(512), LDS_BYTES, stream, a);
#else
#ifndef NPH_LIMIT
#define NPH_LIMIT NPHASES
#endif
    for (int p = 0; p < NPH_LIMIT; ++p) { a.ph_lo = p; a.ph_hi = p + 1; hipLaunchKernelGGL(fwd, dim3(grid), dim3(512), LDS_BYTES, stream, a); }
#endif
    const hipError_t le = hipPeekAtLastError();
    if (le != hipSuccess) fprintf(stderr, "kernel_launch: launch failed: %s\n", hipGetErrorName(le));
}
```

```cpp
#define MK_ONE_LAUNCH 1
#include <hip/hip_runtime.h>
#include <cstdio>
#include <cstdint>

#define LAS __attribute__((address_space(3)))
#define GAS __attribute__((address_space(1)))
typedef unsigned short bf16_t;
typedef short bf16x8 __attribute__((ext_vector_type(8)));
typedef short s16x4 __attribute__((ext_vector_type(4)));
typedef float f32x2 __attribute__((ext_vector_type(2)));
typedef float f32x4 __attribute__((ext_vector_type(4)));
typedef float f32x16 __attribute__((ext_vector_type(16)));
typedef unsigned u32x2 __attribute__((ext_vector_type(2)));
typedef unsigned u32x4 __attribute__((ext_vector_type(4)));
typedef unsigned long long u64;

constexpr int DM = 2048, NB = 8, SEQ = 4096, MTOK = NB * SEQ, DFF = 5632, NH = 16, HD = 128, NMEM = 256, MEMW = 512, OUTIN = 2560;
constexpr float RMS_EPS = 1e-6f;
constexpr float LOG2E = 1.4426950408889634f;

__device__ __forceinline__ unsigned cvt_pk_bf16(float lo, float hi) { unsigned r; asm volatile("v_cvt_pk_bf16_f32 %0, %1, %2" : "=v"(r) : "v"(lo), "v"(hi)); return r; }
__device__ __forceinline__ float bf_lo(unsigned w) { return __uint_as_float(w << 16); }
__device__ __forceinline__ float bf_hi(unsigned w) { return __uint_as_float(w & 0xffff0000u); }

__device__ __forceinline__ int tid_opaque(int wave_id) {
    int l; asm volatile("v_mbcnt_lo_u32_b32 %0, -1, 0\n\tv_mbcnt_hi_u32_b32 %0, -1, %0" : "=v"(l)); return wave_id * 64 + l; }

namespace pg8 {
constexpr int BM = 256, BK = 64, HALF = 128, HTB = HALF * BK * 2, STAGE_BYTES = 8 * HTB, NXCD = 8, WGM = 8;
__host__ __device__ __forceinline__ int lds_byte(int r, int c) { const int st = (r >> 4) * 2 + (c >> 5), rr = r & 15, cc = c & 31, ob = rr * 64 + cc * 2; return st * 1024 + (ob ^ (((ob >> 9) & 1) << 5)); }
__host__ __device__ __forceinline__ void stage_rc(int b, int& R, int& C) { const int st = b / 1024, sb = b % 1024, swz = sb ^ (((sb >> 9) & 1) << 5); R = (st >> 1) * 16 + swz / 64; C = (st & 1) * 32 + (swz % 64) / 2; }
__host__ __device__ __forceinline__ int perm32(int rho) { const int n = rho >> 4, i = rho & 15; return 8 * (i >> 2) + 4 * n + (i & 3); }

struct Unit { int pm, pn; };
struct Gemm { const bf16_t* A; const bf16_t* Bt; int M, N, K, lda, ldb; int a_tiled; int b_tiled; int pm_and; };

struct StaticOrder {
    int nM, nN, nwg, G, c, wgm;
    __host__ __device__ void init(int M, int N, int G_, int c_) { nM = M / BM; nN = N / BM; nwg = nM * nN; G = G_; c = c_; wgm = (nN == 8) ? 4 : WGM; }
    __host__ __device__ bool next(int i, Unit& u) const {
        const long L = (long)i * G + c; if (L >= nwg) return false;
        int wgid = (int)L; { const int q = nwg / NXCD, r = nwg % NXCD, xcd = wgid % NXCD, off = wgid / NXCD; wgid = (xcd < r ? xcd * (q + 1) : r * (q + 1) + (xcd - r) * q) + off; }
        const int nig = wgm * nN, gid = wgid / nig, fm = gid * wgm, gsz = (nM - fm) < wgm ? (nM - fm) : wgm;
        u.pm = fm + ((wgid % nig) % gsz); u.pn = (wgid % nig) / gsz; return true;
    }
};

constexpr float SSQ_SCALE = 16777216.0f;
__device__ __forceinline__ float rs_from_ssq(const u64 v) { return __builtin_amdgcn_rsqf((float)v * (1.0f / (SSQ_SCALE * DM)) + RMS_EPS); }
__device__ __forceinline__ float rs_of(const void* rsv, int row, int mode) { return mode ? rs_from_ssq(((const u64*)rsv)[row]) : ((const float*)rsv)[row]; }

struct EpiProj {
    bf16_t* O; int ldc; const void* rsv; int rs_mode;
    float* fgout; int fg_tile;
    const float* g0; int t0a, t0b; const float* g1; int t1a, t1b; const float* g2; int t2a, t2b;
    float oscale;
    int gper, gcnt, gstride;
    __device__ __forceinline__ void operator()(f32x4 (&acc)[2][2][4][2], const Unit& u, int wr, int wc, int fr, int fq, LAS unsigned char* xlds) const {
        const int row0 = u.pm * BM + wr * 64 + fr; const int col0 = u.pn * BM + wc * 32 + 8 * fq;
        const float* gain = (u.pn >= t0a && u.pn < t0b) ? g0 : (u.pn >= t1a && u.pn < t1b) ? g1 : (u.pn >= t2a && u.pn < t2b) ? g2 : nullptr;
        if (gper) gain = (u.pn % gper < gcnt) ? g0 + (size_t)(u.pn / gper) * gstride : nullptr;
        float rsa[2][4];
#pragma unroll
        for (int ai = 0; ai < 2; ++ai)
#pragma unroll
            for (int m = 0; m < 4; ++m) rsa[ai][m] = rs_of(rsv, row0 + ai * HALF + m * 16, rs_mode) * oscale;
#pragma unroll
        for (int ai = 0; ai < 2; ++ai)
#pragma unroll
            for (int m = 0; m < 4; ++m) { const float rs = rsa[ai][m];
#pragma unroll
                for (int bj = 0; bj < 2; ++bj) { acc[ai][bj][m][0] *= rs; acc[ai][bj][m][1] *= rs; } }
        if (gain) {
            LAS float* part = (LAS float*)xlds;
#pragma unroll
            for (int ai = 0; ai < 2; ++ai)
#pragma unroll
                for (int m = 0; m < 4; ++m)
#pragma unroll
                    for (int bj = 0; bj < 2; ++bj) { const f32x4 a = acc[ai][bj][m][0], b = acc[ai][bj][m][1];
                        float ss = ((a[0] * a[0] + a[1] * a[1]) + (a[2] * a[2] + a[3] * a[3])) + ((b[0] * b[0] + b[1] * b[1]) + (b[2] * b[2] + b[3] * b[3]));
                        ss += __shfl_xor(ss, 16); ss += __shfl_xor(ss, 32);
                        if (fq == 0) part[((ai * HALF + wr * 64 + m * 16 + fr) * 2 + bj) * 4 + wc] = ss; }
            asm volatile("s_waitcnt lgkmcnt(0)" ::: "memory"); __builtin_amdgcn_s_barrier(); asm volatile("" ::: "memory");
            const f32x4 gv0 = *(const f32x4*)(gain + wc * 32 + 8 * fq), gv1 = *(const f32x4*)(gain + wc * 32 + 8 * fq + 4);
#pragma unroll
            for (int ai = 0; ai < 2; ++ai)
#pragma unroll
                for (int m = 0; m < 4; ++m)
#pragma unroll
                    for (int bj = 0; bj < 2; ++bj) { const f32x4 p4 = *(const LAS f32x4*)(part + ((ai * HALF + wr * 64 + m * 16 + fr) * 2 + bj) * 4);
                        const float r2 = __builtin_amdgcn_rsqf(((p4[0] + p4[1]) + (p4[2] + p4[3])) * (1.0f / 128.0f) + RMS_EPS);
                        acc[ai][bj][m][0] *= gv0 * r2; acc[ai][bj][m][1] *= gv1 * r2; }
        }
#pragma unroll
        for (int ai = 0; ai < 2; ++ai)
#pragma unroll
            for (int m = 0; m < 4; ++m) { const int row = row0 + ai * HALF + m * 16;
                bf16_t* rowp = O + (size_t)row * ldc + col0;
#pragma unroll
                for (int bj = 0; bj < 2; ++bj) { const f32x4 v0 = acc[ai][bj][m][0], v1 = acc[ai][bj][m][1];
                    u32x4 w; w.x = cvt_pk_bf16(v0[0], v0[1]); w.y = cvt_pk_bf16(v0[2], v0[3]); w.z = cvt_pk_bf16(v1[0], v1[1]); w.w = cvt_pk_bf16(v1[2], v1[3]);
                    *(u32x4*)(rowp + bj * HALF) = w;
                    if (fgout && bj == 0 && u.pn == fg_tile && wc == 0 && fq < 2) { float* fp = fgout + (size_t)row * 16 + 8 * fq; *(f32x4*)fp = v0; *(f32x4*)(fp + 4) = v1; } } }
    }
};
struct EpiSwiGLU {
    bf16_t* O; int ldc; const u64* ssq; float oscale; int h8;
    __device__ __forceinline__ void operator()(f32x4 (&acc)[2][2][4][2], const Unit& u, int wr, int wc, int fr, int fq, LAS unsigned char*) const {
        const int row0 = u.pm * BM + wr * 64 + fr; const int col0 = u.pn * HALF + wc * 32 + 8 * fq;
        float rsv[2][4];
#pragma unroll
        for (int ai = 0; ai < 2; ++ai)
#pragma unroll
            for (int m = 0; m < 4; ++m) rsv[ai][m] = rs_from_ssq(ssq[row0 + ai * HALF + m * 16]) * oscale;
#pragma unroll
        for (int ai = 0; ai < 2; ++ai)
#pragma unroll
            for (int m = 0; m < 4; ++m) { const int row = row0 + ai * HALF + m * 16; const float rs = rsv[ai][m];
                float h[8];
#pragma unroll
                for (int n = 0; n < 2; ++n)
#pragma unroll
                    for (int j = 0; j < 4; ++j) { const float g = acc[ai][0][m][n][j] * rs, uu = acc[ai][1][m][n][j] * rs;
                        const float e = __builtin_amdgcn_exp2f(-g * LOG2E); h[n * 4 + j] = g * __builtin_amdgcn_rcpf(1.0f + e) * uu; }
                if (h8) {
                    int q0 = __builtin_amdgcn_cvt_pk_fp8_f32(h[0] * 8.f, h[1] * 8.f, 0, false); q0 = __builtin_amdgcn_cvt_pk_fp8_f32(h[2] * 8.f, h[3] * 8.f, q0, true);
                    int q1 = __builtin_amdgcn_cvt_pk_fp8_f32(h[4] * 8.f, h[5] * 8.f, 0, false); q1 = __builtin_amdgcn_cvt_pk_fp8_f32(h[6] * 8.f, h[7] * 8.f, q1, true);
                    const int kt8 = col0 >> 7, hh8 = (row >> 7) & 1;
                    __builtin_nontemporal_store((u32x2){(unsigned)q0, (unsigned)q1}, (u32x2*)((unsigned char*)O + ((size_t)((size_t)u.pm * (ldc >> 7) + kt8) * 2 + hh8) * (size_t)HTB + (size_t)(row & 127) * 128 + (col0 & 127)));
                    continue; }
                u32x4 w; w.x = cvt_pk_bf16(h[0], h[1]); w.y = cvt_pk_bf16(h[2], h[3]); w.z = cvt_pk_bf16(h[4], h[5]); w.w = cvt_pk_bf16(h[6], h[7]);
                const int kt = col0 >> 6, hh = (row >> 7) & 1;
                __builtin_nontemporal_store(w, (u32x4*)(O + ((size_t)((size_t)u.pm * (ldc >> 6) + kt) * 2 + hh) * (HALF * BK) + (size_t)(row & 127) * BK + (col0 & 63))); }
    }
};
struct EpiResid {
    const float* xin; float* xout; bf16_t* xb; u64* ssq_out; unsigned char* xb8; float alpha;
    __device__ __forceinline__ void operator()(f32x4 (&acc)[2][2][4][2], const Unit& u, int wr, int wc, int fr, int fq, LAS unsigned char*) const {
        const int row0 = u.pm * BM + wr * 64 + fr; const int col0 = u.pn * BM + wc * 32 + 8 * fq;
#pragma unroll
        for (int ai = 0; ai < 2; ++ai) {
            f32x4 xi[4][2][2];
#pragma unroll
            for (int m = 0; m < 4; ++m) { const size_t off = (size_t)(row0 + ai * HALF + m * 16) * DM + col0;
#pragma unroll
                for (int bj = 0; bj < 2; ++bj) { xi[m][bj][0] = __builtin_nontemporal_load((const f32x4*)(xin + off + bj * HALF)); xi[m][bj][1] = __builtin_nontemporal_load((const f32x4*)(xin + off + bj * HALF + 4)); } }
            asm volatile("" ::: "memory");
#pragma unroll
            for (int m = 0; m < 4; ++m) { const int row = row0 + ai * HALF + m * 16; const size_t off = (size_t)row * DM + col0; float ss = 0.f;
#pragma unroll
                for (int bj = 0; bj < 2; ++bj) {
                    const f32x4 v0 = xi[m][bj][0] + acc[ai][bj][m][0] * alpha, v1 = xi[m][bj][1] + acc[ai][bj][m][1] * alpha;
                    __builtin_nontemporal_store(v0, (f32x4*)(xout + off + bj * HALF)); __builtin_nontemporal_store(v1, (f32x4*)(xout + off + bj * HALF + 4));
                    u32x4 w; w.x = cvt_pk_bf16(v0[0], v0[1]); w.y = cvt_pk_bf16(v0[2], v0[3]); w.z = cvt_pk_bf16(v1[0], v1[1]); w.w = cvt_pk_bf16(v1[2], v1[3]);
                    *(u32x4*)(xb + off + bj * HALF) = w;
                    if (xb8) { int q0 = __builtin_amdgcn_cvt_pk_fp8_f32(v0[0], v0[1], 0, false); q0 = __builtin_amdgcn_cvt_pk_fp8_f32(v0[2], v0[3], q0, true);
                               int q1 = __builtin_amdgcn_cvt_pk_fp8_f32(v1[0], v1[1], 0, false); q1 = __builtin_amdgcn_cvt_pk_fp8_f32(v1[2], v1[3], q1, true);
                               *(u32x2*)(xb8 + off + bj * HALF) = (u32x2){(unsigned)q0, (unsigned)q1}; }
                    ss += (v0[0] * v0[0] + v0[1] * v0[1]) + (v0[2] * v0[2] + v0[3] * v0[3]) + (v1[0] * v1[0] + v1[1] * v1[1]) + (v1[2] * v1[2] + v1[3] * v1[3]); }
                if (ssq_out) { ss += __shfl_xor(ss, 16); ss += __shfl_xor(ss, 32); if (fq == 0) atomicAdd(ssq_out + row, (u64)(ss * SSQ_SCALE)); } }
            asm volatile("" ::: "memory");
        }
    }
};

template <int FP8 = 0, class Epi, class Sched>
__device__ __forceinline__ void gemm_phase(LAS unsigned char* lds, const Gemm g, const Sched& S, const Epi& E, const int tid) {
    const int wid = __builtin_amdgcn_readfirstlane(tid >> 6), lane = tid & 63, wr = wid >> 2, wc = wid & 3, fr = lane & 15, fq = lane >> 4;
    const int K = g.K, nt = K / BK;
    unsigned voffA[2], voffB[2];
#pragma unroll
    for (int i = 0; i < 2; ++i) { int R, C; stage_rc(tid * 16 + i * 8192, R, C); const int Rb = (R & ~31) + perm32(R & 31);
        voffA[i] = (unsigned)(R * (g.a_tiled ? BK : g.lda) + C) * 2u; voffB[i] = (unsigned)(Rb * (g.b_tiled ? BK : g.ldb) + C) * 2u; }
    const size_t kstep = (size_t)(BK * 2), kstepA = g.a_tiled ? (size_t)(2 * HTB) : kstep, kstepB = g.b_tiled ? (size_t)(2 * HTB) : kstep;
    const size_t hstepA = g.a_tiled ? (size_t)HTB : (size_t)HALF * g.lda * 2, hstepB = g.b_tiled ? (size_t)HTB : (size_t)HALF * g.ldb * 2;
    const size_t tstepA = g.a_tiled ? (size_t)nt * 2 * HTB : 2 * hstepA, tstepB = g.b_tiled ? (size_t)nt * 2 * HTB : 2 * hstepB;
    const unsigned ldsw = (unsigned)wid * 1024u;
    const int aoff = lds_byte(wr * 64 + fr, fq * 8), boff = lds_byte(wc * 32 + fr, fq * 8);
#define PG8_SA(b, h) (((b) * 2 + (h)) * HTB)
#define PG8_SB(b, h) ((4 + (b) * 2 + (h)) * HTB)
#define PG8_STAGE(bufoff, gbase, voff) do { _Pragma("unroll") for (int _i = 0; _i < 2; ++_i) \
        __builtin_amdgcn_global_load_lds((const unsigned*)((const char*)(gbase) + (voff)[_i]), (LAS unsigned*)(lds + (bufoff) + ldsw + _i * 8192), 16, 0, 0); } while (0)
#define PG8_LD8(p_) __builtin_shufflevector(*(const LAS i32x4_t*)(p_), *(const LAS i32x4_t*)((p_) + 1024), 0, 1, 2, 3, 4, 5, 6, 7)
#define PG8_LDA(dst, b, h) do { if constexpr (FP8 == 2) { _Pragma("unroll") for (int m = 0; m < 4; ++m) dst##8[m] = PG8_LD8(lds + PG8_SA(b, h) + aoff + m * 2048); } \
        else { _Pragma("unroll") for (int m = 0; m < 4; ++m) _Pragma("unroll") for (int k = 0; k < 2; ++k) dst[m][k] = *(const LAS bf16x8*)(lds + PG8_SA(b, h) + aoff + m * 2048 + k * 1024); } } while (0)
#define PG8_LDB(dst, b, h) do { if constexpr (FP8 == 2) { _Pragma("unroll") for (int n = 0; n < 2; ++n) dst##8[n] = PG8_LD8(lds + PG8_SB(b, h) + boff + n * 2048); } \
        else { _Pragma("unroll") for (int n = 0; n < 2; ++n) _Pragma("unroll") for (int k = 0; k < 2; ++k) dst[n][k] = *(const LAS bf16x8*)(lds + PG8_SB(b, h) + boff + n * 2048 + k * 1024); } } while (0)
typedef long i64x2_t __attribute__((ext_vector_type(2)));
typedef int i32x4_t __attribute__((ext_vector_type(4)));
typedef int i32x8_t __attribute__((ext_vector_type(8)));
#define PG8_MMA(ai, bj, At, Bt) do { __builtin_amdgcn_s_setprio(1); \
        if constexpr (FP8 == 2) { _Pragma("unroll") for (int m = 0; m < 4; ++m) _Pragma("unroll") for (int n = 0; n < 2; ++n) \
            asm volatile("v_mfma_scale_f32_16x16x128_f8f6f4 %0, %1, %2, %0, %3, %3 op_sel_hi:[0,0,0]" : "+v"(acc[ai][bj][m][n]) : "v"(Bt##8[n]), "v"(At##8[m]), "v"(f8sc)); } \
        else if constexpr (FP8 == 1) { _Pragma("unroll") for (int m = 0; m < 4; ++m) _Pragma("unroll") for (int n = 0; n < 2; ++n) _Pragma("unroll") for (int k = 0; k < 2; ++k) { \
            const i64x2_t b_ = __builtin_bit_cast(i64x2_t, Bt[n][k]), a_ = __builtin_bit_cast(i64x2_t, At[m][k]); \
            acc[ai][bj][m][n] = __builtin_amdgcn_mfma_f32_16x16x32_fp8_fp8(b_[0], a_[0], acc[ai][bj][m][n], 0, 0, 0); \
            acc[ai][bj][m][n] = __builtin_amdgcn_mfma_f32_16x16x32_fp8_fp8(b_[1], a_[1], acc[ai][bj][m][n], 0, 0, 0); } } \
        else { _Pragma("unroll") for (int m = 0; m < 4; ++m) _Pragma("unroll") for (int n = 0; n < 2; ++n) _Pragma("unroll") for (int k = 0; k < 2; ++k) \
            acc[ai][bj][m][n] = __builtin_amdgcn_mfma_f32_16x16x32_bf16(Bt[n][k], At[m][k], acc[ai][bj][m][n], 0, 0, 0); } \
        __builtin_amdgcn_s_setprio(0); } while (0)
#define PG8_WAIT_V(n) asm volatile("s_waitcnt vmcnt(" #n ")" ::: "memory")
#define PG8_WAIT_L(n) asm volatile("s_waitcnt lgkmcnt(" #n ")" ::: "memory")
#define PG8_BAR __builtin_amdgcn_s_barrier()
#define PG8_SCHED __builtin_amdgcn_sched_barrier(0)
    Unit cur, nxt; int ui = 0;
    if (!S.next(0, cur)) return;
    f32x4 acc[2][2][4][2];
#pragma unroll
    for (int a = 0; a < 2; ++a)
#pragma unroll
        for (int b = 0; b < 2; ++b)
#pragma unroll
            for (int m = 0; m < 4; ++m)
#pragma unroll
                for (int n = 0; n < 2; ++n) acc[a][b][m][n] = (f32x4){0.f, 0.f, 0.f, 0.f};
    const int f8sc = 0x7f7f7f7f;
    bf16x8 At[4][2], B0[2][2], B1[2][2]; i32x8_t At8[4], B08[2], B18[2];
#ifdef PROBE_PM
#define PG8_PM(u_) ((g.pm_and & 1) ? ((u_).pm & 1) : (u_).pm)
#define PG8_PN(u_) ((g.pm_and & 2) ? ((u_).pn & 1) : (u_).pn)
#else
#define PG8_PM(u_) (u_).pm
#define PG8_PN(u_) (u_).pn
#endif
    const char* cA = (const char*)g.A + (size_t)PG8_PM(cur) * tstepA; const char* cB = (const char*)g.Bt + (size_t)PG8_PN(cur) * tstepB;
    PG8_STAGE(PG8_SB(0, 0), cB, voffB); PG8_STAGE(PG8_SB(0, 1), cB + hstepB, voffB); PG8_STAGE(PG8_SA(0, 0), cA, voffA); PG8_STAGE(PG8_SA(0, 1), cA + hstepA, voffA);
    if (wr == 1) PG8_BAR;
    PG8_WAIT_V(2); PG8_BAR;
    PG8_STAGE(PG8_SB(1, 0), cB + kstepB, voffB); PG8_STAGE(PG8_SA(1, 0), cA + kstepA, voffA); PG8_STAGE(PG8_SB(1, 1), cB + hstepB + kstepB, voffB);
    PG8_WAIT_V(6); PG8_BAR;
    for (;;) {
        const bool has_next = S.next(ui + 1, nxt);
        const char* nA = has_next ? (const char*)g.A + (size_t)PG8_PM(nxt) * tstepA : cA; const char* nB = has_next ? (const char*)g.Bt + (size_t)PG8_PN(nxt) * tstepB : cB;
        for (int t = 0; t < nt; t += 2) {
            const bool last = (t == nt - 2);
            const char* a1 = cA + (size_t)(t + 1) * kstepA;
            const char* a2 = last ? nA : cA + (size_t)(t + 2) * kstepA; const char* b2 = last ? nB : cB + (size_t)(t + 2) * kstepB;
            const char* a3 = a2 + kstepA; const char* b3 = b2 + kstepB;
            PG8_LDB(B0, 0, 0); PG8_LDB(B1, 0, 1); PG8_SCHED; PG8_LDA(At, 0, 0); PG8_STAGE(PG8_SA(1, 1), a1 + hstepA, voffA);
            PG8_WAIT_V(8); PG8_WAIT_L(0); PG8_BAR; PG8_MMA(0, 0, At, B0); PG8_MMA(0, 1, At, B1); PG8_BAR; PG8_SCHED;
            PG8_LDA(At, 0, 1); PG8_STAGE(PG8_SB(0, 0), b2, voffB); PG8_STAGE(PG8_SB(0, 1), b2 + hstepB, voffB); PG8_STAGE(PG8_SA(0, 0), a2, voffA);
            PG8_WAIT_V(8); PG8_WAIT_L(0); PG8_BAR; PG8_MMA(1, 0, At, B0); PG8_MMA(1, 1, At, B1); PG8_BAR; PG8_SCHED;
            PG8_LDB(B0, 1, 0); PG8_LDB(B1, 1, 1); PG8_SCHED; PG8_LDA(At, 1, 0); PG8_STAGE(PG8_SA(0, 1), a2 + hstepA, voffA);
            PG8_WAIT_V(8); PG8_WAIT_L(0); PG8_BAR; PG8_MMA(0, 0, At, B0); PG8_MMA(0, 1, At, B1); PG8_BAR; PG8_SCHED;
            PG8_LDA(At, 1, 1); PG8_STAGE(PG8_SB(1, 0), b3, voffB); PG8_STAGE(PG8_SB(1, 1), b3 + hstepB, voffB); PG8_STAGE(PG8_SA(1, 0), a3, voffA);
            PG8_WAIT_V(8); PG8_WAIT_L(0); PG8_BAR; PG8_MMA(1, 0, At, B0); PG8_MMA(1, 1, At, B1); PG8_BAR; PG8_SCHED;
        }
        if (wr == 0) PG8_BAR;
        if constexpr (FP8 == 2) { asm volatile("s_nop 7\n\ts_nop 7\n\ts_nop 7\n\ts_nop 7" ::: "memory"); PG8_SCHED; }
        E(acc, cur, wr, wc, fr, fq, lds + STAGE_BYTES);
        if (!has_next) break;
#pragma unroll
        for (int a = 0; a < 2; ++a)
#pragma unroll
            for (int b = 0; b < 2; ++b)
#pragma unroll
                for (int m = 0; m < 4; ++m)
#pragma unroll
                    for (int n = 0; n < 2; ++n) acc[a][b][m][n] = (f32x4){0.f, 0.f, 0.f, 0.f};
        cur = nxt; cA = nA; cB = nB; ++ui;
        if (wr == 1) PG8_BAR;
    }
    PG8_WAIT_V(0);
    PG8_BAR;
#undef PG8_SA
#undef PG8_SB
#undef PG8_STAGE
#undef PG8_LDA
#undef PG8_LD8
#undef PG8_LDB
#undef PG8_MMA
#undef PG8_WAIT_V
#undef PG8_WAIT_L
#undef PG8_BAR
#undef PG8_SCHED
}
}

#define XB_TMO      128
#define XB_XCNT(j)  (256  + 64 * (j))
#define XB_XSUB(j)  (1280 + 64 * (j))
#define XB_XGEN(j)  (2304 + 64 * (j))
#define XB_TOP      3328
#define XB_TOPGEN   3392
#define XCD_BAR_WORDS 3456
#define XB_SPIN_CAP (1u << 22)

__device__ __forceinline__ unsigned xb_ld(unsigned* p)              { return __hip_atomic_load(p, __ATOMIC_RELAXED, __HIP_MEMORY_SCOPE_AGENT); }
__device__ __forceinline__ unsigned xb_add(unsigned* p, unsigned v) { return __hip_atomic_fetch_add(p, v, __ATOMIC_RELAXED, __HIP_MEMORY_SCOPE_AGENT); }
__device__ __forceinline__ unsigned xb_xcc_id() { return (unsigned)__builtin_amdgcn_s_getreg((3 << 11) | 20) & 0xFu; }
#define XB_SPIN(cond, bar) do { unsigned _sp = 0; while (cond) { __builtin_amdgcn_s_sleep(1); \
    if ((++_sp & 255u) == 0u) { if (xb_ld(&(bar)[XB_TMO])) break; if (_sp > XB_SPIN_CAP) { atomicAdd(&(bar)[XB_TMO], 1u); break; } } } } while (0)

struct XcdBarrier { unsigned* bar; unsigned x; volatile LAS unsigned* st; };

__device__ __forceinline__ XcdBarrier xcd_barrier_post(unsigned* bar, volatile LAS unsigned* st) {
    XcdBarrier b; b.bar = bar; b.x = xb_xcc_id(); b.st = st;
    if (threadIdx.x == 0) (void)xb_add(&bar[XB_XCNT(b.x)], 1u);
    return b;
}
__device__ __forceinline__ void xcd_barrier_complete(unsigned* bar, unsigned x, unsigned& nloc, unsigned& nx) {
    const unsigned G = gridDim.x * gridDim.y * gridDim.z;
    unsigned sum, cnt, mine, sp = 0u;
    for (;;) {
        sum = 0u; cnt = 0u; mine = 0u;
#pragma unroll
        for (unsigned j = 0; j < 16; ++j) { const unsigned c = xb_ld(&bar[XB_XCNT(j)]); sum += c; cnt += (c > 0u) ? 1u : 0u; mine = (j == x) ? c : mine; }
        if (sum == G) break;
        __builtin_amdgcn_s_sleep(1);
        if ((++sp & 255u) == 0u) { if (xb_ld(&bar[XB_TMO])) break; if (sp > XB_SPIN_CAP) { atomicAdd(&bar[XB_TMO], 1u); break; } }
    }
    nloc = mine > 0u ? mine : 1u; nx = cnt > 0u ? cnt : 1u;
}
__device__ __forceinline__ void xcd_barrier(const XcdBarrier& b) {
    asm volatile("s_waitcnt vmcnt(0)" ::: "memory");
    __syncthreads();
    if (threadIdx.x == 0) {
        unsigned* bar = b.bar; unsigned bx_ = b.x; asm volatile("" : "+s"(bar), "+s"(bx_));
        __builtin_amdgcn_s_waitcnt(0);
        unsigned nloc = b.st[0], nx = b.st[1];
        if (nloc == 0u) { xcd_barrier_complete(bar, bx_, nloc, nx); b.st[0] = nloc; b.st[1] = nx; }
        const unsigned old = xb_add(&bar[XB_XSUB(bx_)], 1u);
        const unsigned gen = old / nloc;
        if (old + 1u == (gen + 1u) * nloc) {
            __builtin_amdgcn_fence(__ATOMIC_RELEASE, "agent");
            asm volatile("s_waitcnt vmcnt(0)" ::: "memory");
            const unsigned og = xb_add(&bar[XB_TOP], 1u);
            const unsigned tg = og / nx;
            if (og + 1u == (tg + 1u) * nx) xb_add(&bar[XB_TOPGEN], 1u);
            else XB_SPIN(xb_ld(&bar[XB_TOPGEN]) == tg, bar);
            __builtin_amdgcn_fence(__ATOMIC_ACQUIRE, "agent");
            xb_add(&bar[XB_XGEN(bx_)], 1u);
            asm volatile("s_waitcnt vmcnt(0)" ::: "memory");
        } else {
            XB_SPIN(xb_ld(&bar[XB_XGEN(bx_)]) == gen, bar);
            __builtin_amdgcn_fence(__ATOMIC_ACQUIRE, "agent");
            asm volatile("s_waitcnt vmcnt(0)" ::: "memory");
        }
    }
    __syncthreads();
}

namespace att {
constexpr int NW = 8, QBLK = 32, KVBLK = 64;
constexpr float THR2 = 8.f * LOG2E;
enum { K_MEM = 0, K_FOX = 1, K_MLA = 2, K_DIL = 3, K_DSA = 4 };
constexpr int L_V = 0, L_K = 49152, L_XB = 100352, L_TBL = 106496, L_END = 141312, VB = 16384;

struct AP {
    const bf16_t* Q; const bf16_t* K; const bf16_t* V; bf16_t* O;
    long qs, ks, vs, os;
    int kt0, nt;
    int q0;
    float C;
    const float* cum; long cums;
    const u64* msk;
    float* ost; long osts;
    float* mst; long msts;
    int carry_in, carry_out;
    int o8;
    const float* t5; int head, dil;
};

#define ATT_SBAR() __builtin_amdgcn_sched_barrier(0)
__device__ __forceinline__ int crow(int r, int hi) { return (r & 3) + 8 * (r >> 2) + 4 * hi; }
__device__ __forceinline__ int t5_bucket(int dist) {
    const int n = dist < 0 ? 0 : dist; if (n < 16) return n;
    const float v = __log2f((float)n * 0.0625f) * (16.0f / 7.0f); int b = 16 + (int)v; return b > 31 ? 31 : b;
}
__device__ __forceinline__ void rowmax_decide(const f32x16& p0, const f32x16& p1, float& m_reg, float& alpha) {
    float pmax = p0[0];
#pragma unroll
    for (int r = 1; r < 16; ++r) pmax = fmaxf(pmax, p0[r]);
#pragma unroll
    for (int r = 0; r < 16; ++r) pmax = fmaxf(pmax, p1[r]);
    { auto rr = __builtin_amdgcn_permlane32_swap(__float_as_uint(pmax), __float_as_uint(pmax), false, false); pmax = fmaxf(__uint_as_float(rr[0]), __uint_as_float(rr[1])); }
    if (__builtin_expect(__all(pmax - m_reg <= THR2), 1)) { alpha = 1.f; }
    else { const float mn = fmaxf(m_reg, pmax); alpha = __builtin_amdgcn_exp2f(m_reg - mn); m_reg = mn; }
}
__device__ __forceinline__ float half_sum(float ps) {
    auto rr = __builtin_amdgcn_permlane32_swap(__float_as_uint(ps), __float_as_uint(ps), false, false); return __uint_as_float(rr[0]) + __uint_as_float(rr[1]);
}
__device__ __forceinline__ void pack_p(const f32x16& p0, const f32x16& p1, bf16x8& pa0, bf16x8& pa1, bf16x8& pa2, bf16x8& pa3) {
#define ATT_PK4(P, BASE, OUT) do { unsigned a0 = cvt_pk_bf16(P[BASE + 0], P[BASE + 1]), a1 = cvt_pk_bf16(P[BASE + 2], P[BASE + 3]);   \
    unsigned b0 = cvt_pk_bf16(P[BASE + 4], P[BASE + 5]), b1 = cvt_pk_bf16(P[BASE + 6], P[BASE + 7]);                              \
    auto r0 = __builtin_amdgcn_permlane32_swap(a0, b0, false, false); auto r1 = __builtin_amdgcn_permlane32_swap(a1, b1, false, false); \
    u32x4 w = {r0[0], r1[0], r0[1], r1[1]}; OUT = __builtin_bit_cast(bf16x8, w); } while (0)
    ATT_PK4(p0, 0, pa0); ATT_PK4(p0, 8, pa1); ATT_PK4(p1, 0, pa2); ATT_PK4(p1, 8, pa3);
#undef ATT_PK4
}
template <int DK, int NQL>
__device__ __forceinline__ void qkt(f32x16& p0, f32x16& p1, const LAS unsigned char* Ks, const int (&kad)[4], const bf16x8* qr, const LAS unsigned char* qsp) {
    p0 = f32x16{}; p1 = f32x16{};
    constexpr int ND = DK / 16, NQR = ND - NQL;
#define ATT_LDK(d, hf) (*(const LAS bf16x8*)(Ks + ((DK == 128) ? (kad[(d) & 3] ^ (((d) >> 2) ? 128 : 0)) : (kad[(d) & 3] + 128 * ((d) >> 2))) + (hf) * 32 * DK * 2))
#define ATT_LDQ(d) (((d) < NQR) ? qr[(d) < NQR ? (d) : 0] : *(const LAS bf16x8*)(qsp + ((d) - NQR) * 1024))
    bf16x8 b0 = ATT_LDK(0, 0), b1 = ATT_LDK(0, 1), qf = ATT_LDQ(0);
#pragma unroll
    for (int d0 = 0; d0 < ND; ++d0) {
        bf16x8 c0 = b0, c1 = b1, qn = qf;
        if (d0 + 1 < ND) { c0 = ATT_LDK(d0 + 1, 0); c1 = ATT_LDK(d0 + 1, 1); qn = ATT_LDQ(d0 + 1); }
        ATT_SBAR();
        p0 = __builtin_amdgcn_mfma_f32_32x32x16_bf16(b0, qf, p0, 0, 0, 0);
        p1 = __builtin_amdgcn_mfma_f32_32x32x16_bf16(b1, qf, p1, 0, 0, 0);
        ATT_SBAR();
        b0 = c0; b1 = c1; qf = qn; }
#undef ATT_LDK
#undef ATT_LDQ
}
__device__ __forceinline__ int v_st(int k, int c) { const int kk = (k & ~0xC) | ((k & 4) << 1) | ((k & 8) >> 1); return ((kk >> 3) * 4 + (c >> 5)) * 512 + ((kk & 7) * 32 + (c & 31)) * 2; }
__device__ __forceinline__ int v_rd_base(int lane) { return ((lane & 3) << 3) | (((lane >> 2) & 3) << 6) | (((lane >> 4) & 1) << 5) | (((lane >> 5) & 1) << 8); }
constexpr int v_rd_off(int d0, int ks, int half) { return d0 * 512 + ks * 4096 + half * 2048; }
template <int OFF> __device__ __forceinline__ s16x4 tr_read(int vb) { s16x4 r; asm volatile("ds_read_b64_tr_b16 %0, %1 offset:%2" : "=&v"(r) : "v"(vb), "i"(OFF) : "memory"); return r; }
struct VF { s16x4 l0, h0, l1, h1, l2, h2, l3, h3; };
template <int D0> __device__ __forceinline__ void pv_read(VF& f, int vb) {
    f.l0 = tr_read<v_rd_off(D0, 0, 0)>(vb); f.h0 = tr_read<v_rd_off(D0, 0, 1)>(vb); f.l1 = tr_read<v_rd_off(D0, 1, 0)>(vb); f.h1 = tr_read<v_rd_off(D0, 1, 1)>(vb);
    f.l2 = tr_read<v_rd_off(D0, 2, 0)>(vb); f.h2 = tr_read<v_rd_off(D0, 2, 1)>(vb); f.l3 = tr_read<v_rd_off(D0, 3, 0)>(vb); f.h3 = tr_read<v_rd_off(D0, 3, 1)>(vb);
}
#define ATT_VWAIT(n, f) asm volatile("s_waitcnt lgkmcnt(" #n ")" : "+v"(f.l0), "+v"(f.h0), "+v"(f.l1), "+v"(f.h1), "+v"(f.l2), "+v"(f.h2), "+v"(f.l3), "+v"(f.h3) :: "memory")
#define ATT_PK(L, H) (bf16x8){L[0], L[1], L[2], L[3], H[0], H[1], H[2], H[3]}
__device__ __forceinline__ void pv_only(f32x16* o, int vb, bf16x8 pa0, bf16x8 pa1, bf16x8 pa2, bf16x8 pa3) {
    VF fa, fb;
#define ATT_MMA4(od, f) do { od = __builtin_amdgcn_mfma_f32_32x32x16_bf16(pa0, ATT_PK(f.l0, f.h0), od, 0, 0, 0); od = __builtin_amdgcn_mfma_f32_32x32x16_bf16(pa1, ATT_PK(f.l1, f.h1), od, 0, 0, 0); \
        od = __builtin_amdgcn_mfma_f32_32x32x16_bf16(pa2, ATT_PK(f.l2, f.h2), od, 0, 0, 0); od = __builtin_amdgcn_mfma_f32_32x32x16_bf16(pa3, ATT_PK(f.l3, f.h3), od, 0, 0, 0); } while (0)
    pv_read<0>(fa, vb); pv_read<1>(fb, vb);
    ATT_VWAIT(8, fa); ATT_SBAR(); ATT_MMA4(o[0], fa); ATT_SBAR(); pv_read<2>(fa, vb);
    ATT_VWAIT(8, fb); ATT_SBAR(); ATT_MMA4(o[1], fb); ATT_SBAR(); pv_read<3>(fb, vb);
    ATT_VWAIT(8, fa); ATT_SBAR(); ATT_MMA4(o[2], fa); ATT_SBAR();
    ATT_VWAIT(0, fb); ATT_SBAR(); ATT_MMA4(o[3], fb);
#undef ATT_MMA4
}
__device__ __forceinline__ float sm_only(f32x16& p0, f32x16& p1, float m) {
    float s = 0.f;
#pragma unroll
    for (int r = 0; r < 16; ++r) { p0[r] = __builtin_amdgcn_exp2f(p0[r] - m); s += p0[r]; }
#pragma unroll
    for (int r = 0; r < 16; ++r) { p1[r] = __builtin_amdgcn_exp2f(p1[r] - m); s += p1[r]; }
    return s;
}
__device__ __forceinline__ float pv_sm(f32x16* o, int vb, bf16x8 pa0, bf16x8 pa1, bf16x8 pa2, bf16x8 pa3, f32x16& p0, f32x16& p1, float m) {
    VF fa, fb; float s = 0.f;
#define ATT_GAP(od, pa, L, H, X, B) do { od = __builtin_amdgcn_mfma_f32_32x32x16_bf16(pa, ATT_PK(L, H), od, 0, 0, 0); \
        { float t0_ = X[B] - m, t1_ = X[B + 1] - m, e0_, e1_; asm volatile("v_exp_f32 %0, %1" : "=v"(e0_) : "v"(t0_)); asm volatile("v_exp_f32 %0, %1" : "=v"(e1_) : "v"(t1_));     \
          X[B] = e0_; X[B + 1] = e1_; s += e0_; s += e1_; } ATT_SBAR(); } while (0)
    pv_read<0>(fa, vb); pv_read<1>(fb, vb);
    ATT_VWAIT(8, fa); ATT_SBAR();
    ATT_GAP(o[0], pa0, fa.l0, fa.h0, p0, 0); ATT_GAP(o[0], pa1, fa.l1, fa.h1, p0, 2); ATT_GAP(o[0], pa2, fa.l2, fa.h2, p0, 4); ATT_GAP(o[0], pa3, fa.l3, fa.h3, p0, 6);
    pv_read<2>(fa, vb); ATT_VWAIT(8, fb); ATT_SBAR();
    ATT_GAP(o[1], pa0, fb.l0, fb.h0, p0, 8); ATT_GAP(o[1], pa1, fb.l1, fb.h1, p0, 10); ATT_GAP(o[1], pa2, fb.l2, fb.h2, p0, 12); ATT_GAP(o[1], pa3, fb.l3, fb.h3, p0, 14);
    pv_read<3>(fb, vb); ATT_VWAIT(8, fa); ATT_SBAR();
    ATT_GAP(o[2], pa0, fa.l0, fa.h0, p1, 0); ATT_GAP(o[2], pa1, fa.l1, fa.h1, p1, 2); ATT_GAP(o[2], pa2, fa.l2, fa.h2, p1, 4); ATT_GAP(o[2], pa3, fa.l3, fa.h3, p1, 6);
    ATT_VWAIT(0, fb); ATT_SBAR();
    ATT_GAP(o[3], pa0, fb.l0, fb.h0, p1, 8); ATT_GAP(o[3], pa1, fb.l1, fb.h1, p1, 10); ATT_GAP(o[3], pa2, fb.l2, fb.h2, p1, 12); ATT_GAP(o[3], pa3, fb.l3, fb.h3, p1, 14);
#undef ATT_GAP
    return s;
}

template <int KIND>
__device__ __forceinline__ void score(f32x16& p0, f32x16& p1, const AP& a, int t, int buf, LAS unsigned char* lds, int wid, int r32, int hi, float cq) {
    const float C = a.C; const int k0 = t * 64; const int q = a.q0 + wid * 32 + r32; const float NEG = -INFINITY;
    if constexpr (KIND == K_FOX) {
        const LAS f32x4* cb = (const LAS f32x4*)(lds + L_XB + buf * 2048) + hi;
#pragma unroll
        for (int g = 0; g < 4; ++g) { const f32x4 c4 = cb[2 * g], c4b = cb[2 * g + 8];
#pragma unroll
            for (int j = 0; j < 4; ++j) { p0[4 * g + j] = fmaf(p0[4 * g + j], C, -c4[j]); p1[4 * g + j] = fmaf(p1[4 * g + j], C, -c4b[j]); } }
    } else if constexpr (KIND == K_DSA || KIND == K_DIL) {
        const LAS float* tb = (const LAS float*)(lds + L_TBL) + (q - k0 - 4 * hi + 256 - 59);
#pragma unroll
        for (int r = 0; r < 16; ++r) { const int cc = (r & 3) + 8 * (r >> 2); p0[r] = fmaf(p0[r], C, tb[59 - cc]); p1[r] = fmaf(p1[r], C, tb[59 - cc - 32]); }
        if constexpr (KIND == K_DSA) {
            const LAS unsigned* mb = (const LAS unsigned*)(lds + L_XB + buf * 2048) + wid * 64;
            const unsigned wl = mb[r32] >> (4 * hi), wh = mb[32 + r32] >> (4 * hi);
#pragma unroll
            for (int r = 0; r < 16; ++r) { const int cc = (r & 3) + 8 * (r >> 2); p0[r] = ((wl >> cc) & 1u) ? p0[r] : NEG; p1[r] = ((wh >> cc) & 1u) ? p1[r] : NEG; }
        }
    } else {
#pragma unroll
        for (int r = 0; r < 16; ++r) { p0[r] *= C; p1[r] *= C; }
    }
    if constexpr (KIND == K_FOX || KIND == K_MLA) {
        if (k0 + 63 > a.q0) {
            const int kb = k0 + 4 * hi;
#pragma unroll
            for (int r = 0; r < 16; ++r) { const int kv = kb + (r & 3) + 8 * (r >> 2); if (kv > q) p0[r] = NEG; if (kv + 32 > q) p1[r] = NEG; }
        }
    }
}

template <int KIND, int DK>
__device__ __forceinline__ void attn_unit(LAS unsigned char* lds, const AP& a, const int wave_id) {
    const int tid = tid_opaque(wave_id);
    const int lane = tid & 63, r32 = lane & 31, hi = lane >> 5; const int wid = __builtin_amdgcn_readfirstlane(tid >> 6);
    constexpr bool HAS_TBL = (KIND == K_DSA || KIND == K_DIL), HAS_X = (KIND == K_FOX || KIND == K_DSA);
    constexpr int KB = KVBLK * DK * 2, NKC = DK / 8, NKL = (64 * NKC) / 512, ND0 = DK / 16;
    constexpr int NQL = (DK == 192) ? 2 : (HAS_TBL ? 2 : 4), NQR = ND0 - NQL, NLD = NKL + 2 + (HAS_X ? 1 : 0);
    constexpr int LWS = (DK == 192) ? 122880 : 98304, LQSP = (DK == 192) ? 124928 : (HAS_TBL ? 123904 : 106496);
    LAS unsigned char* V_lds = lds + L_V; LAS unsigned char* K_lds = lds + L_K;
    LAS float* wsf = (LAS float*)(lds + LWS) + wid * 64; LAS float* li_l = wsf; LAS float* al_l = wsf + 32;
    LAS unsigned char* qsp = lds + LQSP + wid * (NQL * 1024) + lane * 16;
    float m_reg = -1e30f, l_reg = 0.f; f32x16 o[4] = {}; bf16x8 qr[NQR];
    const int qi = wid * 32 + r32;
    const bf16_t* Qw = a.Q + (long)qi * a.qs + hi * 8;
#pragma unroll
    for (int d0 = 0; d0 < ND0; ++d0) { const bf16x8 qv = *(const bf16x8*)(Qw + d0 * 16); if (d0 < NQR) qr[d0 < NQR ? d0 : 0] = qv; else *(LAS bf16x8*)(qsp + (d0 - NQR) * 1024) = qv; }
    float cq = 0.f;

    if constexpr (KIND == K_DIL) {
        if (a.carry_in) {
            m_reg = a.mst[(long)qi * a.msts]; l_reg = a.mst[(long)qi * a.msts + 1];
#pragma unroll
            for (int r = 0; r < 16; ++r) { const unsigned* orow = (const unsigned*)a.ost + (long)(wid * 32 + crow(r, hi)) * a.osts + r32;
                const unsigned w0 = __builtin_nontemporal_load(orow), w1 = __builtin_nontemporal_load(orow + 32);
                o[0][r] = bf_lo(w0); o[1][r] = bf_hi(w0); o[2][r] = bf_lo(w1); o[3][r] = bf_hi(w1); }
        }
    }
    if constexpr (KIND == K_DSA) {
        LAS float* tbl = (LAS float*)(lds + L_TBL);
        for (int i = tid; i < 4352; i += 512) { const int dist = i - 256; tbl[i] = dist < 0 ? -INFINITY : a.t5[t5_bucket(dist) * 16 + a.head] * LOG2E; }
    }
    if constexpr (KIND == K_DIL) {
        LAS float* tbl = (LAS float*)(lds + L_TBL);
        for (int i = tid; i < 640; i += 512) { const int rel = i - 256; tbl[i] = (rel < 0 || rel > 128) ? -INFINITY : a.t5[t5_bucket(rel * a.dil) * 16 + a.head] * LOG2E; }
    }
    int ksrc[NKL], vsrc[2];
#pragma unroll
    for (int c = 0; c < NKL; ++c) { const int Lb = (wid * NKL + c) * 1024 + lane * 16, row = Lb / (DK * 2), chp = (Lb % (DK * 2)) / 16; ksrc[c] = row * (int)a.ks + ((DK == 128) ? (chp ^ (row & 15)) : ((chp & ~7) | ((chp & 7) ^ (row & 7)))) * 8; }
#pragma unroll
    for (int c = 0; c < 2; ++c) { const int sl = (2 * wid + c) * 64 + lane, st = sl >> 5, wi = sl & 31, kk = ((st >> 2) << 3) | (wi >> 2), k = (kk & ~0xC) | ((kk & 4) << 1) | ((kk & 8) >> 1); vsrc[c] = k * (int)a.vs + (st & 3) * 32 + (wi & 3) * 8; }
    const int vb0 = (int)(unsigned)(uintptr_t)V_lds + v_rd_base(lane);
    int kad[4];
#pragma unroll
    for (int j = 0; j < 4; ++j) kad[j] = r32 * (DK * 2) + (((hi | (j << 1)) ^ (r32 & 7)) << 4) + ((DK == 128) ? 128 * ((r32 >> 3) & 1) : 0);
#define ATT_DMA(t, sl) do { const long kb_ = (long)(t) * 64; \
        _Pragma("unroll") for (int c_ = 0; c_ < NKL; ++c_) __builtin_amdgcn_global_load_lds((const unsigned*)(a.K + kb_ * a.ks + ksrc[c_]), (LAS unsigned*)(K_lds + (sl) * KB + (wid * NKL + c_) * 1024), 16, 0, 0); \
        _Pragma("unroll") for (int c_ = 0; c_ < 2; ++c_) __builtin_amdgcn_global_load_lds((const unsigned*)(a.V + kb_ * a.vs + vsrc[c_]), (LAS unsigned*)(V_lds + (sl) * VB + (2 * wid + c_) * 1024), 16, 0, 0); \
        if constexpr (KIND == K_FOX) __builtin_amdgcn_global_load_lds((const unsigned*)(a.cum + (kb_ + lane) * a.cums), (LAS unsigned*)(lds + L_XB + (sl) * 2048), 4, 0, 0);     \
        if constexpr (KIND == K_DSA) __builtin_amdgcn_global_load_lds((const unsigned*)(a.msk + (long)(wid * 32 + r32) * 64 + (t)) + hi, (LAS unsigned*)(lds + L_XB + (sl) * 2048 + wid * 256), 4, 0, 0); } while (0)
#define ATT_RESC(al) do { if (__any((al) < 1.f)) { if (hi == 0) al_l[r32] = (al); asm volatile("s_waitcnt lgkmcnt(0)" ::: "memory"); \
        _Pragma("unroll") for (int d = 0; d < 4; ++d) _Pragma("unroll") for (int r = 0; r < 16; ++r) o[d][r] *= al_l[crow(r, hi)]; } } while (0)
#define ATT_BAR() do { asm volatile("s_waitcnt lgkmcnt(0)" ::: "memory"); __builtin_amdgcn_s_barrier(); asm volatile("" ::: "memory"); } while (0)
    f32x16 p0, p1; float al = 1.f; bf16x8 pa0, pa1, pa2, pa3; const int NT = a.nt, T0 = a.kt0;
    asm volatile("s_waitcnt vmcnt(0) lgkmcnt(0)" ::: "memory");
    ATT_DMA(T0, 0);
    if (NT > 1) { ATT_DMA(T0 + 1, 1); asm volatile("s_waitcnt vmcnt(%0)" :: "n"(NLD) : "memory"); } else { asm volatile("s_waitcnt vmcnt(0)" ::: "memory"); }
    ATT_BAR();
    int sl = 0, sl2 = 2;
    for (int jj = 0; jj < NT; ++jj) {
        const int t = T0 + jj;
        if (jj + 2 < NT) ATT_DMA(t + 2, sl2);
        bool lv = true; { const int k0_ = t * 64, qw_ = a.q0 + wid * 32;
            if constexpr (KIND == K_FOX || KIND == K_MLA || KIND == K_DSA) lv = k0_ <= qw_ + 31;
            if constexpr (KIND == K_DIL) lv = (k0_ <= qw_ + 31) && (k0_ + 63 >= qw_ - 128); }
        if (lv) {
            ATT_SBAR(); qkt<DK, NQL>(p0, p1, K_lds + sl * KB, kad, qr, qsp);
            score<KIND>(p0, p1, a, t, sl, lds, wid, r32, hi, cq);
            rowmax_decide(p0, p1, m_reg, al);
            const float ps = sm_only(p0, p1, m_reg);
            l_reg = l_reg * al + half_sum(ps);
            ATT_RESC(al);
            pack_p(p0, p1, pa0, pa1, pa2, pa3); ATT_SBAR();
            pv_only(o, vb0 + sl * VB, pa0, pa1, pa2, pa3);
        }
        if (jj + 2 < NT) asm volatile("s_waitcnt vmcnt(%0)" :: "n"(NLD) : "memory"); else asm volatile("s_waitcnt vmcnt(0)" ::: "memory");
        ATT_BAR();
        sl = (sl == 2) ? 0 : sl + 1; sl2 = (sl2 == 2) ? 0 : sl2 + 1;
    }
    bool stateout = false;
    if constexpr (KIND == K_DIL) stateout = a.carry_out != 0;
    if (stateout) {
        int qi2 = qi; asm volatile("" : "+v"(qi2));
        if (hi == 0) { a.mst[(long)qi2 * a.msts] = m_reg; a.mst[(long)qi2 * a.msts + 1] = l_reg; }
        asm volatile("s_nop 7\n\ts_nop 7\n\ts_nop 7" : "+v"(o[0]), "+v"(o[1]), "+v"(o[2]), "+v"(o[3]));
#pragma unroll
        for (int r = 0; r < 16; ++r) { unsigned* orow = (unsigned*)a.ost + (long)(wid * 32 + crow(r, hi)) * a.osts + r32;
            __builtin_nontemporal_store(cvt_pk_bf16(o[0][r], o[1][r]), orow); __builtin_nontemporal_store(cvt_pk_bf16(o[2][r], o[3][r]), orow + 32); }
        __syncthreads();
    } else {
        if (hi == 0) li_l[r32] = l_reg;
        asm volatile("s_waitcnt lgkmcnt(0)" ::: "memory");
        float rli[16];
#pragma unroll
        for (int r = 0; r < 16; ++r) rli[r] = __builtin_amdgcn_rcpf(li_l[crow(r, hi)]);
        __syncthreads();
        LAS unsigned short* ost = (LAS unsigned short*)(lds + wid * 8192);
#pragma unroll
        for (int r = 0; r < 16; ++r) { const int orow = crow(r, hi);
#pragma unroll
            for (int d0 = 0; d0 < 4; ++d0) { const unsigned w = cvt_pk_bf16(o[d0][r] * rli[r], 0.f); ost[orow * 128 + d0 * 32 + r32] = (unsigned short)w; } }
        asm volatile("s_waitcnt lgkmcnt(0)" ::: "memory");
#pragma unroll
        for (int i = 0; i < 8; ++i) { const int ch = lane + 64 * i, row = ch >> 4, c16 = ch & 15;
            const u32x4 v = *(const LAS u32x4*)(lds + wid * 8192 + row * 256 + c16 * 16);
            if (a.o8) {
              int q0 = __builtin_amdgcn_cvt_pk_fp8_f32(bf_lo(v.x) * 16.f, bf_hi(v.x) * 16.f, 0, false); q0 = __builtin_amdgcn_cvt_pk_fp8_f32(bf_lo(v.y) * 16.f, bf_hi(v.y) * 16.f, q0, true);
              int q1 = __builtin_amdgcn_cvt_pk_fp8_f32(bf_lo(v.z) * 16.f, bf_hi(v.z) * 16.f, 0, false); q1 = __builtin_amdgcn_cvt_pk_fp8_f32(bf_lo(v.w) * 16.f, bf_hi(v.w) * 16.f, q1, true);
              *(u32x2*)((unsigned char*)a.O + (long)(wid * 32 + row) * a.os + c16 * 8) = (u32x2){(unsigned)q0, (unsigned)q1}; }
            else *(u32x4*)(a.O + (long)(wid * 32 + row) * a.os + c16 * 8) = v; }
        __syncthreads();
    }
#undef ATT_DMA
#undef ATT_RESC
#undef ATT_BAR
}
#undef ATT_VWAIT
#undef ATT_PK
}

struct Fr { LAS unsigned char* lds; int tid, lane, wave, vcu, G, gw, ngw; };

__device__ __forceinline__ float wave_sum(float v) {
#pragma unroll
    for (int o = 1; o < 64; o <<= 1) v += __shfl_xor(v, o);
    return v;
}
__device__ __forceinline__ void unpack8(const u32x4 w, float (&v)[8]) {
    v[0] = bf_lo(w.x); v[1] = bf_hi(w.x); v[2] = bf_lo(w.y); v[3] = bf_hi(w.y); v[4] = bf_lo(w.z); v[5] = bf_hi(w.z); v[6] = bf_lo(w.w); v[7] = bf_hi(w.w);
}
__device__ __forceinline__ u32x4 pack8(const float (&v)[8]) {
    u32x4 w; w.x = cvt_pk_bf16(v[0], v[1]); w.y = cvt_pk_bf16(v[2], v[3]); w.z = cvt_pk_bf16(v[4], v[5]); w.w = cvt_pk_bf16(v[6], v[7]); return w;
}
__device__ __forceinline__ float sumsq8(const float (&v)[8]) { return ((v[0] * v[0] + v[1] * v[1]) + (v[2] * v[2] + v[3] * v[3])) + ((v[4] * v[4] + v[5] * v[5]) + (v[6] * v[6] + v[7] * v[7])); }

__device__ __forceinline__ int map_col(int kind, int n) {
    switch (kind) {
        case 1: return 256 * (n >> 7) + (n & 127);
        case 2: return 256 * (n >> 7) + 128 + (n & 127);
        case 3: return n < 6144 ? n : (n < 6160 ? 6656 + (n - 6144) : 6144 + (n - 6160));
        case 4: return n < 1088 ? n : 1280 + (n - 1088);
        case 5: return n < 6144 ? n : (n < 18432 ? n + 512 : 6144 + (n - 18432));
        case 6: return n < 4176 ? n : 4352 + (n - 4176);
        default: return n;
    }
}
struct TrDesc { const float* W; const float* gain; bf16_t* WT; int K, N, ldt, kind, r, f8, tiled; };
__device__ __forceinline__ void tr_load(const TrDesc& d, int lane, f32x4 (&v)[16]) {
    const int nblk = (d.N + 63) / 64, kb = d.r / nblk, nb = d.r % nblk, k0 = 64 * kb, n = 64 * nb + 4 * (lane & 15); const bool ok = n < d.N;
    const float* src = d.W + (size_t)(k0 + (lane >> 4)) * d.N + (ok ? n : 0); const size_t rs = (size_t)4 * d.N;
#pragma unroll
    for (int j = 0; j < 16; ++j) v[j] = __builtin_nontemporal_load((const f32x4*)(src + (size_t)j * rs));
}
__device__ __forceinline__ void tr_store(const TrDesc& d, int lane, const f32x4 (&v)[16], LAS float* scr) {
    const int nblk = (d.N + 63) / 64, kb = d.r / nblk, nb = d.r % nblk, k0 = 64 * kb, n0 = 64 * nb;
    { LAS float* w = scr + (lane >> 4) * 65 + 4 * (lane & 15);
#pragma unroll
      for (int j = 0; j < 16; ++j) { w[j * 260 + 0] = v[j][0]; w[j * 260 + 1] = v[j][1]; w[j * 260 + 2] = v[j][2]; w[j * 260 + 3] = v[j][3]; } }
    const int c = lane & 7, nn = lane >> 3; float g[8];
#pragma unroll
    for (int jj = 0; jj < 8; ++jj) g[jj] = d.gain ? d.gain[k0 + 8 * c + jj] : 1.f;
    asm volatile("s_waitcnt lgkmcnt(0)" ::: "memory");
#pragma unroll
    for (int it = 0; it < 8; ++it) { const int nl = nn + 8 * it; const LAS float* rp = scr + (8 * c) * 65 + nl;
        u32x4 o; o.x = cvt_pk_bf16(rp[0 * 65] * g[0], rp[1 * 65] * g[1]); o.y = cvt_pk_bf16(rp[2 * 65] * g[2], rp[3 * 65] * g[3]); o.z = cvt_pk_bf16(rp[4 * 65] * g[4], rp[5 * 65] * g[5]); o.w = cvt_pk_bf16(rp[6 * 65] * g[6], rp[7 * 65] * g[7]);
        if (n0 + nl < d.N) {
            if (d.f8) { int q0 = __builtin_amdgcn_cvt_pk_fp8_f32(rp[0 * 65] * g[0] * 64.f, rp[1 * 65] * g[1] * 64.f, 0, false); q0 = __builtin_amdgcn_cvt_pk_fp8_f32(rp[2 * 65] * g[2] * 64.f, rp[3 * 65] * g[3] * 64.f, q0, true);
                        int q1 = __builtin_amdgcn_cvt_pk_fp8_f32(rp[4 * 65] * g[4] * 64.f, rp[5 * 65] * g[5] * 64.f, 0, false); q1 = __builtin_amdgcn_cvt_pk_fp8_f32(rp[6 * 65] * g[6] * 64.f, rp[7 * 65] * g[7] * 64.f, q1, true);
                        if (d.tiled) { const int n = n0 + nl;
                            *(u32x2*)((unsigned char*)d.WT + ((((size_t)(n >> 8) * (d.K >> 7) + (k0 >> 7)) * 2 + ((n >> 7) & 1)) * 128 + (n & 127)) * 128 + (k0 & 127) + 8 * c) = (u32x2){(unsigned)q0, (unsigned)q1}; }
                        else *(u32x2*)((unsigned char*)d.WT + (size_t)map_col(d.kind, n0 + nl) * d.ldt + k0 + 8 * c) = (u32x2){(unsigned)q0, (unsigned)q1}; }
            else if (d.tiled) { const int n = n0 + nl;
                *(u32x4*)(d.WT + ((((size_t)(n >> 8) * (d.K >> 6) + (k0 >> 6)) * 2 + ((n >> 7) & 1)) * 128 + (n & 127)) * 64 + 8 * c) = o; }
            else *(u32x4*)(d.WT + (size_t)map_col(d.kind, n0 + nl) * d.ldt + k0 + 8 * c) = o; } }
    asm volatile("s_waitcnt lgkmcnt(0)" ::: "memory");
}

__device__ __forceinline__ void rows2048(const Fr& F, const float* x, int nrows, bf16_t* xb, void* out, int mode) {
    for (int m = F.gw; m < nrows; m += F.ngw) {
        const f32x4* xr = (const f32x4*)(x + (size_t)m * DM) + F.lane; f32x4 v[8]; float s = 0.f;
#pragma unroll
        for (int j = 0; j < 8; ++j) { v[j] = xr[64 * j]; s += (v[j].x * v[j].x + v[j].y * v[j].y) + (v[j].z * v[j].z + v[j].w * v[j].w); }
        s = wave_sum(s);
        if (F.lane == 0) { if (mode) ((float*)out)[m] = __builtin_amdgcn_rsqf(s * (1.0f / DM) + RMS_EPS); else ((u64*)out)[m] = (u64)(s * pg8::SSQ_SCALE); }
        if (xb) { u32x2* o8 = (u32x2*)(xb + (size_t)m * DM) + F.lane;
#pragma unroll
            for (int j = 0; j < 8; ++j) { u32x2 w; w.x = cvt_pk_bf16(v[j].x, v[j].y); w.y = cvt_pk_bf16(v[j].z, v[j].w); o8[64 * j] = w; } }
    }
}

__device__ __forceinline__ void hn_step(bf16_t* p, const float (&g)[8]) {
    float v[8]; unpack8(*(const u32x4*)p, v); float ss = sumsq8(v);
    ss += __shfl_xor(ss, 1); ss += __shfl_xor(ss, 2); ss += __shfl_xor(ss, 4); ss += __shfl_xor(ss, 8);
    const float rs = __builtin_amdgcn_rsqf(ss * (1.0f / 128.0f) + RMS_EPS);
#pragma unroll
    for (int j = 0; j < 8; ++j) v[j] = v[j] * rs * g[j];
    *(u32x4*)p = pack8(v);
}
__device__ __forceinline__ void load_gain8(const float* g, int lane, float (&o)[8]) {
#pragma unroll
    for (int j = 0; j < 8; ++j) o[j] = g ? g[(lane & 15) * 8 + j] : 1.f;
}
__device__ __forceinline__ void prep_rows(const Fr& F, bf16_t* P, long ld, int nrows, int c0, int n0, const float* g0, int c1, int n1, const float* g1, int c2, int n2, const float* g2) {
    float ga[8], gb[8], gc[8]; load_gain8(g0, F.lane, ga); load_gain8(g1, F.lane, gb); load_gain8(g2, F.lane, gc);
    for (int m = F.gw; m < nrows; m += F.ngw) {
        bf16_t* row = P + (size_t)m * ld + F.lane * 8;
        for (int s = 0; s < n0; ++s) hn_step(row + c0 + s * 512, ga);
        for (int s = 0; s < n1; ++s) hn_step(row + c1 + s * 512, gb);
        for (int s = 0; s < n2; ++s) hn_step(row + c2 + s * 512, gc);
    }
}

__device__ __forceinline__ void fox_cumsum(const Fr& F, const float* FG, const float* b_f, float* CUM) {
    for (int task = ((F.gw & 15) == 0) ? (F.gw >> 4) : NB * NH; task < NB * NH; task += (F.ngw >> 4)) {
        const int b = task >> 4, h = task & 15; const float bias = b_f[h];
        const float* src = FG + ((size_t)b * SEQ + (size_t)F.lane * 64) * 16 + h; float v[64]; float run = 0.f;
#pragma unroll
        for (int i = 0; i < 64; ++i) { const float xg = src[(size_t)i * 16] + bias;
            const float e = __expf(-fabsf(xg)); const float ls = fminf(xg, 0.f) - __logf(1.0f + e);
            run += ls; v[i] = run; }
        float incl = run;
#pragma unroll
        for (int o = 1; o < 64; o <<= 1) { const float t = __shfl_up(incl, o); if (F.lane >= o) incl += t; }
        const float excl = incl - run;
        float* dst = CUM + ((size_t)b * SEQ + (size_t)F.lane * 64) * 16 + h;
#pragma unroll
        for (int i = 0; i < 64; ++i) dst[(size_t)i * 16] = (v[i] + excl) * LOG2E;
    }
}

__device__ const double ROPE_INV[32] = {
    1.0, 0.7498942093324559, 0.5623413251903491, 0.4216965034285822, 0.31622776601683794, 0.23713737056616552, 0.1778279410038923, 0.1333521432163324,
    0.1, 0.07498942093324558, 0.05623413251903491, 0.04216965034285822, 0.03162277660168379, 0.023713737056616554, 0.01778279410038923, 0.01333521432163324,
    0.01, 0.007498942093324558, 0.005623413251903491, 0.004216965034285823, 0.0031622776601683794, 0.0023713737056616554, 0.001778279410038923, 0.001333521432163324,
    0.001, 0.0007498942093324559, 0.0005623413251903491, 0.0004216965034285823, 0.00031622776601683794, 0.00023713737056616554, 0.0001778279410038923, 0.0001333521432163324};
__device__ __forceinline__ void rope_table(const Fr& F, const int* pos, float* COS, float* SIN) {
    const int gt = F.vcu * 512 + F.tid, ngt = F.G * 512;
    for (int i = gt; i < MTOK * 32; i += ngt) { const int m = i >> 5, f = i & 31;
        const double a = (double)pos[m] * (double)(float)ROPE_INV[f]; const double rev = a * 0.15915494309189535; const float fr = (float)(rev - floor(rev));
        COS[i] = __builtin_amdgcn_cosf(fr); SIN[i] = __builtin_amdgcn_sinf(fr); }
}

__device__ __forceinline__ void mla_prep_a(const Fr& F, bf16_t* P, float* RSQ, float* RSKV, bf16_t* KR, const float* rope_g1, const float* gmem, const float* COS, const float* SIN) {
    const int lane = F.lane; float gr[8];
#pragma unroll
    for (int j = 0; j < 8; ++j) gr[j] = rope_g1[(lane & 7) * 8 + j];
    for (int m = F.gw; m < MTOK; m += F.ngw) {
        bf16_t* pr = P + (size_t)m * 1792; float v[8];
        const u32x4 wq = *(const u32x4*)(pr + lane * 8), wk = *(const u32x4*)(pr + 512 + lane * 8);
        u32x4 w = (u32x4){0u, 0u, 0u, 0u}; if (lane < 8) w = *(const u32x4*)(pr + 1024 + lane * 8);
        const float* cp = COS + (size_t)m * 32 + (lane & 3) * 8; const float* sp = SIN + (size_t)m * 32 + (lane & 3) * 8; float cs[8], sn[8];
#pragma unroll
        for (int j = 0; j < 8; ++j) { cs[j] = cp[j]; sn[j] = sp[j]; }
        asm volatile("" ::: "memory");
        unpack8(wq, v); float ss = wave_sum(sumsq8(v)); if (lane == 0) RSQ[m] = __builtin_amdgcn_rsqf(ss * (1.0f / 512.0f) + RMS_EPS);
        unpack8(wk, v); ss = wave_sum(sumsq8(v)); if (lane == 0) RSKV[m] = __builtin_amdgcn_rsqf(ss * (1.0f / 512.0f) + RMS_EPS);
        unpack8(w, v); ss = sumsq8(v); ss += __shfl_xor(ss, 1); ss += __shfl_xor(ss, 2); ss += __shfl_xor(ss, 4);
        const float rs = __builtin_amdgcn_rsqf(ss * (1.0f / 64.0f) + RMS_EPS); float o[8];
#pragma unroll
        for (int j = 0; j < 8; ++j) { const float x = v[j] * rs * gr[j]; const float y = __shfl_xor(x, 4); o[j] = (lane & 4) ? (y * sn[j] + x * cs[j]) : (x * cs[j] - y * sn[j]); }
        if (lane < 8) *(u32x4*)(KR + (size_t)m * 64 + lane * 8) = pack8(o);
    }
}
__device__ __forceinline__ void mla_prep_b(const Fr& F, bf16_t* Q, const bf16_t* KV, bf16_t* KF, const bf16_t* KR, const float* nope_g, const float* rope_g, const float* COS, const float* SIN) {
    const int lane = F.lane, half = lane >> 5, l5 = lane & 31; float gqn[8], gqr[8], gkn[8];
#pragma unroll
    for (int j = 0; j < 8; ++j) { gqn[j] = nope_g[(l5 & 15) * 8 + j]; gkn[j] = nope_g[128 + (l5 & 15) * 8 + j]; gqr[j] = rope_g[(l5 & 7) * 8 + j]; }
    for (int m = F.gw; m < MTOK; m += F.ngw) {
        const float* cp = COS + (size_t)m * 32 + (l5 & 3) * 8; const float* sp = SIN + (size_t)m * 32 + (l5 & 3) * 8; float cs[8], sn[8];
#pragma unroll
        for (int j = 0; j < 8; ++j) { cs[j] = cp[j]; sn[j] = sp[j]; }
        u32x4 krw = (u32x4){0u, 0u, 0u, 0u}; if (l5 >= 16 && l5 < 24) krw = *(const u32x4*)(KR + (size_t)m * 64 + (l5 - 16) * 8);
        u32x4 qw[8], kw[8];
#pragma unroll
        for (int it = 0; it < 8; ++it) { const int h = 2 * it + half;
            qw[it] = (u32x4){0u, 0u, 0u, 0u}; if (l5 < 24) qw[it] = *(const u32x4*)(Q + (size_t)m * 3072 + h * 192 + l5 * 8);
            kw[it] = (u32x4){0u, 0u, 0u, 0u}; if (l5 < 16) kw[it] = *(const u32x4*)(KV + (size_t)m * 4096 + h * 256 + l5 * 8); }
        asm volatile("" ::: "memory");
#pragma unroll
        for (int it = 0; it < 8; ++it) { const int h = 2 * it + half;
            bf16_t* qrow = Q + (size_t)m * 3072 + h * 192 + l5 * 8; float v[8];
            unpack8(qw[it], v); float s8 = sumsq8(v); s8 += __shfl_xor(s8, 1); s8 += __shfl_xor(s8, 2); s8 += __shfl_xor(s8, 4); const float s16 = s8 + __shfl_xor(s8, 8);
            const float rs = (l5 < 16) ? __builtin_amdgcn_rsqf(s16 * (1.0f / 128.0f) + RMS_EPS) : __builtin_amdgcn_rsqf(s8 * (1.0f / 64.0f) + RMS_EPS);
            float o[8];
#pragma unroll
            for (int j = 0; j < 8; ++j) { const float x = v[j] * rs * ((l5 < 16) ? gqn[j] : gqr[j]); const float y = __shfl_xor(x, 4);
                const float rot = (l5 & 4) ? (y * sn[j] + x * cs[j]) : (x * cs[j] - y * sn[j]); o[j] = (l5 < 16) ? x : rot; }
            if (l5 < 24) *(u32x4*)qrow = pack8(o);
            bf16_t* kfrow = KF + (size_t)m * 3072 + h * 192;
            unpack8(kw[it], v); float k16 = sumsq8(v); k16 += __shfl_xor(k16, 1); k16 += __shfl_xor(k16, 2); k16 += __shfl_xor(k16, 4); k16 += __shfl_xor(k16, 8);
            const float krs = __builtin_amdgcn_rsqf(k16 * (1.0f / 128.0f) + RMS_EPS);
#pragma unroll
            for (int j = 0; j < 8; ++j) o[j] = v[j] * krs * gkn[j];
            if (l5 < 16) *(u32x4*)(kfrow + l5 * 8) = pack8(o);
            else if (l5 < 24) *(u32x4*)(kfrow + 128 + (l5 - 16) * 8) = krw;
        }
    }
}

__device__ __forceinline__ void dsa_indexer(const Fr& F, const bf16_t* P, float* SC) {
    constexpr int LDP = 4864, CQI = 3072, CKI = 4096, CWI = 4160;
    constexpr int RING = 81920;
    const int lane = F.lane, r32 = lane & 31, hg = lane >> 5;
    LAS float* ibuf = (LAS float*)(F.lds + F.wave * 9216);
    const int drow = 8 * F.wave + (lane >> 3), dchunk = (lane & 7) ^ ((lane >> 3) & 7);
#define IDX_DMA(t_) __builtin_amdgcn_global_load_lds((const unsigned*)(kbase + (size_t)(t_) * 64 * LDP), (LAS unsigned*)(F.lds + RING + ((t_) & 3) * 8192 + F.wave * 1024), 16, 0, 0)
    for (int ui = blockIdx.x; ui < 512; ui += F.G) {
        const int c = ui & 255, second = ui >> 8, b = c >> 5, qb0 = c & 31, qb = second ? 63 - qb0 : qb0;
        const size_t tok0 = (size_t)b * SEQ + qb * 64 + F.wave * 8;
        bf16x8 aq[4][4]; f32x2 wv[4][8];
#pragma unroll
        for (int g = 0; g < 4; ++g) { const size_t tok = tok0 + 2 * g + (r32 >> 4); const bf16_t* qp = P + tok * LDP + CQI + (r32 & 15) * 64 + 8 * hg;
#pragma unroll
            for (int ks = 0; ks < 4; ++ks) aq[g][ks] = *(const bf16x8*)(qp + 16 * ks);
#pragma unroll
            for (int r = 0; r < 16; ++r) { const int head = (r & 3) + 8 * ((r >> 2) & 1) + 4 * hg; const size_t tq = tok0 + 2 * g + (r >> 3);
                wv[g][r >> 1][r & 1] = bf_lo((unsigned)P[tq * LDP + CWI + head]) * (0.25f * 0.125f); } }
        const int nt = qb + 1;
        const bf16_t* kbase = P + ((size_t)b * SEQ + drow) * LDP + CKI + 8 * dchunk;
        asm volatile("s_waitcnt vmcnt(0) lgkmcnt(0)" ::: "memory"); __builtin_amdgcn_s_barrier(); asm volatile("" ::: "memory");
        IDX_DMA(0); if (nt > 1) IDX_DMA(1);
        for (int t = 0; t < nt; ++t) {
            if (t + 1 < nt) asm volatile("s_waitcnt vmcnt(1)" ::: "memory"); else asm volatile("s_waitcnt vmcnt(0)" ::: "memory");
            asm volatile("s_waitcnt lgkmcnt(0)" ::: "memory"); __builtin_amdgcn_s_barrier(); asm volatile("" ::: "memory");
            if (t + 2 < nt) IDX_DMA(t + 2);
            const LAS unsigned char* slot = F.lds + RING + (t & 3) * 8192;
            bf16x8 bk[2][4];
#pragma unroll
            for (int kg = 0; kg < 2; ++kg) { const int key = kg * 32 + r32;
#pragma unroll
                for (int ks = 0; ks < 4; ++ks) bk[kg][ks] = *(const LAS bf16x8*)(slot + key * 128 + (((2 * ks + hg) ^ (key & 7)) << 4)); }
            f32x16 dcur = f32x16{};
#pragma unroll
            for (int ks = 0; ks < 4; ++ks) dcur = __builtin_amdgcn_mfma_f32_32x32x16_bf16(aq[0][ks], bk[0][ks], dcur, 0, 0, 0);
#pragma unroll
            for (int j = 0; j < 8; ++j) { const int kg = j >> 2, g = j & 3;
                f32x16 dnext = f32x16{};
                if (j < 7) {
#pragma unroll
                    for (int ks = 0; ks < 4; ++ks) dnext = __builtin_amdgcn_mfma_f32_32x32x16_bf16(aq[(j + 1) & 3][ks], bk[(j + 1) >> 2][ks], dnext, 0, 0, 0); }
                f32x2 accA = {0.f, 0.f}, accB = {0.f, 0.f};
#pragma unroll
                for (int i = 0; i < 4; ++i) { f32x2 xa, xb;
#define IDX_RELU(x_) __int_as_float(max(__float_as_int(x_), 0))
                    xa[0] = IDX_RELU(dcur[2 * i]); xa[1] = IDX_RELU(dcur[2 * i + 1]); xb[0] = IDX_RELU(dcur[8 + 2 * i]); xb[1] = IDX_RELU(dcur[9 + 2 * i]);
#undef IDX_RELU
                    accA = __builtin_elementwise_fma(wv[g][i], xa, accA); accB = __builtin_elementwise_fma(wv[g][4 + i], xb, accB); }
                const float s0 = accA[0] + accA[1], s1 = accB[0] + accB[1];
                auto rr = __builtin_amdgcn_permlane32_swap(__float_as_uint(s0), __float_as_uint(s1), false, false);
                const float tot = __uint_as_float(rr[0]) + __uint_as_float(rr[1]);
                ibuf[(2 * g + hg) * 288 + (t & 3) * 64 + kg * 32 + r32] = tot;
                if (j < 7) {
#pragma unroll
                    for (int i = 0; i < 4; ++i) { __builtin_amdgcn_sched_group_barrier(0x008, 1, 0); __builtin_amdgcn_sched_group_barrier(0x002, 6, 0); } }
                dcur = dnext;
            }
            if ((t & 3) == 3 || t == nt - 1) { const int t0 = t & ~3, cnt = (t - t0 + 1) * 64;
                if (4 * lane < cnt) {
#pragma unroll
                    for (int q = 0; q < 8; ++q) { const f32x4 v = *(const LAS f32x4*)(ibuf + q * 288 + 4 * lane);
                        __builtin_nontemporal_store(v, (f32x4*)(SC + (tok0 + q) * (size_t)SEQ + t0 * 64 + 4 * lane)); } } }
        }
    }
#undef IDX_DMA
}

__device__ __forceinline__ int dsa_qmap(const Fr& F, int k) { return k * F.ngw + ((k & 1) ? F.ngw - 1 - F.gw : F.gw); }
__device__ __forceinline__ void dsa_issue(const float* SC, int q, int lane, unsigned (&raw)[64]) {
    const int s = q & (SEQ - 1); const float* row = SC + (size_t)q * SEQ;
    if (s < 256) return;
#pragma unroll
    for (int c4 = 0; c4 < 4; ++c4) {
        if (1024 * c4 <= s) {
#pragma unroll
            for (int i = 16 * c4; i < 16 * c4 + 16; ++i) raw[i] = __float_as_uint(__builtin_nontemporal_load(row + 64 * i + lane)); }
        else {
#pragma unroll
            for (int i = 16 * c4; i < 16 * c4 + 16; ++i) raw[i] = 0u; } }
}
__device__ __forceinline__ void dsa_select(const Fr& F, const float* SC, u64* MSK) {
    const int lane = F.lane;
    int k = 0, q = dsa_qmap(F, 0); bool have = q < MTOK;
    unsigned raw[64];
#pragma unroll
    for (int i = 0; i < 64; ++i) raw[i] = 0u;
    if (have) dsa_issue(SC, q, lane, raw);
    while (have) {
        const int s = q & (SEQ - 1); u64* mrow = MSK + (size_t)q * 64;
        const int qn = dsa_qmap(F, k + 1); const bool hn = qn < MTOK;
        if (s < 256) { const int lo = 64 * lane; u64 w = 0ull; if (s >= lo + 63) w = ~0ull; else if (s >= lo) w = (2ull << (s - lo)) - 1ull; mrow[lane] = w;
            if (hn) dsa_issue(SC, qn, lane, raw); q = qn; have = hn; ++k; continue; }
        unsigned u[64];
#pragma unroll
        for (int i = 0; i < 64; ++i) { const int key = 64 * i + lane; const unsigned bits = raw[i]; const unsigned ord = (bits & 0x80000000u) ? ~bits : (bits | 0x80000000u); u[i] = (key <= s) ? ord : 0u; }
        if (hn) dsa_issue(SC, qn, lane, raw);
        unsigned T = 0u; const int ng = (s >> 9) + 1;
        for (int bit = 31; bit >= 0; --bit) { const unsigned cand = T | (1u << bit); int cl = 0;
#pragma unroll
            for (int g8 = 0; g8 < 8; ++g8) { if (g8 >= ng) break;
                u64 m[8];
#pragma unroll
                for (int j = 0; j < 8; ++j) asm("v_cmp_le_u32_e64 %0, %1, %2" : "=s"(m[j]) : "s"(cand), "v"(u[8 * g8 + j]));
#pragma unroll
                for (int j = 0; j < 8; ++j) cl += __popcll(m[j]); }
            cl = __builtin_amdgcn_readfirstlane(cl);
            if (cl >= 256) { T = cand; if (cl == 256) break; } }
        int cgt = 0;
#pragma unroll
        for (int g8 = 0; g8 < 8; ++g8) { if (g8 >= ng) break;
            u64 m[8];
#pragma unroll
            for (int j = 0; j < 8; ++j) asm("v_cmp_lt_u32_e64 %0, %1, %2" : "=s"(m[j]) : "s"(T), "v"(u[8 * g8 + j]));
#pragma unroll
            for (int j = 0; j < 8; ++j) cgt += __popcll(m[j]); }
        int need = 256 - __builtin_amdgcn_readfirstlane(cgt); unsigned mlo = 0u, mhi = 0u;
#pragma unroll
        for (int i = 0; i < 64; ++i) { if ((i & 7) == 0 && (i >> 3) >= ng) break;
            const u64 gt = __ballot(u[i] > T), eq = __ballot(u[i] == T); u64 take = 0ull;
            if (need > 0 && eq != 0ull) { const int c = __popcll(eq);
                if (c <= need) { take = eq; need -= c; }
                else { u64 e = eq; for (int n = 0; n < need; ++n) { const u64 low = e & (0ull - e); take |= low; e ^= low; } need = 0; } }
            const u64 w = gt | take; const bool me = lane == i;
            mlo = me ? (unsigned)w : mlo; mhi = me ? (unsigned)(w >> 32) : mhi; }
        mrow[lane] = ((u64)mhi << 32) | (u64)mlo;
        q = qn; have = hn; ++k;
    }
}

constexpr size_t MiB = 1u << 20;
constexpr size_t WS_CTL = 0, CTL_ZERO_BYTES = 8 * MiB;
constexpr int CW_BAR = 4096;
constexpr size_t WS_SSQ = 1 * MiB;
constexpr size_t WS_WB = 8 * MiB;
constexpr size_t WS_XB = 236 * MiB;
constexpr size_t WS_MEMB = 364 * MiB;
constexpr size_t WS_MEMKV = 372 * MiB;
constexpr size_t WS_COS = 388 * MiB, WS_SIN = 392 * MiB, WS_RSMEM = 396 * MiB, WS_RSQ = 397 * MiB, WS_RSKV = 398 * MiB;
constexpr size_t WS_XB8 = 560 * MiB;
constexpr size_t WS_MIX = 400 * MiB;
constexpr size_t WS_SCR = 624 * MiB;
constexpr size_t WS_END = (624 + 832) * MiB;
constexpr size_t WB_GU0 = 0, WB_GU1 = 23068672, WB_D0 = 46137344, WB_D1 = 57671680, WB_IN = 69206016, WB_OUT = 108003328, WB_MKV = 113246208, WB_UQ = 115343360, WB_UKV = 116916224;
constexpr int RING_BYTES = 146944, MISC_OFF = RING_BYTES + 64, LDS_BYTES = 147456;
static_assert(att::L_END <= RING_BYTES && pg8::STAGE_BYTES <= RING_BYTES, "LDS map");
constexpr int NPHASES = 44;
#ifndef F8MASK
#define F8MASK 4
#endif
#define F8LAYER(L) (((F8MASK) >> (L)) & 1)
#ifndef RG
#define RG 1
#endif
#ifndef RD
#define RD 1
#endif
#ifndef RI
#define RI 1
#endif
#ifndef RA
#define RA 1
#endif
#ifndef F8OUT
#define F8OUT 8
#endif
#define F8OUTL(L_) (((F8OUT) >> (L_)) & 1)
#ifndef F8FFN
#define F8FFN 128
#endif
#define F8FFNL(L_, f_) (((F8FFN) >> (2 * (L_) + (f_))) & 1)
#ifndef F8FFND
#define F8FFND 128
#endif
#define F8FFNDL(L_, f_) (((F8FFND) >> (2 * (L_) + (f_))) & 1)
#ifndef F8MODE
#define F8MODE 2
#endif
#ifndef RCV
#define RCV 1
#endif
#ifndef RIX
#define RIX 1
#endif
#ifndef RSL
#define RSL 1
#endif
#ifndef RC
#define RC 1
#endif
#define REP(n) for (int rep_ = 0; rep_ < (n); ++rep_)

struct Args { const void* in[27]; float* out; unsigned char* ws; int ph_lo, ph_hi; };

typedef const __attribute__((address_space(4))) struct Args* ArgsPc;
__device__ __forceinline__ TrDesc tr_desc(ArgsPc A, int L, bf16_t* WB, int it) {
    const float* w_gate = (const float*)A->in[5]; const float* w_up = (const float*)A->in[6]; const float* w_down = (const float*)A->in[7];
    const float* ffn_norm = (const float*)A->in[4]; const float* attn_norm = (const float*)A->in[8];
    const float* w_out = (const float*)A->in[12];
    const float* w_in = (const float*)(L == 0 ? A->in[13] : L == 1 ? A->in[16] : L == 2 ? A->in[23] : A->in[25]);
    const int nin = (L == 0 ? 6672 : L == 1 ? 1600 : L == 2 ? 18944 : 4688);
    const int I_GU = 32 * 88, I_D = 88 * 32, I_IN = 32 * ((nin + 63) / 64), I_OUT = 40 * 32, I_UQ = (L == 1) ? 8 * 48 : 0;
    TrDesc d; d.f8 = 0; d.tiled = 0; int r = it;
    if (r < 4 * I_GU) { const int s = r / I_GU; r -= s * I_GU; const int f = s >> 1, up = s & 1;
        d.W = (up ? w_up : w_gate) + (size_t)(L * 2 + f) * DM * DFF; d.K = DM; d.N = DFF; d.gain = ffn_norm + (size_t)(L * 2 + f) * DM; d.WT = WB + (f ? WB_GU1 : WB_GU0); d.ldt = DM; d.kind = up ? 2 : 1; d.f8 = F8FFNL(L, f); }
    else { r -= 4 * I_GU;
        if (r < 2 * I_D) { const int f = r / I_D; r -= f * I_D; d.W = w_down + (size_t)(L * 2 + f) * DFF * DM; d.K = DFF; d.N = DM; d.gain = nullptr; d.WT = WB + (f ? WB_D1 : WB_D0); d.ldt = DFF; d.kind = 0; d.tiled = 1; d.f8 = F8FFNDL(L, f); }
        else { r -= 2 * I_D;
            if (r < I_IN) { d.W = w_in; d.K = DM; d.N = nin; d.gain = attn_norm + (size_t)L * DM; d.WT = WB + WB_IN; d.ldt = DM; d.kind = 3 + L; d.f8 = F8LAYER(L) ? 1 : 0; }
            else { r -= I_IN;
                if (r < I_OUT) { d.W = w_out + (size_t)L * OUTIN * DM; d.K = OUTIN; d.N = DM; d.gain = nullptr; d.WT = WB + WB_OUT; d.ldt = OUTIN; d.kind = 0;
                    d.f8 = F8OUTL(L);
                }
                else { r -= I_OUT;
                    if (r < I_UQ) { d.W = (const float*)A->in[18]; d.K = 512; d.N = 3072; d.gain = (const float*)A->in[17]; d.WT = WB + WB_UQ; d.ldt = 512; d.kind = 0; }
                    else { r -= I_UQ; d.W = (const float*)A->in[20]; d.K = 512; d.N = 4096; d.gain = (const float*)A->in[19]; d.WT = WB + WB_UKV; d.ldt = 512; d.kind = 0; } } } } }
    d.r = r; return d;
}
__device__ __forceinline__ void convert_layer(const Fr& F, ArgsPc A, int L, bf16_t* WB) {
    const int nin = (L == 0 ? 6672 : L == 1 ? 1600 : L == 2 ? 18944 : 4688);
    const int total = 4 * 32 * 88 + 2 * 88 * 32 + 32 * ((nin + 63) / 64) + 40 * 32 + ((L == 1) ? 8 * 48 + 8 * 64 : 0);
    LAS float* scr = (LAS float*)(F.lds + F.wave * 16640);
    f32x4 va[16], vb[16]; int it = F.gw;
    if (it >= total) return;
    TrDesc da = tr_desc(A, L, WB, it), db = da; tr_load(da, F.lane, va);
    for (;;) {
        const bool nb_ = it + F.ngw < total; if (nb_) { db = tr_desc(A, L, WB, it + F.ngw); tr_load(db, F.lane, vb); }
        tr_store(da, F.lane, va, scr); it += F.ngw; if (!nb_) break;
        const bool na_ = it + F.ngw < total; if (na_) { da = tr_desc(A, L, WB, it + F.ngw); tr_load(da, F.lane, va); }
        tr_store(db, F.lane, vb, scr); it += F.ngw; if (!na_) break;
    }
}

#define MIXP(off_) (o8_ ? (bf16_t*)((unsigned char*)MIX + (off_)) : MIX + (off_))
__device__ __forceinline__ void mem_attn_units(const Fr& F, const bf16_t* P, long ldp, int memq_col, const bf16_t* MEMKV, bf16_t* MIX, int o8_) {
    for (int i = blockIdx.x; i < 512; i += F.G) {
        const int b = i >> 6, mh = (i >> 4) & 3, qb = i & 15; const size_t tok = (size_t)b * SEQ + qb * 256;
        att::AP a{}; a.Q = P + tok * ldp + memq_col + mh * 128; a.qs = ldp; a.K = MEMKV + (size_t)b * NMEM * 4096 + mh * 128; a.ks = 4096; a.V = a.K + 512; a.vs = 4096;
        a.O = MIXP(tok * OUTIN + 2048 + mh * 128); a.o8 = o8_; a.os = OUTIN; a.kt0 = 0; a.nt = 4; a.q0 = 0; a.C = 0.08838834764831845f * LOG2E;
        att::attn_unit<att::K_MEM, 128>(F.lds, a, F.wave);
    }
}
__device__ __forceinline__ void causal_unit_ids(int i, int& b, int& h, int& qb) {
    const int slot = i >> 8, c = i & 255, bh = (c >> 4) * 8 + (c & 7), half = (c >> 3) & 1;
    qb = half ? ((slot & 1) ? slot : 14 - slot) : ((slot & 1) ? slot - 1 : 15 - slot); b = bh >> 4; h = bh & 15;
}

__device__ __forceinline__ Fr mk_frame(unsigned char* lds_raw, int wave_id) {
    Fr F; F.lds = (LAS unsigned char*)lds_raw; F.tid = tid_opaque(wave_id); F.lane = F.tid & 63; F.wave = __builtin_amdgcn_readfirstlane(F.tid >> 6);
    F.G = gridDim.x; { const int bx = blockIdx.x; F.vcu = (F.G % 8 == 0) ? (bx % 8) * (F.G / 8) + bx / 8 : bx; }
    F.gw = F.vcu * 8 + F.wave; F.ngw = F.G * 8; return F;
}
typedef const __attribute__((address_space(4))) Args* ArgsP;
__device__ __forceinline__ ArgsP args_ptr() { auto p = __builtin_amdgcn_kernarg_segment_ptr(); asm volatile("" : "+s"(p)); return (ArgsP)p; }
#define WSP(T, off) ((T*)(AP_->ws + (off)))
#define SCRP(T, mib) ((T*)(AP_->ws + WS_SCR + (size_t)(mib) * MiB))

__global__ void __launch_bounds__(512, 2) fwd(Args A) {
    extern __shared__ __attribute__((aligned(16))) unsigned char lds_raw[];
    { LAS unsigned* z = (LAS unsigned*)((LAS unsigned char*)lds_raw + RING_BYTES); for (int u = threadIdx.x; u < (LDS_BYTES - RING_BYTES) / 4; u += 512) z[u] = 0u; }
    __syncthreads();
    const int lo = A.ph_lo, hi = A.ph_hi; const int wave_id = __builtin_amdgcn_readfirstlane((int)threadIdx.x >> 6);
    XcdBarrier bar; bar.bar = (unsigned*)(A.ws + WS_CTL) + CW_BAR; bar.x = 0; bar.st = nullptr;
    if (hi - lo > 1) bar = xcd_barrier_post((unsigned*)(A.ws + WS_CTL) + CW_BAR, (volatile LAS unsigned*)((LAS unsigned char*)lds_raw + MISC_OFF) + 8);
    int ph = 0;
#ifdef TMASK
    unsigned long long tacc_ = 0ull, tb_ = 0ull;
#define PH_BEGIN if (ph >= lo && ph < hi) { if ((TMASK >> ph) & 1ull) tb_ = __builtin_amdgcn_s_memrealtime(); const Fr F = mk_frame(lds_raw, wave_id); const ArgsP AP_ = args_ptr();
#define PH_END   if (ph + 1 < hi) xcd_barrier(bar); if ((TMASK >> ph) & 1ull) tacc_ += __builtin_amdgcn_s_memrealtime() - tb_; } ++ph;
#else
#define PH_BEGIN if (ph >= lo && ph < hi) { const Fr F = mk_frame(lds_raw, wave_id); const ArgsP AP_ = args_ptr();
#define PH_END   if (ph + 1 < hi) xcd_barrier(bar); } ++ph;
#endif
    const float SC128 = 0.08838834764831845f * LOG2E, SC192 = 0.07216878364870323f * LOG2E;

    PH_BEGIN
        rows2048(F, (const float*)AP_->in[1], NB * NMEM, WSP(bf16_t, WS_MEMB), WSP(float, WS_RSMEM), 1);
        rope_table(F, (const int*)AP_->in[2], WSP(float, WS_COS), WSP(float, WS_SIN));
        rows2048(F, (const float*)AP_->in[0], MTOK, WSP(bf16_t, WS_XB), WSP(u64, WS_SSQ), 0);
#ifdef RZ
        { u32x4* z = WSP(u32x4, WS_END); for (size_t i = (size_t)F.vcu * 512 + F.tid; i < (size_t)2 * DFF * DM * 2 / 16; i += (size_t)F.G * 512) z[i] = (u32x4){0u, 0u, 0u, 0u}; }
#endif
        { LAS float* scr = (LAS float*)(F.lds + F.wave * 16640);
          for (int it = F.gw; it < 4 * 512; it += F.ngw) { const int Lm = it >> 9; TrDesc d; d.W = (const float*)AP_->in[10] + (size_t)Lm * DM * 1024; d.K = DM; d.N = 1024; d.gain = (const float*)AP_->in[9] + (size_t)Lm * DM;
              d.WT = SCRP(bf16_t, 0) + (size_t)Lm * 1024 * DM; d.ldt = DM; d.kind = 0; d.f8 = 0; d.tiled = 0; d.r = it & 511; f32x4 v[16]; tr_load(d, F.lane, v); tr_store(d, F.lane, v, scr); } }
    PH_END
    PH_BEGIN { pg8::Gemm g{WSP(bf16_t, WS_MEMB), SCRP(bf16_t, 0), NB * NMEM, 4096, DM, DM, DM, 0}; pg8::StaticOrder S; S.init(g.M, g.N, F.G, (int)blockIdx.x);
        pg8::EpiProj E{WSP(bf16_t, WS_MEMKV), 4096, WSP(float, WS_RSMEM), 0, nullptr, -1, (const float*)AP_->in[11] + 128, 0, 0, nullptr, 0, 0, nullptr, 0, 0, 1.0f, 4, 2, 256}; pg8::gemm_phase(F.lds, g, S, E, F.tid); } PH_END

    int ver = 0;
#pragma clang loop unroll(full)
    for (int hl = 0; hl < 8; ++hl) {
        const int L = hl >> 1, f = hl & 1;
        if (f == 0) {
            PH_BEGIN REP(RCV) convert_layer(F, AP_, L, WSP(bf16_t, WS_WB)); PH_END

        }
        PH_BEGIN
#ifdef RZ
            { pg8::Gemm g{WSP(bf16_t, WS_XB), WSP(bf16_t, WS_END), MTOK, 2 * DFF, DM, DM, DM, 0}; pg8::StaticOrder S; S.init(g.M, g.N, F.G, (int)blockIdx.x);
              pg8::EpiSwiGLU E{SCRP(bf16_t, 0), DFF, WSP(u64, WS_SSQ) + (size_t)ver * MTOK, 1.0f, 0}; pg8::gemm_phase(F.lds, g, S, E, F.tid); }
#endif
            REP(RG) { const bool f8_ = F8FFNL(L, f);
            pg8::Gemm g = f8_ ? pg8::Gemm{WSP(bf16_t, WS_XB8), WSP(bf16_t, WS_WB) + (f ? WB_GU1 : WB_GU0), MTOK, 2 * DFF, DM / 2, DM / 2, DM / 2, 0}
                              : pg8::Gemm{WSP(bf16_t, WS_XB), WSP(bf16_t, WS_WB) + (f ? WB_GU1 : WB_GU0), MTOK, 2 * DFF, DM, DM, DM, 0}; pg8::StaticOrder S; S.init(g.M, g.N, F.G, (int)blockIdx.x);
            pg8::EpiSwiGLU E{SCRP(bf16_t, 0), DFF, WSP(u64, WS_SSQ) + (size_t)ver * MTOK, f8_ ? (1.0f / 64.0f) : 1.0f, F8FFNDL(L, f)};
            if (f8_) pg8::gemm_phase<F8MODE>(F.lds, g, S, E, F.tid); else pg8::gemm_phase<0>(F.lds, g, S, E, F.tid); } PH_END
        if (F8FFNDL(L, f)) { PH_BEGIN { pg8::Gemm g{SCRP(bf16_t, 0), WSP(bf16_t, WS_WB) + (f ? WB_D1 : WB_D0), MTOK, DM, DFF / 2, DFF / 2, DFF / 2, 1, 1};   pg8::StaticOrder S; S.init(g.M, g.N, F.G, (int)blockIdx.x);
            pg8::EpiResid E{ver == 0 ? (const float*)AP_->in[0] : AP_->out, AP_->out, WSP(bf16_t, WS_XB), WSP(u64, WS_SSQ) + (size_t)(ver + 1) * MTOK, nullptr, 0.5f / 512.0f}; pg8::gemm_phase<F8MODE>(F.lds, g, S, E, F.tid); } PH_END }
        else { PH_BEGIN { pg8::Gemm g{SCRP(bf16_t, 0), WSP(bf16_t, WS_WB) + (f ? WB_D1 : WB_D0), MTOK, DM, DFF, DFF, DFF, 1, 1}; pg8::StaticOrder S; S.init(g.M, g.N, F.G, (int)blockIdx.x);
            if (RD > 1) { pg8::EpiResid E0{ver == 0 ? (const float*)AP_->in[0] : AP_->out, SCRP(float, 400), SCRP(bf16_t, 660), nullptr, nullptr, 0.5f};
#ifdef PROBE_PM
                pg8::Gemm g0 = g; g0.pm_and = PROBE_PM; pg8::gemm_phase(F.lds, g0, S, E0, F.tid);
#else
                pg8::gemm_phase(F.lds, g, S, E0, F.tid);
#endif
            }
            pg8::EpiResid E{ver == 0 ? (const float*)AP_->in[0] : AP_->out, AP_->out, WSP(bf16_t, WS_XB), WSP(u64, WS_SSQ) + (size_t)(ver + 1) * MTOK, (f == 0 && F8LAYER(L)) ? WSP(unsigned char, WS_XB8) : nullptr, 0.5f}; pg8::gemm_phase(F.lds, g, S, E, F.tid); } PH_END }
        ++ver;
        if (f != 0) continue;
        const int ngrp = (L == 2) ? 3 : 1;
#pragma clang loop unroll(full)
        for (int g = 0; g < ngrp; ++g) {
            PH_BEGIN REP(RI) { const int ldp = (L == 0) ? 6912 : (L == 1) ? 1792 : (L == 2) ? 6656 : 4864;
                const int nproj = (L == 2) ? (g == 0 ? 6656 : 6144) : ldp; const size_t roff = (L == 2) ? (g == 0 ? 0 : (g == 1 ? 6656 : 12800)) : 0;
                pg8::Gemm gm = F8LAYER(L) ? pg8::Gemm{WSP(bf16_t, WS_XB8), (const bf16_t*)((const unsigned char*)(WSP(bf16_t, WS_WB) + WB_IN) + roff * DM), MTOK, nproj, DM / 2, DM / 2, DM / 2, 0}
                                       : pg8::Gemm{WSP(bf16_t, WS_XB), WSP(bf16_t, WS_WB) + WB_IN + roff * DM, MTOK, nproj, DM, DM, DM, 0};
                pg8::StaticOrder S; S.init(gm.M, gm.N, F.G, (int)blockIdx.x);
                const float* gmq = (const float*)AP_->in[11] + (size_t)L * 256;
                const float* qg = (L == 0) ? (const float*)AP_->in[15] : (L == 2) ? (const float*)AP_->in[24] + (size_t)g * 256 : (L == 3) ? (const float*)AP_->in[26] : nullptr;
                const int kt_hi = (L == 3) ? 10 : 16, mq_lo = (L == 0 || L == 2) ? 24 : (L == 1) ? 5 : 17, mq_hi = (L == 2 && g > 0) ? mq_lo : mq_lo + 2;
                pg8::EpiProj E{SCRP(bf16_t, 0), ldp, WSP(u64, WS_SSQ) + (size_t)ver * MTOK, 1, (L == 0) ? SCRP(float, 432) : nullptr, 26,
                               qg, 0, (L == 1) ? 0 : 8, qg ? qg + 128 : nullptr, 8, (L == 1) ? 8 : kt_hi, gmq, mq_lo, mq_hi, F8LAYER(L) ? (1.0f / 64.0f) : 1.0f, 0, 0, 0}; if (F8LAYER(L)) pg8::gemm_phase<F8MODE>(F.lds, gm, S, E, F.tid); else pg8::gemm_phase<0>(F.lds, gm, S, E, F.tid); } PH_END
            if (L == 0) { PH_BEGIN fox_cumsum(F, SCRP(const float, 432), (const float*)AP_->in[14], SCRP(float, 434)); PH_END }
            if (L == 1) { PH_BEGIN mla_prep_a(F, SCRP(bf16_t, 0), WSP(float, WS_RSQ), WSP(float, WS_RSKV), SCRP(bf16_t, 752), (const float*)AP_->in[22] + 64, nullptr, WSP(float, WS_COS), WSP(float, WS_SIN)); PH_END }
            if (L == 1) {
                PH_BEGIN
                    REP(RI) for (int i = 0; i < 2; ++i) { pg8::Gemm gm{SCRP(bf16_t, 0) + (i ? 512 : 0), WSP(bf16_t, WS_WB) + (i ? WB_UKV : WB_UQ), MTOK, i ? 4096 : 3072, 512, 1792, 512, 0}; pg8::StaticOrder S; S.init(gm.M, gm.N, F.G, (int)blockIdx.x);
                        pg8::EpiProj E{i ? SCRP(bf16_t, 304) : SCRP(bf16_t, 112), i ? 4096 : 3072, i ? WSP(float, WS_RSKV) : WSP(float, WS_RSQ), 0, nullptr, -1, nullptr, 0, 0, nullptr, 0, 0, nullptr, 0, 0, 1.0f, 0, 0, 0}; pg8::gemm_phase(F.lds, gm, S, E, F.tid); }
                PH_END
                PH_BEGIN mla_prep_b(F, SCRP(bf16_t, 112), SCRP(const bf16_t, 304), SCRP(bf16_t, 560), SCRP(const bf16_t, 752), (const float*)AP_->in[21], (const float*)AP_->in[22], WSP(float, WS_COS), WSP(float, WS_SIN)); PH_END
            }
            if (L == 3) {
                PH_BEGIN REP(RIX) dsa_indexer(F, SCRP(const bf16_t, 0), SCRP(float, 304)); PH_END
                PH_BEGIN REP(RSL) dsa_select(F, SCRP(const float, 304), SCRP(u64, 816)); PH_END
            }
            PH_BEGIN
                bf16_t* P = SCRP(bf16_t, 0); bf16_t* MIX = WSP(bf16_t, WS_MIX); const int o8_ = F8OUTL(L);
                const long ldp = (L == 0) ? 6912 : (L == 1) ? 1792 : (L == 2) ? 6656 : 4864;
                REP(L == 2 ? 1 : RA) {
                if (L == 0) {
                    const float* CUM = SCRP(const float, 434);
                    for (int i = blockIdx.x; i < 2048; i += F.G) { int b, h, qb; causal_unit_ids(i, b, h, qb); const size_t t0 = (size_t)b * SEQ;
                        att::AP a{}; a.Q = P + (t0 + qb * 256) * ldp + h * 128; a.qs = ldp; a.K = P + t0 * ldp + 2048 + h * 128; a.ks = ldp; a.V = a.K + 2048; a.vs = ldp;
                        a.O = MIXP((t0 + qb * 256) * OUTIN + h * 128); a.o8 = o8_; a.os = OUTIN; a.kt0 = 0; a.nt = 4 * (qb + 1); a.q0 = qb * 256; a.C = SC128; a.cum = CUM + t0 * 16 + h; a.cums = 16;
                        att::attn_unit<att::K_FOX, 128>(F.lds, a, F.wave); }
                }
                if (L == 1) {
                    const bf16_t* Qb = SCRP(const bf16_t, 112); const bf16_t* KVb = SCRP(const bf16_t, 304); const bf16_t* KF = SCRP(const bf16_t, 560);
                    for (int i = blockIdx.x; i < 2048; i += F.G) { int b, h, qb; causal_unit_ids(i, b, h, qb); const size_t t0 = (size_t)b * SEQ;
                        att::AP a{}; a.Q = Qb + (t0 + qb * 256) * 3072 + h * 192; a.qs = 3072; a.K = KF + t0 * 3072 + h * 192; a.ks = 3072; a.V = KVb + t0 * 4096 + h * 256 + 128; a.vs = 4096;
                        a.O = MIXP((t0 + qb * 256) * OUTIN + h * 128); a.o8 = o8_; a.os = OUTIN; a.kt0 = 0; a.nt = 4 * (qb + 1); a.q0 = qb * 256; a.C = SC192;
                        att::attn_unit<att::K_MLA, 192>(F.lds, a, F.wave); }
                }
                if (L == 2) {
                    const int dil = (g == 0) ? 1 : (g == 1 ? 4 : 16), nblk = 16 / dil; float* OST = SCRP(float, 416); float* ML = SCRP(float, 672);
                    for (int i = blockIdx.x; i < 2048; i += F.G) { const int h = i & 15, rest = i >> 4, b = rest >> 4, rj = rest & 15, r = rj / nblk, jb = rj % nblk;
                        const size_t tokz = (size_t)b * SEQ + r, tokq = tokz + (size_t)jb * 256 * dil;
                        att::AP a{}; a.Q = P + tokq * ldp + h * 128; a.qs = (long)dil * ldp; a.K = P + tokz * ldp + 2048 + h * 128; a.ks = (long)dil * ldp; a.V = a.K + 2048; a.vs = a.ks;
                        a.O = MIXP(tokq * OUTIN + h * 128); a.o8 = o8_; a.os = (long)dil * OUTIN; a.q0 = jb * 256; a.kt0 = jb == 0 ? 0 : 4 * jb - 2; a.nt = jb == 0 ? 4 : 6; a.C = SC128;
                        a.ost = OST + tokq * 1024 + h * 64; a.osts = (long)dil * 1024; a.mst = ML + (tokq * 16 + h) * 2; a.msts = (long)dil * 32; a.carry_in = g > 0; a.carry_out = g < 2;
                        a.t5 = (const float*)AP_->in[3]; a.head = h; a.dil = dil;
                        att::attn_unit<att::K_DIL, 128>(F.lds, a, F.wave); }
                }
                if (L == 3) {
                    const u64* MSK = SCRP(const u64, 816);
                    for (int i = blockIdx.x; i < 2048; i += F.G) { int b, h, qb; causal_unit_ids(i, b, h, qb); const size_t t0 = (size_t)b * SEQ;
                        att::AP a{}; a.Q = P + (t0 + qb * 256) * ldp + h * 128; a.qs = ldp; a.K = P + t0 * ldp + 2048 + (h >> 2) * 128; a.ks = ldp; a.V = a.K + 512; a.vs = ldp;
                        a.O = MIXP((t0 + qb * 256) * OUTIN + h * 128); a.o8 = o8_; a.os = OUTIN; a.kt0 = 0; a.nt = 4 * (qb + 1); a.q0 = qb * 256; a.C = SC128; a.msk = MSK + (t0 + qb * 256) * 64; a.t5 = (const float*)AP_->in[3]; a.head = h;
                        att::attn_unit<att::K_DSA, 128>(F.lds, a, F.wave); }
                }
                if (g == 0) { const int memq_col = (L == 0) ? 6144 : (L == 1) ? 1280 : (L == 2) ? 6144 : 4352; mem_attn_units(F, P, ldp, memq_col, WSP(const bf16_t, WS_MEMKV) + L * 1024, MIX, o8_); }
                }
            PH_END
        }
        if (F8OUTL(L)) { PH_BEGIN { pg8::Gemm gm{WSP(bf16_t, WS_MIX), WSP(bf16_t, WS_WB) + WB_OUT, MTOK, DM, OUTIN / 2, OUTIN / 2, OUTIN / 2, 0};   pg8::StaticOrder S; S.init(gm.M, gm.N, F.G, (int)blockIdx.x);
            pg8::EpiResid E{AP_->out, AP_->out, WSP(bf16_t, WS_XB), WSP(u64, WS_SSQ) + (size_t)(ver + 1) * MTOK, F8FFNL(L, 1) ? WSP(unsigned char, WS_XB8) : nullptr, 1.0f / 1024.0f}; pg8::gemm_phase<F8MODE>(F.lds, gm, S, E, F.tid); } PH_END }
        else { PH_BEGIN { pg8::Gemm gm{WSP(bf16_t, WS_MIX), WSP(bf16_t, WS_WB) + WB_OUT, MTOK, DM, OUTIN, OUTIN, OUTIN, 0}; pg8::StaticOrder S; S.init(gm.M, gm.N, F.G, (int)blockIdx.x);
            if (RD > 1) { pg8::EpiResid E0{AP_->out, SCRP(float, 400), SCRP(bf16_t, 660), nullptr, nullptr, 1.0f}; pg8::gemm_phase(F.lds, gm, S, E0, F.tid); }
            pg8::EpiResid E{AP_->out, AP_->out, WSP(bf16_t, WS_XB), WSP(u64, WS_SSQ) + (size_t)(ver + 1) * MTOK, F8FFNL(L, 1) ? WSP(unsigned char, WS_XB8) : nullptr, 1.0f}; pg8::gemm_phase(F.lds, gm, S, E, F.tid); } PH_END }
        ++ver;
    }
#ifdef TMASK
    if (blockIdx.x == 0) { const unsigned long long t0_ = __builtin_amdgcn_s_memrealtime(); while (__builtin_amdgcn_s_memrealtime() - t0_ < tacc_ * (unsigned long long)TMUL) __builtin_amdgcn_s_sleep(8); }
#endif
#undef PH_BEGIN
#undef PH_END
}

#ifndef MK_ONE_LAUNCH
#define MK_ONE_LAUNCH 0
#endif
extern "C" void kernel_launch(void* const* d_in, const int* in_sizes, int n_in, void* d_out, int out_size, void* d_ws, size_t ws_size, hipStream_t stream) {
    static int grid = 0;
    if (grid == 0) {
        if (n_in != 27 || in_sizes[0] != MTOK * DM || out_size != MTOK * DM || ws_size < WS_END) {
            fprintf(stderr, "kernel_launch: unexpected shapes: n_in %d in0 %d out %d ws %zu (need >= %zu); nothing launched\n", n_in, n_in > 0 ? in_sizes[0] : -1, out_size, ws_size, (size_t)WS_END); grid = -1; return; }
        int dev = 0, cus = 0, per_cu = 0;
        if (hipGetDevice(&dev) != hipSuccess || hipDeviceGetAttribute(&cus, hipDeviceAttributeMultiprocessorCount, dev) != hipSuccess) { fprintf(stderr, "kernel_launch: device query failed\n"); grid = -1; return; }
        if (hipFuncSetAttribute((const void*)fwd, hipFuncAttributeMaxDynamicSharedMemorySize, LDS_BYTES) != hipSuccess) { fprintf(stderr, "kernel_launch: hipFuncSetAttribute failed\n"); grid = -1; return; }
        if (hipOccupancyMaxActiveBlocksPerMultiprocessor(&per_cu, (const void*)fwd, 512, LDS_BYTES) != hipSuccess || per_cu < 1)
            fprintf(stderr, "kernel_launch: note: occupancy query reports %d workgroups per CU\n", per_cu);
        (void)hipGetLastError();
        grid = cus;
    }
    if (grid < 0) return;
    if (hipMemsetAsync((char*)d_ws + WS_CTL, 0, CTL_ZERO_BYTES, stream) != hipSuccess) { fprintf(stderr, "kernel_launch: memset failed\n"); return; }
    Args a{};
    for (int i = 0; i < 27; ++i) a.in[i] = d_in[i];
    a.out = (float*)d_out; a.ws = (unsigned char*)d_ws;
#if MK_ONE_LAUNCH
    a.ph_lo = 0; a.ph_hi = NPHASES;
    hipLaunchKernelGGL(fwd, dim3(grid), dim3(512), LDS_BYTES, stream, a);
#else
#ifndef NPH_LIMIT
#define NPH_LIMIT NPHASES
#endif
    for (int p = 0; p < NPH_LIMIT; ++p) { a.ph_lo = p; a.ph_hi = p + 1; hipLaunchKernelGGL(fwd, dim3(grid), dim3(512), LDS_BYTES, stream, a); }
#endif
    const hipError_t le = hipPeekAtLastError();
    if (le != hipSuccess) fprintf(stderr, "kernel_launch: launch failed: %s\n", hipGetErrorName(le));
}
```

```cpp
#define MK_ONE_LAUNCH 1
#define F8FFN 192
#define F8FFND 192
#include <hip/hip_runtime.h>
#include <cstdio>
#include <cstdint>

#define LAS __attribute__((address_space(3)))
#define GAS __attribute__((address_space(1)))
typedef unsigned short bf16_t;
typedef short bf16x8 __attribute__((ext_vector_type(8)));
typedef short s16x4 __attribute__((ext_vector_type(4)));
typedef float f32x2 __attribute__((ext_vector_type(2)));
typedef float f32x4 __attribute__((ext_vector_type(4)));
typedef float f32x16 __attribute__((ext_vector_type(16)));
typedef unsigned u32x2 __attribute__((ext_vector_type(2)));
typedef unsigned u32x4 __attribute__((ext_vector_type(4)));
typedef unsigned long long u64;

constexpr int DM = 2048, NB = 8, SEQ = 4096, MTOK = NB * SEQ, DFF = 5632, NH = 16, HD = 128, NMEM = 256, MEMW = 512, OUTIN = 2560;
constexpr float RMS_EPS = 1e-6f;
constexpr float LOG2E = 1.4426950408889634f;

__device__ __forceinline__ unsigned cvt_pk_bf16(float lo, float hi) { unsigned r; asm volatile("v_cvt_pk_bf16_f32 %0, %1, %2" : "=v"(r) : "v"(lo), "v"(hi)); return r; }
__device__ __forceinline__ float bf_lo(unsigned w) { return __uint_as_float(w << 16); }
__device__ __forceinline__ float bf_hi(unsigned w) { return __uint_as_float(w & 0xffff0000u); }

__device__ __forceinline__ int tid_opaque(int wave_id) {
    int l; asm volatile("v_mbcnt_lo_u32_b32 %0, -1, 0\n\tv_mbcnt_hi_u32_b32 %0, -1, %0" : "=v"(l)); return wave_id * 64 + l; }

namespace pg8 {
constexpr int BM = 256, BK = 64, HALF = 128, HTB = HALF * BK * 2, STAGE_BYTES = 8 * HTB, NXCD = 8, WGM = 8;
__host__ __device__ __forceinline__ int lds_byte(int r, int c) { const int st = (r >> 4) * 2 + (c >> 5), rr = r & 15, cc = c & 31, ob = rr * 64 + cc * 2; return st * 1024 + (ob ^ (((ob >> 9) & 1) << 5)); }
__host__ __device__ __forceinline__ void stage_rc(int b, int& R, int& C) { const int st = b / 1024, sb = b % 1024, swz = sb ^ (((sb >> 9) & 1) << 5); R = (st >> 1) * 16 + swz / 64; C = (st & 1) * 32 + (swz % 64) / 2; }
__host__ __device__ __forceinline__ int perm32(int rho) { const int n = rho >> 4, i = rho & 15; return 8 * (i >> 2) + 4 * n + (i & 3); }

struct Unit { int pm, pn; };
struct Gemm { const bf16_t* A; const bf16_t* Bt; int M, N, K, lda, ldb; int a_tiled; int b_tiled; int pm_and; };

struct StaticOrder {
    int nM, nN, nwg, G, c, wgm;
    __host__ __device__ void init(int M, int N, int G_, int c_) { nM = M / BM; nN = N / BM; nwg = nM * nN; G = G_; c = c_; wgm = (nN == 8) ? 4 : WGM; }
    __host__ __device__ bool next(int i, Unit& u) const {
        const long L = (long)i * G + c; if (L >= nwg) return false;
        int wgid = (int)L; { const int q = nwg / NXCD, r = nwg % NXCD, xcd = wgid % NXCD, off = wgid / NXCD; wgid = (xcd < r ? xcd * (q + 1) : r * (q + 1) + (xcd - r) * q) + off; }
        const int nig = wgm * nN, gid = wgid / nig, fm = gid * wgm, gsz = (nM - fm) < wgm ? (nM - fm) : wgm;
        u.pm = fm + ((wgid % nig) % gsz); u.pn = (wgid % nig) / gsz; return true;
    }
};

constexpr float SSQ_SCALE = 16777216.0f;
__device__ __forceinline__ float rs_from_ssq(const u64 v) { return __builtin_amdgcn_rsqf((float)v * (1.0f / (SSQ_SCALE * DM)) + RMS_EPS); }
__device__ __forceinline__ float rs_of(const void* rsv, int row, int mode) { return mode ? rs_from_ssq(((const u64*)rsv)[row]) : ((const float*)rsv)[row]; }

struct EpiProj {
    bf16_t* O; int ldc; const void* rsv; int rs_mode;
    float* fgout; int fg_tile;
    const float* g0; int t0a, t0b; const float* g1; int t1a, t1b; const float* g2; int t2a, t2b;
    float oscale;
    int gper, gcnt, gstride;
    __device__ __forceinline__ void operator()(f32x4 (&acc)[2][2][4][2], const Unit& u, int wr, int wc, int fr, int fq, LAS unsigned char* xlds) const {
        const int row0 = u.pm * BM + wr * 64 + fr; const int col0 = u.pn * BM + wc * 32 + 8 * fq;
        const float* gain = (u.pn >= t0a && u.pn < t0b) ? g0 : (u.pn >= t1a && u.pn < t1b) ? g1 : (u.pn >= t2a && u.pn < t2b) ? g2 : nullptr;
        if (gper) gain = (u.pn % gper < gcnt) ? g0 + (size_t)(u.pn / gper) * gstride : nullptr;
        float rsa[2][4];
#pragma unroll
        for (int ai = 0; ai < 2; ++ai)
#pragma unroll
            for (int m = 0; m < 4; ++m) rsa[ai][m] = rs_of(rsv, row0 + ai * HALF + m * 16, rs_mode) * oscale;
#pragma unroll
        for (int ai = 0; ai < 2; ++ai)
#pragma unroll
            for (int m = 0; m < 4; ++m) { const float rs = rsa[ai][m];
#pragma unroll
                for (int bj = 0; bj < 2; ++bj) { acc[ai][bj][m][0] *= rs; acc[ai][bj][m][1] *= rs; } }
        if (gain) {
            LAS float* part = (LAS float*)xlds;
#pragma unroll
            for (int ai = 0; ai < 2; ++ai)
#pragma unroll
                for (int m = 0; m < 4; ++m)
#pragma unroll
                    for (int bj = 0; bj < 2; ++bj) { const f32x4 a = acc[ai][bj][m][0], b = acc[ai][bj][m][1];
                        float ss = ((a[0] * a[0] + a[1] * a[1]) + (a[2] * a[2] + a[3] * a[3])) + ((b[0] * b[0] + b[1] * b[1]) + (b[2] * b[2] + b[3] * b[3]));
                        ss += __shfl_xor(ss, 16); ss += __shfl_xor(ss, 32);
                        if (fq == 0) part[((ai * HALF + wr * 64 + m * 16 + fr) * 2 + bj) * 4 + wc] = ss; }
            asm volatile("s_waitcnt lgkmcnt(0)" ::: "memory"); __builtin_amdgcn_s_barrier(); asm volatile("" ::: "memory");
            const f32x4 gv0 = *(const f32x4*)(gain + wc * 32 + 8 * fq), gv1 = *(const f32x4*)(gain + wc * 32 + 8 * fq + 4);
#pragma unroll
            for (int ai = 0; ai < 2; ++ai)
#pragma unroll
                for (int m = 0; m < 4; ++m)
#pragma unroll
                    for (int bj = 0; bj < 2; ++bj) { const f32x4 p4 = *(const LAS f32x4*)(part + ((ai * HALF + wr * 64 + m * 16 + fr) * 2 + bj) * 4);
                        const float r2 = __builtin_amdgcn_rsqf(((p4[0] + p4[1]) + (p4[2] + p4[3])) * (1.0f / 128.0f) + RMS_EPS);
                        acc[ai][bj][m][0] *= gv0 * r2; acc[ai][bj][m][1] *= gv1 * r2; }
        }
#pragma unroll
        for (int ai = 0; ai < 2; ++ai)
#pragma unroll
            for (int m = 0; m < 4; ++m) { const int row = row0 + ai * HALF + m * 16;
                bf16_t* rowp = O + (size_t)row * ldc + col0;
#pragma unroll
                for (int bj = 0; bj < 2; ++bj) { const f32x4 v0 = acc[ai][bj][m][0], v1 = acc[ai][bj][m][1];
                    u32x4 w; w.x = cvt_pk_bf16(v0[0], v0[1]); w.y = cvt_pk_bf16(v0[2], v0[3]); w.z = cvt_pk_bf16(v1[0], v1[1]); w.w = cvt_pk_bf16(v1[2], v1[3]);
                    *(u32x4*)(rowp + bj * HALF) = w;
                    if (fgout && bj == 0 && u.pn == fg_tile && wc == 0 && fq < 2) { float* fp = fgout + (size_t)row * 16 + 8 * fq; *(f32x4*)fp = v0; *(f32x4*)(fp + 4) = v1; } } }
    }
};
struct EpiSwiGLU {
    bf16_t* O; int ldc; const u64* ssq; float oscale; int h8;
    __device__ __forceinline__ void operator()(f32x4 (&acc)[2][2][4][2], const Unit& u, int wr, int wc, int fr, int fq, LAS unsigned char*) const {
        const int row0 = u.pm * BM + wr * 64 + fr; const int col0 = u.pn * HALF + wc * 32 + 8 * fq;
        float rsv[2][4];
#pragma unroll
        for (int ai = 0; ai < 2; ++ai)
#pragma unroll
            for (int m = 0; m < 4; ++m) rsv[ai][m] = rs_from_ssq(ssq[row0 + ai * HALF + m * 16]) * oscale;
#pragma unroll
        for (int ai = 0; ai < 2; ++ai)
#pragma unroll
            for (int m = 0; m < 4; ++m) { const int row = row0 + ai * HALF + m * 16; const float rs = rsv[ai][m];
                float h[8];
#pragma unroll
                for (int n = 0; n < 2; ++n)
#pragma unroll
                    for (int j = 0; j < 4; ++j) { const float g = acc[ai][0][m][n][j] * rs, uu = acc[ai][1][m][n][j] * rs;
                        const float e = __builtin_amdgcn_exp2f(-g * LOG2E); h[n * 4 + j] = g * __builtin_amdgcn_rcpf(1.0f + e) * uu; }
                if (h8) {
                    int q0 = __builtin_amdgcn_cvt_pk_fp8_f32(h[0] * 8.f, h[1] * 8.f, 0, false); q0 = __builtin_amdgcn_cvt_pk_fp8_f32(h[2] * 8.f, h[3] * 8.f, q0, true);
                    int q1 = __builtin_amdgcn_cvt_pk_fp8_f32(h[4] * 8.f, h[5] * 8.f, 0, false); q1 = __builtin_amdgcn_cvt_pk_fp8_f32(h[6] * 8.f, h[7] * 8.f, q1, true);
                    const int kt8 = col0 >> 7, hh8 = (row >> 7) & 1;
                    __builtin_nontemporal_store((u32x2){(unsigned)q0, (unsigned)q1}, (u32x2*)((unsigned char*)O + ((size_t)((size_t)u.pm * (ldc >> 7) + kt8) * 2 + hh8) * (size_t)HTB + (size_t)(row & 127) * 128 + (col0 & 127)));
                    continue; }
                u32x4 w; w.x = cvt_pk_bf16(h[0], h[1]); w.y = cvt_pk_bf16(h[2], h[3]); w.z = cvt_pk_bf16(h[4], h[5]); w.w = cvt_pk_bf16(h[6], h[7]);
                const int kt = col0 >> 6, hh = (row >> 7) & 1;
                __builtin_nontemporal_store(w, (u32x4*)(O + ((size_t)((size_t)u.pm * (ldc >> 6) + kt) * 2 + hh) * (HALF * BK) + (size_t)(row & 127) * BK + (col0 & 63))); }
    }
};
struct EpiResid {
    const float* xin; float* xout; bf16_t* xb; u64* ssq_out; unsigned char* xb8; float alpha;
    __device__ __forceinline__ void operator()(f32x4 (&acc)[2][2][4][2], const Unit& u, int wr, int wc, int fr, int fq, LAS unsigned char*) const {
        const int row0 = u.pm * BM + wr * 64 + fr; const int col0 = u.pn * BM + wc * 32 + 8 * fq;
#pragma unroll
        for (int ai = 0; ai < 2; ++ai) {
            f32x4 xi[4][2][2];
#pragma unroll
            for (int m = 0; m < 4; ++m) { const size_t off = (size_t)(row0 + ai * HALF + m * 16) * DM + col0;
#pragma unroll
                for (int bj = 0; bj < 2; ++bj) { xi[m][bj][0] = __builtin_nontemporal_load((const f32x4*)(xin + off + bj * HALF)); xi[m][bj][1] = __builtin_nontemporal_load((const f32x4*)(xin + off + bj * HALF + 4)); } }
            asm volatile("" ::: "memory");
#pragma unroll
            for (int m = 0; m < 4; ++m) { const int row = row0 + ai * HALF + m * 16; const size_t off = (size_t)row * DM + col0; float ss = 0.f;
#pragma unroll
                for (int bj = 0; bj < 2; ++bj) {
                    const f32x4 v0 = xi[m][bj][0] + acc[ai][bj][m][0] * alpha, v1 = xi[m][bj][1] + acc[ai][bj][m][1] * alpha;
                    __builtin_nontemporal_store(v0, (f32x4*)(xout + off + bj * HALF)); __builtin_nontemporal_store(v1, (f32x4*)(xout + off + bj * HALF + 4));
                    u32x4 w; w.x = cvt_pk_bf16(v0[0], v0[1]); w.y = cvt_pk_bf16(v0[2], v0[3]); w.z = cvt_pk_bf16(v1[0], v1[1]); w.w = cvt_pk_bf16(v1[2], v1[3]);
                    *(u32x4*)(xb + off + bj * HALF) = w;
                    if (xb8) { int q0 = __builtin_amdgcn_cvt_pk_fp8_f32(v0[0], v0[1], 0, false); q0 = __builtin_amdgcn_cvt_pk_fp8_f32(v0[2], v0[3], q0, true);
                               int q1 = __builtin_amdgcn_cvt_pk_fp8_f32(v1[0], v1[1], 0, false); q1 = __builtin_amdgcn_cvt_pk_fp8_f32(v1[2], v1[3], q1, true);
                               *(u32x2*)(xb8 + off + bj * HALF) = (u32x2){(unsigned)q0, (unsigned)q1}; }
                    ss += (v0[0] * v0[0] + v0[1] * v0[1]) + (v0[2] * v0[2] + v0[3] * v0[3]) + (v1[0] * v1[0] + v1[1] * v1[1]) + (v1[2] * v1[2] + v1[3] * v1[3]); }
                if (ssq_out) { ss += __shfl_xor(ss, 16); ss += __shfl_xor(ss, 32); if (fq == 0) atomicAdd(ssq_out + row, (u64)(ss * SSQ_SCALE)); } }
            asm volatile("" ::: "memory");
        }
    }
};

template <int FP8 = 0, class Epi, class Sched>
__device__ __forceinline__ void gemm_phase(LAS unsigned char* lds, const Gemm g, const Sched& S, const Epi& E, const int tid) {
    const int wid = __builtin_amdgcn_readfirstlane(tid >> 6), lane = tid & 63, wr = wid >> 2, wc = wid & 3, fr = lane & 15, fq = lane >> 4;
    const int K = g.K, nt = K / BK;
    unsigned voffA[2], voffB[2];
#pragma unroll
    for (int i = 0; i < 2; ++i) { int R, C; stage_rc(tid * 16 + i * 8192, R, C); const int Rb = (R & ~31) + perm32(R & 31);
        voffA[i] = (unsigned)(R * (g.a_tiled ? BK : g.lda) + C) * 2u; voffB[i] = (unsigned)(Rb * (g.b_tiled ? BK : g.ldb) + C) * 2u; }
    const size_t kstep = (size_t)(BK * 2), kstepA = g.a_tiled ? (size_t)(2 * HTB) : kstep, kstepB = g.b_tiled ? (size_t)(2 * HTB) : kstep;
    const size_t hstepA = g.a_tiled ? (size_t)HTB : (size_t)HALF * g.lda * 2, hstepB = g.b_tiled ? (size_t)HTB : (size_t)HALF * g.ldb * 2;
    const size_t tstepA = g.a_tiled ? (size_t)nt * 2 * HTB : 2 * hstepA, tstepB = g.b_tiled ? (size_t)nt * 2 * HTB : 2 * hstepB;
    const unsigned ldsw = (unsigned)wid * 1024u;
    const int aoff = lds_byte(wr * 64 + fr, fq * 8), boff = lds_byte(wc * 32 + fr, fq * 8);
#define PG8_SA(b, h) (((b) * 2 + (h)) * HTB)
#define PG8_SB(b, h) ((4 + (b) * 2 + (h)) * HTB)
#define PG8_STAGE(bufoff, gbase, voff) do { _Pragma("unroll") for (int _i = 0; _i < 2; ++_i) \
        __builtin_amdgcn_global_load_lds((const unsigned*)((const char*)(gbase) + (voff)[_i]), (LAS unsigned*)(lds + (bufoff) + ldsw + _i * 8192), 16, 0, 0); } while (0)
#define PG8_LD8(p_) __builtin_shufflevector(*(const LAS i32x4_t*)(p_), *(const LAS i32x4_t*)((p_) + 1024), 0, 1, 2, 3, 4, 5, 6, 7)
#define PG8_LDA(dst, b, h) do { if constexpr (FP8 == 2) { _Pragma("unroll") for (int m = 0; m < 4; ++m) dst##8[m] = PG8_LD8(lds + PG8_SA(b, h) + aoff + m * 2048); } \
        else { _Pragma("unroll") for (int m = 0; m < 4; ++m) _Pragma("unroll") for (int k = 0; k < 2; ++k) dst[m][k] = *(const LAS bf16x8*)(lds + PG8_SA(b, h) + aoff + m * 2048 + k * 1024); } } while (0)
#define PG8_LDB(dst, b, h) do { if constexpr (FP8 == 2) { _Pragma("unroll") for (int n = 0; n < 2; ++n) dst##8[n] = PG8_LD8(lds + PG8_SB(b, h) + boff + n * 2048); } \
        else { _Pragma("unroll") for (int n = 0; n < 2; ++n) _Pragma("unroll") for (int k = 0; k < 2; ++k) dst[n][k] = *(const LAS bf16x8*)(lds + PG8_SB(b, h) + boff + n * 2048 + k * 1024); } } while (0)
typedef long i64x2_t __attribute__((ext_vector_type(2)));
typedef int i32x4_t __attribute__((ext_vector_type(4)));
typedef int i32x8_t __attribute__((ext_vector_type(8)));
#define PG8_MMA(ai, bj, At, Bt) do { __builtin_amdgcn_s_setprio(1); \
        if constexpr (FP8 == 2) { _Pragma("unroll") for (int m = 0; m < 4; ++m) _Pragma("unroll") for (int n = 0; n < 2; ++n) \
            asm volatile("v_mfma_scale_f32_16x16x128_f8f6f4 %0, %1, %2, %0, %3, %3 op_sel_hi:[0,0,0]" : "+v"(acc[ai][bj][m][n]) : "v"(Bt##8[n]), "v"(At##8[m]), "v"(f8sc)); } \
        else if constexpr (FP8 == 1) { _Pragma("unroll") for (int m = 0; m < 4; ++m) _Pragma("unroll") for (int n = 0; n < 2; ++n) _Pragma("unroll") for (int k = 0; k < 2; ++k) { \
            const i64x2_t b_ = __builtin_bit_cast(i64x2_t, Bt[n][k]), a_ = __builtin_bit_cast(i64x2_t, At[m][k]); \
            acc[ai][bj][m][n] = __builtin_amdgcn_mfma_f32_16x16x32_fp8_fp8(b_[0], a_[0], acc[ai][bj][m][n], 0, 0, 0); \
            acc[ai][bj][m][n] = __builtin_amdgcn_mfma_f32_16x16x32_fp8_fp8(b_[1], a_[1], acc[ai][bj][m][n], 0, 0, 0); } } \
        else { _Pragma("unroll") for (int m = 0; m < 4; ++m) _Pragma("unroll") for (int n = 0; n < 2; ++n) _Pragma("unroll") for (int k = 0; k < 2; ++k) \
            acc[ai][bj][m][n] = __builtin_amdgcn_mfma_f32_16x16x32_bf16(Bt[n][k], At[m][k], acc[ai][bj][m][n], 0, 0, 0); } \
        __builtin_amdgcn_s_setprio(0); } while (0)
#define PG8_WAIT_V(n) asm volatile("s_waitcnt vmcnt(" #n ")" ::: "memory")
#define PG8_WAIT_L(n) asm volatile("s_waitcnt lgkmcnt(" #n ")" ::: "memory")
#define PG8_BAR __builtin_amdgcn_s_barrier()
#define PG8_SCHED __builtin_amdgcn_sched_barrier(0)
    Unit cur, nxt; int ui = 0;
    if (!S.next(0, cur)) return;
    f32x4 acc[2][2][4][2];
#pragma unroll
    for (int a = 0; a < 2; ++a)
#pragma unroll
        for (int b = 0; b < 2; ++b)
#pragma unroll
            for (int m = 0; m < 4; ++m)
#pragma unroll
                for (int n = 0; n < 2; ++n) acc[a][b][m][n] = (f32x4){0.f, 0.f, 0.f, 0.f};
    const int f8sc = 0x7f7f7f7f;
    bf16x8 At[4][2], B0[2][2], B1[2][2]; i32x8_t At8[4], B08[2], B18[2];
#ifdef PROBE_PM
#define PG8_PM(u_) ((g.pm_and & 1) ? ((u_).pm & 1) : (u_).pm)
#define PG8_PN(u_) ((g.pm_and & 2) ? ((u_).pn & 1) : (u_).pn)
#else
#define PG8_PM(u_) (u_).pm
#define PG8_PN(u_) (u_).pn
#endif
    const char* cA = (const char*)g.A + (size_t)PG8_PM(cur) * tstepA; const char* cB = (const char*)g.Bt + (size_t)PG8_PN(cur) * tstepB;
    PG8_STAGE(PG8_SB(0, 0), cB, voffB); PG8_STAGE(PG8_SB(0, 1), cB + hstepB, voffB); PG8_STAGE(PG8_SA(0, 0), cA, voffA); PG8_STAGE(PG8_SA(0, 1), cA + hstepA, voffA);
    if (wr == 1) PG8_BAR;
    PG8_WAIT_V(2); PG8_BAR;
    PG8_STAGE(PG8_SB(1, 0), cB + kstepB, voffB); PG8_STAGE(PG8_SA(1, 0), cA + kstepA, voffA); PG8_STAGE(PG8_SB(1, 1), cB + hstepB + kstepB, voffB);
    PG8_WAIT_V(6); PG8_BAR;
    for (;;) {
        const bool has_next = S.next(ui + 1, nxt);
        const char* nA = has_next ? (const char*)g.A + (size_t)PG8_PM(nxt) * tstepA : cA; const char* nB = has_next ? (const char*)g.Bt + (size_t)PG8_PN(nxt) * tstepB : cB;
        for (int t = 0; t < nt; t += 2) {
            const bool last = (t == nt - 2);
            const char* a1 = cA + (size_t)(t + 1) * kstepA;
            const char* a2 = last ? nA : cA + (size_t)(t + 2) * kstepA; const char* b2 = last ? nB : cB + (size_t)(t + 2) * kstepB;
            const char* a3 = a2 + kstepA; const char* b3 = b2 + kstepB;
            PG8_LDB(B0, 0, 0); PG8_LDB(B1, 0, 1); PG8_SCHED; PG8_LDA(At, 0, 0); PG8_STAGE(PG8_SA(1, 1), a1 + hstepA, voffA);
            PG8_WAIT_V(8); PG8_WAIT_L(0); PG8_BAR; PG8_MMA(0, 0, At, B0); PG8_MMA(0, 1, At, B1); PG8_BAR; PG8_SCHED;
            PG8_LDA(At, 0, 1); PG8_STAGE(PG8_SB(0, 0), b2, voffB); PG8_STAGE(PG8_SB(0, 1), b2 + hstepB, voffB); PG8_STAGE(PG8_SA(0, 0), a2, voffA);
            PG8_WAIT_V(8); PG8_WAIT_L(0); PG8_BAR; PG8_MMA(1, 0, At, B0); PG8_MMA(1, 1, At, B1); PG8_BAR; PG8_SCHED;
            PG8_LDB(B0, 1, 0); PG8_LDB(B1, 1, 1); PG8_SCHED; PG8_LDA(At, 1, 0); PG8_STAGE(PG8_SA(0, 1), a2 + hstepA, voffA);
            PG8_WAIT_V(8); PG8_WAIT_L(0); PG8_BAR; PG8_MMA(0, 0, At, B0); PG8_MMA(0, 1, At, B1); PG8_BAR; PG8_SCHED;
            PG8_LDA(At, 1, 1); PG8_STAGE(PG8_SB(1, 0), b3, voffB); PG8_STAGE(PG8_SB(1, 1), b3 + hstepB, voffB); PG8_STAGE(PG8_SA(1, 0), a3, voffA);
            PG8_WAIT_V(8); PG8_WAIT_L(0); PG8_BAR; PG8_MMA(1, 0, At, B0); PG8_MMA(1, 1, At, B1); PG8_BAR; PG8_SCHED;
        }
        if (wr == 0) PG8_BAR;
        if constexpr (FP8 == 2) { asm volatile("s_nop 7\n\ts_nop 7\n\ts_nop 7\n\ts_nop 7" ::: "memory"); PG8_SCHED; }
        E(acc, cur, wr, wc, fr, fq, lds + STAGE_BYTES);
        if (!has_next) break;
#pragma unroll
        for (int a = 0; a < 2; ++a)
#pragma unroll
            for (int b = 0; b < 2; ++b)
#pragma unroll
                for (int m = 0; m < 4; ++m)
#pragma unroll
                    for (int n = 0; n < 2; ++n) acc[a][b][m][n] = (f32x4){0.f, 0.f, 0.f, 0.f};
        cur = nxt; cA = nA; cB = nB; ++ui;
        if (wr == 1) PG8_BAR;
    }
    PG8_WAIT_V(0);
    PG8_BAR;
#undef PG8_SA
#undef PG8_SB
#undef PG8_STAGE
#undef PG8_LDA
#undef PG8_LD8
#undef PG8_LDB
#undef PG8_MMA
#undef PG8_WAIT_V
#undef PG8_WAIT_L
#undef PG8_BAR
#undef PG8_SCHED
}
}

#define XB_TMO      128
#define XB_XCNT(j)  (256  + 64 * (j))
#define XB_XSUB(j)  (1280 + 64 * (j))
#define XB_XGEN(j)  (2304 + 64 * (j))
#define XB_TOP      3328
#define XB_TOPGEN   3392
#define XCD_BAR_WORDS 3456
#define XB_SPIN_CAP (1u << 22)

__device__ __forceinline__ unsigned xb_ld(unsigned* p)              { return __hip_atomic_load(p, __ATOMIC_RELAXED, __HIP_MEMORY_SCOPE_AGENT); }
__device__ __forceinline__ unsigned xb_add(unsigned* p, unsigned v) { return __hip_atomic_fetch_add(p, v, __ATOMIC_RELAXED, __HIP_MEMORY_SCOPE_AGENT); }
__device__ __forceinline__ unsigned xb_xcc_id() { return (unsigned)__builtin_amdgcn_s_getreg((3 << 11) | 20) & 0xFu; }
#define XB_SPIN(cond, bar) do { unsigned _sp = 0; while (cond) { __builtin_amdgcn_s_sleep(1); \
    if ((++_sp & 255u) == 0u) { if (xb_ld(&(bar)[XB_TMO])) break; if (_sp > XB_SPIN_CAP) { atomicAdd(&(bar)[XB_TMO], 1u); break; } } } } while (0)

struct XcdBarrier { unsigned* bar; unsigned x; volatile LAS unsigned* st; };

__device__ __forceinline__ XcdBarrier xcd_barrier_post(unsigned* bar, volatile LAS unsigned* st) {
    XcdBarrier b; b.bar = bar; b.x = xb_xcc_id(); b.st = st;
    if (threadIdx.x == 0) (void)xb_add(&bar[XB_XCNT(b.x)], 1u);
    return b;
}
__device__ __forceinline__ void xcd_barrier_complete(unsigned* bar, unsigned x, unsigned& nloc, unsigned& nx) {
    const unsigned G = gridDim.x * gridDim.y * gridDim.z;
    unsigned sum, cnt, mine, sp = 0u;
    for (;;) {
        sum = 0u; cnt = 0u; mine = 0u;
#pragma unroll
        for (unsigned j = 0; j < 16; ++j) { const unsigned c = xb_ld(&bar[XB_XCNT(j)]); sum += c; cnt += (c > 0u) ? 1u : 0u; mine = (j == x) ? c : mine; }
        if (sum == G) break;
        __builtin_amdgcn_s_sleep(1);
        if ((++sp & 255u) == 0u) { if (xb_ld(&bar[XB_TMO])) break; if (sp > XB_SPIN_CAP) { atomicAdd(&bar[XB_TMO], 1u); break; } }
    }
    nloc = mine > 0u ? mine : 1u; nx = cnt > 0u ? cnt : 1u;
}
__device__ __forceinline__ void xcd_barrier(const XcdBarrier& b) {
    asm volatile("s_waitcnt vmcnt(0)" ::: "memory");
    __syncthreads();
    if (threadIdx.x == 0) {
        unsigned* bar = b.bar; unsigned bx_ = b.x; asm volatile("" : "+s"(bar), "+s"(bx_));
        __builtin_amdgcn_s_waitcnt(0);
        unsigned nloc = b.st[0], nx = b.st[1];
        if (nloc == 0u) { xcd_barrier_complete(bar, bx_, nloc, nx); b.st[0] = nloc; b.st[1] = nx; }
        const unsigned old = xb_add(&bar[XB_XSUB(bx_)], 1u);
        const unsigned gen = old / nloc;
        if (old + 1u == (gen + 1u) * nloc) {
            __builtin_amdgcn_fence(__ATOMIC_RELEASE, "agent");
            asm volatile("s_waitcnt vmcnt(0)" ::: "memory");
            const unsigned og = xb_add(&bar[XB_TOP], 1u);
            const unsigned tg = og / nx;
            if (og + 1u == (tg + 1u) * nx) xb_add(&bar[XB_TOPGEN], 1u);
            else XB_SPIN(xb_ld(&bar[XB_TOPGEN]) == tg, bar);
            __builtin_amdgcn_fence(__ATOMIC_ACQUIRE, "agent");
            xb_add(&bar[XB_XGEN(bx_)], 1u);
            asm volatile("s_waitcnt vmcnt(0)" ::: "memory");
        } else {
            XB_SPIN(xb_ld(&bar[XB_XGEN(bx_)]) == gen, bar);
            __builtin_amdgcn_fence(__ATOMIC_ACQUIRE, "agent");
            asm volatile("s_waitcnt vmcnt(0)" ::: "memory");
        }
    }
    __syncthreads();
}

namespace att {
constexpr int NW = 8, QBLK = 32, KVBLK = 64;
constexpr float THR2 = 8.f * LOG2E;
enum { K_MEM = 0, K_FOX = 1, K_MLA = 2, K_DIL = 3, K_DSA = 4 };
constexpr int L_V = 0, L_K = 49152, L_XB = 100352, L_TBL = 106496, L_END = 141312, VB = 16384;

struct AP {
    const bf16_t* Q; const bf16_t* K; const bf16_t* V; bf16_t* O;
    long qs, ks, vs, os;
    int kt0, nt;
    int q0;
    float C;
    const float* cum; long cums;
    const u64* msk;
    float* ost; long osts;
    float* mst; long msts;
    int carry_in, carry_out;
    int o8;
    const float* t5; int head, dil;
};

#define ATT_SBAR() __builtin_amdgcn_sched_barrier(0)
__device__ __forceinline__ int crow(int r, int hi) { return (r & 3) + 8 * (r >> 2) + 4 * hi; }
__device__ __forceinline__ int t5_bucket(int dist) {
    const int n = dist < 0 ? 0 : dist; if (n < 16) return n;
    const float v = __log2f((float)n * 0.0625f) * (16.0f / 7.0f); int b = 16 + (int)v; return b > 31 ? 31 : b;
}
__device__ __forceinline__ void rowmax_decide(const f32x16& p0, const f32x16& p1, float& m_reg, float& alpha) {
    float pmax = p0[0];
#pragma unroll
    for (int r = 1; r < 16; ++r) pmax = fmaxf(pmax, p0[r]);
#pragma unroll
    for (int r = 0; r < 16; ++r) pmax = fmaxf(pmax, p1[r]);
    { auto rr = __builtin_amdgcn_permlane32_swap(__float_as_uint(pmax), __float_as_uint(pmax), false, false); pmax = fmaxf(__uint_as_float(rr[0]), __uint_as_float(rr[1])); }
    if (__builtin_expect(__all(pmax - m_reg <= THR2), 1)) { alpha = 1.f; }
    else { const float mn = fmaxf(m_reg, pmax); alpha = __builtin_amdgcn_exp2f(m_reg - mn); m_reg = mn; }
}
__device__ __forceinline__ float half_sum(float ps) {
    auto rr = __builtin_amdgcn_permlane32_swap(__float_as_uint(ps), __float_as_uint(ps), false, false); return __uint_as_float(rr[0]) + __uint_as_float(rr[1]);
}
__device__ __forceinline__ void pack_p(const f32x16& p0, const f32x16& p1, bf16x8& pa0, bf16x8& pa1, bf16x8& pa2, bf16x8& pa3) {
#define ATT_PK4(P, BASE, OUT) do { unsigned a0 = cvt_pk_bf16(P[BASE + 0], P[BASE + 1]), a1 = cvt_pk_bf16(P[BASE + 2], P[BASE + 3]);   \
    unsigned b0 = cvt_pk_bf16(P[BASE + 4], P[BASE + 5]), b1 = cvt_pk_bf16(P[BASE + 6], P[BASE + 7]);                              \
    auto r0 = __builtin_amdgcn_permlane32_swap(a0, b0, false, false); auto r1 = __builtin_amdgcn_permlane32_swap(a1, b1, false, false); \
    u32x4 w = {r0[0], r1[0], r0[1], r1[1]}; OUT = __builtin_bit_cast(bf16x8, w); } while (0)
    ATT_PK4(p0, 0, pa0); ATT_PK4(p0, 8, pa1); ATT_PK4(p1, 0, pa2); ATT_PK4(p1, 8, pa3);
#undef ATT_PK4
}
template <int DK, int NQL>
__device__ __forceinline__ void qkt(f32x16& p0, f32x16& p1, const LAS unsigned char* Ks, const int (&kad)[4], const bf16x8* qr, const LAS unsigned char* qsp) {
    p0 = f32x16{}; p1 = f32x16{};
    constexpr int ND = DK / 16, NQR = ND - NQL;
#define ATT_LDK(d, hf) (*(const LAS bf16x8*)(Ks + ((DK == 128) ? (kad[(d) & 3] ^ (((d) >> 2) ? 128 : 0)) : (kad[(d) & 3] + 128 * ((d) >> 2))) + (hf) * 32 * DK * 2))
#define ATT_LDQ(d) (((d) < NQR) ? qr[(d) < NQR ? (d) : 0] : *(const LAS bf16x8*)(qsp + ((d) - NQR) * 1024))
    bf16x8 b0 = ATT_LDK(0, 0), b1 = ATT_LDK(0, 1), qf = ATT_LDQ(0);
#pragma unroll
    for (int d0 = 0; d0 < ND; ++d0) {
        bf16x8 c0 = b0, c1 = b1, qn = qf;
        if (d0 + 1 < ND) { c0 = ATT_LDK(d0 + 1, 0); c1 = ATT_LDK(d0 + 1, 1); qn = ATT_LDQ(d0 + 1); }
        ATT_SBAR();
        p0 = __builtin_amdgcn_mfma_f32_32x32x16_bf16(b0, qf, p0, 0, 0, 0);
        p1 = __builtin_amdgcn_mfma_f32_32x32x16_bf16(b1, qf, p1, 0, 0, 0);
        ATT_SBAR();
        b0 = c0; b1 = c1; qf = qn; }
#undef ATT_LDK
#undef ATT_LDQ
}
__device__ __forceinline__ int v_st(int k, int c) { const int kk = (k & ~0xC) | ((k & 4) << 1) | ((k & 8) >> 1); return ((kk >> 3) * 4 + (c >> 5)) * 512 + ((kk & 7) * 32 + (c & 31)) * 2; }
__device__ __forceinline__ int v_rd_base(int lane) { return ((lane & 3) << 3) | (((lane >> 2) & 3) << 6) | (((lane >> 4) & 1) << 5) | (((lane >> 5) & 1) << 8); }
constexpr int v_rd_off(int d0, int ks, int half) { return d0 * 512 + ks * 4096 + half * 2048; }
template <int OFF> __device__ __forceinline__ s16x4 tr_read(int vb) { s16x4 r; asm volatile("ds_read_b64_tr_b16 %0, %1 offset:%2" : "=&v"(r) : "v"(vb), "i"(OFF) : "memory"); return r; }
struct VF { s16x4 l0, h0, l1, h1, l2, h2, l3, h3; };
template <int D0> __device__ __forceinline__ void pv_read(VF& f, int vb) {
    f.l0 = tr_read<v_rd_off(D0, 0, 0)>(vb); f.h0 = tr_read<v_rd_off(D0, 0, 1)>(vb); f.l1 = tr_read<v_rd_off(D0, 1, 0)>(vb); f.h1 = tr_read<v_rd_off(D0, 1, 1)>(vb);
    f.l2 = tr_read<v_rd_off(D0, 2, 0)>(vb); f.h2 = tr_read<v_rd_off(D0, 2, 1)>(vb); f.l3 = tr_read<v_rd_off(D0, 3, 0)>(vb); f.h3 = tr_read<v_rd_off(D0, 3, 1)>(vb);
}
#define ATT_VWAIT(n, f) asm volatile("s_waitcnt lgkmcnt(" #n ")" : "+v"(f.l0), "+v"(f.h0), "+v"(f.l1), "+v"(f.h1), "+v"(f.l2), "+v"(f.h2), "+v"(f.l3), "+v"(f.h3) :: "memory")
#define ATT_PK(L, H) (bf16x8){L[0], L[1], L[2], L[3], H[0], H[1], H[2], H[3]}
__device__ __forceinline__ void pv_only(f32x16* o, int vb, bf16x8 pa0, bf16x8 pa1, bf16x8 pa2, bf16x8 pa3) {
    VF fa, fb;
#define ATT_MMA4(od, f) do { od = __builtin_amdgcn_mfma_f32_32x32x16_bf16(pa0, ATT_PK(f.l0, f.h0), od, 0, 0, 0); od = __builtin_amdgcn_mfma_f32_32x32x16_bf16(pa1, ATT_PK(f.l1, f.h1), od, 0, 0, 0); \
        od = __builtin_amdgcn_mfma_f32_32x32x16_bf16(pa2, ATT_PK(f.l2, f.h2), od, 0, 0, 0); od = __builtin_amdgcn_mfma_f32_32x32x16_bf16(pa3, ATT_PK(f.l3, f.h3), od, 0, 0, 0); } while (0)
    pv_read<0>(fa, vb); pv_read<1>(fb, vb);
    ATT_VWAIT(8, fa); ATT_SBAR(); ATT_MMA4(o[0], fa); ATT_SBAR(); pv_read<2>(fa, vb);
    ATT_VWAIT(8, fb); ATT_SBAR(); ATT_MMA4(o[1], fb); ATT_SBAR(); pv_read<3>(fb, vb);
    ATT_VWAIT(8, fa); ATT_SBAR(); ATT_MMA4(o[2], fa); ATT_SBAR();
    ATT_VWAIT(0, fb); ATT_SBAR(); ATT_MMA4(o[3], fb);
#undef ATT_MMA4
}
__device__ __forceinline__ float sm_only(f32x16& p0, f32x16& p1, float m) {
    float s = 0.f;
#pragma unroll
    for (int r = 0; r < 16; ++r) { p0[r] = __builtin_amdgcn_exp2f(p0[r] - m); s += p0[r]; }
#pragma unroll
    for (int r = 0; r < 16; ++r) { p1[r] = __builtin_amdgcn_exp2f(p1[r] - m); s += p1[r]; }
    return s;
}
__device__ __forceinline__ float pv_sm(f32x16* o, int vb, bf16x8 pa0, bf16x8 pa1, bf16x8 pa2, bf16x8 pa3, f32x16& p0, f32x16& p1, float m) {
    VF fa, fb; float s = 0.f;
#define ATT_GAP(od, pa, L, H, X, B) do { od = __builtin_amdgcn_mfma_f32_32x32x16_bf16(pa, ATT_PK(L, H), od, 0, 0, 0); \
        { float t0_ = X[B] - m, t1_ = X[B + 1] - m, e0_, e1_; asm volatile("v_exp_f32 %0, %1" : "=v"(e0_) : "v"(t0_)); asm volatile("v_exp_f32 %0, %1" : "=v"(e1_) : "v"(t1_));     \
          X[B] = e0_; X[B + 1] = e1_; s += e0_; s += e1_; } ATT_SBAR(); } while (0)
    pv_read<0>(fa, vb); pv_read<1>(fb, vb);
    ATT_VWAIT(8, fa); ATT_SBAR();
    ATT_GAP(o[0], pa0, fa.l0, fa.h0, p0, 0); ATT_GAP(o[0], pa1, fa.l1, fa.h1, p0, 2); ATT_GAP(o[0], pa2, fa.l2, fa.h2, p0, 4); ATT_GAP(o[0], pa3, fa.l3, fa.h3, p0, 6);
    pv_read<2>(fa, vb); ATT_VWAIT(8, fb); ATT_SBAR();
    ATT_GAP(o[1], pa0, fb.l0, fb.h0, p0, 8); ATT_GAP(o[1], pa1, fb.l1, fb.h1, p0, 10); ATT_GAP(o[1], pa2, fb.l2, fb.h2, p0, 12); ATT_GAP(o[1], pa3, fb.l3, fb.h3, p0, 14);
    pv_read<3>(fb, vb); ATT_VWAIT(8, fa); ATT_SBAR();
    ATT_GAP(o[2], pa0, fa.l0, fa.h0, p1, 0); ATT_GAP(o[2], pa1, fa.l1, fa.h1, p1, 2); ATT_GAP(o[2], pa2, fa.l2, fa.h2, p1, 4); ATT_GAP(o[2], pa3, fa.l3, fa.h3, p1, 6);
    ATT_VWAIT(0, fb); ATT_SBAR();
    ATT_GAP(o[3], pa0, fb.l0, fb.h0, p1, 8); ATT_GAP(o[3], pa1, fb.l1, fb.h1, p1, 10); ATT_GAP(o[3], pa2, fb.l2, fb.h2, p1, 12); ATT_GAP(o[3], pa3, fb.l3, fb.h3, p1, 14);
#undef ATT_GAP
    return s;
}

template <int KIND>
__device__ __forceinline__ void score(f32x16& p0, f32x16& p1, const AP& a, int t, int buf, LAS unsigned char* lds, int wid, int r32, int hi, float cq) {
    const float C = a.C; const int k0 = t * 64; const int q = a.q0 + wid * 32 + r32; const float NEG = -INFINITY;
    if constexpr (KIND == K_FOX) {
        const LAS f32x4* cb = (const LAS f32x4*)(lds + L_XB + buf * 2048) + hi;
#pragma unroll
        for (int g = 0; g < 4; ++g) { const f32x4 c4 = cb[2 * g], c4b = cb[2 * g + 8];
#pragma unroll
            for (int j = 0; j < 4; ++j) { p0[4 * g + j] = fmaf(p0[4 * g + j], C, -c4[j]); p1[4 * g + j] = fmaf(p1[4 * g + j], C, -c4b[j]); } }
    } else if constexpr (KIND == K_DSA || KIND == K_DIL) {
        const LAS float* tb = (const LAS float*)(lds + L_TBL) + (q - k0 - 4 * hi + 256 - 59);
#pragma unroll
        for (int r = 0; r < 16; ++r) { const int cc = (r & 3) + 8 * (r >> 2); p0[r] = fmaf(p0[r], C, tb[59 - cc]); p1[r] = fmaf(p1[r], C, tb[59 - cc - 32]); }
        if constexpr (KIND == K_DSA) {
            const LAS unsigned* mb = (const LAS unsigned*)(lds + L_XB + buf * 2048) + wid * 64;
            const unsigned wl = mb[r32] >> (4 * hi), wh = mb[32 + r32] >> (4 * hi);
#pragma unroll
            for (int r = 0; r < 16; ++r) { const int cc = (r & 3) + 8 * (r >> 2); p0[r] = ((wl >> cc) & 1u) ? p0[r] : NEG; p1[r] = ((wh >> cc) & 1u) ? p1[r] : NEG; }
        }
    } else {
#pragma unroll
        for (int r = 0; r < 16; ++r) { p0[r] *= C; p1[r] *= C; }
    }
    if constexpr (KIND == K_FOX || KIND == K_MLA) {
        if (k0 + 63 > a.q0) {
            const int kb = k0 + 4 * hi;
#pragma unroll
            for (int r = 0; r < 16; ++r) { const int kv = kb + (r & 3) + 8 * (r >> 2); if (kv > q) p0[r] = NEG; if (kv + 32 > q) p1[r] = NEG; }
        }
    }
}

template <int KIND, int DK>
__device__ __forceinline__ void attn_unit(LAS unsigned char* lds, const AP& a, const int wave_id) {
    const int tid = tid_opaque(wave_id);
    const int lane = tid & 63, r32 = lane & 31, hi = lane >> 5; const int wid = __builtin_amdgcn_readfirstlane(tid >> 6);
    constexpr bool HAS_TBL = (KIND == K_DSA || KIND == K_DIL), HAS_X = (KIND == K_FOX || KIND == K_DSA);
    constexpr int KB = KVBLK * DK * 2, NKC = DK / 8, NKL = (64 * NKC) / 512, ND0 = DK / 16;
    constexpr int NQL = (DK == 192) ? 2 : (HAS_TBL ? 2 : 4), NQR = ND0 - NQL, NLD = NKL + 2 + (HAS_X ? 1 : 0);
    constexpr int LWS = (DK == 192) ? 122880 : 98304, LQSP = (DK == 192) ? 124928 : (HAS_TBL ? 123904 : 106496);
    LAS unsigned char* V_lds = lds + L_V; LAS unsigned char* K_lds = lds + L_K;
    LAS float* wsf = (LAS float*)(lds + LWS) + wid * 64; LAS float* li_l = wsf; LAS float* al_l = wsf + 32;
    LAS unsigned char* qsp = lds + LQSP + wid * (NQL * 1024) + lane * 16;
    float m_reg = -1e30f, l_reg = 0.f; f32x16 o[4] = {}; bf16x8 qr[NQR];
    const int qi = wid * 32 + r32;
    const bf16_t* Qw = a.Q + (long)qi * a.qs + hi * 8;
#pragma unroll
    for (int d0 = 0; d0 < ND0; ++d0) { const bf16x8 qv = *(const bf16x8*)(Qw + d0 * 16); if (d0 < NQR) qr[d0 < NQR ? d0 : 0] = qv; else *(LAS bf16x8*)(qsp + (d0 - NQR) * 1024) = qv; }
    float cq = 0.f;

    if constexpr (KIND == K_DIL) {
        if (a.carry_in) {
            m_reg = a.mst[(long)qi * a.msts]; l_reg = a.mst[(long)qi * a.msts + 1];
#pragma unroll
            for (int r = 0; r < 16; ++r) { const unsigned* orow = (const unsigned*)a.ost + (long)(wid * 32 + crow(r, hi)) * a.osts + r32;
                const unsigned w0 = __builtin_nontemporal_load(orow), w1 = __builtin_nontemporal_load(orow + 32);
                o[0][r] = bf_lo(w0); o[1][r] = bf_hi(w0); o[2][r] = bf_lo(w1); o[3][r] = bf_hi(w1); }
        }
    }
    if constexpr (KIND == K_DSA) {
        LAS float* tbl = (LAS float*)(lds + L_TBL);
        for (int i = tid; i < 4352; i += 512) { const int dist = i - 256; tbl[i] = dist < 0 ? -INFINITY : a.t5[t5_bucket(dist) * 16 + a.head] * LOG2E; }
    }
    if constexpr (KIND == K_DIL) {
        LAS float* tbl = (LAS float*)(lds + L_TBL);
        for (int i = tid; i < 640; i += 512) { const int rel = i - 256; tbl[i] = (rel < 0 || rel > 128) ? -INFINITY : a.t5[t5_bucket(rel * a.dil) * 16 + a.head] * LOG2E; }
    }
    int ksrc[NKL], vsrc[2];
#pragma unroll
    for (int c = 0; c < NKL; ++c) { const int Lb = (wid * NKL + c) * 1024 + lane * 16, row = Lb / (DK * 2), chp = (Lb % (DK * 2)) / 16; ksrc[c] = row * (int)a.ks + ((DK == 128) ? (chp ^ (row & 15)) : ((chp & ~7) | ((chp & 7) ^ (row & 7)))) * 8; }
#pragma unroll
    for (int c = 0; c < 2; ++c) { const int sl = (2 * wid + c) * 64 + lane, st = sl >> 5, wi = sl & 31, kk = ((st >> 2) << 3) | (wi >> 2), k = (kk & ~0xC) | ((kk & 4) << 1) | ((kk & 8) >> 1); vsrc[c] = k * (int)a.vs + (st & 3) * 32 + (wi & 3) * 8; }
    const int vb0 = (int)(unsigned)(uintptr_t)V_lds + v_rd_base(lane);
    int kad[4];
#pragma unroll
    for (int j = 0; j < 4; ++j) kad[j] = r32 * (DK * 2) + (((hi | (j << 1)) ^ (r32 & 7)) << 4) + ((DK == 128) ? 128 * ((r32 >> 3) & 1) : 0);
#define ATT_DMA(t, sl) do { const long kb_ = (long)(t) * 64; \
        _Pragma("unroll") for (int c_ = 0; c_ < NKL; ++c_) __builtin_amdgcn_global_load_lds((const unsigned*)(a.K + kb_ * a.ks + ksrc[c_]), (LAS unsigned*)(K_lds + (sl) * KB + (wid * NKL + c_) * 1024), 16, 0, 0); \
        _Pragma("unroll") for (int c_ = 0; c_ < 2; ++c_) __builtin_amdgcn_global_load_lds((const unsigned*)(a.V + kb_ * a.vs + vsrc[c_]), (LAS unsigned*)(V_lds + (sl) * VB + (2 * wid + c_) * 1024), 16, 0, 0); \
        if constexpr (KIND == K_FOX) __builtin_amdgcn_global_load_lds((const unsigned*)(a.cum + (kb_ + lane) * a.cums), (LAS unsigned*)(lds + L_XB + (sl) * 2048), 4, 0, 0);     \
        if constexpr (KIND == K_DSA) __builtin_amdgcn_global_load_lds((const unsigned*)(a.msk + (long)(wid * 32 + r32) * 64 + (t)) + hi, (LAS unsigned*)(lds + L_XB + (sl) * 2048 + wid * 256), 4, 0, 0); } while (0)
#define ATT_RESC(al) do { if (__any((al) < 1.f)) { if (hi == 0) al_l[r32] = (al); asm volatile("s_waitcnt lgkmcnt(0)" ::: "memory"); \
        _Pragma("unroll") for (int d = 0; d < 4; ++d) _Pragma("unroll") for (int r = 0; r < 16; ++r) o[d][r] *= al_l[crow(r, hi)]; } } while (0)
#define ATT_BAR() do { asm volatile("s_waitcnt lgkmcnt(0)" ::: "memory"); __builtin_amdgcn_s_barrier(); asm volatile("" ::: "memory"); } while (0)
    f32x16 p0, p1; float al = 1.f; bf16x8 pa0, pa1, pa2, pa3; const int NT = a.nt, T0 = a.kt0;
    asm volatile("s_waitcnt vmcnt(0) lgkmcnt(0)" ::: "memory");
    ATT_DMA(T0, 0);
    if (NT > 1) { ATT_DMA(T0 + 1, 1); asm volatile("s_waitcnt vmcnt(%0)" :: "n"(NLD) : "memory"); } else { asm volatile("s_waitcnt vmcnt(0)" ::: "memory"); }
    ATT_BAR();
    int sl = 0, sl2 = 2;
    for (int jj = 0; jj < NT; ++jj) {
        const int t = T0 + jj;
        if (jj + 2 < NT) ATT_DMA(t + 2, sl2);
        bool lv = true; { const int k0_ = t * 64, qw_ = a.q0 + wid * 32;
            if constexpr (KIND == K_FOX || KIND == K_MLA || KIND == K_DSA) lv = k0_ <= qw_ + 31;
            if constexpr (KIND == K_DIL) lv = (k0_ <= qw_ + 31) && (k0_ + 63 >= qw_ - 128); }
        if (lv) {
            ATT_SBAR(); qkt<DK, NQL>(p0, p1, K_lds + sl * KB, kad, qr, qsp);
            score<KIND>(p0, p1, a, t, sl, lds, wid, r32, hi, cq);
            rowmax_decide(p0, p1, m_reg, al);
            const float ps = sm_only(p0, p1, m_reg);
            l_reg = l_reg * al + half_sum(ps);
            ATT_RESC(al);
            pack_p(p0, p1, pa0, pa1, pa2, pa3); ATT_SBAR();
            pv_only(o, vb0 + sl * VB, pa0, pa1, pa2, pa3);
        }
        if (jj + 2 < NT) asm volatile("s_waitcnt vmcnt(%0)" :: "n"(NLD) : "memory"); else asm volatile("s_waitcnt vmcnt(0)" ::: "memory");
        ATT_BAR();
        sl = (sl == 2) ? 0 : sl + 1; sl2 = (sl2 == 2) ? 0 : sl2 + 1;
    }
    bool stateout = false;
    if constexpr (KIND == K_DIL) stateout = a.carry_out != 0;
    if (stateout) {
        int qi2 = qi; asm volatile("" : "+v"(qi2));
        if (hi == 0) { a.mst[(long)qi2 * a.msts] = m_reg; a.mst[(long)qi2 * a.msts + 1] = l_reg; }
        asm volatile("s_nop 7\n\ts_nop 7\n\ts_nop 7" : "+v"(o[0]), "+v"(o[1]), "+v"(o[2]), "+v"(o[3]));
#pragma unroll
        for (int r = 0; r < 16; ++r) { unsigned* orow = (unsigned*)a.ost + (long)(wid * 32 + crow(r, hi)) * a.osts + r32;
            __builtin_nontemporal_store(cvt_pk_bf16(o[0][r], o[1][r]), orow); __builtin_nontemporal_store(cvt_pk_bf16(o[2][r], o[3][r]), orow + 32); }
        __syncthreads();
    } else {
        if (hi == 0) li_l[r32] = l_reg;
        asm volatile("s_waitcnt lgkmcnt(0)" ::: "memory");
        float rli[16];
#pragma unroll
        for (int r = 0; r < 16; ++r) rli[r] = __builtin_amdgcn_rcpf(li_l[crow(r, hi)]);
        __syncthreads();
        LAS unsigned short* ost = (LAS unsigned short*)(lds + wid * 8192);
#pragma unroll
        for (int r = 0; r < 16; ++r) { const int orow = crow(r, hi);
#pragma unroll
            for (int d0 = 0; d0 < 4; ++d0) { const unsigned w = cvt_pk_bf16(o[d0][r] * rli[r], 0.f); ost[orow * 128 + d0 * 32 + r32] = (unsigned short)w; } }
        asm volatile("s_waitcnt lgkmcnt(0)" ::: "memory");
#pragma unroll
        for (int i = 0; i < 8; ++i) { const int ch = lane + 64 * i, row = ch >> 4, c16 = ch & 15;
            const u32x4 v = *(const LAS u32x4*)(lds + wid * 8192 + row * 256 + c16 * 16);
            if (a.o8) {
              int q0 = __builtin_amdgcn_cvt_pk_fp8_f32(bf_lo(v.x) * 16.f, bf_hi(v.x) * 16.f, 0, false); q0 = __builtin_amdgcn_cvt_pk_fp8_f32(bf_lo(v.y) * 16.f, bf_hi(v.y) * 16.f, q0, true);
              int q1 = __builtin_amdgcn_cvt_pk_fp8_f32(bf_lo(v.z) * 16.f, bf_hi(v.z) * 16.f, 0, false); q1 = __builtin_amdgcn_cvt_pk_fp8_f32(bf_lo(v.w) * 16.f, bf_hi(v.w) * 16.f, q1, true);
              *(u32x2*)((unsigned char*)a.O + (long)(wid * 32 + row) * a.os + c16 * 8) = (u32x2){(unsigned)q0, (unsigned)q1}; }
            else *(u32x4*)(a.O + (long)(wid * 32 + row) * a.os + c16 * 8) = v; }
        __syncthreads();
    }
#undef ATT_DMA
#undef ATT_RESC
#undef ATT_BAR
}
#undef ATT_VWAIT
#undef ATT_PK
}

struct Fr { LAS unsigned char* lds; int tid, lane, wave, vcu, G, gw, ngw; };

__device__ __forceinline__ float wave_sum(float v) {
#pragma unroll
    for (int o = 1; o < 64; o <<= 1) v += __shfl_xor(v, o);
    return v;
}
__device__ __forceinline__ void unpack8(const u32x4 w, float (&v)[8]) {
    v[0] = bf_lo(w.x); v[1] = bf_hi(w.x); v[2] = bf_lo(w.y); v[3] = bf_hi(w.y); v[4] = bf_lo(w.z); v[5] = bf_hi(w.z); v[6] = bf_lo(w.w); v[7] = bf_hi(w.w);
}
__device__ __forceinline__ u32x4 pack8(const float (&v)[8]) {
    u32x4 w; w.x = cvt_pk_bf16(v[0], v[1]); w.y = cvt_pk_bf16(v[2], v[3]); w.z = cvt_pk_bf16(v[4], v[5]); w.w = cvt_pk_bf16(v[6], v[7]); return w;
}
__device__ __forceinline__ float sumsq8(const float (&v)[8]) { return ((v[0] * v[0] + v[1] * v[1]) + (v[2] * v[2] + v[3] * v[3])) + ((v[4] * v[4] + v[5] * v[5]) + (v[6] * v[6] + v[7] * v[7])); }

__device__ __forceinline__ int map_col(int kind, int n) {
    switch (kind) {
        case 1: return 256 * (n >> 7) + (n & 127);
        case 2: return 256 * (n >> 7) + 128 + (n & 127);
        case 3: return n < 6144 ? n : (n < 6160 ? 6656 + (n - 6144) : 6144 + (n - 6160));
        case 4: return n < 1088 ? n : 1280 + (n - 1088);
        case 5: return n < 6144 ? n : (n < 18432 ? n + 512 : 6144 + (n - 18432));
        case 6: return n < 4176 ? n : 4352 + (n - 4176);
        default: return n;
    }
}
struct TrDesc { const float* W; const float* gain; bf16_t* WT; int K, N, ldt, kind, r, f8, tiled; };
__device__ __forceinline__ void tr_load(const TrDesc& d, int lane, f32x4 (&v)[16]) {
    const int nblk = (d.N + 63) / 64, kb = d.r / nblk, nb = d.r % nblk, k0 = 64 * kb, n = 64 * nb + 4 * (lane & 15); const bool ok = n < d.N;
    const float* src = d.W + (size_t)(k0 + (lane >> 4)) * d.N + (ok ? n : 0); const size_t rs = (size_t)4 * d.N;
#pragma unroll
    for (int j = 0; j < 16; ++j) v[j] = __builtin_nontemporal_load((const f32x4*)(src + (size_t)j * rs));
}
__device__ __forceinline__ void tr_store(const TrDesc& d, int lane, const f32x4 (&v)[16], LAS float* scr) {
    const int nblk = (d.N + 63) / 64, kb = d.r / nblk, nb = d.r % nblk, k0 = 64 * kb, n0 = 64 * nb;
    { LAS float* w = scr + (lane >> 4) * 65 + 4 * (lane & 15);
#pragma unroll
      for (int j = 0; j < 16; ++j) { w[j * 260 + 0] = v[j][0]; w[j * 260 + 1] = v[j][1]; w[j * 260 + 2] = v[j][2]; w[j * 260 + 3] = v[j][3]; } }
    const int c = lane & 7, nn = lane >> 3; float g[8];
#pragma unroll
    for (int jj = 0; jj < 8; ++jj) g[jj] = d.gain ? d.gain[k0 + 8 * c + jj] : 1.f;
    asm volatile("s_waitcnt lgkmcnt(0)" ::: "memory");
#pragma unroll
    for (int it = 0; it < 8; ++it) { const int nl = nn + 8 * it; const LAS float* rp = scr + (8 * c) * 65 + nl;
        u32x4 o; o.x = cvt_pk_bf16(rp[0 * 65] * g[0], rp[1 * 65] * g[1]); o.y = cvt_pk_bf16(rp[2 * 65] * g[2], rp[3 * 65] * g[3]); o.z = cvt_pk_bf16(rp[4 * 65] * g[4], rp[5 * 65] * g[5]); o.w = cvt_pk_bf16(rp[6 * 65] * g[6], rp[7 * 65] * g[7]);
        if (n0 + nl < d.N) {
            if (d.f8) { int q0 = __builtin_amdgcn_cvt_pk_fp8_f32(rp[0 * 65] * g[0] * 64.f, rp[1 * 65] * g[1] * 64.f, 0, false); q0 = __builtin_amdgcn_cvt_pk_fp8_f32(rp[2 * 65] * g[2] * 64.f, rp[3 * 65] * g[3] * 64.f, q0, true);
                        int q1 = __builtin_amdgcn_cvt_pk_fp8_f32(rp[4 * 65] * g[4] * 64.f, rp[5 * 65] * g[5] * 64.f, 0, false); q1 = __builtin_amdgcn_cvt_pk_fp8_f32(rp[6 * 65] * g[6] * 64.f, rp[7 * 65] * g[7] * 64.f, q1, true);
                        if (d.tiled) { const int n = n0 + nl;
                            *(u32x2*)((unsigned char*)d.WT + ((((size_t)(n >> 8) * (d.K >> 7) + (k0 >> 7)) * 2 + ((n >> 7) & 1)) * 128 + (n & 127)) * 128 + (k0 & 127) + 8 * c) = (u32x2){(unsigned)q0, (unsigned)q1}; }
                        else *(u32x2*)((unsigned char*)d.WT + (size_t)map_col(d.kind, n0 + nl) * d.ldt + k0 + 8 * c) = (u32x2){(unsigned)q0, (unsigned)q1}; }
            else if (d.tiled) { const int n = n0 + nl;
                *(u32x4*)(d.WT + ((((size_t)(n >> 8) * (d.K >> 6) + (k0 >> 6)) * 2 + ((n >> 7) & 1)) * 128 + (n & 127)) * 64 + 8 * c) = o; }
            else *(u32x4*)(d.WT + (size_t)map_col(d.kind, n0 + nl) * d.ldt + k0 + 8 * c) = o; } }
    asm volatile("s_waitcnt lgkmcnt(0)" ::: "memory");
}

__device__ __forceinline__ void rows2048(const Fr& F, const float* x, int nrows, bf16_t* xb, void* out, int mode) {
    for (int m = F.gw; m < nrows; m += F.ngw) {
        const f32x4* xr = (const f32x4*)(x + (size_t)m * DM) + F.lane; f32x4 v[8]; float s = 0.f;
#pragma unroll
        for (int j = 0; j < 8; ++j) { v[j] = xr[64 * j]; s += (v[j].x * v[j].x + v[j].y * v[j].y) + (v[j].z * v[j].z + v[j].w * v[j].w); }
        s = wave_sum(s);
        if (F.lane == 0) { if (mode) ((float*)out)[m] = __builtin_amdgcn_rsqf(s * (1.0f / DM) + RMS_EPS); else ((u64*)out)[m] = (u64)(s * pg8::SSQ_SCALE); }
        if (xb) { u32x2* o8 = (u32x2*)(xb + (size_t)m * DM) + F.lane;
#pragma unroll
            for (int j = 0; j < 8; ++j) { u32x2 w; w.x = cvt_pk_bf16(v[j].x, v[j].y); w.y = cvt_pk_bf16(v[j].z, v[j].w); o8[64 * j] = w; } }
    }
}

__device__ __forceinline__ void hn_step(bf16_t* p, const float (&g)[8]) {
    float v[8]; unpack8(*(const u32x4*)p, v); float ss = sumsq8(v);
    ss += __shfl_xor(ss, 1); ss += __shfl_xor(ss, 2); ss += __shfl_xor(ss, 4); ss += __shfl_xor(ss, 8);
    const float rs = __builtin_amdgcn_rsqf(ss * (1.0f / 128.0f) + RMS_EPS);
#pragma unroll
    for (int j = 0; j < 8; ++j) v[j] = v[j] * rs * g[j];
    *(u32x4*)p = pack8(v);
}
__device__ __forceinline__ void load_gain8(const float* g, int lane, float (&o)[8]) {
#pragma unroll
    for (int j = 0; j < 8; ++j) o[j] = g ? g[(lane & 15) * 8 + j] : 1.f;
}
__device__ __forceinline__ void prep_rows(const Fr& F, bf16_t* P, long ld, int nrows, int c0, int n0, const float* g0, int c1, int n1, const float* g1, int c2, int n2, const float* g2) {
    float ga[8], gb[8], gc[8]; load_gain8(g0, F.lane, ga); load_gain8(g1, F.lane, gb); load_gain8(g2, F.lane, gc);
    for (int m = F.gw; m < nrows; m += F.ngw) {
        bf16_t* row = P + (size_t)m * ld + F.lane * 8;
        for (int s = 0; s < n0; ++s) hn_step(row + c0 + s * 512, ga);
        for (int s = 0; s < n1; ++s) hn_step(row + c1 + s * 512, gb);
        for (int s = 0; s < n2; ++s) hn_step(row + c2 + s * 512, gc);
    }
}

__device__ __forceinline__ void fox_cumsum(const Fr& F, const float* FG, const float* b_f, float* CUM) {
    for (int task = ((F.gw & 15) == 0) ? (F.gw >> 4) : NB * NH; task < NB * NH; task += (F.ngw >> 4)) {
        const int b = task >> 4, h = task & 15; const float bias = b_f[h];
        const float* src = FG + ((size_t)b * SEQ + (size_t)F.lane * 64) * 16 + h; float v[64]; float run = 0.f;
#pragma unroll
        for (int i = 0; i < 64; ++i) { const float xg = src[(size_t)i * 16] + bias;
            const float e = __expf(-fabsf(xg)); const float ls = fminf(xg, 0.f) - __logf(1.0f + e);
            run += ls; v[i] = run; }
        float incl = run;
#pragma unroll
        for (int o = 1; o < 64; o <<= 1) { const float t = __shfl_up(incl, o); if (F.lane >= o) incl += t; }
        const float excl = incl - run;
        float* dst = CUM + ((size_t)b * SEQ + (size_t)F.lane * 64) * 16 + h;
#pragma unroll
        for (int i = 0; i < 64; ++i) dst[(size_t)i * 16] = (v[i] + excl) * LOG2E;
    }
}

__device__ const double ROPE_INV[32] = {
    1.0, 0.7498942093324559, 0.5623413251903491, 0.4216965034285822, 0.31622776601683794, 0.23713737056616552, 0.1778279410038923, 0.1333521432163324,
    0.1, 0.07498942093324558, 0.05623413251903491, 0.04216965034285822, 0.03162277660168379, 0.023713737056616554, 0.01778279410038923, 0.01333521432163324,
    0.01, 0.007498942093324558, 0.005623413251903491, 0.004216965034285823, 0.0031622776601683794, 0.0023713737056616554, 0.001778279410038923, 0.001333521432163324,
    0.001, 0.0007498942093324559, 0.0005623413251903491, 0.0004216965034285823, 0.00031622776601683794, 0.00023713737056616554, 0.0001778279410038923, 0.0001333521432163324};
__device__ __forceinline__ void rope_table(const Fr& F, const int* pos, float* COS, float* SIN) {
    const int gt = F.vcu * 512 + F.tid, ngt = F.G * 512;
    for (int i = gt; i < MTOK * 32; i += ngt) { const int m = i >> 5, f = i & 31;
        const double a = (double)pos[m] * (double)(float)ROPE_INV[f]; const double rev = a * 0.15915494309189535; const float fr = (float)(rev - floor(rev));
        COS[i] = __builtin_amdgcn_cosf(fr); SIN[i] = __builtin_amdgcn_sinf(fr); }
}

__device__ __forceinline__ void mla_prep_a(const Fr& F, bf16_t* P, float* RSQ, float* RSKV, bf16_t* KR, const float* rope_g1, const float* gmem, const float* COS, const float* SIN) {
    const int lane = F.lane; float gr[8];
#pragma unroll
    for (int j = 0; j < 8; ++j) gr[j] = rope_g1[(lane & 7) * 8 + j];
    for (int m = F.gw; m < MTOK; m += F.ngw) {
        bf16_t* pr = P + (size_t)m * 1792; float v[8];
        const u32x4 wq = *(const u32x4*)(pr + lane * 8), wk = *(const u32x4*)(pr + 512 + lane * 8);
        u32x4 w = (u32x4){0u, 0u, 0u, 0u}; if (lane < 8) w = *(const u32x4*)(pr + 1024 + lane * 8);
        const float* cp = COS + (size_t)m * 32 + (lane & 3) * 8; const float* sp = SIN + (size_t)m * 32 + (lane & 3) * 8; float cs[8], sn[8];
#pragma unroll
        for (int j = 0; j < 8; ++j) { cs[j] = cp[j]; sn[j] = sp[j]; }
        asm volatile("" ::: "memory");
        unpack8(wq, v); float ss = wave_sum(sumsq8(v)); if (lane == 0) RSQ[m] = __builtin_amdgcn_rsqf(ss * (1.0f / 512.0f) + RMS_EPS);
        unpack8(wk, v); ss = wave_sum(sumsq8(v)); if (lane == 0) RSKV[m] = __builtin_amdgcn_rsqf(ss * (1.0f / 512.0f) + RMS_EPS);
        unpack8(w, v); ss = sumsq8(v); ss += __shfl_xor(ss, 1); ss += __shfl_xor(ss, 2); ss += __shfl_xor(ss, 4);
        const float rs = __builtin_amdgcn_rsqf(ss * (1.0f / 64.0f) + RMS_EPS); float o[8];
#pragma unroll
        for (int j = 0; j < 8; ++j) { const float x = v[j] * rs * gr[j]; const float y = __shfl_xor(x, 4); o[j] = (lane & 4) ? (y * sn[j] + x * cs[j]) : (x * cs[j] - y * sn[j]); }
        if (lane < 8) *(u32x4*)(KR + (size_t)m * 64 + lane * 8) = pack8(o);
    }
}
__device__ __forceinline__ void mla_prep_b(const Fr& F, bf16_t* Q, const bf16_t* KV, bf16_t* KF, const bf16_t* KR, const float* nope_g, const float* rope_g, const float* COS, const float* SIN) {
    const int lane = F.lane, half = lane >> 5, l5 = lane & 31; float gqn[8], gqr[8], gkn[8];
#pragma unroll
    for (int j = 0; j < 8; ++j) { gqn[j] = nope_g[(l5 & 15) * 8 + j]; gkn[j] = nope_g[128 + (l5 & 15) * 8 + j]; gqr[j] = rope_g[(l5 & 7) * 8 + j]; }
    for (int m = F.gw; m < MTOK; m += F.ngw) {
        const float* cp = COS + (size_t)m * 32 + (l5 & 3) * 8; const float* sp = SIN + (size_t)m * 32 + (l5 & 3) * 8; float cs[8], sn[8];
#pragma unroll
        for (int j = 0; j < 8; ++j) { cs[j] = cp[j]; sn[j] = sp[j]; }
        u32x4 krw = (u32x4){0u, 0u, 0u, 0u}; if (l5 >= 16 && l5 < 24) krw = *(const u32x4*)(KR + (size_t)m * 64 + (l5 - 16) * 8);
        u32x4 qw[8], kw[8];
#pragma unroll
        for (int it = 0; it < 8; ++it) { const int h = 2 * it + half;
            qw[it] = (u32x4){0u, 0u, 0u, 0u}; if (l5 < 24) qw[it] = *(const u32x4*)(Q + (size_t)m * 3072 + h * 192 + l5 * 8);
            kw[it] = (u32x4){0u, 0u, 0u, 0u}; if (l5 < 16) kw[it] = *(const u32x4*)(KV + (size_t)m * 4096 + h * 256 + l5 * 8); }
        asm volatile("" ::: "memory");
#pragma unroll
        for (int it = 0; it < 8; ++it) { const int h = 2 * it + half;
            bf16_t* qrow = Q + (size_t)m * 3072 + h * 192 + l5 * 8; float v[8];
            unpack8(qw[it], v); float s8 = sumsq8(v); s8 += __shfl_xor(s8, 1); s8 += __shfl_xor(s8, 2); s8 += __shfl_xor(s8, 4); const float s16 = s8 + __shfl_xor(s8, 8);
            const float rs = (l5 < 16) ? __builtin_amdgcn_rsqf(s16 * (1.0f / 128.0f) + RMS_EPS) : __builtin_amdgcn_rsqf(s8 * (1.0f / 64.0f) + RMS_EPS);
            float o[8];
#pragma unroll
            for (int j = 0; j < 8; ++j) { const float x = v[j] * rs * ((l5 < 16) ? gqn[j] : gqr[j]); const float y = __shfl_xor(x, 4);
                const float rot = (l5 & 4) ? (y * sn[j] + x * cs[j]) : (x * cs[j] - y * sn[j]); o[j] = (l5 < 16) ? x : rot; }
            if (l5 < 24) *(u32x4*)qrow = pack8(o);
            bf16_t* kfrow = KF + (size_t)m * 3072 + h * 192;
            unpack8(kw[it], v); float k16 = sumsq8(v); k16 += __shfl_xor(k16, 1); k16 += __shfl_xor(k16, 2); k16 += __shfl_xor(k16, 4); k16 += __shfl_xor(k16, 8);
            const float krs = __builtin_amdgcn_rsqf(k16 * (1.0f / 128.0f) + RMS_EPS);
#pragma unroll
            for (int j = 0; j < 8; ++j) o[j] = v[j] * krs * gkn[j];
            if (l5 < 16) *(u32x4*)(kfrow + l5 * 8) = pack8(o);
            else if (l5 < 24) *(u32x4*)(kfrow + 128 + (l5 - 16) * 8) = krw;
        }
    }
}

__device__ __forceinline__ void dsa_indexer(const Fr& F, const bf16_t* P, float* SC) {
    constexpr int LDP = 4864, CQI = 3072, CKI = 4096, CWI = 4160;
    constexpr int RING = 81920;
    const int lane = F.lane, r32 = lane & 31, hg = lane >> 5;
    LAS float* ibuf = (LAS float*)(F.lds + F.wave * 9216);
    const int drow = 8 * F.wave + (lane >> 3), dchunk = (lane & 7) ^ ((lane >> 3) & 7);
#define IDX_DMA(t_) __builtin_amdgcn_global_load_lds((const unsigned*)(kbase + (size_t)(t_) * 64 * LDP), (LAS unsigned*)(F.lds + RING + ((t_) & 3) * 8192 + F.wave * 1024), 16, 0, 0)
    for (int ui = blockIdx.x; ui < 512; ui += F.G) {
        const int c = ui & 255, second = ui >> 8, b = c >> 5, qb0 = c & 31, qb = second ? 63 - qb0 : qb0;
        const size_t tok0 = (size_t)b * SEQ + qb * 64 + F.wave * 8;
        bf16x8 aq[4][4]; f32x2 wv[4][8];
#pragma unroll
        for (int g = 0; g < 4; ++g) { const size_t tok = tok0 + 2 * g + (r32 >> 4); const bf16_t* qp = P + tok * LDP + CQI + (r32 & 15) * 64 + 8 * hg;
#pragma unroll
            for (int ks = 0; ks < 4; ++ks) aq[g][ks] = *(const bf16x8*)(qp + 16 * ks);
#pragma unroll
            for (int r = 0; r < 16; ++r) { const int head = (r & 3) + 8 * ((r >> 2) & 1) + 4 * hg; const size_t tq = tok0 + 2 * g + (r >> 3);
                wv[g][r >> 1][r & 1] = bf_lo((unsigned)P[tq * LDP + CWI + head]) * (0.25f * 0.125f); } }
        const int nt = qb + 1;
        const bf16_t* kbase = P + ((size_t)b * SEQ + drow) * LDP + CKI + 8 * dchunk;
        asm volatile("s_waitcnt vmcnt(0) lgkmcnt(0)" ::: "memory"); __builtin_amdgcn_s_barrier(); asm volatile("" ::: "memory");
        IDX_DMA(0); if (nt > 1) IDX_DMA(1);
        for (int t = 0; t < nt; ++t) {
            if (t + 1 < nt) asm volatile("s_waitcnt vmcnt(1)" ::: "memory"); else asm volatile("s_waitcnt vmcnt(0)" ::: "memory");
            asm volatile("s_waitcnt lgkmcnt(0)" ::: "memory"); __builtin_amdgcn_s_barrier(); asm volatile("" ::: "memory");
            if (t + 2 < nt) IDX_DMA(t + 2);
            const LAS unsigned char* slot = F.lds + RING + (t & 3) * 8192;
            bf16x8 bk[2][4];
#pragma unroll
            for (int kg = 0; kg < 2; ++kg) { const int key = kg * 32 + r32;
#pragma unroll
                for (int ks = 0; ks < 4; ++ks) bk[kg][ks] = *(const LAS bf16x8*)(slot + key * 128 + (((2 * ks + hg) ^ (key & 7)) << 4)); }
            f32x16 dcur = f32x16{};
#pragma unroll
            for (int ks = 0; ks < 4; ++ks) dcur = __builtin_amdgcn_mfma_f32_32x32x16_bf16(aq[0][ks], bk[0][ks], dcur, 0, 0, 0);
#pragma unroll
            for (int j = 0; j < 8; ++j) { const int kg = j >> 2, g = j & 3;
                f32x16 dnext = f32x16{};
                if (j < 7) {
#pragma unroll
                    for (int ks = 0; ks < 4; ++ks) dnext = __builtin_amdgcn_mfma_f32_32x32x16_bf16(aq[(j + 1) & 3][ks], bk[(j + 1) >> 2][ks], dnext, 0, 0, 0); }
                f32x2 accA = {0.f, 0.f}, accB = {0.f, 0.f};
#pragma unroll
                for (int i = 0; i < 4; ++i) { f32x2 xa, xb;
#define IDX_RELU(x_) __int_as_float(max(__float_as_int(x_), 0))
                    xa[0] = IDX_RELU(dcur[2 * i]); xa[1] = IDX_RELU(dcur[2 * i + 1]); xb[0] = IDX_RELU(dcur[8 + 2 * i]); xb[1] = IDX_RELU(dcur[9 + 2 * i]);
#undef IDX_RELU
                    accA = __builtin_elementwise_fma(wv[g][i], xa, accA); accB = __builtin_elementwise_fma(wv[g][4 + i], xb, accB); }
                const float s0 = accA[0] + accA[1], s1 = accB[0] + accB[1];
                auto rr = __builtin_amdgcn_permlane32_swap(__float_as_uint(s0), __float_as_uint(s1), false, false);
                const float tot = __uint_as_float(rr[0]) + __uint_as_float(rr[1]);
                ibuf[(2 * g + hg) * 288 + (t & 3) * 64 + kg * 32 + r32] = tot;
                if (j < 7) {
#pragma unroll
                    for (int i = 0; i < 4; ++i) { __builtin_amdgcn_sched_group_barrier(0x008, 1, 0); __builtin_amdgcn_sched_group_barrier(0x002, 6, 0); } }
                dcur = dnext;
            }
            if ((t & 3) == 3 || t == nt - 1) { const int t0 = t & ~3, cnt = (t - t0 + 1) * 64;
                if (4 * lane < cnt) {
#pragma unroll
                    for (int q = 0; q < 8; ++q) { const f32x4 v = *(const LAS f32x4*)(ibuf + q * 288 + 4 * lane);
                        __builtin_nontemporal_store(v, (f32x4*)(SC + (tok0 + q) * (size_t)SEQ + t0 * 64 + 4 * lane)); } } }
        }
    }
#undef IDX_DMA
}

__device__ __forceinline__ int dsa_qmap(const Fr& F, int k) { return k * F.ngw + ((k & 1) ? F.ngw - 1 - F.gw : F.gw); }
__device__ __forceinline__ void dsa_issue(const float* SC, int q, int lane, unsigned (&raw)[64]) {
    const int s = q & (SEQ - 1); const float* row = SC + (size_t)q * SEQ;
    if (s < 256) return;
#pragma unroll
    for (int c4 = 0; c4 < 4; ++c4) {
        if (1024 * c4 <= s) {
#pragma unroll
            for (int i = 16 * c4; i < 16 * c4 + 16; ++i) raw[i] = __float_as_uint(__builtin_nontemporal_load(row + 64 * i + lane)); }
        else {
#pragma unroll
            for (int i = 16 * c4; i < 16 * c4 + 16; ++i) raw[i] = 0u; } }
}
__device__ __forceinline__ void dsa_select(const Fr& F, const float* SC, u64* MSK) {
    const int lane = F.lane;
    int k = 0, q = dsa_qmap(F, 0); bool have = q < MTOK;
    unsigned raw[64];
#pragma unroll
    for (int i = 0; i < 64; ++i) raw[i] = 0u;
    if (have) dsa_issue(SC, q, lane, raw);
    while (have) {
        const int s = q & (SEQ - 1); u64* mrow = MSK + (size_t)q * 64;
        const int qn = dsa_qmap(F, k + 1); const bool hn = qn < MTOK;
        if (s < 256) { const int lo = 64 * lane; u64 w = 0ull; if (s >= lo + 63) w = ~0ull; else if (s >= lo) w = (2ull << (s - lo)) - 1ull; mrow[lane] = w;
            if (hn) dsa_issue(SC, qn, lane, raw); q = qn; have = hn; ++k; continue; }
        unsigned u[64];
#pragma unroll
        for (int i = 0; i < 64; ++i) { const int key = 64 * i + lane; const unsigned bits = raw[i]; const unsigned ord = (bits & 0x80000000u) ? ~bits : (bits | 0x80000000u); u[i] = (key <= s) ? ord : 0u; }
        if (hn) dsa_issue(SC, qn, lane, raw);
        unsigned T = 0u; const int ng = (s >> 9) + 1;
        for (int bit = 31; bit >= 0; --bit) { const unsigned cand = T | (1u << bit); int cl = 0;
#pragma unroll
            for (int g8 = 0; g8 < 8; ++g8) { if (g8 >= ng) break;
                u64 m[8];
#pragma unroll
                for (int j = 0; j < 8; ++j) asm("v_cmp_le_u32_e64 %0, %1, %2" : "=s"(m[j]) : "s"(cand), "v"(u[8 * g8 + j]));
#pragma unroll
                for (int j = 0; j < 8; ++j) cl += __popcll(m[j]); }
            cl = __builtin_amdgcn_readfirstlane(cl);
            if (cl >= 256) { T = cand; if (cl == 256) break; } }
        int cgt = 0;
#pragma unroll
        for (int g8 = 0; g8 < 8; ++g8) { if (g8 >= ng) break;
            u64 m[8];
#pragma unroll
            for (int j = 0; j < 8; ++j) asm("v_cmp_lt_u32_e64 %0, %1, %2" : "=s"(m[j]) : "s"(T), "v"(u[8 * g8 + j]));
#pragma unroll
            for (int j = 0; j < 8; ++j) cgt += __popcll(m[j]); }
        int need = 256 - __builtin_amdgcn_readfirstlane(cgt); unsigned mlo = 0u, mhi = 0u;
#pragma unroll
        for (int i = 0; i < 64; ++i) { if ((i & 7) == 0 && (i >> 3) >= ng) break;
            const u64 gt = __ballot(u[i] > T), eq = __ballot(u[i] == T); u64 take = 0ull;
            if (need > 0 && eq != 0ull) { const int c = __popcll(eq);
                if (c <= need) { take = eq; need -= c; }
                else { u64 e = eq; for (int n = 0; n < need; ++n) { const u64 low = e & (0ull - e); take |= low; e ^= low; } need = 0; } }
            const u64 w = gt | take; const bool me = lane == i;
            mlo = me ? (unsigned)w : mlo; mhi = me ? (unsigned)(w >> 32) : mhi; }
        mrow[lane] = ((u64)mhi << 32) | (u64)mlo;
        q = qn; have = hn; ++k;
    }
}

constexpr size_t MiB = 1u << 20;
constexpr size_t WS_CTL = 0, CTL_ZERO_BYTES = 8 * MiB;
constexpr int CW_BAR = 4096;
constexpr size_t WS_SSQ = 1 * MiB;
constexpr size_t WS_WB = 8 * MiB;
constexpr size_t WS_XB = 236 * MiB;
constexpr size_t WS_MEMB = 364 * MiB;
constexpr size_t WS_MEMKV = 372 * MiB;
constexpr size_t WS_COS = 388 * MiB, WS_SIN = 392 * MiB, WS_RSMEM = 396 * MiB, WS_RSQ = 397 * MiB, WS_RSKV = 398 * MiB;
constexpr size_t WS_XB8 = 560 * MiB;
constexpr size_t WS_MIX = 400 * MiB;
constexpr size_t WS_SCR = 624 * MiB;
constexpr size_t WS_END = (624 + 832) * MiB;
constexpr size_t WB_GU0 = 0, WB_GU1 = 23068672, WB_D0 = 46137344, WB_D1 = 57671680, WB_IN = 69206016, WB_OUT = 108003328, WB_MKV = 113246208, WB_UQ = 115343360, WB_UKV = 116916224;
constexpr int RING_BYTES = 146944, MISC_OFF = RING_BYTES + 64, LDS_BYTES = 147456;
static_assert(att::L_END <= RING_BYTES && pg8::STAGE_BYTES <= RING_BYTES, "LDS map");
constexpr int NPHASES = 44;
#ifndef F8MASK
#define F8MASK 4
#endif
#define F8LAYER(L) (((F8MASK) >> (L)) & 1)
#ifndef RG
#define RG 1
#endif
#ifndef RD
#define RD 1
#endif
#ifndef RI
#define RI 1
#endif
#ifndef RA
#define RA 1
#endif
#ifndef F8OUT
#define F8OUT 8
#endif
#define F8OUTL(L_) (((F8OUT) >> (L_)) & 1)
#ifndef F8FFN
#define F8FFN 128
#endif
#define F8FFNL(L_, f_) (((F8FFN) >> (2 * (L_) + (f_))) & 1)
#ifndef F8FFND
#define F8FFND 128
#endif
#define F8FFNDL(L_, f_) (((F8FFND) >> (2 * (L_) + (f_))) & 1)
#ifndef F8MODE
#define F8MODE 2
#endif
#ifndef RCV
#define RCV 1
#endif
#ifndef RIX
#define RIX 1
#endif
#ifndef RSL
#define RSL 1
#endif
#ifndef RC
#define RC 1
#endif
#define REP(n) for (int rep_ = 0; rep_ < (n); ++rep_)

struct Args { const void* in[27]; float* out; unsigned char* ws; int ph_lo, ph_hi; };

typedef const __attribute__((address_space(4))) struct Args* ArgsPc;
__device__ __forceinline__ TrDesc tr_desc(ArgsPc A, int L, bf16_t* WB, int it) {
    const float* w_gate = (const float*)A->in[5]; const float* w_up = (const float*)A->in[6]; const float* w_down = (const float*)A->in[7];
    const float* ffn_norm = (const float*)A->in[4]; const float* attn_norm = (const float*)A->in[8];
    const float* w_out = (const float*)A->in[12];
    const float* w_in = (const float*)(L == 0 ? A->in[13] : L == 1 ? A->in[16] : L == 2 ? A->in[23] : A->in[25]);
    const int nin = (L == 0 ? 6672 : L == 1 ? 1600 : L == 2 ? 18944 : 4688);
    const int I_GU = 32 * 88, I_D = 88 * 32, I_IN = 32 * ((nin + 63) / 64), I_OUT = 40 * 32, I_UQ = (L == 1) ? 8 * 48 : 0;
    TrDesc d; d.f8 = 0; d.tiled = 0; int r = it;
    if (r < 4 * I_GU) { const int s = r / I_GU; r -= s * I_GU; const int f = s >> 1, up = s & 1;
        d.W = (up ? w_up : w_gate) + (size_t)(L * 2 + f) * DM * DFF; d.K = DM; d.N = DFF; d.gain = ffn_norm + (size_t)(L * 2 + f) * DM; d.WT = WB + (f ? WB_GU1 : WB_GU0); d.ldt = DM; d.kind = up ? 2 : 1; d.f8 = F8FFNL(L, f); }
    else { r -= 4 * I_GU;
        if (r < 2 * I_D) { const int f = r / I_D; r -= f * I_D; d.W = w_down + (size_t)(L * 2 + f) * DFF * DM; d.K = DFF; d.N = DM; d.gain = nullptr; d.WT = WB + (f ? WB_D1 : WB_D0); d.ldt = DFF; d.kind = 0; d.tiled = 1; d.f8 = F8FFNDL(L, f); }
        else { r -= 2 * I_D;
            if (r < I_IN) { d.W = w_in; d.K = DM; d.N = nin; d.gain = attn_norm + (size_t)L * DM; d.WT = WB + WB_IN; d.ldt = DM; d.kind = 3 + L; d.f8 = F8LAYER(L) ? 1 : 0; }
            else { r -= I_IN;
                if (r < I_OUT) { d.W = w_out + (size_t)L * OUTIN * DM; d.K = OUTIN; d.N = DM; d.gain = nullptr; d.WT = WB + WB_OUT; d.ldt = OUTIN; d.kind = 0;
                    d.f8 = F8OUTL(L);
                }
                else { r -= I_OUT;
                    if (r < I_UQ) { d.W = (const float*)A->in[18]; d.K = 512; d.N = 3072; d.gain = (const float*)A->in[17]; d.WT = WB + WB_UQ; d.ldt = 512; d.kind = 0; }
                    else { r -= I_UQ; d.W = (const float*)A->in[20]; d.K = 512; d.N = 4096; d.gain = (const float*)A->in[19]; d.WT = WB + WB_UKV; d.ldt = 512; d.kind = 0; } } } } }
    d.r = r; return d;
}
__device__ __forceinline__ void convert_layer(const Fr& F, ArgsPc A, int L, bf16_t* WB) {
    const int nin = (L == 0 ? 6672 : L == 1 ? 1600 : L == 2 ? 18944 : 4688);
    const int total = 4 * 32 * 88 + 2 * 88 * 32 + 32 * ((nin + 63) / 64) + 40 * 32 + ((L == 1) ? 8 * 48 + 8 * 64 : 0);
    LAS float* scr = (LAS float*)(F.lds + F.wave * 16640);
    f32x4 va[16], vb[16]; int it = F.gw;
    if (it >= total) return;
    TrDesc da = tr_desc(A, L, WB, it), db = da; tr_load(da, F.lane, va);
    for (;;) {
        const bool nb_ = it + F.ngw < total; if (nb_) { db = tr_desc(A, L, WB, it + F.ngw); tr_load(db, F.lane, vb); }
        tr_store(da, F.lane, va, scr); it += F.ngw; if (!nb_) break;
        const bool na_ = it + F.ngw < total; if (na_) { da = tr_desc(A, L, WB, it + F.ngw); tr_load(da, F.lane, va); }
        tr_store(db, F.lane, vb, scr); it += F.ngw; if (!na_) break;
    }
}

#define MIXP(off_) (o8_ ? (bf16_t*)((unsigned char*)MIX + (off_)) : MIX + (off_))
__device__ __forceinline__ void mem_attn_units(const Fr& F, const bf16_t* P, long ldp, int memq_col, const bf16_t* MEMKV, bf16_t* MIX, int o8_) {
    for (int i = blockIdx.x; i < 512; i += F.G) {
        const int b = i >> 6, mh = (i >> 4) & 3, qb = i & 15; const size_t tok = (size_t)b * SEQ + qb * 256;
        att::AP a{}; a.Q = P + tok * ldp + memq_col + mh * 128; a.qs = ldp; a.K = MEMKV + (size_t)b * NMEM * 4096 + mh * 128; a.ks = 4096; a.V = a.K + 512; a.vs = 4096;
        a.O = MIXP(tok * OUTIN + 2048 + mh * 128); a.o8 = o8_; a.os = OUTIN; a.kt0 = 0; a.nt = 4; a.q0 = 0; a.C = 0.08838834764831845f * LOG2E;
        att::attn_unit<att::K_MEM, 128>(F.lds, a, F.wave);
    }
}
__device__ __forceinline__ void causal_unit_ids(int i, int& b, int& h, int& qb) {
    const int slot = i >> 8, c = i & 255, bh = (c >> 4) * 8 + (c & 7), half = (c >> 3) & 1;
    qb = half ? ((slot & 1) ? slot : 14 - slot) : ((slot & 1) ? slot - 1 : 15 - slot); b = bh >> 4; h = bh & 15;
}

__device__ __forceinline__ Fr mk_frame(unsigned char* lds_raw, int wave_id) {
    Fr F; F.lds = (LAS unsigned char*)lds_raw; F.tid = tid_opaque(wave_id); F.lane = F.tid & 63; F.wave = __builtin_amdgcn_readfirstlane(F.tid >> 6);
    F.G = gridDim.x; { const int bx = blockIdx.x; F.vcu = (F.G % 8 == 0) ? (bx % 8) * (F.G / 8) + bx / 8 : bx; }
    F.gw = F.vcu * 8 + F.wave; F.ngw = F.G * 8; return F;
}
typedef const __attribute__((address_space(4))) Args* ArgsP;
__device__ __forceinline__ ArgsP args_ptr() { auto p = __builtin_amdgcn_kernarg_segment_ptr(); asm volatile("" : "+s"(p)); return (ArgsP)p; }
#define WSP(T, off) ((T*)(AP_->ws + (off)))
#define SCRP(T, mib) ((T*)(AP_->ws + WS_SCR + (size_t)(mib) * MiB))

__global__ void __launch_bounds__(512, 2) fwd(Args A) {
    extern __shared__ __attribute__((aligned(16))) unsigned char lds_raw[];
    { LAS unsigned* z = (LAS unsigned*)((LAS unsigned char*)lds_raw + RING_BYTES); for (int u = threadIdx.x; u < (LDS_BYTES - RING_BYTES) / 4; u += 512) z[u] = 0u; }
    __syncthreads();
    const int lo = A.ph_lo, hi = A.ph_hi; const int wave_id = __builtin_amdgcn_readfirstlane((int)threadIdx.x >> 6);
    XcdBarrier bar; bar.bar = (unsigned*)(A.ws + WS_CTL) + CW_BAR; bar.x = 0; bar.st = nullptr;
    if (hi - lo > 1) bar = xcd_barrier_post((unsigned*)(A.ws + WS_CTL) + CW_BAR, (volatile LAS unsigned*)((LAS unsigned char*)lds_raw + MISC_OFF) + 8);
    int ph = 0;
#ifdef TMASK
    unsigned long long tacc_ = 0ull, tb_ = 0ull;
#define PH_BEGIN if (ph >= lo && ph < hi) { if ((TMASK >> ph) & 1ull) tb_ = __builtin_amdgcn_s_memrealtime(); const Fr F = mk_frame(lds_raw, wave_id); const ArgsP AP_ = args_ptr();
#define PH_END   if (ph + 1 < hi) xcd_barrier(bar); if ((TMASK >> ph) & 1ull) tacc_ += __builtin_amdgcn_s_memrealtime() - tb_; } ++ph;
#else
#define PH_BEGIN if (ph >= lo && ph < hi) { const Fr F = mk_frame(lds_raw, wave_id); const ArgsP AP_ = args_ptr();
#define PH_END   if (ph + 1 < hi) xcd_barrier(bar); } ++ph;
#endif
    const float SC128 = 0.08838834764831845f * LOG2E, SC192 = 0.07216878364870323f * LOG2E;

    PH_BEGIN
        rows2048(F, (const float*)AP_->in[1], NB * NMEM, WSP(bf16_t, WS_MEMB), WSP(float, WS_RSMEM), 1);
        rope_table(F, (const int*)AP_->in[2], WSP(float, WS_COS), WSP(float, WS_SIN));
        rows2048(F, (const float*)AP_->in[0], MTOK, WSP(bf16_t, WS_XB), WSP(u64, WS_SSQ), 0);
#ifdef RZ
        { u32x4* z = WSP(u32x4, WS_END); for (size_t i = (size_t)F.vcu * 512 + F.tid; i < (size_t)2 * DFF * DM * 2 / 16; i += (size_t)F.G * 512) z[i] = (u32x4){0u, 0u, 0u, 0u}; }
#endif
        { LAS float* scr = (LAS float*)(F.lds + F.wave * 16640);
          for (int it = F.gw; it < 4 * 512; it += F.ngw) { const int Lm = it >> 9; TrDesc d; d.W = (const float*)AP_->in[10] + (size_t)Lm * DM * 1024; d.K = DM; d.N = 1024; d.gain = (const float*)AP_->in[9] + (size_t)Lm * DM;
              d.WT = SCRP(bf16_t, 0) + (size_t)Lm * 1024 * DM; d.ldt = DM; d.kind = 0; d.f8 = 0; d.tiled = 0; d.r = it & 511; f32x4 v[16]; tr_load(d, F.lane, v); tr_store(d, F.lane, v, scr); } }
    PH_END
    PH_BEGIN { pg8::Gemm g{WSP(bf16_t, WS_MEMB), SCRP(bf16_t, 0), NB * NMEM, 4096, DM, DM, DM, 0}; pg8::StaticOrder S; S.init(g.M, g.N, F.G, (int)blockIdx.x);
        pg8::EpiProj E{WSP(bf16_t, WS_MEMKV), 4096, WSP(float, WS_RSMEM), 0, nullptr, -1, (const float*)AP_->in[11] + 128, 0, 0, nullptr, 0, 0, nullptr, 0, 0, 1.0f, 4, 2, 256}; pg8::gemm_phase(F.lds, g, S, E, F.tid); } PH_END

    int ver = 0;
#pragma clang loop unroll(full)
    for (int hl = 0; hl < 8; ++hl) {
        const int L = hl >> 1, f = hl & 1;
        if (f == 0) {
            PH_BEGIN REP(RCV) convert_layer(F, AP_, L, WSP(bf16_t, WS_WB)); PH_END

        }
        PH_BEGIN
#ifdef RZ
            { pg8::Gemm g{WSP(bf16_t, WS_XB), WSP(bf16_t, WS_END), MTOK, 2 * DFF, DM, DM, DM, 0}; pg8::StaticOrder S; S.init(g.M, g.N, F.G, (int)blockIdx.x);
              pg8::EpiSwiGLU E{SCRP(bf16_t, 0), DFF, WSP(u64, WS_SSQ) + (size_t)ver * MTOK, 1.0f, 0}; pg8::gemm_phase(F.lds, g, S, E, F.tid); }
#endif
            REP(RG) { const bool f8_ = F8FFNL(L, f);
            pg8::Gemm g = f8_ ? pg8::Gemm{WSP(bf16_t, WS_XB8), WSP(bf16_t, WS_WB) + (f ? WB_GU1 : WB_GU0), MTOK, 2 * DFF, DM / 2, DM / 2, DM / 2, 0}
                              : pg8::Gemm{WSP(bf16_t, WS_XB), WSP(bf16_t, WS_WB) + (f ? WB_GU1 : WB_GU0), MTOK, 2 * DFF, DM, DM, DM, 0}; pg8::StaticOrder S; S.init(g.M, g.N, F.G, (int)blockIdx.x);
            pg8::EpiSwiGLU E{SCRP(bf16_t, 0), DFF, WSP(u64, WS_SSQ) + (size_t)ver * MTOK, f8_ ? (1.0f / 64.0f) : 1.0f, F8FFNDL(L, f)};
            if (f8_) pg8::gemm_phase<F8MODE>(F.lds, g, S, E, F.tid); else pg8::gemm_phase<0>(F.lds, g, S, E, F.tid); } PH_END
        if (F8FFNDL(L, f)) { PH_BEGIN { pg8::Gemm g{SCRP(bf16_t, 0), WSP(bf16_t, WS_WB) + (f ? WB_D1 : WB_D0), MTOK, DM, DFF / 2, DFF / 2, DFF / 2, 1, 1};   pg8::StaticOrder S; S.init(g.M, g.N, F.G, (int)blockIdx.x);
            pg8::EpiResid E{ver == 0 ? (const float*)AP_->in[0] : AP_->out, AP_->out, WSP(bf16_t, WS_XB), WSP(u64, WS_SSQ) + (size_t)(ver + 1) * MTOK, nullptr, 0.5f / 512.0f}; pg8::gemm_phase<F8MODE>(F.lds, g, S, E, F.tid); } PH_END }
        else { PH_BEGIN { pg8::Gemm g{SCRP(bf16_t, 0), WSP(bf16_t, WS_WB) + (f ? WB_D1 : WB_D0), MTOK, DM, DFF, DFF, DFF, 1, 1}; pg8::StaticOrder S; S.init(g.M, g.N, F.G, (int)blockIdx.x);
            if (RD > 1) { pg8::EpiResid E0{ver == 0 ? (const float*)AP_->in[0] : AP_->out, SCRP(float, 400), SCRP(bf16_t, 660), nullptr, nullptr, 0.5f};
#ifdef PROBE_PM
                pg8::Gemm g0 = g; g0.pm_and = PROBE_PM; pg8::gemm_phase(F.lds, g0, S, E0, F.tid);
#else
                pg8::gemm_phase(F.lds, g, S, E0, F.tid);
#endif
            }
            pg8::EpiResid E{ver == 0 ? (const float*)AP_->in[0] : AP_->out, AP_->out, WSP(bf16_t, WS_XB), WSP(u64, WS_SSQ) + (size_t)(ver + 1) * MTOK, ((f == 0 && F8LAYER(L)) || (f == 1 && L < 3 && F8FFNL(L + 1, 0))) ? WSP(unsigned char, WS_XB8) : nullptr, 0.5f}; pg8::gemm_phase(F.lds, g, S, E, F.tid); } PH_END }
        ++ver;
        if (f != 0) continue;
        const int ngrp = (L == 2) ? 3 : 1;
#pragma clang loop unroll(full)
        for (int g = 0; g < ngrp; ++g) {
            PH_BEGIN REP(RI) { const int ldp = (L == 0) ? 6912 : (L == 1) ? 1792 : (L == 2) ? 6656 : 4864;
                const int nproj = (L == 2) ? (g == 0 ? 6656 : 6144) : ldp; const size_t roff = (L == 2) ? (g == 0 ? 0 : (g == 1 ? 6656 : 12800)) : 0;
                pg8::Gemm gm = F8LAYER(L) ? pg8::Gemm{WSP(bf16_t, WS_XB8), (const bf16_t*)((const unsigned char*)(WSP(bf16_t, WS_WB) + WB_IN) + roff * DM), MTOK, nproj, DM / 2, DM / 2, DM / 2, 0}
                                       : pg8::Gemm{WSP(bf16_t, WS_XB), WSP(bf16_t, WS_WB) + WB_IN + roff * DM, MTOK, nproj, DM, DM, DM, 0};
                pg8::StaticOrder S; S.init(gm.M, gm.N, F.G, (int)blockIdx.x);
                const float* gmq = (const float*)AP_->in[11] + (size_t)L * 256;
                const float* qg = (L == 0) ? (const float*)AP_->in[15] : (L == 2) ? (const float*)AP_->in[24] + (size_t)g * 256 : (L == 3) ? (const float*)AP_->in[26] : nullptr;
                const int kt_hi = (L == 3) ? 10 : 16, mq_lo = (L == 0 || L == 2) ? 24 : (L == 1) ? 5 : 17, mq_hi = (L == 2 && g > 0) ? mq_lo : mq_lo + 2;
                pg8::EpiProj E{SCRP(bf16_t, 0), ldp, WSP(u64, WS_SSQ) + (size_t)ver * MTOK, 1, (L == 0) ? SCRP(float, 432) : nullptr, 26,
                               qg, 0, (L == 1) ? 0 : 8, qg ? qg + 128 : nullptr, 8, (L == 1) ? 8 : kt_hi, gmq, mq_lo, mq_hi, F8LAYER(L) ? (1.0f / 64.0f) : 1.0f, 0, 0, 0}; if (F8LAYER(L)) pg8::gemm_phase<F8MODE>(F.lds, gm, S, E, F.tid); else pg8::gemm_phase<0>(F.lds, gm, S, E, F.tid); } PH_END
            if (L == 0) { PH_BEGIN fox_cumsum(F, SCRP(const float, 432), (const float*)AP_->in[14], SCRP(float, 434)); PH_END }
            if (L == 1) { PH_BEGIN mla_prep_a(F, SCRP(bf16_t, 0), WSP(float, WS_RSQ), WSP(float, WS_RSKV), SCRP(bf16_t, 752), (const float*)AP_->in[22] + 64, nullptr, WSP(float, WS_COS), WSP(float, WS_SIN)); PH_END }
            if (L == 1) {
                PH_BEGIN
                    REP(RI) for (int i = 0; i < 2; ++i) { pg8::Gemm gm{SCRP(bf16_t, 0) + (i ? 512 : 0), WSP(bf16_t, WS_WB) + (i ? WB_UKV : WB_UQ), MTOK, i ? 4096 : 3072, 512, 1792, 512, 0}; pg8::StaticOrder S; S.init(gm.M, gm.N, F.G, (int)blockIdx.x);
                        pg8::EpiProj E{i ? SCRP(bf16_t, 304) : SCRP(bf16_t, 112), i ? 4096 : 3072, i ? WSP(float, WS_RSKV) : WSP(float, WS_RSQ), 0, nullptr, -1, nullptr, 0, 0, nullptr, 0, 0, nullptr, 0, 0, 1.0f, 0, 0, 0}; pg8::gemm_phase(F.lds, gm, S, E, F.tid); }
                PH_END
                PH_BEGIN mla_prep_b(F, SCRP(bf16_t, 112), SCRP(const bf16_t, 304), SCRP(bf16_t, 560), SCRP(const bf16_t, 752), (const float*)AP_->in[21], (const float*)AP_->in[22], WSP(float, WS_COS), WSP(float, WS_SIN)); PH_END
            }
            if (L == 3) {
                PH_BEGIN REP(RIX) dsa_indexer(F, SCRP(const bf16_t, 0), SCRP(float, 304)); PH_END
                PH_BEGIN REP(RSL) dsa_select(F, SCRP(const float, 304), SCRP(u64, 816)); PH_END
            }
            PH_BEGIN
                bf16_t* P = SCRP(bf16_t, 0); bf16_t* MIX = WSP(bf16_t, WS_MIX); const int o8_ = F8OUTL(L);
                const long ldp = (L == 0) ? 6912 : (L == 1) ? 1792 : (L == 2) ? 6656 : 4864;
                REP(L == 2 ? 1 : RA) {
                if (L == 0) {
                    const float* CUM = SCRP(const float, 434);
                    for (int i = blockIdx.x; i < 2048; i += F.G) { int b, h, qb; causal_unit_ids(i, b, h, qb); const size_t t0 = (size_t)b * SEQ;
                        att::AP a{}; a.Q = P + (t0 + qb * 256) * ldp + h * 128; a.qs = ldp; a.K = P + t0 * ldp + 2048 + h * 128; a.ks = ldp; a.V = a.K + 2048; a.vs = ldp;
                        a.O = MIXP((t0 + qb * 256) * OUTIN + h * 128); a.o8 = o8_; a.os = OUTIN; a.kt0 = 0; a.nt = 4 * (qb + 1); a.q0 = qb * 256; a.C = SC128; a.cum = CUM + t0 * 16 + h; a.cums = 16;
                        att::attn_unit<att::K_FOX, 128>(F.lds, a, F.wave); }
                }
                if (L == 1) {
                    const bf16_t* Qb = SCRP(const bf16_t, 112); const bf16_t* KVb = SCRP(const bf16_t, 304); const bf16_t* KF = SCRP(const bf16_t, 560);
                    for (int i = blockIdx.x; i < 2048; i += F.G) { int b, h, qb; causal_unit_ids(i, b, h, qb); const size_t t0 = (size_t)b * SEQ;
                        att::AP a{}; a.Q = Qb + (t0 + qb * 256) * 3072 + h * 192; a.qs = 3072; a.K = KF + t0 * 3072 + h * 192; a.ks = 3072; a.V = KVb + t0 * 4096 + h * 256 + 128; a.vs = 4096;
                        a.O = MIXP((t0 + qb * 256) * OUTIN + h * 128); a.o8 = o8_; a.os = OUTIN; a.kt0 = 0; a.nt = 4 * (qb + 1); a.q0 = qb * 256; a.C = SC192;
                        att::attn_unit<att::K_MLA, 192>(F.lds, a, F.wave); }
                }
                if (L == 2) {
                    const int dil = (g == 0) ? 1 : (g == 1 ? 4 : 16), nblk = 16 / dil; float* OST = SCRP(float, 416); float* ML = SCRP(float, 672);
                    for (int i = blockIdx.x; i < 2048; i += F.G) { const int h = i & 15, rest = i >> 4, b = rest >> 4, rj = rest & 15, r = rj / nblk, jb = rj % nblk;
                        const size_t tokz = (size_t)b * SEQ + r, tokq = tokz + (size_t)jb * 256 * dil;
                        att::AP a{}; a.Q = P + tokq * ldp + h * 128; a.qs = (long)dil * ldp; a.K = P + tokz * ldp + 2048 + h * 128; a.ks = (long)dil * ldp; a.V = a.K + 2048; a.vs = a.ks;
                        a.O = MIXP(tokq * OUTIN + h * 128); a.o8 = o8_; a.os = (long)dil * OUTIN; a.q0 = jb * 256; a.kt0 = jb == 0 ? 0 : 4 * jb - 2; a.nt = jb == 0 ? 4 : 6; a.C = SC128;
                        a.ost = OST + tokq * 1024 + h * 64; a.osts = (long)dil * 1024; a.mst = ML + (tokq * 16 + h) * 2; a.msts = (long)dil * 32; a.carry_in = g > 0; a.carry_out = g < 2;
                        a.t5 = (const float*)AP_->in[3]; a.head = h; a.dil = dil;
                        att::attn_unit<att::K_DIL, 128>(F.lds, a, F.wave); }
                }
                if (L == 3) {
                    const u64* MSK = SCRP(const u64, 816);
                    for (int i = blockIdx.x; i < 2048; i += F.G) { int b, h, qb; causal_unit_ids(i, b, h, qb); const size_t t0 = (size_t)b * SEQ;
                        att::AP a{}; a.Q = P + (t0 + qb * 256) * ldp + h * 128; a.qs = ldp; a.K = P + t0 * ldp + 2048 + (h >> 2) * 128; a.ks = ldp; a.V = a.K + 512; a.vs = ldp;
                        a.O = MIXP((t0 + qb * 256) * OUTIN + h * 128); a.o8 = o8_; a.os = OUTIN; a.kt0 = 0; a.nt = 4 * (qb + 1); a.q0 = qb * 256; a.C = SC128; a.msk = MSK + (t0 + qb * 256) * 64; a.t5 = (const float*)AP_->in[3]; a.head = h;
                        att::attn_unit<att::K_DSA, 128>(F.lds, a, F.wave); }
                }
                if (g == 0) { const int memq_col = (L == 0) ? 6144 : (L == 1) ? 1280 : (L == 2) ? 6144 : 4352; mem_attn_units(F, P, ldp, memq_col, WSP(const bf16_t, WS_MEMKV) + L * 1024, MIX, o8_); }
                }
            PH_END
        }
        if (F8OUTL(L)) { PH_BEGIN { pg8::Gemm gm{WSP(bf16_t, WS_MIX), WSP(bf16_t, WS_WB) + WB_OUT, MTOK, DM, OUTIN / 2, OUTIN / 2, OUTIN / 2, 0};   pg8::StaticOrder S; S.init(gm.M, gm.N, F.G, (int)blockIdx.x);
            pg8::EpiResid E{AP_->out, AP_->out, WSP(bf16_t, WS_XB), WSP(u64, WS_SSQ) + (size_t)(ver + 1) * MTOK, F8FFNL(L, 1) ? WSP(unsigned char, WS_XB8) : nullptr, 1.0f / 1024.0f}; pg8::gemm_phase<F8MODE>(F.lds, gm, S, E, F.tid); } PH_END }
        else { PH_BEGIN { pg8::Gemm gm{WSP(bf16_t, WS_MIX), WSP(bf16_t, WS_WB) + WB_OUT, MTOK, DM, OUTIN, OUTIN, OUTIN, 0}; pg8::StaticOrder S; S.init(gm.M, gm.N, F.G, (int)blockIdx.x);
            if (RD > 1) { pg8::EpiResid E0{AP_->out, SCRP(float, 400), SCRP(bf16_t, 660), nullptr, nullptr, 1.0f}; pg8::gemm_phase(F.lds, gm, S, E0, F.tid); }
            pg8::EpiResid E{AP_->out, AP_->out, WSP(bf16_t, WS_XB), WSP(u64, WS_SSQ) + (size_t)(ver + 1) * MTOK, F8FFNL(L, 1) ? WSP(unsigned char, WS_XB8) : nullptr, 1.0f}; pg8::gemm_phase(F.lds, gm, S, E, F.tid); } PH_END }
        ++ver;
    }
#ifdef TMASK
    if (blockIdx.x == 0) { const unsigned long long t0_ = __builtin_amdgcn_s_memrealtime(); while (__builtin_amdgcn_s_memrealtime() - t0_ < tacc_ * (unsigned long long)TMUL) __builtin_amdgcn_s_sleep(8); }
#endif
#undef PH_BEGIN
#undef PH_END
}

#ifndef MK_ONE_LAUNCH
#define MK_ONE_LAUNCH 0
#endif
extern "C" void kernel_launch(void* const* d_in, const int* in_sizes, int n_in, void* d_out, int out_size, void* d_ws, size_t ws_size, hipStream_t stream) {
    static int grid = 0;
    if (grid == 0) {
        if (n_in != 27 || in_sizes[0] != MTOK * DM || out_size != MTOK * DM || ws_size < WS_END) {
            fprintf(stderr, "kernel_launch: unexpected shapes: n_in %d in0 %d out %d ws %zu (need >= %zu); nothing launched\n", n_in, n_in > 0 ? in_sizes[0] : -1, out_size, ws_size, (size_t)WS_END); grid = -1; return; }
        int dev = 0, cus = 0, per_cu = 0;
        if (hipGetDevice(&dev) != hipSuccess || hipDeviceGetAttribute(&cus, hipDeviceAttributeMultiprocessorCount, dev) != hipSuccess) { fprintf(stderr, "kernel_launch: device query failed\n"); grid = -1; return; }
        if (hipFuncSetAttribute((const void*)fwd, hipFuncAttributeMaxDynamicSharedMemorySize, LDS_BYTES) != hipSuccess) { fprintf(stderr, "kernel_launch: hipFuncSetAttribute failed\n"); grid = -1; return; }
        if (hipOccupancyMaxActiveBlocksPerMultiprocessor(&per_cu, (const void*)fwd, 512, LDS_BYTES) != hipSuccess || per_cu < 1)
            fprintf(stderr, "kernel_launch: note: occupancy query reports %d workgroups per CU\n", per_cu);
        (void)hipGetLastError();
        grid = cus;
    }
    if (grid < 0) return;
    if (hipMemsetAsync((char*)d_ws + WS_CTL, 0, CTL_ZERO_BYTES, stream) != hipSuccess) { fprintf(stderr, "kernel_launch: memset failed\n"); return; }
    Args a{};
    for (int i = 0; i < 27; ++i) a.in[i] = d_in[i];
    a.out = (float*)d_out; a.ws = (unsigned char*)d_ws;
#if MK_ONE_LAUNCH
    a.ph_lo = 0; a.ph_hi = NPHASES;
    hipLaunchKernelGGL(fwd, dim3(grid), dim3(512), LDS_BYTES, stream, a);
#else
#ifndef NPH_LIMIT
#define NPH_LIMIT NPHASES
#endif
    for (int p = 0; p < NPH_LIMIT; ++p) { a.ph_lo = p; a.ph_hi = p + 1; hipLaunchKernelGGL(fwd, dim3(grid), dim3(512), LDS_BYTES, stream, a); }
#endif
    const hipError_t le = hipPeekAtLastError();
    if (le != hipSuccess) fprintf(stderr, "kernel_launch: launch failed: %s\n", hipGetErrorName(le));
}
```
